# Optimizing an MI355X kernel written in HIP

```python
import jax
import jax.numpy as jnp
from jax import lax
import numpy as np

D_MODEL = 1024
BATCH = 4
SEQ = 8192
DEPTH = 2

D_MIX = D_MODEL
D_FF = 4 * D_MODEL
NORM_EPS = 1e-5
SHORT_CONV = 4

ATT_HEAD_DIM = 64
ATT_Q_HEADS = (D_MIX // 2) // ATT_HEAD_DIM
ATT_KV_HEADS = ATT_Q_HEADS // 4
ATT_WINDOW = 128
ROPE_THETA = 500000.0
ROPE_DIM = ATT_HEAD_DIM // 4

ML_HEADS = 4
ML_V_DIM = (D_MIX // 2) // ML_HEADS
ML_QK_DIM = ML_V_DIM // 2
ML_CHUNK = 128
ML_NORM_EPS = 1e-6

SSM_HEAD_DIM = 64
SSM_HEADS = (D_MIX // 2) // SSM_HEAD_DIM
SSM_GROUPS = 2
SSM_STATE = 128
SSM_CHUNK = 128

RW_HEAD_DIM = 64
RW_HEADS = (D_MIX // 2) // RW_HEAD_DIM
RW_DECAY_LORA = 64
RW_AAA_LORA = 64
RW_GATE_LORA = 128
RW_LN_EPS = 64e-5

N_EVEN = (DEPTH + 1) // 2
N_ODD = DEPTH // 2

ATT_Q_W = ATT_Q_HEADS * ATT_HEAD_DIM
ATT_KV_W = ATT_KV_HEADS * ATT_HEAD_DIM
ML_QK_W = ML_HEADS * ML_QK_DIM
ML_V_W = ML_HEADS * ML_V_DIM
EVEN_IN = ATT_Q_W + 2 * ATT_KV_W + 2 * ML_QK_W + 2 * ML_V_W + 2 * ML_HEADS
EVEN_OUT = ATT_Q_W + ML_V_W

SSM_INNER = SSM_HEADS * SSM_HEAD_DIM
SSM_BC = SSM_GROUPS * SSM_STATE
SSM_CONV_W = SSM_INNER + 2 * SSM_BC
RW_W = RW_HEADS * RW_HEAD_DIM
RW_IN = 3 * RW_W + RW_DECAY_LORA + RW_AAA_LORA + RW_GATE_LORA
ODD_IN = SSM_INNER + SSM_CONV_W + SSM_HEADS + RW_IN
ODD_OUT = SSM_INNER + RW_W

F32 = jnp.float32

kernel_name = 'hybrid_swa_mlstm_ssd_rwkv7_trunk'


def rmsnorm(x, g):
    xf = x.astype(F32)
    y = xf * lax.rsqrt(jnp.mean(xf * xf, axis=-1, keepdims=True) + NORM_EPS)
    return (y * g.astype(F32)).astype(x.dtype)


def group_rmsnorm(x, g, groups):
    shp = x.shape
    xf = x.astype(F32).reshape(shp[:-1] + (groups, shp[-1] // groups))
    y = xf * lax.rsqrt(jnp.mean(xf * xf, axis=-1, keepdims=True) + NORM_EPS)
    return y.reshape(shp) * g.astype(F32)


def head_layernorm(x, eps):
    xf = x.astype(F32)
    mu = jnp.mean(xf, axis=-1, keepdims=True)
    var = jnp.mean(jnp.square(xf - mu), axis=-1, keepdims=True)
    return (xf - mu) * lax.rsqrt(var + eps)


def split_cols(p, sizes):
    idx = np.cumsum(np.array(sizes))[:-1].tolist()
    return jnp.split(p, idx, axis=-1)


def causal_conv(x, w, b):
    K = w.shape[0]
    T = x.shape[1]
    xp = jnp.pad(x, ((0, 0), (K - 1, 0), (0, 0)))
    out = b
    for tap in range(K):
        out = out + xp[:, tap:tap + T, :] * w[tap]
    return out


def token_shift(x):
    return jnp.pad(x, ((0, 0), (1, 0), (0, 0)))[:, :-1, :]


def partial_rope(x):
    T = x.shape[1]
    half = ROPE_DIM // 2
    inv_freq = ROPE_THETA ** (-jnp.arange(half, dtype=F32) * 2.0 / ROPE_DIM)
    ang = jnp.arange(T, dtype=F32)[:, None] * inv_freq[None, :]
    cos = jnp.cos(ang)[None, :, None, :]
    sin = jnp.sin(ang)[None, :, None, :]
    xf = x.astype(F32)
    x1 = xf[..., :half]
    x2 = xf[..., half:ROPE_DIM]
    rot = jnp.concatenate([x1 * cos - x2 * sin, x2 * cos + x1 * sin, xf[..., ROPE_DIM:]], axis=-1)
    return rot.astype(x.dtype)


def sliding_window_sink_attention(q, k, v, sinks):
    bsz, T, hq, dh = q.shape
    hkv = k.shape[2]
    grp = hq // hkv
    W = ATT_WINDOW
    nb = T // W
    qb = q.reshape(bsz, nb, W, hkv, grp, dh)

    def band(t):
        tp = jnp.pad(t, ((0, 0), (W, 0), (0, 0), (0, 0)))
        prev = tp[:, :T].reshape(bsz, nb, W, hkv, dh)
        cur = t.reshape(bsz, nb, W, hkv, dh)
        return jnp.concatenate([prev, cur], axis=2)

    kb = band(k)
    vb = band(v)
    s = jnp.einsum('bnqhgd,bnkhd->bhgnqk', qb, kb).astype(F32) * (dh ** -0.5)
    i = jnp.arange(W)[:, None]
    j = jnp.arange(2 * W)[None, :]
    blk = jnp.arange(nb)[:, None, None]
    mask = (j > i) & (j <= i + W) & (blk * W - W + j >= 0)
    s = jnp.where(mask, s, -jnp.inf)
    sink = sinks.astype(F32).reshape(hkv, grp, 1, 1, 1)
    m = jnp.maximum(jnp.max(s, axis=-1, keepdims=True), sink)
    p = jnp.exp(s - m)
    p = p / (jnp.sum(p, axis=-1, keepdims=True) + jnp.exp(sink - m))
    o = jnp.einsum('bhgnqk,bnkhd->bnqhgd', p.astype(v.dtype), vb)
    return o.reshape(bsz, T, hq * dh)


def mlstm_chunkwise(q, k, v, log_i, log_f):
    bsz, T, H, dk = q.shape
    dv = v.shape[-1]
    L = ML_CHUNK
    nc = T // L
    qc = q.astype(F32).reshape(bsz, nc, L, H, dk)
    kc = k.astype(F32).reshape(bsz, nc, L, H, dk) * (dk ** -0.5)
    vc = v.astype(F32).reshape(bsz, nc, L, H, dv)
    li = log_i.reshape(bsz, nc, L, H)
    b = jnp.cumsum(log_f.reshape(bsz, nc, L, H), axis=2)
    causal = jnp.tril(jnp.ones((L, L), dtype=bool))
    dlog = b[:, :, :, None, :] - b[:, :, None, :, :] + li[:, :, None, :, :]
    dlog = jnp.where(causal[None, None, :, :, None], dlog, -jnp.inf)
    bL = b[:, :, -1, :]
    a = bL[:, :, None, :] - b + li
    m_loc = jnp.max(a, axis=2)
    wgt = jnp.exp(a - m_loc[:, :, None, :])
    C_loc = jnp.einsum('bnlh,bnlhk,bnlhv->bnhkv', wgt, kc, vc)
    n_loc = jnp.einsum('bnlh,bnlhk->bnhk', wgt, kc)

    def step(carry, inp):
        C, n, m = carry
        Cl, nl, ml, gl = inp
        m_new = jnp.maximum(gl + m, ml)
        fa = jnp.exp(gl + m - m_new)
        fb = jnp.exp(ml - m_new)
        C_new = fa[..., None, None] * C + fb[..., None, None] * Cl
        n_new = fa[..., None] * n + fb[..., None] * nl
        return (C_new, n_new, m_new), (C, n, m)

    init = (jnp.zeros((bsz, H, dk, dv), F32), jnp.zeros((bsz, H, dk), F32), jnp.zeros((bsz, H), F32))
    xs = (jnp.moveaxis(C_loc, 1, 0), jnp.moveaxis(n_loc, 1, 0), jnp.moveaxis(m_loc, 1, 0), jnp.moveaxis(bL, 1, 0))
    _, (C_prev, n_prev, m_prev) = lax.scan(step, init, xs)
    C_prev = jnp.moveaxis(C_prev, 0, 1)
    n_prev = jnp.moveaxis(n_prev, 0, 1)
    m_prev = jnp.moveaxis(m_prev, 0, 1)
    inter_log = b + m_prev[:, :, None, :]
    m_t = jnp.maximum(inter_log, jnp.max(dlog, axis=3))
    w_intra = jnp.exp(dlog - m_t[:, :, :, None, :])
    w_inter = jnp.exp(inter_log - m_t)
    qk = jnp.einsum('bnthd,bnshd->bntsh', qc, kc) * w_intra
    num = jnp.einsum('bntsh,bnshv->bnthv', qk, vc) + w_inter[..., None] * jnp.einsum('bnthk,bnhkv->bnthv', qc, C_prev)
    den = jnp.sum(qk, axis=3) + w_inter * jnp.einsum('bnthk,bnhk->bnth', qc, n_prev)
    h = num / jnp.maximum(jnp.abs(den), jnp.exp(-m_t))[..., None]
    return h.reshape(bsz, T, H, dv)


def ssd_chunked(x, dt, A, Bm, Cm):
    bsz, T, H, P = x.shape
    G = Bm.shape[2]
    N = Bm.shape[-1]
    hg = H // G
    L = SSM_CHUNK
    nc = T // L
    xc = (x.astype(F32) * dt[..., None]).reshape(bsz, nc, L, G, hg, P)
    a_cum = jnp.cumsum((dt * A.astype(F32)).reshape(bsz, nc, L, G, hg), axis=2)
    Bc = Bm.astype(F32).reshape(bsz, nc, L, G, N)
    Cc = Cm.astype(F32).reshape(bsz, nc, L, G, N)
    causal = jnp.tril(jnp.ones((L, L), dtype=bool))[:, :, None, None]
    seg = a_cum[:, :, :, None] - a_cum[:, :, None, :]
    decay = jnp.exp(jnp.where(causal, seg, -jnp.inf))
    cb = jnp.einsum('bctgn,bcsgn->bctsg', Cc, Bc)
    y_diag = jnp.einsum('bctsgh,bcsghp->bctghp', cb[..., None] * decay, xc)
    decay_s = jnp.exp(a_cum[:, :, -1:] - a_cum)
    states = jnp.einsum('bclgn,bclgh,bclghp->bcghpn', Bc, decay_s, xc)
    chunk_decay = jnp.exp(a_cum[:, :, -1])

    def step(S, inp):
        st, dec = inp
        return S * dec[..., None, None] + st, S

    S0 = jnp.zeros((bsz, G, hg, P, N), F32)
    _, S_prev = lax.scan(step, S0, (jnp.moveaxis(states, 1, 0), jnp.moveaxis(chunk_decay, 1, 0)))
    S_prev = jnp.moveaxis(S_prev, 0, 1)
    y_off = jnp.einsum('bctgn,bcghpn->bctghp', Cc, S_prev) * jnp.exp(a_cum)[..., None]
    return (y_diag + y_off).reshape(bsz, T, H, P)


def rwkv7_scan(r, w, k, v, kk, kka):
    bsz, T, H, dh = r.shape

    def step(S, inp):
        r_t, w_t, k_t, v_t, kk_t, b_t = inp
        sa = jnp.einsum('bhvk,bhk->bhv', S, kk_t)
        S = S * w_t[:, :, None, :] - sa[..., None] * b_t[:, :, None, :] + v_t[..., None] * k_t[:, :, None, :]
        return S, jnp.einsum('bhvk,bhk->bhv', S, r_t)

    xs = (jnp.moveaxis(r, 1, 0), jnp.moveaxis(w, 1, 0), jnp.moveaxis(k, 1, 0), jnp.moveaxis(v, 1, 0), jnp.moveaxis(kk, 1, 0), jnp.moveaxis(kka, 1, 0))
    S0 = jnp.zeros((bsz, H, dh, dh), F32)
    _, y = lax.scan(step, S0, xs)
    return jnp.moveaxis(y, 0, 1)


def even_mixer(h, w_in, w_out, sinks, conv_w, conv_b, i_bias, f_bias, ml_norm):
    bsz, T, _ = h.shape
    p = h @ w_in
    q_a, k_a, v_a, qk_m, v_m, o_m, i_m, f_m = split_cols(p, (ATT_Q_W, ATT_KV_W, ATT_KV_W, 2 * ML_QK_W, ML_V_W, ML_V_W, ML_HEADS, ML_HEADS))
    q = partial_rope(q_a.reshape(bsz, T, ATT_Q_HEADS, ATT_HEAD_DIM))
    k = partial_rope(k_a.reshape(bsz, T, ATT_KV_HEADS, ATT_HEAD_DIM))
    v = v_a.reshape(bsz, T, ATT_KV_HEADS, ATT_HEAD_DIM)
    y_att = sliding_window_sink_attention(q, k, v, sinks)
    qk = jax.nn.silu(causal_conv(qk_m, conv_w, conv_b))
    q_m, k_m = jnp.split(qk, 2, axis=-1)
    log_f = jax.nn.log_sigmoid(f_m.astype(F32) + f_bias.astype(F32))
    log_i = i_m.astype(F32) + i_bias.astype(F32)
    hm = mlstm_chunkwise(q_m.reshape(bsz, T, ML_HEADS, ML_QK_DIM), k_m.reshape(bsz, T, ML_HEADS, ML_QK_DIM), v_m.reshape(bsz, T, ML_HEADS, ML_V_DIM), log_i, log_f)
    hm = head_layernorm(hm, ML_NORM_EPS).reshape(bsz, T, ML_V_W) * ml_norm.astype(F32)
    y_ml = (hm * jax.nn.sigmoid(o_m.astype(F32))).astype(h.dtype)
    return jnp.concatenate([y_att, y_ml], axis=-1) @ w_out


def odd_mixer(h, w_in, w_out, ssm_conv_w, ssm_conv_b, ssm_dt_bias, ssm_a_log, ssm_d, ssm_norm,
              rw_mu, rw_w0, rw_w2, rw_a0, rw_a2, rw_g2, rw_k_k, rw_k_a, rw_r_k, rw_ln_w, rw_ln_b):
    bsz, T, _ = h.shape
    p = h @ w_in
    z, xbc, dt_raw, rw = split_cols(p, (SSM_INNER, SSM_CONV_W, SSM_HEADS, RW_IN))
    xbc = jax.nn.silu(causal_conv(xbc, ssm_conv_w, ssm_conv_b))
    xs, Bm, Cm = split_cols(xbc, (SSM_INNER, SSM_BC, SSM_BC))
    dt = jax.nn.softplus(dt_raw.astype(F32) + ssm_dt_bias.astype(F32))
    A = -jnp.exp(ssm_a_log.astype(F32))
    xh = xs.reshape(bsz, T, SSM_HEADS, SSM_HEAD_DIM)
    y = ssd_chunked(xh, dt, A, Bm.reshape(bsz, T, SSM_GROUPS, SSM_STATE), Cm.reshape(bsz, T, SSM_GROUPS, SSM_STATE))
    y = y + ssm_d.astype(F32)[None, None, :, None] * xh.astype(F32)
    y = y.reshape(bsz, T, SSM_INNER) * jax.nn.silu(z.astype(F32))
    y_ssm = group_rmsnorm(y, ssm_norm, SSM_GROUPS).astype(h.dtype)
    rw = rw + (token_shift(rw) - rw) * rw_mu
    r, k, v, wd, ad, gd = split_cols(rw, (RW_W, RW_W, RW_W, RW_DECAY_LORA, RW_AAA_LORA, RW_GATE_LORA))
    w_log = -jax.nn.softplus(-(rw_w0 + jnp.tanh(wd) @ rw_w2).astype(F32)) - 0.5
    decay = jnp.exp(-jnp.exp(w_log))
    a = jax.nn.sigmoid((rw_a0 + ad @ rw_a2).astype(F32))
    g = (jax.nn.sigmoid(gd) @ rw_g2).astype(F32)
    hd = (bsz, T, RW_HEADS, RW_HEAD_DIM)
    rh = r.astype(F32).reshape(hd)
    kh = k.astype(F32).reshape(hd)
    vh = v.astype(F32).reshape(hd)
    ah = a.reshape(hd)
    kk = kh * rw_k_k.astype(F32).reshape(RW_HEADS, RW_HEAD_DIM)
    kk = kk / jnp.maximum(jnp.sqrt(jnp.sum(kk * kk, axis=-1, keepdims=True)), 1e-12)
    kh = kh * (1.0 + (ah - 1.0) * rw_k_a.astype(F32).reshape(RW_HEADS, RW_HEAD_DIM))
    yr = rwkv7_scan(rh, decay.reshape(hd), kh, vh, kk, kk * ah)
    yr = head_layernorm(yr, RW_LN_EPS).reshape(bsz, T, RW_W) * rw_ln_w.astype(F32) + rw_ln_b.astype(F32)
    bonus = (jnp.sum(rh * kh * rw_r_k.astype(F32), axis=-1, keepdims=True) * vh).reshape(bsz, T, RW_W)
    y_rw = ((yr + bonus) * g).astype(h.dtype)
    return jnp.concatenate([y_ssm, y_rw], axis=-1) @ w_out


def squared_relu_mlp(h, w_up, w_down):
    return jnp.square(jax.nn.relu(h @ w_up)) @ w_down


def setup_inputs(seed: int = 0) -> dict:
    key = jax.random.key(seed)
    keys = iter(jax.random.split(key, 48))

    def normal(shape, scale):
        return jax.random.normal(next(keys), shape, F32) * scale

    def gain(shape):
        return 1.0 + normal(shape, 0.05)

    def unif(shape, lo, hi):
        return jax.random.uniform(next(keys), shape, F32, lo, hi)

    E, O, L = N_EVEN, N_ODD, DEPTH
    x = normal((BATCH, SEQ, D_MODEL), 1.0)
    mix_norm = gain((L, D_MODEL))
    mlp_norm = gain((L, D_MODEL))
    w_up = normal((L, D_MODEL, D_FF), D_MODEL ** -0.5)
    w_down = normal((L, D_FF, D_MODEL), D_FF ** -0.5)
    e_w_in = normal((E, D_MODEL, EVEN_IN), D_MODEL ** -0.5)
    e_w_out = normal((E, EVEN_OUT, D_MODEL), EVEN_OUT ** -0.5)
    att_sinks = normal((E, ATT_Q_HEADS), 1.0)
    ml_conv_w = normal((E, SHORT_CONV, 2 * ML_QK_W), SHORT_CONV ** -0.5)
    ml_conv_b = normal((E, 2 * ML_QK_W), 0.02)
    ml_i_bias = normal((E, ML_HEADS), 0.1)
    ml_f_bias = jnp.linspace(3.0, 6.0, ML_HEADS)[None, :] + normal((E, ML_HEADS), 0.1)
    ml_norm = gain((E, ML_V_W))
    o_w_in = normal((O, D_MODEL, ODD_IN), D_MODEL ** -0.5)
    o_w_out = normal((O, ODD_OUT, D_MODEL), ODD_OUT ** -0.5)
    ssm_conv_w = normal((O, SHORT_CONV, SSM_CONV_W), SHORT_CONV ** -0.5)
    ssm_conv_b = normal((O, SSM_CONV_W), 0.02)
    dt0 = jnp.exp(unif((O, SSM_HEADS), float(np.log(1e-3)), float(np.log(1e-1))))
    ssm_dt_bias = dt0 + jnp.log(-jnp.expm1(-dt0))
    ssm_a_log = jnp.log(unif((O, SSM_HEADS), 1.0, 16.0))
    ssm_d = gain((O, SSM_HEADS))
    ssm_norm = gain((O, SSM_INNER))
    rw_mu = unif((O, RW_IN), 0.0, 1.0)
    rw_w0 = jnp.tile(jnp.linspace(-6.0, -0.5, RW_HEAD_DIM), RW_HEADS)[None, :] + normal((O, RW_W), 0.1)
    rw_w2 = normal((O, RW_DECAY_LORA, RW_W), 0.1)
    rw_a0 = normal((O, RW_W), 0.1)
    rw_a2 = normal((O, RW_AAA_LORA, RW_W), 0.1)
    rw_g2 = normal((O, RW_GATE_LORA, RW_W), RW_GATE_LORA ** -0.5)
    rw_k_k = 0.85 + normal((O, RW_W), 0.05)
    rw_k_a = gain((O, RW_W))
    rw_r_k = normal((O, RW_HEADS, RW_HEAD_DIM), 0.1)
    rw_ln_w = gain((O, RW_W))
    rw_ln_b = normal((O, RW_W), 0.02)
    final_norm = gain((D_MODEL,))
    return {'x': x, 'mix_norm': mix_norm, 'mlp_norm': mlp_norm, 'w_up': w_up, 'w_down': w_down,
            'e_w_in': e_w_in, 'e_w_out': e_w_out, 'att_sinks': att_sinks, 'ml_conv_w': ml_conv_w,
            'ml_conv_b': ml_conv_b, 'ml_i_bias': ml_i_bias, 'ml_f_bias': ml_f_bias, 'ml_norm': ml_norm,
            'o_w_in': o_w_in, 'o_w_out': o_w_out, 'ssm_conv_w': ssm_conv_w, 'ssm_conv_b': ssm_conv_b,
            'ssm_dt_bias': ssm_dt_bias, 'ssm_a_log': ssm_a_log, 'ssm_d': ssm_d, 'ssm_norm': ssm_norm,
            'rw_mu': rw_mu, 'rw_w0': rw_w0, 'rw_w2': rw_w2, 'rw_a0': rw_a0, 'rw_a2': rw_a2, 'rw_g2': rw_g2,
            'rw_k_k': rw_k_k, 'rw_k_a': rw_k_a, 'rw_r_k': rw_r_k, 'rw_ln_w': rw_ln_w, 'rw_ln_b': rw_ln_b,
            'final_norm': final_norm}


def reference(x, mix_norm, mlp_norm, w_up, w_down, e_w_in, e_w_out, att_sinks, ml_conv_w, ml_conv_b,
              ml_i_bias, ml_f_bias, ml_norm, o_w_in, o_w_out, ssm_conv_w, ssm_conv_b, ssm_dt_bias,
              ssm_a_log, ssm_d, ssm_norm, rw_mu, rw_w0, rw_w2, rw_a0, rw_a2, rw_g2, rw_k_k, rw_k_a,
              rw_r_k, rw_ln_w, rw_ln_b, final_norm):
    h = x
    for layer in range(DEPTH):
        hn = rmsnorm(h, mix_norm[layer])
        if layer % 2 == 0:
            e = layer // 2
            h = h + even_mixer(hn, e_w_in[e], e_w_out[e], att_sinks[e], ml_conv_w[e], ml_conv_b[e],
                               ml_i_bias[e], ml_f_bias[e], ml_norm[e])
        else:
            o = layer // 2
            h = h + odd_mixer(hn, o_w_in[o], o_w_out[o], ssm_conv_w[o], ssm_conv_b[o], ssm_dt_bias[o],
                              ssm_a_log[o], ssm_d[o], ssm_norm[o], rw_mu[o], rw_w0[o], rw_w2[o],
                              rw_a0[o], rw_a2[o], rw_g2[o], rw_k_k[o], rw_k_a[o], rw_r_k[o],
                              rw_ln_w[o], rw_ln_b[o])
        h = h + squared_relu_mlp(rmsnorm(h, mlp_norm[layer]), w_up[layer], w_down[layer])
    return rmsnorm(h, final_norm)
```

```cpp
#include <hip/hip_runtime.h>
#include <cstdio>
#include <cstdint>
namespace pg8 {
#define PG8_LAS __attribute__((address_space(3)))
typedef unsigned short bf16_t;
typedef short bf16x8 __attribute__((ext_vector_type(8)));
typedef float f32x4 __attribute__((ext_vector_type(4)));
typedef unsigned u32x4 __attribute__((ext_vector_type(4)));
constexpr int BM = 256, BK = 64, HALF = 128, HTB = HALF * BK * 2  , STAGE_BYTES = 8 * HTB, NXCD = 8, WGM = 8;

__host__ __device__ __forceinline__ int lds_byte(int r, int c) { const int st = (r >> 4) * 2 + (c >> 5), rr = r & 15, cc = c & 31, ob = rr * 64 + cc * 2; return st * 1024 + (ob ^ (((ob >> 9) & 1) << 5)); }
__host__ __device__ __forceinline__ void stage_rc(int b, int& R, int& C) { const int st = b / 1024, sb = b % 1024, swz = sb ^ (((sb >> 9) & 1) << 5); R = (st >> 1) * 16 + swz / 64; C = (st & 1) * 32 + (swz % 64) / 2; }
__host__ __device__ __forceinline__ int perm32(int rho) { const int n = rho >> 4, i = rho & 15; return 8 * (i >> 2) + 4 * n + (i & 3); }

struct Unit { int pm, pn; };
struct Gemm { const bf16_t* A; const bf16_t* Bt; int M, N, K; };

struct StaticOrder {
    int nM, nN, nwg, G, c;
    __host__ __device__ void init(int M, int N, int G_, int c_) { nM = M / BM; nN = N / BM; nwg = nM * nN; G = G_; c = c_; }
    __host__ __device__ bool next(int i, Unit& u) const {
        const long L = (long)i * G + c; if (L >= nwg) return false;
        int wgid = (int)L; { const int q = nwg / NXCD, r = nwg % NXCD, xcd = wgid % NXCD, off = wgid / NXCD; wgid = (xcd < r ? xcd * (q + 1) : r * (q + 1) + (xcd - r) * q) + off; }
        const int nig = WGM * nN, gid = wgid / nig, fm = gid * WGM, gsz = (nM - fm) < WGM ? (nM - fm) : WGM;
        u.pm = fm + ((wgid % nig) % gsz); u.pn = (wgid % nig) / gsz; return true;
    }
    __device__ __forceinline__ void a_ready(const Unit&) const {}
    __device__ __forceinline__ void done(const Unit&) const {}
};

__device__ __forceinline__ unsigned cvt_pk_bf16(float lo, float hi) { unsigned r; asm volatile("v_cvt_pk_bf16_f32 %0, %1, %2" : "=v"(r) : "v"(lo), "v"(hi)); return r; }
template <int ACT> struct EpiBf16 {
    static constexpr bool PERM = true, AFTER_DRAIN = false;
    bf16_t* O; int ldc;
    __device__ __forceinline__ void operator()(const f32x4 (&acc)[2][2][4][2], const Unit& u, int wr, int wc, int fr, int fq) const {
        const int row0 = u.pm * BM + wr * 64 + fr; const int col0 = u.pn * BM + wc * 32 + 8 * fq;
#pragma unroll
        for (int ai = 0; ai < 2; ++ai)
#pragma unroll
            for (int m = 0; m < 4; ++m) { bf16_t* rowp = O + (size_t)(row0 + ai * HALF + m * 16) * ldc + col0;
#pragma unroll
                for (int bj = 0; bj < 2; ++bj) { f32x4 v0 = acc[ai][bj][m][0], v1 = acc[ai][bj][m][1];
                    if (ACT == 2) {
#pragma unroll
                        for (int j = 0; j < 4; ++j) { const float a0 = v0[j] > 0.f ? v0[j] : 0.f, a1 = v1[j] > 0.f ? v1[j] : 0.f; v0[j] = a0 * a0; v1[j] = a1 * a1; } }
                    u32x4 w; w.x = cvt_pk_bf16(v0[0], v0[1]); w.y = cvt_pk_bf16(v0[2], v0[3]); w.z = cvt_pk_bf16(v1[0], v1[1]); w.w = cvt_pk_bf16(v1[2], v1[3]);
                    *(u32x4*)(rowp + bj * HALF) = w; } }
    }
};
struct EpiF32Res {
    static constexpr bool PERM = false, AFTER_DRAIN = false;
    const float* base; float* out; int ldc;
    __device__ __forceinline__ void operator()(const f32x4 (&acc)[2][2][4][2], const Unit& u, int wr, int wc, int fr, int fq) const {
        const int row0 = u.pm * BM + wr * 64 + fr, col0 = u.pn * BM + wc * 32 + 4 * fq;
#pragma unroll
        for (int ai = 0; ai < 2; ++ai)
#pragma unroll
            for (int m = 0; m < 4; ++m) { const size_t off = (size_t)(row0 + ai * HALF + m * 16) * ldc + col0;
                f32x4 bs[2][2];
#pragma unroll
                for (int bj = 0; bj < 2; ++bj)
#pragma unroll
                    for (int n = 0; n < 2; ++n) bs[bj][n] = *(const f32x4*)(base + off + bj * HALF + n * 16);
#pragma unroll
                for (int bj = 0; bj < 2; ++bj)
#pragma unroll
                    for (int n = 0; n < 2; ++n) *(f32x4*)(out + off + bj * HALF + n * 16) = bs[bj][n] + acc[ai][bj][m][n];
                asm volatile("" ::: "memory"); }
    }
};
template <class Epi, class Sched, bool ALIGN_EPI = false, bool SP2 = false>
__device__ __forceinline__ void gemm_phase(PG8_LAS unsigned char* lds, const Gemm g, const Sched& S, const Epi& E) {
    const int tid = threadIdx.x, wid = __builtin_amdgcn_readfirstlane(tid >> 6), lane = tid & 63, wr = wid >> 2, wc = wid & 3, fr = lane & 15, fq = lane >> 4;
    const int K = g.K, nt = K / BK;
    unsigned voffA[2], voffB[2];
#pragma unroll
    for (int i = 0; i < 2; ++i) { int R, C; stage_rc(tid * 16 + i * 8192, R, C); const int Rb = Epi::PERM ? ((R & ~31) + perm32(R & 31)) : R;
        voffA[i] = (unsigned)(R * K + C) * 2u; voffB[i] = (unsigned)(Rb * K + C) * 2u; }
    const size_t kstep = (size_t)(BK * 2);
    const size_t hstep = (size_t)HALF * K * 2;
    const size_t tstep = 2 * hstep;
    const unsigned ldsw = (unsigned)wid * 1024u;
    const int aoff = lds_byte(wr * 64 + fr, fq * 8), boff = lds_byte(wc * 32 + fr, fq * 8);
#define PG8_SA(b, h) (((b) * 2 + (h)) * HTB)
#define PG8_SB(b, h) ((4 + (b) * 2 + (h)) * HTB)
#define PG8_STAGE(bufoff, gbase, voff) do { _Pragma("unroll") for (int _i = 0; _i < 2; ++_i) \
        __builtin_amdgcn_global_load_lds((const unsigned*)((const char*)(gbase) + (voff)[_i]), (PG8_LAS unsigned*)(lds + (bufoff) + ldsw + _i * 8192), 16, 0, 0); } while (0)
#define PG8_LDA(dst, b, h) do { _Pragma("unroll") for (int m = 0; m < 4; ++m) _Pragma("unroll") for (int k = 0; k < 2; ++k) dst[m][k] = *(const PG8_LAS bf16x8*)(lds + PG8_SA(b, h) + aoff + m * 2048 + k * 1024); } while (0)
#define PG8_LDB(dst, b, h) do { _Pragma("unroll") for (int n = 0; n < 2; ++n) _Pragma("unroll") for (int k = 0; k < 2; ++k) dst[n][k] = *(const PG8_LAS bf16x8*)(lds + PG8_SB(b, h) + boff + n * 2048 + k * 1024); } while (0)
#define PG8_MMA(ai, bj, At, Bt) do { __builtin_amdgcn_s_setprio(1); _Pragma("unroll") for (int m = 0; m < 4; ++m) _Pragma("unroll") for (int n = 0; n < 2; ++n) _Pragma("unroll") for (int k = 0; k < 2; ++k) \
        acc[ai][bj][m][n] = __builtin_amdgcn_mfma_f32_16x16x32_bf16(Bt[n][k], At[m][k], acc[ai][bj][m][n], 0, 0, 0); __builtin_amdgcn_s_setprio(0); } while (0)
#define PG8_WAIT_V(n) asm volatile("s_waitcnt vmcnt(" #n ")" ::: "memory")
#define PG8_WAIT_L(n) asm volatile("s_waitcnt lgkmcnt(" #n ")" ::: "memory")
#define PG8_BAR __builtin_amdgcn_s_barrier()
#define PG8_SCHED __builtin_amdgcn_sched_barrier(0)
    Unit cur, nxt; int ui = 0;
    if (!S.next(0, cur)) return;
    f32x4 acc[2][2][4][2];
#pragma unroll
    for (int a = 0; a < 2; ++a)
#pragma unroll
        for (int b = 0; b < 2; ++b)
#pragma unroll
            for (int m = 0; m < 4; ++m)
#pragma unroll
                for (int n = 0; n < 2; ++n) acc[a][b][m][n] = (f32x4){0.f, 0.f, 0.f, 0.f};
    bf16x8 At[4][2], B0[2][2], B1[2][2];
    const char* cA = (const char*)g.A + (size_t)cur.pm * tstep; const char* cB = (const char*)g.Bt + (size_t)cur.pn * tstep;
    S.a_ready(cur);
    if constexpr (SP2) {
        PG8_STAGE(PG8_SB(0, 0), cB, voffB); PG8_STAGE(PG8_SB(0, 1), cB + hstep, voffB); PG8_STAGE(PG8_SA(0, 0), cA, voffA); PG8_STAGE(PG8_SA(0, 1), cA + hstep, voffA);
        if (wr == 1) PG8_BAR;
        PG8_WAIT_V(2); PG8_BAR;
        PG8_STAGE(PG8_SB(1, 0), cB + kstep, voffB); PG8_STAGE(PG8_SA(1, 0), cA + kstep, voffA); PG8_STAGE(PG8_SB(1, 1), cB + hstep + kstep, voffB);
        PG8_WAIT_V(6); PG8_BAR;
    } else {
        PG8_STAGE(PG8_SB(0, 0), cB, voffB); PG8_STAGE(PG8_SA(0, 0), cA, voffA); PG8_STAGE(PG8_SB(0, 1), cB + hstep, voffB); PG8_STAGE(PG8_SA(0, 1), cA + hstep, voffA);
        if (wr == 1) PG8_BAR;
        PG8_WAIT_V(4); PG8_BAR;
        PG8_STAGE(PG8_SB(1, 0), cB + kstep, voffB); PG8_STAGE(PG8_SA(1, 0), cA + kstep, voffA); PG8_STAGE(PG8_SB(1, 1), cB + hstep + kstep, voffB);
        PG8_WAIT_V(6); PG8_BAR;
    }
    for (;;) {
        const bool has_next = S.next(ui + 1, nxt);
        const char* nA = has_next ? (const char*)g.A + (size_t)nxt.pm * tstep : cA; const char* nB = has_next ? (const char*)g.Bt + (size_t)nxt.pn * tstep : cB;
        for (int t = 0; t < nt; t += 2) {
            const bool last = (t == nt - 2);
            const char* a1 = cA + (size_t)(t + 1) * kstep;
            const char* a2 = last ? nA : cA + (size_t)(t + 2) * kstep; const char* b2 = last ? nB : cB + (size_t)(t + 2) * kstep;
            const char* a3 = a2 + kstep; const char* b3 = b2 + kstep;
            if (last && has_next) S.a_ready(nxt);
            if constexpr (SP2) {
            PG8_LDB(B0, 0, 0); PG8_LDB(B1, 0, 1); PG8_SCHED; PG8_LDA(At, 0, 0); PG8_STAGE(PG8_SA(1, 1), a1 + hstep, voffA);
            PG8_WAIT_V(8); PG8_WAIT_L(0); PG8_BAR; PG8_MMA(0, 0, At, B0); PG8_MMA(0, 1, At, B1); PG8_BAR; PG8_SCHED;
            PG8_LDA(At, 0, 1); PG8_STAGE(PG8_SB(0, 0), b2, voffB); PG8_STAGE(PG8_SB(0, 1), b2 + hstep, voffB); PG8_STAGE(PG8_SA(0, 0), a2, voffA);
            PG8_WAIT_V(8); PG8_WAIT_L(0); PG8_BAR; PG8_MMA(1, 0, At, B0); PG8_MMA(1, 1, At, B1); PG8_BAR; PG8_SCHED;
            PG8_LDB(B0, 1, 0); PG8_LDB(B1, 1, 1); PG8_SCHED; PG8_LDA(At, 1, 0); PG8_STAGE(PG8_SA(0, 1), a2 + hstep, voffA);
            PG8_WAIT_V(8); PG8_WAIT_L(0); PG8_BAR; PG8_MMA(0, 0, At, B0); PG8_MMA(0, 1, At, B1); PG8_BAR; PG8_SCHED;
            PG8_LDA(At, 1, 1); PG8_STAGE(PG8_SB(1, 0), b3, voffB); PG8_STAGE(PG8_SB(1, 1), b3 + hstep, voffB); PG8_STAGE(PG8_SA(1, 0), a3, voffA);
            PG8_WAIT_V(8); PG8_WAIT_L(0); PG8_BAR; PG8_MMA(1, 0, At, B0); PG8_MMA(1, 1, At, B1); PG8_BAR; PG8_SCHED;
            } else {
            PG8_LDB(B0, 0, 0); PG8_SCHED; PG8_LDA(At, 0, 0); PG8_STAGE(PG8_SA(1, 1), a1 + hstep, voffA);
            PG8_WAIT_L(8); PG8_BAR; PG8_WAIT_L(0); PG8_MMA(0, 0, At, B0); PG8_BAR; PG8_SCHED;
            PG8_LDB(B1, 0, 1); PG8_STAGE(PG8_SB(0, 0), b2, voffB);
            PG8_BAR; PG8_WAIT_L(0); PG8_MMA(0, 1, At, B1); PG8_BAR;
            PG8_LDA(At, 0, 1); PG8_STAGE(PG8_SA(0, 0), a2, voffA);
            PG8_BAR; PG8_WAIT_L(0); PG8_MMA(1, 0, At, B0); PG8_BAR; PG8_SCHED;
            PG8_STAGE(PG8_SB(0, 1), b2 + hstep, voffB);
            PG8_WAIT_V(6); PG8_BAR; PG8_MMA(1, 1, At, B1); PG8_BAR;
            PG8_LDB(B0, 1, 0); PG8_SCHED; PG8_LDA(At, 1, 0); PG8_STAGE(PG8_SA(0, 1), a2 + hstep, voffA);
            PG8_WAIT_L(8); PG8_BAR; PG8_WAIT_L(0); PG8_MMA(0, 0, At, B0); PG8_BAR; PG8_SCHED;
            PG8_LDB(B1, 1, 1); PG8_STAGE(PG8_SB(1, 0), b3, voffB);
            PG8_BAR; PG8_WAIT_L(0); PG8_MMA(0, 1, At, B1); PG8_BAR;
            PG8_LDA(At, 1, 1); PG8_STAGE(PG8_SA(1, 0), a3, voffA);
            PG8_BAR; PG8_WAIT_L(0); PG8_MMA(1, 0, At, B0); PG8_BAR; PG8_SCHED;
            PG8_STAGE(PG8_SB(1, 1), b3 + hstep, voffB);
            PG8_WAIT_V(6); PG8_BAR; PG8_MMA(1, 1, At, B1); PG8_BAR;
            }
        }
        if constexpr (ALIGN_EPI) { if (wr == 0) PG8_BAR; }
        if constexpr (!Epi::AFTER_DRAIN) { E(acc, cur, wr, wc, fr, fq); S.done(cur); }
        if (!has_next) break;
#pragma unroll
        for (int a = 0; a < 2; ++a)
#pragma unroll
            for (int b = 0; b < 2; ++b)
#pragma unroll
                for (int m = 0; m < 4; ++m)
#pragma unroll
                    for (int n = 0; n < 2; ++n) acc[a][b][m][n] = (f32x4){0.f, 0.f, 0.f, 0.f};
        cur = nxt; cA = nA; cB = nB; ++ui;
        if constexpr (ALIGN_EPI) { if (wr == 1) PG8_BAR; }
    }
    PG8_WAIT_V(0);
    if constexpr (!ALIGN_EPI) { if (wr == 0) PG8_BAR; }
    PG8_BAR;
    if constexpr (Epi::AFTER_DRAIN) { E.fused(acc, cur, wr, wc, fr, fq, lds, wid, lane); S.done(cur); }
#undef PG8_SA
#undef PG8_SB
#undef PG8_STAGE
#undef PG8_LDA
#undef PG8_LDB
#undef PG8_MMA
#undef PG8_WAIT_V
#undef PG8_WAIT_L
#undef PG8_BAR
#undef PG8_SCHED
}
}
#ifndef PG8_SP2
#define PG8_SP2 true
#endif
#ifndef PG8_ALIGN
#define PG8_ALIGN true
#endif
#ifndef MK_PER_PHASE
#define MK_PER_PHASE 0
#endif
constexpr int NWAVES = 8;
constexpr int NB = 4, T = 8192, D = 1024, M = NB * T, FF = 4096;
constexpr int NE = 2304;
constexpr int NO = 3328;
constexpr int N_PHASES = 19;
constexpr size_t MiB = 1u << 20;
constexpr size_t WS_CTL = 0, CTL_ZERO_BYTES = 64 * 1024;
constexpr size_t WS_ROPE = 1 * MiB, WS_LORA = 2 * MiB, WS_G0 = 3 * MiB, WS_DT = 4 * MiB, WS_MLS = 5 * MiB, WS_DEC = 6 * MiB;
constexpr size_t WS_WINE = 8 * MiB, WS_WOUTE = 13 * MiB, WS_WUP0 = 15 * MiB, WS_WDN0 = 23 * MiB, WS_WINO = 31 * MiB, WS_WOUTO = 38 * MiB, WS_WUP1 = 40 * MiB, WS_WDN1 = 48 * MiB;
constexpr size_t WS_XN = 56 * MiB;
constexpr size_t WS_R1 = 120 * MiB;
constexpr size_t WS_GF = WS_R1 + 208 * MiB;
constexpr size_t WS_Y = 376 * MiB;
constexpr size_t WS_HS = 440 * MiB;
constexpr size_t WS_END = 504 * MiB;
constexpr int CW_BAR = 1024;
constexpr int LDS_MAIN = 155648, LDSCTL_OFF = LDS_MAIN, LDS_BYTES = LDS_MAIN + 1024;

#define GAS __attribute__((address_space(1)))
#define LAS __attribute__((address_space(3)))
typedef unsigned short bf16;
typedef unsigned v4u __attribute__((ext_vector_type(4)));
typedef unsigned v2u __attribute__((ext_vector_type(2)));
typedef float f32x4 __attribute__((ext_vector_type(4)));
typedef short bf16x8 __attribute__((ext_vector_type(8)));
typedef GAS unsigned gu32;
#define RLX_AGENT __ATOMIC_RELAXED, __HIP_MEMORY_SCOPE_AGENT
#define LDS_WAIT() asm volatile("s_waitcnt lgkmcnt(0)" ::: "memory")
#define VM_WAIT() asm volatile("s_waitcnt vmcnt(0)" ::: "memory")
__device__ __forceinline__ unsigned f2bf(float f) { unsigned u = __builtin_bit_cast(unsigned, f); return (u + 0x7fffu + ((u >> 16) & 1u)) >> 16; }
typedef float f32x2_t __attribute__((ext_vector_type(2)));
typedef __bf16 bf16x2_t __attribute__((ext_vector_type(2)));
__device__ __forceinline__ unsigned pk2(float lo, float hi) { const f32x2_t v = {lo, hi}; const bf16x2_t b = __builtin_convertvector(v, bf16x2_t); return __builtin_bit_cast(unsigned, b); }
__device__ __forceinline__ float bflo(unsigned w) { return __builtin_bit_cast(float, w << 16); }
__device__ __forceinline__ float bfhi(unsigned w) { return __builtin_bit_cast(float, w & 0xffff0000u); }
__device__ __forceinline__ float bf1(bf16 v) { return __builtin_bit_cast(float, (unsigned)v << 16); }
__device__ __forceinline__ void unpack8(const v4u w, float (&x)[8]) { x[0] = bflo(w.x); x[1] = bfhi(w.x); x[2] = bflo(w.y); x[3] = bfhi(w.y); x[4] = bflo(w.z); x[5] = bfhi(w.z); x[6] = bflo(w.w); x[7] = bfhi(w.w); }
__device__ __forceinline__ v4u pack8(const float (&x)[8]) { v4u w; w.x = pk2(x[0], x[1]); w.y = pk2(x[2], x[3]); w.z = pk2(x[4], x[5]); w.w = pk2(x[6], x[7]); return w; }
__device__ __forceinline__ bf16x8 frag8(const f32x4 a, const f32x4 b) { v4u w; w.x = pk2(a[0], a[1]); w.y = pk2(a[2], a[3]); w.z = pk2(b[0], b[1]); w.w = pk2(b[2], b[3]); return __builtin_bit_cast(bf16x8, w); }
__device__ __forceinline__ bf16x8 frag2(const v2u lo, const v2u hi) { v4u w; w.x = lo.x; w.y = lo.y; w.z = hi.x; w.w = hi.y; return __builtin_bit_cast(bf16x8, w); }
__device__ __forceinline__ f32x4 mfma16(bf16x8 a, bf16x8 b, f32x4 c) { return __builtin_amdgcn_mfma_f32_16x16x32_bf16(a, b, c, 0, 0, 0); }
__device__ __forceinline__ float sigmoidf_(float x) { return 1.f / (1.f + __expf(-x)); }
__device__ __forceinline__ float siluf_(float x) { return x / (1.f + __expf(-x)); }
__device__ __forceinline__ float softplusf_(float x) { return fmaxf(x, 0.f) + log1pf(expf(-fabsf(x))); }
__device__ __forceinline__ float wave_sum(float v) {
#pragma unroll
    for (int o = 1; o < 64; o <<= 1) v += __shfl_xor(v, o);
    return v;
}
__device__ __forceinline__ float wave_max(float v) {
#pragma unroll
    for (int o = 1; o < 64; o <<= 1) v = fmaxf(v, __shfl_xor(v, o));
    return v;
}
__device__ __forceinline__ float quad_sum(float v) { v += __shfl_xor(v, 16); v += __shfl_xor(v, 32); return v; }
__device__ __forceinline__ float quad_max(float v) { v = fmaxf(v, __shfl_xor(v, 16)); v = fmaxf(v, __shfl_xor(v, 32)); return v; }
__device__ __forceinline__ float scan_add(float v, int lane) {
#pragma unroll
    for (int o = 1; o < 64; o <<= 1) { const float t = __shfl_up(v, o); if (lane >= o) v += t; }
    return v;
}
__device__ __forceinline__ float scan_max(float v, int lane) {
#pragma unroll
    for (int o = 1; o < 64; o <<= 1) { const float t = __shfl_up(v, o); if (lane >= o) v = fmaxf(v, t); }
    return v;
}
#define XB_TMO      128
#define XB_XCNT(j)  (256  + 64 * (j))
#define XB_XSUB(j)  (1280 + 64 * (j))
#define XB_XGEN(j)  (2304 + 64 * (j))
#define XB_TOP      3328
#define XB_TOPGEN   3392
#define XCD_BAR_WORDS 3456
#define XB_SPIN_CAP (1u << 18)

__device__ __forceinline__ unsigned xb_ld(unsigned* p)              { return __hip_atomic_load(p, __ATOMIC_RELAXED, __HIP_MEMORY_SCOPE_AGENT); }
__device__ __forceinline__ unsigned xb_add(unsigned* p, unsigned v) { return __hip_atomic_fetch_add(p, v, __ATOMIC_RELAXED, __HIP_MEMORY_SCOPE_AGENT); }
__device__ __forceinline__ unsigned xb_xcc_id() { return (unsigned)__builtin_amdgcn_s_getreg((3 << 11) | 20) & 0xFu; }
#define XB_SPIN(cond, bar) do { unsigned _sp = 0; while (cond) { __builtin_amdgcn_s_sleep(1); \
    if ((++_sp & 255u) == 0u) { if (xb_ld(&(bar)[XB_TMO])) break; if (_sp > XB_SPIN_CAP) { atomicAdd(&(bar)[XB_TMO], 1u); break; } } } } while (0)

struct XcdBarrier {
    unsigned* bar; unsigned x;
    volatile LAS unsigned* st;
};

__device__ __forceinline__ XcdBarrier xcd_barrier_post(unsigned* bar, volatile LAS unsigned* st) {
    XcdBarrier b; b.bar = bar; b.x = xb_xcc_id(); b.st = st;
    if (threadIdx.x == 0) (void)xb_add(&bar[XB_XCNT(b.x)], 1u);
    return b;
}
__device__ __forceinline__ void xcd_barrier_complete(unsigned* bar, unsigned x, unsigned& nloc, unsigned& nx) {
    const unsigned G = gridDim.x * gridDim.y * gridDim.z;
    unsigned sum, cnt, mine, sp = 0u;
    for (;;) {
        sum = 0u; cnt = 0u; mine = 0u;
#pragma unroll
        for (unsigned j = 0; j < 16; ++j) { const unsigned c = xb_ld(&bar[XB_XCNT(j)]); sum += c; cnt += (c > 0u) ? 1u : 0u; mine = (j == x) ? c : mine; }
        if (sum == G) break;
        __builtin_amdgcn_s_sleep(1);
        if ((++sp & 255u) == 0u) { if (xb_ld(&bar[XB_TMO])) break; if (sp > XB_SPIN_CAP) { atomicAdd(&bar[XB_TMO], 1u); break; } }
    }
    nloc = mine > 0u ? mine : 1u; nx = cnt > 0u ? cnt : 1u;
}

__device__ __forceinline__ void xcd_barrier(const XcdBarrier& b) {
    asm volatile("s_waitcnt vmcnt(0)" ::: "memory");
    __syncthreads();
    if (threadIdx.x == 0) {
        unsigned* bar = b.bar;
        __builtin_amdgcn_s_waitcnt(0);
        unsigned nloc = b.st[0], nx = b.st[1];
        if (nloc == 0u) { xcd_barrier_complete(bar, b.x, nloc, nx); b.st[0] = nloc; b.st[1] = nx; }
        const unsigned old = xb_add(&bar[XB_XSUB(b.x)], 1u);
        const unsigned gen = old / nloc;
        if (old + 1u == (gen + 1u) * nloc) {
            __builtin_amdgcn_fence(__ATOMIC_RELEASE, "agent");
            asm volatile("s_waitcnt vmcnt(0)" ::: "memory");
            const unsigned og = xb_add(&bar[XB_TOP], 1u);
            const unsigned tg = og / nx;
            if (og + 1u == (tg + 1u) * nx) xb_add(&bar[XB_TOPGEN], 1u);
            else XB_SPIN(xb_ld(&bar[XB_TOPGEN]) == tg, bar);
            __builtin_amdgcn_fence(__ATOMIC_ACQUIRE, "agent");
            xb_add(&bar[XB_XGEN(b.x)], 1u);
            asm volatile("s_waitcnt vmcnt(0)" ::: "memory");
        } else {
            XB_SPIN(xb_ld(&bar[XB_XGEN(b.x)]) == gen, bar);
            __builtin_amdgcn_fence(__ATOMIC_ACQUIRE, "agent");
            asm volatile("s_waitcnt vmcnt(0)" ::: "memory");
        }
    }
    __syncthreads();
}
__device__ __forceinline__ void p0_transpose_item(const float* W, int K, int ldw, int n_src0, bf16* WT, int row_dst0, int nblk, LAS float* scr, int item, int lane) {
    const int kb = item / nblk, nb = item % nblk, k0 = 64 * kb, n0 = 32 * nb;
#pragma unroll 8
    for (int i = 0; i < 32; ++i) { const int kk = 2 * i + (lane >> 5); scr[kk * 33 + (lane & 31)] = W[(size_t)(k0 + kk) * ldw + n_src0 + n0 + (lane & 31)]; }
    LDS_WAIT(); asm volatile("" ::: "memory");
    const int c = lane & 7;
#pragma unroll
    for (int j = 0; j < 4; ++j) { const int n = (lane >> 3) + 8 * j; const LAS float* s = scr + (8 * c) * 33 + n;
        v4u o; o.x = pk2(s[0 * 33], s[1 * 33]); o.y = pk2(s[2 * 33], s[3 * 33]); o.z = pk2(s[4 * 33], s[5 * 33]); o.w = pk2(s[6 * 33], s[7 * 33]);
        *(GAS v4u*)(WT + (size_t)(row_dst0 + n0 + n) * K + k0 + 8 * c) = o; }
    LDS_WAIT(); asm volatile("" ::: "memory");
}
struct TrJob { const float* W; int K, ldw, n_src0; bf16* WT; int row_dst0, nblk, nitems; };
__device__ __forceinline__ void p0_prologue(const float* const* in, unsigned char* ws, LAS unsigned char* lds, int tid, int G) {
    const int lane = tid & 63, wave = tid >> 6;
    LAS float* scr = (LAS float*)(lds + wave * 16384);
    const int gw = blockIdx.x * NWAVES + wave, NGW = G * NWAVES;
#define TRJ(Wp, K_, ldw_, s0_, dst_, r0_, ncols_) { int nblk_ = (ncols_) / 32; int ni_ = ((K_) / 64) * nblk_; if (it < ni_) { p0_transpose_item(Wp, K_, ldw_, s0_, (bf16*)(ws + dst_), r0_, nblk_, scr, it, lane); continue; } it -= ni_; }
    constexpr int NITEMS = 16 * 72 + 16 * 32 + 2 * 16 * 128 + 2 * 64 * 32 + 16 * 48 + 16 * 56 + 16 * 32;
    for (int it0 = gw; it0 < NITEMS; it0 += NGW) {
        int it = it0;
        TRJ(in[5], 1024, 2312, 0, WS_WINE, 0, 2304)
        TRJ(in[6], 1024, 1024, 0, WS_WOUTE, 0, 1024)
        TRJ(in[3], 1024, 4096, 0, WS_WUP0, 0, 4096)
        TRJ(in[3] + (size_t)1024 * 4096, 1024, 4096, 0, WS_WUP1, 0, 4096)
        TRJ(in[4], 4096, 1024, 0, WS_WDN0, 0, 1024)
        TRJ(in[4] + (size_t)4096 * 1024, 4096, 1024, 0, WS_WDN1, 0, 1024)
        TRJ(in[13], 1024, 3336, 0, WS_WINO, 0, 1536)
        TRJ(in[13], 1024, 3336, 1544, WS_WINO, 1536, 1792)
        TRJ(in[14], 1024, 1024, 0, WS_WOUTO, 0, 1024)
    }
#undef TRJ
    const int gt = blockIdx.x * 512 + tid, NGT = G * 512;
    bf16* w2t = (bf16*)(ws + WS_LORA); bf16* a2t = w2t + 512 * 64; bf16* g2t = a2t + 512 * 64;
    for (int i = gt; i < 512 * 64; i += NGT) { const int n = i >> 6, j = i & 63; w2t[i] = (bf16)f2bf(in[23][j * 512 + n]); a2t[i] = (bf16)f2bf(in[25][j * 512 + n]); }
    for (int i = gt; i < 512 * 128; i += NGT) { const int n = i >> 7, j = i & 127; g2t[i] = (bf16)f2bf(in[26][j * 512 + n]); }
    float2* rope = (float2*)(ws + WS_ROPE);
    for (int i = gt; i < T * 8; i += NGT) { const int t = i >> 3, d = i & 7; const float inv = powf(500000.0f, -(float)d * 0.125f); const float ang = (float)t * inv; rope[i] = make_float2(cosf(ang), sinf(ang)); }
}
template <int MODE>
__device__ __forceinline__ void norm_phase(const float* src, const float* gain, bf16* dst, float* dstf, const float* gw, int ldg, float* gout, LAS unsigned char* lds, int tid, int G) {
    const int lane = tid & 63, wave = tid >> 6;
    LAS float* Wg = (LAS float*)lds;
    if (MODE == 1) { for (int i = tid; i < 8192; i += 512) { const int k = i >> 3, j = i & 7; Wg[j * 1024 + k] = gw[(size_t)k * ldg + j]; } __syncthreads(); }
    f32x4 gv[4];
#pragma unroll
    for (int j = 0; j < 4; ++j) gv[j] = *(const f32x4*)(gain + 4 * lane + 256 * j);
    for (int m = blockIdx.x * NWAVES + wave; m < M; m += G * NWAVES) {
        const f32x4* xr = (const f32x4*)(src + (size_t)m * D) + lane;
        f32x4 v[4]; float s = 0.f;
#pragma unroll
        for (int j = 0; j < 4; ++j) { v[j] = xr[64 * j]; s += (v[j].x * v[j].x + v[j].y * v[j].y) + (v[j].z * v[j].z + v[j].w * v[j].w); }
        const float rs = 1.0f / sqrtf(wave_sum(s) * (1.f / D) + 1e-5f);
#pragma unroll
        for (int j = 0; j < 4; ++j) v[j] = v[j] * rs * gv[j];
        if (MODE == 2) {
            f32x4* o = (f32x4*)(dstf + (size_t)m * D) + lane;
#pragma unroll
            for (int j = 0; j < 4; ++j) o[64 * j] = v[j];
        } else {
            v2u* o = (v2u*)(dst + (size_t)m * D) + lane;
#pragma unroll
            for (int j = 0; j < 4; ++j) { v2u w; w.x = pk2(v[j].x, v[j].y); w.y = pk2(v[j].z, v[j].w); o[64 * j] = w; }
        }
        if (MODE == 1) {
            float g8[8];
#pragma unroll
            for (int q = 0; q < 8; ++q) { float a = 0.f;
#pragma unroll
                for (int j = 0; j < 4; ++j) { const f32x4 w = *(const LAS f32x4*)(Wg + q * 1024 + 4 * lane + 256 * j); a += (v[j].x * w.x + v[j].y * w.y) + (v[j].z * w.z + v[j].w * w.w); }
                g8[q] = wave_sum(a); }
            if (lane == 0) { f32x4* o = (f32x4*)(gout + (size_t)m * 8); o[0] = (f32x4){g8[0], g8[1], g8[2], g8[3]}; o[1] = (f32x4){g8[4], g8[5], g8[6], g8[7]}; }
        }
    }
}
__device__ __forceinline__ void attn_unit(int u, const bf16* P, const float2* rope, const float* sinks, bf16* Y, LAS unsigned char* lds, int tid) {
    const int lane = tid & 63, wave = __builtin_amdgcn_readfirstlane(tid >> 6), fr = lane & 15, fq = lane >> 4;
    const int blk = u & 63, kvh = (u >> 6) & 1, b = u >> 7;
    LAS bf16* Ks = (LAS bf16*)lds;
    LAS bf16* Vt = Ks + 256 * 72;
    const int tok0 = blk * 128 - 128;
    for (int it = tid; it < 2048; it += 512) {
        const int r = it >> 3, c = it & 7, t = tok0 + r;
        const bf16* src = P + (size_t)(b * T + (t < 0 ? 0 : t)) * NE;
        v4u vv = (v4u){0u, 0u, 0u, 0u};
        if (t >= 0) vv = *(const v4u*)(src + 640 + kvh * 64 + c * 8);
#pragma unroll
        for (int e = 0; e < 8; ++e) Vt[(c * 8 + e) * 264 + r] = (bf16)(vv[e >> 1] >> ((e & 1) * 16));
        if (c == 1) continue;
        v4u k0 = (v4u){0u, 0u, 0u, 0u}, k1 = k0;
        if (t >= 0) { k0 = *(const v4u*)(src + 512 + kvh * 64 + c * 8); if (c == 0) k1 = *(const v4u*)(src + 512 + kvh * 64 + 8); }
        if (c == 0) {
            float x1[8], x2[8], o1[8], o2[8]; unpack8(k0, x1); unpack8(k1, x2);
            const float2* cs = rope + (size_t)(t < 0 ? 0 : t) * 8;
#pragma unroll
            for (int e = 0; e < 8; ++e) { const float2 q = cs[e]; o1[e] = x1[e] * q.x - x2[e] * q.y; o2[e] = x2[e] * q.x + x1[e] * q.y; }
            *(LAS v4u*)(Ks + r * 72) = pack8(o1); *(LAS v4u*)(Ks + r * 72 + 8) = pack8(o2);
        } else *(LAS v4u*)(Ks + r * 72 + c * 8) = k0;
    }
    __syncthreads();
    const int g = wave >> 1, half = wave & 1, hq = kvh * 4 + g;
    const float sink = sinks[hq];
    for (int a = 0; a < 4; ++a) {
        const int ag = half * 4 + a, i = ag * 16 + fr, tq = blk * 128 + i;
        const bf16* qsrc = P + (size_t)(b * T + tq) * NE + hq * 64;
        float x0[8], x1v[8];
        { const v4u r0 = *(const v4u*)(qsrc + 8 * fq), r1 = *(const v4u*)(qsrc + 32 + 8 * fq); unpack8(r0, x0); unpack8(r1, x1v); }
        if (fq < 2) {
            float xp[8]; { const v4u rp = *(const v4u*)(qsrc + 8 * (fq ^ 1)); unpack8(rp, xp); }
            const float2* cs = rope + (size_t)tq * 8;
#pragma unroll
            for (int e = 0; e < 8; ++e) { const float2 q = cs[e]; x0[e] = (fq == 0) ? (x0[e] * q.x - xp[e] * q.y) : (x0[e] * q.x + xp[e] * q.y); }
        }
#pragma unroll
        for (int e = 0; e < 8; ++e) { x0[e] *= 0.125f; x1v[e] *= 0.125f; }
        bf16x8 qf[2]; qf[0] = __builtin_bit_cast(bf16x8, pack8(x0)); qf[1] = __builtin_bit_cast(bf16x8, pack8(x1v));
        const int kt0 = ag < 6 ? ag : 6;
        f32x4 sacc[10];
#pragma unroll
        for (int j = 0; j < 10; ++j) { f32x4 acc = (f32x4){0.f, 0.f, 0.f, 0.f};
#pragma unroll
            for (int s = 0; s < 2; ++s) { const bf16x8 A = *(const LAS bf16x8*)(Ks + (16 * (kt0 + j) + fr) * 72 + 32 * s + 8 * fq); acc = mfma16(A, qf[s], acc); }
            sacc[j] = acc; }
        float mx = sink;
#pragma unroll
        for (int j = 0; j < 10; ++j)
#pragma unroll
            for (int r = 0; r < 4; ++r) { const int key = 16 * (kt0 + j) + 4 * fq + r; const bool valid = (key > i) && (key <= i + 128) && (blk > 0 || key >= 128);
                sacc[j][r] = valid ? sacc[j][r] : -INFINITY; mx = fmaxf(mx, sacc[j][r]); }
        mx = quad_max(mx);
        float sum = 0.f;
#pragma unroll
        for (int j = 0; j < 10; ++j)
#pragma unroll
            for (int r = 0; r < 4; ++r) { const float p = __expf(sacc[j][r] - mx); sacc[j][r] = p; sum += p; }
        sum = quad_sum(sum) + __expf(sink - mx);
        f32x4 o[4];
#pragma unroll
        for (int dt = 0; dt < 4; ++dt) o[dt] = (f32x4){0.f, 0.f, 0.f, 0.f};
#pragma unroll
        for (int jp = 0; jp < 5; ++jp) { const bf16x8 Bf = frag8(sacc[2 * jp], sacc[2 * jp + 1]);
#pragma unroll
            for (int dt = 0; dt < 4; ++dt) { const LAS bf16* vp = Vt + (16 * dt + fr) * 264 + 16 * (kt0 + 2 * jp) + 4 * fq;
                const bf16x8 A = frag2(*(const LAS v2u*)vp, *(const LAS v2u*)(vp + 16)); o[dt] = mfma16(A, Bf, o[dt]); } }
        const float inv = 1.f / sum;
        bf16* yo = Y + (size_t)(b * T + tq) * D + hq * 64 + 4 * fq;
#pragma unroll
        for (int dt = 0; dt < 4; ++dt) { v2u w; w.x = pk2(o[dt][0] * inv, o[dt][1] * inv); w.y = pk2(o[dt][2] * inv, o[dt][3] * inv); *(v2u*)(yo + 16 * dt) = w; }
    }
    __syncthreads();
}
__device__ __forceinline__ void ml_conv8(const bf16* P, int b, int tt, int ch, const float* convw, const float* convb, float (&acc)[8]) {
    { const f32x4 b0 = *(const f32x4*)(convb + ch), b1 = *(const f32x4*)(convb + ch + 4); acc[0] = b0.x; acc[1] = b0.y; acc[2] = b0.z; acc[3] = b0.w; acc[4] = b1.x; acc[5] = b1.y; acc[6] = b1.z; acc[7] = b1.w; }
#pragma unroll
    for (int tap = 0; tap < 4; ++tap) { const int t2 = tt - 3 + tap;
        if (t2 >= 0) { float x[8]; unpack8(*(const v4u*)(P + (size_t)(b * T + t2) * NE + 768 + ch), x);
            const f32x4 w0 = *(const f32x4*)(convw + tap * 512 + ch), w1 = *(const f32x4*)(convw + tap * 512 + ch + 4);
            acc[0] += x[0] * w0.x; acc[1] += x[1] * w0.y; acc[2] += x[2] * w0.z; acc[3] += x[3] * w0.w; acc[4] += x[4] * w1.x; acc[5] += x[5] * w1.y; acc[6] += x[6] * w1.z; acc[7] += x[7] * w1.w; } }
#pragma unroll
    for (int e = 0; e < 8; ++e) acc[e] = siluf_(acc[e]);
}
__device__ __forceinline__ void ml_gates(const float* G0, size_t row0, int h, const float* ibias, const float* fbias, int lane, float& b0, float& b1, float& li0, float& li1, float& bL) {
    const float fb = fbias[h], ib = ibias[h];
    const float f0 = G0[(row0 + 2 * lane) * 8 + 4 + h] + fb, f1 = G0[(row0 + 2 * lane + 1) * 8 + 4 + h] + fb;
    li0 = G0[(row0 + 2 * lane) * 8 + h] + ib; li1 = G0[(row0 + 2 * lane + 1) * 8 + h] + ib;
    const float lf0 = -softplusf_(-f0), lf1 = -softplusf_(-f1);
    const float ps = scan_add(lf0 + lf1, lane);
    b1 = ps; b0 = ps - lf1; bL = __shfl(ps, 63);
}
__device__ __forceinline__ void mlstm_local_unit(int u, const bf16* P, const float* G0, const float* convw, const float* convb, const float* ibias, const float* fbias,
                                                 float* CT, float* NL, float* MLs, LAS unsigned char* lds, int tid) {
    const int lane = tid & 63, wave = __builtin_amdgcn_readfirstlane(tid >> 6), fr = lane & 15, fq = lane >> 4;
    const int c = u & 63, h = (u >> 6) & 3, b = u >> 8, bh = b * 4 + h;
    const size_t row0 = (size_t)b * T + c * 128;
    LAS bf16* kT = (LAS bf16*)lds;
    LAS bf16* vT = kT + 64 * 136;
    LAS float* wg = (LAS float*)(vT + 128 * 136);
    if (wave == 0) {
        float b0, b1, li0, li1, bL; ml_gates(G0, row0, h, ibias, fbias, lane, b0, b1, li0, li1, bL);
        const float a0 = bL - b0 + li0, a1 = bL - b1 + li1; const float ml = wave_max(fmaxf(a0, a1));
        wg[2 * lane] = expf(a0 - ml); wg[2 * lane + 1] = expf(a1 - ml);
        if (lane == 0) { MLs[(bh * 64 + c) * 2] = ml; MLs[(bh * 64 + c) * 2 + 1] = bL; }
    }
    __syncthreads();
    for (int it = tid; it < 1024; it += 512) { const int t = it >> 3, c8 = it & 7; float acc[8]; ml_conv8(P, b, c * 128 + t, 256 + h * 64 + c8 * 8, convw, convb, acc);
        const float sc = 0.125f * wg[t];
#pragma unroll
        for (int e = 0; e < 8; ++e) kT[(c8 * 8 + e) * 136 + t] = (bf16)f2bf(acc[e] * sc); }
    for (int it = tid; it < 2048; it += 512) { const int t = it >> 4, c8 = it & 15; const v4u vv = *(const v4u*)(P + (row0 + t) * NE + 1280 + h * 128 + c8 * 8);
#pragma unroll
        for (int e = 0; e < 8; ++e) vT[(c8 * 8 + e) * 136 + t] = (bf16)(vv[e >> 1] >> ((e & 1) * 16)); }
    __syncthreads();
    if (tid < 64) { float s = 0.f; for (int t = 0; t < 128; ++t) s += bf1(kT[tid * 136 + t]); NL[(size_t)(bh * 64 + c) * 64 + tid] = s; }
    f32x4 acc[4];
#pragma unroll
    for (int k = 0; k < 4; ++k) acc[k] = (f32x4){0.f, 0.f, 0.f, 0.f};
#pragma unroll
    for (int ks = 0; ks < 4; ++ks) { const bf16x8 A = *(const LAS bf16x8*)(vT + (16 * wave + fr) * 136 + 32 * ks + 8 * fq);
#pragma unroll
        for (int k = 0; k < 4; ++k) { const bf16x8 Bf = *(const LAS bf16x8*)(kT + (16 * k + fr) * 136 + 32 * ks + 8 * fq); acc[k] = mfma16(A, Bf, acc[k]); } }
    float* ct = CT + ((size_t)(bh * 64 + c) * 128 + 16 * wave + 4 * fq) * 64 + fr;
#pragma unroll
    for (int k = 0; k < 4; ++k)
#pragma unroll
        for (int r = 0; r < 4; ++r) ct[r * 64 + 16 * k] = acc[k][r];
    __syncthreads();
}
__device__ __forceinline__ void mlstm_scan_phase(float* CT, float* NL, const float* MLs, float* Mprev, int tid, int G) {
    for (int e = blockIdx.x * 512 + tid; e < 16 * 8192; e += G * 512) {
        const int bh = e >> 13, idx = e & 8191; float C = 0.f, n = 0.f, m = 0.f;
        float* cp = CT + (size_t)bh * 64 * 8192 + idx; float* np = NL + (size_t)bh * 64 * 64 + idx;
#pragma unroll 8
        for (int c = 0; c < 64; ++c) {
            const float ml = MLs[(bh * 64 + c) * 2], gl = MLs[(bh * 64 + c) * 2 + 1];
            const float mn = fmaxf(gl + m, ml), fa = expf(gl + m - mn), fb = expf(ml - mn);
            const float Cl = cp[(size_t)c * 8192]; cp[(size_t)c * 8192] = C; C = fa * C + fb * Cl;
            if (idx < 64) { const float nl = np[c * 64]; np[c * 64] = n; n = fa * n + fb * nl; }
            if (idx == 0) Mprev[bh * 64 + c] = m;
            m = mn; }
    }
}
__device__ __forceinline__ void mlstm_out_unit(int u, const bf16* P, const float* G0, const float* convw, const float* convb, const float* ibias, const float* fbias, const float* mlnorm,
                                               const float* CT, const float* NL, const float* Mprev, bf16* Y, LAS unsigned char* lds, int tid) {
    const int lane = tid & 63, wave = __builtin_amdgcn_readfirstlane(tid >> 6), fr = lane & 15, fq = lane >> 4;
    const int c = u & 63, h = (u >> 6) & 3, b = u >> 8, bh = b * 4 + h;
    const size_t row0 = (size_t)b * T + c * 128;
    LAS bf16* qs = (LAS bf16*)lds;
    LAS bf16* ks = qs + 128 * 72;
    LAS bf16* vT = ks + 128 * 72;
    LAS bf16* cts = vT + 128 * 136;
    LAS float* bc = (LAS float*)(cts + 128 * 72);
    LAS float* lis = bc + 128; LAS float* mxs = lis + 128; LAS float* npv = mxs + 128;
    if (wave == 0) {
        float b0, b1, li0, li1, bL; ml_gates(G0, row0, h, ibias, fbias, lane, b0, b1, li0, li1, bL);
        const float d0 = li0 - b0, d1 = li1 - b1; const float sm = scan_max(fmaxf(d0, d1), lane); float ex = __shfl_up(sm, 1); if (lane == 0) ex = -INFINITY;
        const float m0 = fmaxf(ex, d0);
        bc[2 * lane] = b0; bc[2 * lane + 1] = b1; lis[2 * lane] = li0; lis[2 * lane + 1] = li1; mxs[2 * lane] = m0; mxs[2 * lane + 1] = sm;
        npv[lane] = NL[(size_t)(bh * 64 + c) * 64 + lane];
    }
    for (int it = tid; it < 2048; it += 512) { const int t = (it >> 3) & 127, c8 = it & 7, isk = it >> 10; float acc[8]; ml_conv8(P, b, c * 128 + t, isk * 256 + h * 64 + c8 * 8, convw, convb, acc);
        if (isk) {
#pragma unroll
            for (int e = 0; e < 8; ++e) acc[e] *= 0.125f; }
        *(LAS v4u*)((isk ? ks : qs) + t * 72 + c8 * 8) = pack8(acc); }
    for (int it = tid; it < 2048; it += 512) { const int t = it >> 4, c8 = it & 15; const v4u vv = *(const v4u*)(P + (row0 + t) * NE + 1280 + h * 128 + c8 * 8);
#pragma unroll
        for (int e = 0; e < 8; ++e) vT[(c8 * 8 + e) * 136 + t] = (bf16)(vv[e >> 1] >> ((e & 1) * 16)); }
    for (int it = tid; it < 1024; it += 512) { const int vd = it >> 3, c8 = it & 7; const float* s = CT + ((size_t)(bh * 64 + c) * 128 + vd) * 64 + c8 * 8;
        const f32x4 a0 = *(const f32x4*)s, a1 = *(const f32x4*)(s + 4); v4u w; w.x = pk2(a0.x, a0.y); w.y = pk2(a0.z, a0.w); w.z = pk2(a1.x, a1.y); w.w = pk2(a1.z, a1.w);
        *(LAS v4u*)(cts + vd * 72 + c8 * 8) = w; }
    __syncthreads();
    {
        const int w = wave, t = 16 * w + fr;
        const float bt = bc[t], mp = Mprev[bh * 64 + c];
        const float il = bt + mp, mt = fmaxf(il, bt + mxs[t]), winter = expf(il - mt);
        bf16x8 qf[2]; qf[0] = *(const LAS bf16x8*)(qs + t * 72 + 8 * fq); qf[1] = *(const LAS bf16x8*)(qs + t * 72 + 32 + 8 * fq);
        f32x4 p[8]; float den = 0.f;
#pragma unroll
        for (int st = 0; st < 8; ++st) { p[st] = (f32x4){0.f, 0.f, 0.f, 0.f};
            if (st <= w) { f32x4 acc = (f32x4){0.f, 0.f, 0.f, 0.f};
#pragma unroll
                for (int s2 = 0; s2 < 2; ++s2) { const bf16x8 A = *(const LAS bf16x8*)(ks + (16 * st + fr) * 72 + 32 * s2 + 8 * fq); acc = mfma16(A, qf[s2], acc); }
#pragma unroll
                for (int r = 0; r < 4; ++r) { const int s = 16 * st + 4 * fq + r; const float e = (s <= t) ? expf(bt - bc[s] + lis[s] - mt) : 0.f; const float val = acc[r] * e; den += val; p[st][r] = val; } } }
        den = quad_sum(den);
        float qn = 0.f;
        { float x[8]; unpack8(__builtin_bit_cast(v4u, qf[0]), x);
#pragma unroll
          for (int e = 0; e < 8; ++e) qn += x[e] * npv[8 * fq + e];
          unpack8(__builtin_bit_cast(v4u, qf[1]), x);
#pragma unroll
          for (int e = 0; e < 8; ++e) qn += x[e] * npv[32 + 8 * fq + e]; }
        qn = quad_sum(qn);
        const float dent = den + winter * qn, inv = 1.f / fmaxf(fabsf(dent), expf(-mt));
        f32x4 hv[8]; float s1 = 0.f;
#pragma unroll
        for (int vt = 0; vt < 8; ++vt) { f32x4 a2 = (f32x4){0.f, 0.f, 0.f, 0.f}, a3 = a2;
#pragma unroll
            for (int jp = 0; jp < 4; ++jp) if (2 * jp <= w) { const LAS bf16* vp = vT + (16 * vt + fr) * 136 + 32 * jp + 4 * fq;
                const bf16x8 A = frag2(*(const LAS v2u*)vp, *(const LAS v2u*)(vp + 16)); a2 = mfma16(A, frag8(p[2 * jp], p[2 * jp + 1]), a2); }
#pragma unroll
            for (int s2 = 0; s2 < 2; ++s2) { const bf16x8 A = *(const LAS bf16x8*)(cts + (16 * vt + fr) * 72 + 32 * s2 + 8 * fq); a3 = mfma16(A, qf[s2], a3); }
            hv[vt] = (a2 + winter * a3) * inv; s1 += (hv[vt][0] + hv[vt][1]) + (hv[vt][2] + hv[vt][3]); }
        const float mean = quad_sum(s1) * (1.f / 128.f); float s2v = 0.f;
#pragma unroll
        for (int vt = 0; vt < 8; ++vt) { hv[vt] = hv[vt] - mean; s2v += (hv[vt][0] * hv[vt][0] + hv[vt][1] * hv[vt][1]) + (hv[vt][2] * hv[vt][2] + hv[vt][3] * hv[vt][3]); }
        const float rstd = 1.0f / sqrtf(quad_sum(s2v) * (1.f / 128.f) + 1e-6f);
        const bf16* op = P + (row0 + t) * NE + 1792 + h * 128 + 4 * fq; bf16* yo = Y + (row0 + t) * D + 512 + h * 128 + 4 * fq; const float* gn = mlnorm + h * 128 + 4 * fq;
#pragma unroll
        for (int vt = 0; vt < 8; ++vt) { const v2u ov = *(const v2u*)(op + 16 * vt); const f32x4 g4 = *(const f32x4*)(gn + 16 * vt);
            const float y0 = hv[vt][0] * rstd * g4.x * sigmoidf_(bflo(ov.x)), y1 = hv[vt][1] * rstd * g4.y * sigmoidf_(bfhi(ov.x)), y2 = hv[vt][2] * rstd * g4.z * sigmoidf_(bflo(ov.y)), y3 = hv[vt][3] * rstd * g4.w * sigmoidf_(bfhi(ov.y));
            v2u w2; w2.x = pk2(y0, y1); w2.y = pk2(y2, y3); *(v2u*)(yo + 16 * vt) = w2; }
    }
    __syncthreads();
}
__device__ __forceinline__ void ssm_conv8(const bf16* P, int b, int tt, int pcol, int cch, const float* convw, const float* convb, float (&acc)[8]) {
    { const f32x4 b0 = *(const f32x4*)(convb + cch), b1 = *(const f32x4*)(convb + cch + 4); acc[0] = b0.x; acc[1] = b0.y; acc[2] = b0.z; acc[3] = b0.w; acc[4] = b1.x; acc[5] = b1.y; acc[6] = b1.z; acc[7] = b1.w; }
#pragma unroll
    for (int tap = 0; tap < 4; ++tap) { const int t2 = tt - 3 + tap;
        if (t2 >= 0) { float x[8]; unpack8(*(const v4u*)(P + (size_t)(b * T + t2) * NO + pcol), x);
            const f32x4 w0 = *(const f32x4*)(convw + tap * 1024 + cch), w1 = *(const f32x4*)(convw + tap * 1024 + cch + 4);
            acc[0] += x[0] * w0.x; acc[1] += x[1] * w0.y; acc[2] += x[2] * w0.z; acc[3] += x[3] * w0.w; acc[4] += x[4] * w1.x; acc[5] += x[5] * w1.y; acc[6] += x[6] * w1.z; acc[7] += x[7] * w1.w; } }
#pragma unroll
    for (int e = 0; e < 8; ++e) acc[e] = siluf_(acc[e]);
}
__device__ __forceinline__ float ssm_dt_wave(const float* DT, size_t row0, int hd, const float* dtbias, const float* alog, int lane, LAS float* dtv, LAS float* acum) {
    const float db = dtbias[hd], A = -expf(alog[hd]);
    const float d0 = softplusf_(DT[(row0 + 2 * lane) * 8 + hd] + db), d1 = softplusf_(DT[(row0 + 2 * lane + 1) * 8 + hd] + db);
    const float ps = scan_add(d0 * A + d1 * A, lane);
    dtv[2 * lane] = d0; dtv[2 * lane + 1] = d1; acum[2 * lane] = ps - d1 * A; acum[2 * lane + 1] = ps;
    return __shfl(ps, 63);
}
__device__ __forceinline__ void ssd_local_unit(int u, const bf16* P, const float* DT, const float* convw, const float* convb, const float* dtbias, const float* alog,
                                               float* ST, float* DEC, LAS unsigned char* lds, int tid) {
    const int lane = tid & 63, wave = __builtin_amdgcn_readfirstlane(tid >> 6), fr = lane & 15, fq = lane >> 4;
    const int c = u & 63, g = (u >> 6) & 1, b = u >> 7;
    const size_t row0 = (size_t)b * T + c * 128;
    LAS bf16* xT = (LAS bf16*)lds;
    LAS bf16* bT = xT + 256 * 136;
    LAS float* dtv = (LAS float*)(bT + 128 * 136);
    LAS float* acum = dtv + 512;
    if (wave < 4) { const int hd = 4 * g + wave; const float al = ssm_dt_wave(DT, row0, hd, dtbias, alog, lane, dtv + wave * 128, acum + wave * 128);
        if (lane == 0) DEC[(b * 64 + c) * 8 + hd] = expf(al);
        LAS float* ac = acum + wave * 128; LAS float* dv = dtv + wave * 128;
        ac[2 * lane] = dv[2 * lane] * expf(al - ac[2 * lane]); ac[2 * lane + 1] = dv[2 * lane + 1] * expf(al - ac[2 * lane + 1]); }
    __syncthreads();
    for (int it = tid; it < 4096; it += 512) { const int t = it >> 5, c8 = it & 31; float acc[8]; ssm_conv8(P, b, c * 128 + t, 512 + g * 256 + c8 * 8, g * 256 + c8 * 8, convw, convb, acc);
        const float sc = acum[(c8 >> 3) * 128 + t];
#pragma unroll
        for (int e = 0; e < 8; ++e) xT[(c8 * 8 + e) * 136 + t] = (bf16)f2bf(acc[e] * sc); }
    for (int it = tid; it < 2048; it += 512) { const int t = it >> 4, c8 = it & 15; float acc[8]; ssm_conv8(P, b, c * 128 + t, 1024 + g * 128 + c8 * 8, 512 + g * 128 + c8 * 8, convw, convb, acc);
#pragma unroll
        for (int e = 0; e < 8; ++e) bT[(c8 * 8 + e) * 136 + t] = (bf16)f2bf(acc[e]); }
    __syncthreads();
#pragma unroll
    for (int rr = 0; rr < 2; ++rr) { const int rt = 2 * wave + rr;
        f32x4 acc[8];
#pragma unroll
        for (int nt = 0; nt < 8; ++nt) acc[nt] = (f32x4){0.f, 0.f, 0.f, 0.f};
#pragma unroll
        for (int ks = 0; ks < 4; ++ks) { const bf16x8 A = *(const LAS bf16x8*)(xT + (16 * rt + fr) * 136 + 32 * ks + 8 * fq);
#pragma unroll
            for (int nt = 0; nt < 8; ++nt) { const bf16x8 Bf = *(const LAS bf16x8*)(bT + (16 * nt + fr) * 136 + 32 * ks + 8 * fq); acc[nt] = mfma16(A, Bf, acc[nt]); } }
        const int hd = 4 * g + (rt >> 2), p0 = (rt & 3) * 16 + 4 * fq;
        float* sp = ST + (((size_t)(b * 64 + c) * 8 + hd) * 64 + p0) * 128 + fr;
#pragma unroll
        for (int nt = 0; nt < 8; ++nt)
#pragma unroll
            for (int r = 0; r < 4; ++r) sp[r * 128 + 16 * nt] = acc[nt][r]; }
    __syncthreads();
}
__device__ __forceinline__ void ssd_scan_phase(float* ST, const float* DEC, int tid, int G) {
    const int wave = tid >> 6; if (wave == 0) return;
    for (int e = (blockIdx.x * 7 + wave - 1) * 64 + (tid & 63); e < 4 * 8 * 8192; e += G * 7 * 64) {
        const int b = e >> 16, hd = (e >> 13) & 7, pn = e & 8191; float S = 0.f;
        float* sp = ST + ((size_t)(b * 64) * 8 + hd) * 8192 + pn;
#pragma unroll 8
        for (int c = 0; c < 64; ++c) { const float dec = DEC[(b * 64 + c) * 8 + hd]; const float st = sp[(size_t)c * 65536]; sp[(size_t)c * 65536] = S; S = S * dec + st; }
    }
}
__device__ __forceinline__ void ssd_out_unit(int u, const bf16* P, const float* DT, const float* convw, const float* convb, const float* dtbias, const float* alog, const float* dskip, const float* gnorm,
                                             const float* ST, bf16* Y, LAS unsigned char* lds, int tid) {
    const int lane = tid & 63, wave = __builtin_amdgcn_readfirstlane(tid >> 6), fr = lane & 15, fq = lane >> 4;
    const int c = u & 63, g = (u >> 6) & 1, b = u >> 7;
    const size_t row0 = (size_t)b * T + c * 128;
    LAS bf16* xT = (LAS bf16*)lds;
    LAS bf16* bm = xT + 256 * 136;
    LAS bf16* cm = bm + 128 * 136;
    LAS float* dtv = (LAS float*)(cm + 128 * 136);
    LAS float* acum = dtv + 512;
    if (wave < 4) (void)ssm_dt_wave(DT, row0, 4 * g + wave, dtbias, alog, lane, dtv + wave * 128, acum + wave * 128);
    for (int it = tid; it < 4096; it += 512) { const int t = it >> 5, c8 = it & 31; float acc[8]; ssm_conv8(P, b, c * 128 + t, 512 + g * 256 + c8 * 8, g * 256 + c8 * 8, convw, convb, acc);
#pragma unroll
        for (int e = 0; e < 8; ++e) xT[(c8 * 8 + e) * 136 + t] = (bf16)f2bf(acc[e]); }
    for (int it = tid; it < 4096; it += 512) { const int t = (it >> 4) & 127, c8 = it & 15, isc = it >> 11; float acc[8];
        ssm_conv8(P, b, c * 128 + t, 1024 + isc * 256 + g * 128 + c8 * 8, 512 + isc * 256 + g * 128 + c8 * 8, convw, convb, acc);
        *(LAS v4u*)((isc ? cm : bm) + t * 136 + c8 * 8) = pack8(acc); }
    __syncthreads();
    {
        const int w = wave, t = 16 * w + fr;
        bf16x8 cf[4];
#pragma unroll
        for (int ks = 0; ks < 4; ++ks) cf[ks] = *(const LAS bf16x8*)(cm + t * 136 + 32 * ks + 8 * fq);
        f32x4 cb[8];
#pragma unroll
        for (int st = 0; st < 8; ++st) { cb[st] = (f32x4){0.f, 0.f, 0.f, 0.f};
            if (st <= w) {
#pragma unroll
                for (int ks = 0; ks < 4; ++ks) { const bf16x8 A = *(const LAS bf16x8*)(bm + (16 * st + fr) * 136 + 32 * ks + 8 * fq); cb[st] = mfma16(A, cf[ks], cb[st]); } } }
        float ss = 0.f;
        bf16* yo = Y + (row0 + t) * D + g * 256 + 4 * fq; const float* gn = gnorm + g * 256 + 4 * fq;
#pragma unroll 1
        for (int j = 0; j < 4; ++j) {
            const int hd = 4 * g + j; const float at = acum[j * 128 + t], eat = expf(at), dh = dskip[hd];
            bf16x8 pf[4];
#pragma unroll
            for (int jp = 0; jp < 4; ++jp) { f32x4 p0 = (f32x4){0.f, 0.f, 0.f, 0.f}, p1 = p0;
                if (2 * jp <= w) {
#pragma unroll
                    for (int r = 0; r < 4; ++r) { const int s0 = 32 * jp + 4 * fq + r, s1 = s0 + 16;
                        p0[r] = (s0 <= t) ? cb[2 * jp][r] * expf(at - acum[j * 128 + s0]) * dtv[j * 128 + s0] : 0.f;
                        p1[r] = (s1 <= t) ? cb[2 * jp + 1][r] * expf(at - acum[j * 128 + s1]) * dtv[j * 128 + s1] : 0.f; } }
                pf[jp] = frag8(p0, p1); }
            const bf16* zp = P + (row0 + t) * NO + hd * 64 + 4 * fq;
#pragma unroll
            for (int pt = 0; pt < 4; ++pt) { f32x4 a2 = (f32x4){0.f, 0.f, 0.f, 0.f}, a3 = a2;
#pragma unroll
                for (int jp = 0; jp < 4; ++jp) if (2 * jp <= w) { const LAS bf16* xp = xT + (j * 64 + 16 * pt + fr) * 136 + 32 * jp + 4 * fq;
                    a2 = mfma16(frag2(*(const LAS v2u*)xp, *(const LAS v2u*)(xp + 16)), pf[jp], a2); }
                const float* sp = ST + (((size_t)(b * 64 + c) * 8 + hd) * 64 + 16 * pt + fr) * 128 + 8 * fq;
#pragma unroll
                for (int ks = 0; ks < 4; ++ks) { const f32x4 s0 = *(const f32x4*)(sp + 32 * ks), s1 = *(const f32x4*)(sp + 32 * ks + 4); a3 = mfma16(frag8(s0, s1), cf[ks], a3); }
                const v2u zv = *(const v2u*)(zp + 16 * pt); const float zz[4] = {bflo(zv.x), bfhi(zv.x), bflo(zv.y), bfhi(zv.y)};
                float y4[4];
#pragma unroll
                for (int r = 0; r < 4; ++r) { const float xv = bf1(xT[(j * 64 + 16 * pt + 4 * fq + r) * 136 + t]); const float y = (a2[r] + eat * a3[r] + dh * xv) * siluf_(zz[r]); y4[r] = y; ss += y * y; }
                v2u w2; w2.x = pk2(y4[0], y4[1]); w2.y = pk2(y4[2], y4[3]); *(v2u*)(yo + j * 64 + 16 * pt) = w2; }
        }
        const float rs = 1.0f / sqrtf(quad_sum(ss) * (1.f / 256.f) + 1e-5f);
#pragma unroll 4
        for (int q = 0; q < 16; ++q) { const f32x4 g4 = *(const f32x4*)(gn + 16 * q); const v2u yv = *(const v2u*)(yo + 16 * q);
            v2u w2; w2.x = pk2(bflo(yv.x) * rs * g4.x, bfhi(yv.x) * rs * g4.y); w2.y = pk2(bflo(yv.y) * rs * g4.z, bfhi(yv.y) * rs * g4.w); *(v2u*)(yo + 16 * q) = w2; }
    }
    __syncthreads();
}
constexpr int RW_RS = 0, RW_KS = 9216, RW_VS = 18432, RW_AA = 27648, RW_GG = 36864, RW_BON = 46080, RW_X = 46592;
constexpr int RW_TW = RW_X, RW_AD = RW_X + 9216, RW_GD = RW_X + 18432;
constexpr int RW_AR = RW_X, RW_BK = RW_X + 18432;
constexpr int RW_LW = RW_X + 36864, RW_CL = RW_LW + 16384;
constexpr int RW_MK = RW_LW, RW_NN = RW_LW + 3072, RW_MB = RW_NN + 5120, RW_TT = RW_MB + 4096;
constexpr int RW_YO = RW_CL;
constexpr int RW_KB = RW_CL + 16384, RW_VT = RW_KB + 20480, RW_GL = RW_VT + 8192, RW_END = RW_GL + 1024;
constexpr int RW_GT = RW_RS;
static_assert(RW_TT + 3072 <= RW_CL && RW_END <= LDS_MAIN, "rwkv LDS map");
template <int MODE>
__device__ __forceinline__ void rwkv_chunk_unit(int u, const bf16* P, const float* const* in, const bf16* lora, bf16* GF, float* HS, bf16* Y, LAS unsigned char* lds, int tid) {
    const int lane = tid & 63, wave = __builtin_amdgcn_readfirstlane(tid >> 6), fr = lane & 15, fq = lane >> 4;
    const int c64 = u & 127, h = (u >> 7) & 7, b = u >> 10;
    const size_t row0 = (size_t)b * T + c64 * 64;
    const float* mu = in[21];
    LAS bf16* RS = (LAS bf16*)(lds + RW_RS); LAS bf16* KS = (LAS bf16*)(lds + RW_KS); LAS bf16* VS = (LAS bf16*)(lds + RW_VS); LAS bf16* AA = (LAS bf16*)(lds + RW_AA); LAS bf16* GG = (LAS bf16*)(lds + RW_GG);
    LAS float* BON = (LAS float*)(lds + RW_BON);
    LAS bf16* TW = (LAS bf16*)(lds + RW_TW); LAS bf16* ADs = (LAS bf16*)(lds + RW_AD); LAS bf16* GD = (LAS bf16*)(lds + RW_GD);
    LAS float* LW = (LAS float*)(lds + RW_LW); LAS float* CL = (LAS float*)(lds + RW_CL);
    for (int it = tid; it < 64 * 56; it += 512) {
        const int t = it / 56, q = it % 56; int pcol, mcol;
        if (q < 24) { const int w3 = q >> 3, c8 = q & 7; pcol = 1536 + w3 * 512 + h * 64 + c8 * 8; mcol = w3 * 512 + h * 64 + c8 * 8; }
        else { pcol = 3072 + (q - 24) * 8; mcol = 1536 + (q - 24) * 8; }
        float cur[8], prv[8], o[8]; unpack8(*(const v4u*)(P + (row0 + t) * NO + pcol), cur);
        if (c64 * 64 + t > 0) unpack8(*(const v4u*)(P + (row0 + t - 1) * NO + pcol), prv);
        else {
#pragma unroll
            for (int e = 0; e < 8; ++e) prv[e] = 0.f; }
        const f32x4 m0 = *(const f32x4*)(mu + mcol), m1 = *(const f32x4*)(mu + mcol + 4); const float mm[8] = {m0.x, m0.y, m0.z, m0.w, m1.x, m1.y, m1.z, m1.w};
#pragma unroll
        for (int e = 0; e < 8; ++e) o[e] = cur[e] + (prv[e] - cur[e]) * mm[e];
        if (q < 24) { LAS bf16* dst = (q < 8) ? RS : (q < 16 ? KS : VS); *(LAS v4u*)(dst + t * 72 + (q & 7) * 8) = pack8(o); }
        else if (q < 32) {
#pragma unroll
            for (int e = 0; e < 8; ++e) o[e] = tanhf(o[e]);
            *(LAS v4u*)(TW + t * 72 + (q - 24) * 8) = pack8(o); }
        else if (q < 40) *(LAS v4u*)(ADs + t * 72 + (q - 32) * 8) = pack8(o);
        else if (MODE == 1) {
#pragma unroll
            for (int e = 0; e < 8; ++e) o[e] = sigmoidf_(o[e]);
            *(LAS v4u*)(GD + t * 136 + (q - 40) * 8) = pack8(o); }
    }
    __syncthreads();
    {
        const bf16* w2t = lora + (size_t)(h * 64) * 64; const bf16* a2t = lora + 512 * 64 + (size_t)(h * 64) * 64; const bf16* g2t = lora + 2 * 512 * 64 + (size_t)(h * 64) * 128;
        const int tt = wave & 3;
        f32x4 ga[2];
#pragma unroll
        for (int ni = 0; ni < 2; ++ni) { const int nt = 2 * (wave >> 2) + ni, kh = 16 * nt + fr;
            f32x4 aw = (f32x4){0.f, 0.f, 0.f, 0.f}, aa = aw, ag = aw;
#pragma unroll
            for (int ks = 0; ks < 2; ++ks) { const bf16x8 A1 = *(const LAS bf16x8*)(TW + (16 * tt + fr) * 72 + 32 * ks + 8 * fq), A2 = *(const LAS bf16x8*)(ADs + (16 * tt + fr) * 72 + 32 * ks + 8 * fq);
                aw = mfma16(A1, *(const bf16x8*)(w2t + (size_t)kh * 64 + 32 * ks + 8 * fq), aw); aa = mfma16(A2, *(const bf16x8*)(a2t + (size_t)kh * 64 + 32 * ks + 8 * fq), aa); }
            if (MODE == 1) {
#pragma unroll
                for (int ks = 0; ks < 4; ++ks) ag = mfma16(*(const LAS bf16x8*)(GD + (16 * tt + fr) * 136 + 32 * ks + 8 * fq), *(const bf16x8*)(g2t + (size_t)kh * 128 + 32 * ks + 8 * fq), ag); }
            ga[ni] = ag;
            const float w0 = in[22][h * 64 + kh], a0 = in[24][h * 64 + kh];
#pragma unroll
            for (int r = 0; r < 4; ++r) { const int t = 16 * tt + 4 * fq + r;
                const float wlog = -softplusf_(-(w0 + aw[r])) - 0.5f; LW[t * 64 + kh] = -expf(wlog);
                AA[t * 72 + kh] = (bf16)f2bf(sigmoidf_(a0 + aa[r]));
                if (MODE == 1) GG[t * 72 + kh] = (bf16)f2bf(ga[ni][r]); } }
    }
    __syncthreads();
    if (tid < 256) { const int kh = tid & 63, i = tid >> 6; float s = 0.f;
#pragma unroll
        for (int tl = 0; tl < 16; ++tl) { s += LW[(16 * i + tl) * 64 + kh]; CL[(16 * i + tl) * 64 + kh] = s; } }
    __syncthreads();
    {
        LAS bf16* AR = (LAS bf16*)(lds + RW_AR); LAS bf16* BK = (LAS bf16*)(lds + RW_BK); LAS bf16* KB = (LAS bf16*)(lds + RW_KB); LAS bf16* VT = (LAS bf16*)(lds + RW_VT); LAS float* GL = (LAS float*)(lds + RW_GL);
        const int t = tid >> 3, c8 = tid & 7, i = t >> 4, tl = t & 15, kh0 = c8 * 8;
        float rr[8], kk_[8], vv[8], aa[8], kn[8];
        unpack8(*(const LAS v4u*)(RS + t * 72 + kh0), rr); unpack8(*(const LAS v4u*)(KS + t * 72 + kh0), kk_); unpack8(*(const LAS v4u*)(VS + t * 72 + kh0), vv); unpack8(*(const LAS v4u*)(AA + t * 72 + kh0), aa);
        const float* kkp = in[27] + h * 64 + kh0; const float* kap = in[28] + h * 64 + kh0; const float* rkp = in[29] + h * 64 + kh0;
        float ssq = 0.f, bon = 0.f;
#pragma unroll
        for (int e = 0; e < 8; ++e) { kn[e] = kk_[e] * kkp[e]; ssq += kn[e] * kn[e]; }
        ssq += __shfl_xor(ssq, 1); ssq += __shfl_xor(ssq, 2); ssq += __shfl_xor(ssq, 4);
        const float invn = 1.f / fmaxf(sqrtf(ssq), 1e-12f);
        float al[8], be[8], ka[8], rh[8];
#pragma unroll
        for (int e = 0; e < 8; ++e) { const float cl = CL[t * 64 + kh0 + e], lw = LW[t * 64 + kh0 + e]; const float ep = expf(cl - lw), ec = expf(cl), em = expf(-cl);
            const float kkn = kn[e] * invn, kp = kk_[e] * (1.f + (aa[e] - 1.f) * kap[e]);
            al[e] = kkn * ep; be[e] = kkn * aa[e] * em; ka[e] = kp * em; rh[e] = rr[e] * ec; bon += rr[e] * kp * rkp[e];
            if (tl == 15) GL[i * 64 + kh0 + e] = ec; }
        bon += __shfl_xor(bon, 1); bon += __shfl_xor(bon, 2); bon += __shfl_xor(bon, 4);
        if (c8 == 0) BON[t] = bon;
        *(LAS v4u*)(AR + (i * 32 + tl) * 72 + kh0) = pack8(al); *(LAS v4u*)(AR + (i * 32 + 16 + tl) * 72 + kh0) = pack8(rh);
        *(LAS v4u*)(BK + (i * 32 + tl) * 72 + kh0) = pack8(be); *(LAS v4u*)(BK + (i * 32 + 16 + tl) * 72 + kh0) = pack8(ka);
        const int slot = 8 * (tl >> 2) + (tl & 3);
#pragma unroll
        for (int e = 0; e < 8; ++e) { KB[(i * 64 + kh0 + e) * 40 + slot] = (bf16)f2bf(-be[e]); KB[(i * 64 + kh0 + e) * 40 + slot + 4] = (bf16)f2bf(ka[e]); VT[(i * 64 + kh0 + e) * 16 + tl] = (bf16)f2bf(vv[e]); }
    }
    __syncthreads();
    if (wave < 4) {
        const int i = wave;
        LAS bf16* AR = (LAS bf16*)(lds + RW_AR) + i * 32 * 72; LAS bf16* BK = (LAS bf16*)(lds + RW_BK) + i * 32 * 72;
        LAS bf16* MK = (LAS bf16*)(lds + RW_MK) + i * 16 * 24; LAS bf16* NN = (LAS bf16*)(lds + RW_NN) + i * 16 * 40; LAS float* MB = (LAS float*)(lds + RW_MB) + i * 256; LAS bf16* TT = (LAS bf16*)(lds + RW_TT) + i * 16 * 24;
        f32x4 pr[2][2];
#pragma unroll
        for (int ra = 0; ra < 2; ++ra)
#pragma unroll
            for (int cbx = 0; cbx < 2; ++cbx) { f32x4 acc = (f32x4){0.f, 0.f, 0.f, 0.f};
#pragma unroll
                for (int ks = 0; ks < 2; ++ks) acc = mfma16(*(const LAS bf16x8*)(AR + (16 * ra + fr) * 72 + 32 * ks + 8 * fq), *(const LAS bf16x8*)(BK + (16 * cbx + fr) * 72 + 32 * ks + 8 * fq), acc);
                pr[ra][cbx] = acc; }
        const int slotc = 8 * (fr >> 2) + (fr & 3);
#pragma unroll
        for (int r = 0; r < 4; ++r) { const int ta = 4 * fq + r, tb = fr;
            const float mb = (tb < ta) ? pr[0][0][r] : 0.f, mk = (tb < ta) ? pr[0][1][r] : 0.f, nb = (tb <= ta) ? pr[1][0][r] : 0.f, nk = (tb <= ta) ? pr[1][1][r] : 0.f;
            MB[ta * 16 + tb] = mb; MK[ta * 24 + tb] = (bf16)f2bf(mk); NN[ta * 40 + slotc] = (bf16)f2bf(-nb); NN[ta * 40 + slotc + 4] = (bf16)f2bf(nk); }
        LDS_WAIT(); asm volatile("" ::: "memory");
        { const int cc = lane & 15; float tc[16];
#pragma unroll
          for (int t = 0; t < 16; ++t) { float s = (t == cc) ? 1.f : 0.f;
#pragma unroll
              for (int j = 0; j < t; ++j) s -= MB[t * 16 + j] * tc[j];
              tc[t] = s; }
          if (lane < 16) {
#pragma unroll
              for (int t = 0; t < 16; ++t) TT[t * 24 + cc] = (bf16)f2bf(tc[t]); } }
    }
    __syncthreads();
    constexpr int NCW = (MODE == 0) ? 8 : 4;
    LAS float* YO = (LAS float*)(lds + RW_YO);
    if (wave < NCW) {
        const bool has_v = (MODE == 1) || (wave >= 4);
        const int vcol = (MODE == 1) ? (16 * wave + fr) : (16 * (wave & 3) + fr);
        f32x4 W[4];
        if (MODE == 1) {
#pragma unroll
            for (int kt = 0; kt < 4; ++kt) W[kt] = *(const f32x4*)(HS + (((size_t)u * 4 + wave) * 4 + kt) * 256 + lane * 4);
        } else {
#pragma unroll
            for (int kt = 0; kt < 4; ++kt)
#pragma unroll
                for (int r = 0; r < 4; ++r) W[kt][r] = (wave < 4 && (16 * kt + 4 * fq + r) == (16 * wave + fr)) ? 1.f : 0.f;
        }
        const bf16x8 zero8 = (bf16x8){0, 0, 0, 0, 0, 0, 0, 0}; const v2u zero2 = (v2u){0u, 0u};
#pragma unroll
        for (int i = 0; i < 4; ++i) {
            LAS bf16* AR = (LAS bf16*)(lds + RW_AR) + i * 32 * 72; LAS bf16* KB = (LAS bf16*)(lds + RW_KB) + i * 64 * 40; LAS bf16* VT = (LAS bf16*)(lds + RW_VT) + i * 64 * 16; LAS float* GL = (LAS float*)(lds + RW_GL) + i * 64;
            LAS bf16* MK = (LAS bf16*)(lds + RW_MK) + i * 16 * 24; LAS bf16* NN = (LAS bf16*)(lds + RW_NN) + i * 16 * 40; LAS bf16* TT = (LAS bf16*)(lds + RW_TT) + i * 16 * 24;
            bf16x8 wf[2]; wf[0] = frag8(W[0], W[1]); wf[1] = frag8(W[2], W[3]);
            f32x4 au = (f32x4){0.f, 0.f, 0.f, 0.f}, ay = au;
#pragma unroll
            for (int s = 0; s < 2; ++s) { const LAS bf16* ap = AR + fr * 72 + 32 * s + 4 * fq; au = mfma16(frag2(*(const LAS v2u*)ap, *(const LAS v2u*)(ap + 16)), wf[s], au);
                if (MODE == 1) { const LAS bf16* rp = AR + (16 + fr) * 72 + 32 * s + 4 * fq; ay = mfma16(frag2(*(const LAS v2u*)rp, *(const LAS v2u*)(rp + 16)), wf[s], ay); } }
            v2u vin = zero2;
            if (has_v) { const bf16x8 A = (fq < 2) ? *(const LAS bf16x8*)(MK + fr * 24 + 8 * fq) : zero8; const bf16x8 Bv = (fq < 2) ? *(const LAS bf16x8*)(VT + vcol * 16 + 8 * fq) : zero8;
                au = mfma16(A, Bv, au); vin = *(const LAS v2u*)(VT + vcol * 16 + 4 * fq); }
            f32x4 U;
            { v4u bw; bw.x = pk2(au[0], au[1]); bw.y = pk2(au[2], au[3]); bw.z = 0u; bw.w = 0u; const v2u tl2 = *(const LAS v2u*)(TT + fr * 24 + 4 * fq);
              U = mfma16(frag2(tl2, zero2), __builtin_bit_cast(bf16x8, bw), (f32x4){0.f, 0.f, 0.f, 0.f}); }
            v4u ubw; ubw.x = pk2(U[0], U[1]); ubw.y = pk2(U[2], U[3]); ubw.z = vin.x; ubw.w = vin.y; const bf16x8 ub = __builtin_bit_cast(bf16x8, ubw);
            if (MODE == 1) { ay = mfma16(*(const LAS bf16x8*)(NN + fr * 40 + 8 * fq), ub, ay);
#pragma unroll
                for (int r = 0; r < 4; ++r) YO[(16 * i + 4 * fq + r) * 64 + vcol] = ay[r]; }
#pragma unroll
            for (int kt = 0; kt < 4; ++kt) { W[kt] = mfma16(*(const LAS bf16x8*)(KB + (16 * kt + fr) * 40 + 8 * fq), ub, W[kt]); const f32x4 g4 = *(const LAS f32x4*)(GL + 16 * kt + 4 * fq); W[kt] = W[kt] * g4; }
        }
        if (MODE == 0) {
            if (wave >= 4) {
#pragma unroll
                for (int kt = 0; kt < 4; ++kt) *(f32x4*)(HS + (((size_t)u * 4 + (wave - 4)) * 4 + kt) * 256 + lane * 4) = W[kt];
            } else { LAS bf16* GT = (LAS bf16*)(lds + RW_GT);
#pragma unroll
                for (int kt = 0; kt < 4; ++kt)
#pragma unroll
                    for (int r = 0; r < 4; ++r) GT[(16 * kt + 4 * fq + r) * 72 + 16 * wave + fr] = (bf16)f2bf(W[kt][r]); }
        }
    }
    __syncthreads();
    if (MODE == 0) {
        LAS bf16* GT = (LAS bf16*)(lds + RW_GT);
        const int f = wave, kot = f >> 1, s = f & 1; const LAS bf16* gp = GT + (16 * kot + fr) * 72 + 32 * s + 4 * fq;
        const v2u lo = *(const LAS v2u*)gp, hi = *(const LAS v2u*)(gp + 16); v4u o; o.x = lo.x; o.y = lo.y; o.z = hi.x; o.w = hi.y;
        *(v4u*)(GF + ((size_t)u * 8 + f) * 512 + lane * 8) = o;
    } else {
        const int t = tid >> 3, c8 = tid & 7, v0 = c8 * 8;
        float y[8]; float s1 = 0.f;
#pragma unroll
        for (int e = 0; e < 8; ++e) { y[e] = YO[t * 64 + v0 + e]; s1 += y[e]; }
        s1 += __shfl_xor(s1, 1); s1 += __shfl_xor(s1, 2); s1 += __shfl_xor(s1, 4);
        const float mean = s1 * (1.f / 64.f); float s2 = 0.f;
#pragma unroll
        for (int e = 0; e < 8; ++e) { y[e] -= mean; s2 += y[e] * y[e]; }
        s2 += __shfl_xor(s2, 1); s2 += __shfl_xor(s2, 2); s2 += __shfl_xor(s2, 4);
        const float rstd = 1.0f / sqrtf(s2 * (1.f / 64.f) + 64e-5f), bon = BON[t];
        float vv[8], gg[8], o[8]; unpack8(*(const LAS v4u*)(VS + t * 72 + v0), vv); unpack8(*(const LAS v4u*)(GG + t * 72 + v0), gg);
        const float* lw_ = in[30] + h * 64 + v0; const float* lb_ = in[31] + h * 64 + v0;
#pragma unroll
        for (int e = 0; e < 8; ++e) o[e] = (y[e] * rstd * lw_[e] + lb_[e] + bon * vv[e]) * gg[e];
        *(v4u*)(Y + (row0 + t) * D + 512 + h * 64 + v0) = pack8(o);
    }
    __syncthreads();
}
__device__ __forceinline__ void rwkv_scan_phase(const bf16* GF, float* HS, int tid, int G) {
    if ((tid >> 6) != 0) return;
    const int lane = tid & 63;
    for (int job = blockIdx.x; job < 128; job += G) {
        const int bh = job >> 2, vt = job & 3;
        f32x4 W[4];
#pragma unroll
        for (int kt = 0; kt < 4; ++kt) W[kt] = (f32x4){0.f, 0.f, 0.f, 0.f};
        bf16x8 gc[8]; f32x4 hc[4];
        { const size_t u0 = (size_t)bh * 128;
#pragma unroll
          for (int f = 0; f < 8; ++f) gc[f] = *(const bf16x8*)(GF + (u0 * 8 + f) * 512 + lane * 8);
#pragma unroll
          for (int kt = 0; kt < 4; ++kt) hc[kt] = *(const f32x4*)(HS + ((u0 * 4 + vt) * 4 + kt) * 256 + lane * 4); }
        for (int c = 0; c < 128; ++c) {
            const size_t uu = (size_t)bh * 128 + c, un = (size_t)bh * 128 + (c < 127 ? c + 1 : c);
            bf16x8 gn[8]; f32x4 hn[4];
#pragma unroll
            for (int f = 0; f < 8; ++f) gn[f] = *(const bf16x8*)(GF + (un * 8 + f) * 512 + lane * 8);
#pragma unroll
            for (int kt = 0; kt < 4; ++kt) hn[kt] = *(const f32x4*)(HS + ((un * 4 + vt) * 4 + kt) * 256 + lane * 4);
            f32x4 Wold[4];
#pragma unroll
            for (int kt = 0; kt < 4; ++kt) Wold[kt] = W[kt];
            f32x4 Wl[4];
#pragma unroll
            for (int kt = 0; kt < 4; ++kt)
#pragma unroll
                for (int r = 0; r < 4; ++r) { const float hi = __builtin_bit_cast(float, f2bf(W[kt][r]) << 16); Wl[kt][r] = W[kt][r] - hi; }
            const bf16x8 wh0 = frag8(W[0], W[1]), wh1 = frag8(W[2], W[3]), wl0 = frag8(Wl[0], Wl[1]), wl1 = frag8(Wl[2], Wl[3]);
#pragma unroll
            for (int kt = 0; kt < 4; ++kt) { f32x4 a = hc[kt]; a = mfma16(gc[2 * kt], wh0, a); a = mfma16(gc[2 * kt + 1], wh1, a); a = mfma16(gc[2 * kt], wl0, a); a = mfma16(gc[2 * kt + 1], wl1, a); W[kt] = a; }
            asm volatile("s_waitcnt vmcnt(0)" ::: "memory");
#pragma unroll
            for (int kt = 0; kt < 4; ++kt) *(f32x4*)(HS + ((uu * 4 + vt) * 4 + kt) * 256 + lane * 4) = Wold[kt];
#pragma unroll
            for (int f = 0; f < 8; ++f) gc[f] = gn[f];
#pragma unroll
            for (int kt = 0; kt < 4; ++kt) hc[kt] = hn[kt];
        }
    }
}
struct Args { const float* in[33]; float* out; unsigned char* ws; int ph_lo, ph_hi; };
__global__ void __launch_bounds__(NWAVES * 64, 2) trunk_fwd(Args args) {
    extern __shared__ __attribute__((aligned(16))) unsigned char lds_raw[];
    LAS unsigned char* lds = (LAS unsigned char*)lds_raw;
    const int tid = threadIdx.x, G = gridDim.x;
    unsigned char* ws = args.ws;
    gu32* ctl = (gu32*)(ws + WS_CTL);
    for (int u = tid; u < (LDS_BYTES - LDSCTL_OFF) / 4; u += NWAVES * 64) ((LAS unsigned*)(lds + LDSCTL_OFF))[u] = 0u;
    __syncthreads();
    XcdBarrier bar; bar.bar = (unsigned*)(ctl + CW_BAR); bar.x = 0; bar.st = nullptr;
    if (!MK_PER_PHASE) bar = xcd_barrier_post((unsigned*)(ctl + CW_BAR), (volatile LAS unsigned*)(lds + LDSCTL_OFF + 32));
    const int lo = args.ph_lo, hi = args.ph_hi;
#ifndef NO_SSD
#define NO_SSD 0
#endif
#ifndef NO_RWKV
#define NO_RWKV 0
#endif
#ifndef PHMASK
#define PHMASK 0x7ffffu
#endif
#define IN(k) ((((PHMASK) >> (k)) & 1u) && lo <= (k) && (k) < hi)
#define SEAM(k) do { if (IN(k) && IN((k) + 1)) xcd_barrier(bar); } while (0)
    const float* x = args.in[0]; float* hres = args.out;
    bf16* XN = (bf16*)(ws + WS_XN); bf16* P = (bf16*)(ws + WS_R1); bf16* HB = (bf16*)(ws + WS_R1); bf16* Y = (bf16*)(ws + WS_Y);
    float* G0 = (float*)(ws + WS_G0); float* DT = (float*)(ws + WS_DT);
    float* MLS = (float*)(ws + WS_MLS); float* MPREV = MLS + 4096; float* NL = MLS + 8192;
    float* CT = (float*)(ws + WS_XN); float* ST = (float*)(ws + WS_XN); float* DEC = (float*)(ws + WS_DEC);
    bf16* GF = (bf16*)(ws + WS_GF); float* HS = (float*)(ws + WS_HS);
    const float2* rope = (const float2*)(ws + WS_ROPE); const bf16* lora = (const bf16*)(ws + WS_LORA);

    if (IN(0)) { p0_prologue(args.in, ws, lds, tid, G); __syncthreads();
        norm_phase<1>(x, args.in[1], XN, nullptr, args.in[5] + 2304, 2312, G0, lds, tid, G); }
    SEAM(0);
    if (IN(1)) { pg8::Gemm g{XN, (const bf16*)(ws + WS_WINE), M, NE, D}; pg8::StaticOrder S; S.init(M, NE, G, (int)blockIdx.x); pg8::EpiBf16<0> E{P, NE};
        pg8::gemm_phase<pg8::EpiBf16<0>, pg8::StaticOrder, PG8_ALIGN, PG8_SP2>(lds, g, S, E); }
    SEAM(1);
    if (IN(2)) { for (int u = blockIdx.x; u < 512; u += G) attn_unit(u, P, rope, args.in[7], Y, lds, tid);
        for (int u = blockIdx.x; u < 1024; u += G) mlstm_local_unit(u, P, G0, args.in[8], args.in[9], args.in[10], args.in[11], CT, NL, MLS, lds, tid); }
    SEAM(2);
    if (IN(3)) mlstm_scan_phase(CT, NL, MLS, MPREV, tid, G);
    SEAM(3);
    if (IN(4)) { for (int u = blockIdx.x; u < 1024; u += G) mlstm_out_unit(u, P, G0, args.in[8], args.in[9], args.in[10], args.in[11], args.in[12], CT, NL, MPREV, Y, lds, tid); }
    SEAM(4);
    if (IN(5)) { pg8::Gemm g{Y, (const bf16*)(ws + WS_WOUTE), M, D, D}; pg8::StaticOrder S; S.init(M, D, G, (int)blockIdx.x); pg8::EpiF32Res E{x, hres, D};
        pg8::gemm_phase<pg8::EpiF32Res, pg8::StaticOrder, PG8_ALIGN, PG8_SP2>(lds, g, S, E); }
    SEAM(5);
    if (IN(6)) norm_phase<0>(hres, args.in[2], XN, nullptr, nullptr, 0, nullptr, lds, tid, G);
    SEAM(6);
    if (IN(7)) { pg8::Gemm g{XN, (const bf16*)(ws + WS_WUP0), M, FF, D}; pg8::StaticOrder S; S.init(M, FF, G, (int)blockIdx.x); pg8::EpiBf16<2> E{HB, FF};
        pg8::gemm_phase<pg8::EpiBf16<2>, pg8::StaticOrder, PG8_ALIGN, PG8_SP2>(lds, g, S, E); }
    SEAM(7);
    if (IN(8)) { pg8::Gemm g{HB, (const bf16*)(ws + WS_WDN0), M, D, FF}; pg8::StaticOrder S; S.init(M, D, G, (int)blockIdx.x); pg8::EpiF32Res E{hres, hres, D};
        pg8::gemm_phase<pg8::EpiF32Res, pg8::StaticOrder, PG8_ALIGN, PG8_SP2>(lds, g, S, E); }
    SEAM(8);
    if (IN(9)) norm_phase<1>(hres, args.in[1] + D, XN, nullptr, args.in[13] + 1536, 3336, DT, lds, tid, G);
    SEAM(9);
    if (IN(10)) { pg8::Gemm g{XN, (const bf16*)(ws + WS_WINO), M, NO, D}; pg8::StaticOrder S; S.init(M, NO, G, (int)blockIdx.x); pg8::EpiBf16<0> E{P, NO};
        pg8::gemm_phase<pg8::EpiBf16<0>, pg8::StaticOrder, PG8_ALIGN, PG8_SP2>(lds, g, S, E); }
    SEAM(10);
    if (IN(11)) { if (!NO_SSD) for (int u = blockIdx.x; u < 512; u += G) ssd_local_unit(u, P, DT, args.in[15], args.in[16], args.in[17], args.in[18], ST, DEC, lds, tid);
        if (!NO_RWKV) for (int u = blockIdx.x; u < 4096; u += G) rwkv_chunk_unit<0>(u, P, args.in, lora, GF, HS, Y, lds, tid); }
    SEAM(11);
    if (IN(12)) { rwkv_scan_phase(GF, HS, tid, G); ssd_scan_phase(ST, DEC, tid, G); }
    SEAM(12);
    if (IN(13)) { if (!NO_SSD) for (int u = blockIdx.x; u < 512; u += G) ssd_out_unit(u, P, DT, args.in[15], args.in[16], args.in[17], args.in[18], args.in[19], args.in[20], ST, Y, lds, tid);
        if (!NO_RWKV) for (int u = blockIdx.x; u < 4096; u += G) rwkv_chunk_unit<1>(u, P, args.in, lora, GF, HS, Y, lds, tid); }
    SEAM(13);
    if (IN(14)) { pg8::Gemm g{Y, (const bf16*)(ws + WS_WOUTO), M, D, D}; pg8::StaticOrder S; S.init(M, D, G, (int)blockIdx.x); pg8::EpiF32Res E{hres, hres, D};
        pg8::gemm_phase<pg8::EpiF32Res, pg8::StaticOrder, PG8_ALIGN, PG8_SP2>(lds, g, S, E); }
    SEAM(14);
    if (IN(15)) norm_phase<0>(hres, args.in[2] + D, XN, nullptr, nullptr, 0, nullptr, lds, tid, G);
    SEAM(15);
    if (IN(16)) { pg8::Gemm g{XN, (const bf16*)(ws + WS_WUP1), M, FF, D}; pg8::StaticOrder S; S.init(M, FF, G, (int)blockIdx.x); pg8::EpiBf16<2> E{HB, FF};
        pg8::gemm_phase<pg8::EpiBf16<2>, pg8::StaticOrder, PG8_ALIGN, PG8_SP2>(lds, g, S, E); }
    SEAM(16);
    if (IN(17)) { pg8::Gemm g{HB, (const bf16*)(ws + WS_WDN1), M, D, FF}; pg8::StaticOrder S; S.init(M, D, G, (int)blockIdx.x); pg8::EpiF32Res E{hres, hres, D};
        pg8::gemm_phase<pg8::EpiF32Res, pg8::StaticOrder, PG8_ALIGN, PG8_SP2>(lds, g, S, E); }
    SEAM(17);
    if (IN(18)) norm_phase<2>(hres, args.in[32], nullptr, hres, nullptr, 0, nullptr, lds, tid, G);
#undef IN
#undef SEAM
}
extern "C" void kernel_launch(void* const* d_in, const int* in_sizes, int n_in, void* d_out, int out_size, void* d_ws, size_t ws_size, hipStream_t stream) {
    static int grid = 0;
    if (grid == 0) {
        if (n_in != 33 || in_sizes[0] != M * D || out_size != M * D || ws_size < WS_END) { fprintf(stderr, "kernel_launch: unexpected shapes (n_in %d, in0 %d, out %d, ws %zu < %zu); nothing launched\n", n_in, n_in > 0 ? in_sizes[0] : -1, out_size, ws_size, (size_t)WS_END); grid = -1; return; }
        int dev = 0, cus = 0, per_cu = 0;
        if (hipGetDevice(&dev) != hipSuccess || hipDeviceGetAttribute(&cus, hipDeviceAttributeMultiprocessorCount, dev) != hipSuccess) { grid = -1; return; }
        if (hipFuncSetAttribute((const void*)trunk_fwd, hipFuncAttributeMaxDynamicSharedMemorySize, LDS_BYTES) != hipSuccess) { fprintf(stderr, "kernel_launch: hipFuncSetAttribute failed\n"); grid = -1; return; }
        if (hipOccupancyMaxActiveBlocksPerMultiprocessor(&per_cu, (const void*)trunk_fwd, NWAVES * 64, LDS_BYTES) != hipSuccess || per_cu < 1) { fprintf(stderr, "kernel_launch: occupancy query reports %d workgroups per CU\n", per_cu); }
        (void)hipGetLastError();
        grid = cus;
    }
    if (grid < 0) return;
    if (hipMemsetAsync((char*)d_ws + WS_CTL, 0, CTL_ZERO_BYTES, stream) != hipSuccess) return;
    Args a{};
    for (int i = 0; i < 33; ++i) a.in[i] = (const float*)d_in[i];
    a.out = (float*)d_out; a.ws = (unsigned char*)d_ws;
#if MK_PER_PHASE
    for (int p = 0; p < N_PHASES; ++p) { a.ph_lo = p; a.ph_hi = p + 1; hipLaunchKernelGGL(trunk_fwd, dim3(grid), dim3(NWAVES * 64), LDS_BYTES, stream, a); }
#else
    a.ph_lo = 0; a.ph_hi = N_PHASES; hipLaunchKernelGGL(trunk_fwd, dim3(grid), dim3(NWAVES * 64), LDS_BYTES, stream, a);
#endif
}
```

```cpp
#include <hip/hip_runtime.h>
#include <cstdio>
#include <cstdint>
namespace pg8 {
#define PG8_LAS __attribute__((address_space(3)))
typedef unsigned short bf16_t;
typedef short bf16x8 __attribute__((ext_vector_type(8)));
typedef float f32x4 __attribute__((ext_vector_type(4)));
typedef unsigned u32x4 __attribute__((ext_vector_type(4)));
constexpr int BM = 256, BK = 64, HALF = 128, HTB = HALF * BK * 2  , STAGE_BYTES = 8 * HTB, NXCD = 8, WGM = 8;

__host__ __device__ __forceinline__ int lds_byte(int r, int c) { const int st = (r >> 4) * 2 + (c >> 5), rr = r & 15, cc = c & 31, ob = rr * 64 + cc * 2; return st * 1024 + (ob ^ (((ob >> 9) & 1) << 5)); }
__host__ __device__ __forceinline__ void stage_rc(int b, int& R, int& C) { const int st = b / 1024, sb = b % 1024, swz = sb ^ (((sb >> 9) & 1) << 5); R = (st >> 1) * 16 + swz / 64; C = (st & 1) * 32 + (swz % 64) / 2; }
__host__ __device__ __forceinline__ int perm32(int rho) { const int n = rho >> 4, i = rho & 15; return 8 * (i >> 2) + 4 * n + (i & 3); }

struct Unit { int pm, pn; };
struct Gemm { const bf16_t* A; const bf16_t* Bt; int M, N, K; };

struct StaticOrder {
    int nM, nN, nwg, G, c;
    __host__ __device__ void init(int M, int N, int G_, int c_) { nM = M / BM; nN = N / BM; nwg = nM * nN; G = G_; c = c_; }
    __host__ __device__ bool next(int i, Unit& u) const {
        const long L = (long)i * G + c; if (L >= nwg) return false;
        int wgid = (int)L; { const int q = nwg / NXCD, r = nwg % NXCD, xcd = wgid % NXCD, off = wgid / NXCD; wgid = (xcd < r ? xcd * (q + 1) : r * (q + 1) + (xcd - r) * q) + off; }
        const int nig = WGM * nN, gid = wgid / nig, fm = gid * WGM, gsz = (nM - fm) < WGM ? (nM - fm) : WGM;
        u.pm = fm + ((wgid % nig) % gsz); u.pn = (wgid % nig) / gsz; return true;
    }
    __device__ __forceinline__ void a_ready(const Unit&) const {}
    __device__ __forceinline__ void done(const Unit&) const {}
};

__device__ __forceinline__ unsigned cvt_pk_bf16(float lo, float hi) { unsigned r; asm volatile("v_cvt_pk_bf16_f32 %0, %1, %2" : "=v"(r) : "v"(lo), "v"(hi)); return r; }
template <int ACT> struct EpiBf16 {
    static constexpr bool PERM = true, AFTER_DRAIN = false;
    bf16_t* O; int ldc;
    __device__ __forceinline__ void operator()(const f32x4 (&acc)[2][2][4][2], const Unit& u, int wr, int wc, int fr, int fq) const {
        const int row0 = u.pm * BM + wr * 64 + fr; const int col0 = u.pn * BM + wc * 32 + 8 * fq;
#pragma unroll
        for (int ai = 0; ai < 2; ++ai)
#pragma unroll
            for (int m = 0; m < 4; ++m) { bf16_t* rowp = O + (size_t)(row0 + ai * HALF + m * 16) * ldc + col0;
#pragma unroll
                for (int bj = 0; bj < 2; ++bj) { f32x4 v0 = acc[ai][bj][m][0], v1 = acc[ai][bj][m][1];
                    if (ACT == 2) {
#pragma unroll
                        for (int j = 0; j < 4; ++j) { const float a0 = v0[j] > 0.f ? v0[j] : 0.f, a1 = v1[j] > 0.f ? v1[j] : 0.f; v0[j] = a0 * a0; v1[j] = a1 * a1; } }
                    u32x4 w; w.x = cvt_pk_bf16(v0[0], v0[1]); w.y = cvt_pk_bf16(v0[2], v0[3]); w.z = cvt_pk_bf16(v1[0], v1[1]); w.w = cvt_pk_bf16(v1[2], v1[3]);
                    *(u32x4*)(rowp + bj * HALF) = w; } }
    }
};
struct EpiF32Res {
    static constexpr bool PERM = false, AFTER_DRAIN = false;
    const float* base; float* out; int ldc;
    __device__ __forceinline__ void operator()(const f32x4 (&acc)[2][2][4][2], const Unit& u, int wr, int wc, int fr, int fq) const {
        const int row0 = u.pm * BM + wr * 64 + fr, col0 = u.pn * BM + wc * 32 + 4 * fq;
#pragma unroll
        for (int ai = 0; ai < 2; ++ai)
#pragma unroll
            for (int m = 0; m < 4; ++m) { const size_t off = (size_t)(row0 + ai * HALF + m * 16) * ldc + col0;
                f32x4 bs[2][2];
#pragma unroll
                for (int bj = 0; bj < 2; ++bj)
#pragma unroll
                    for (int n = 0; n < 2; ++n) bs[bj][n] = *(const f32x4*)(base + off + bj * HALF + n * 16);
#pragma unroll
                for (int bj = 0; bj < 2; ++bj)
#pragma unroll
                    for (int n = 0; n < 2; ++n) *(f32x4*)(out + off + bj * HALF + n * 16) = bs[bj][n] + acc[ai][bj][m][n];
                asm volatile("" ::: "memory"); }
    }
};
template <class Epi, class Sched, bool ALIGN_EPI = false, bool SP2 = false>
__device__ __forceinline__ void gemm_phase(PG8_LAS unsigned char* lds, const Gemm g, const Sched& S, const Epi& E) {
    const int tid = threadIdx.x, wid = __builtin_amdgcn_readfirstlane(tid >> 6), lane = tid & 63, wr = wid >> 2, wc = wid & 3, fr = lane & 15, fq = lane >> 4;
    const int K = g.K, nt = K / BK;
    unsigned voffA[2], voffB[2];
#pragma unroll
    for (int i = 0; i < 2; ++i) { int R, C; stage_rc(tid * 16 + i * 8192, R, C); const int Rb = Epi::PERM ? ((R & ~31) + perm32(R & 31)) : R;
        voffA[i] = (unsigned)(R * K + C) * 2u; voffB[i] = (unsigned)(Rb * K + C) * 2u; }
    const size_t kstep = (size_t)(BK * 2);
    const size_t hstep = (size_t)HALF * K * 2;
    const size_t tstep = 2 * hstep;
    const unsigned ldsw = (unsigned)wid * 1024u;
    const int aoff = lds_byte(wr * 64 + fr, fq * 8), boff = lds_byte(wc * 32 + fr, fq * 8);
#define PG8_SA(b, h) (((b) * 2 + (h)) * HTB)
#define PG8_SB(b, h) ((4 + (b) * 2 + (h)) * HTB)
#define PG8_STAGE(bufoff, gbase, voff) do { _Pragma("unroll") for (int _i = 0; _i < 2; ++_i) \
        __builtin_amdgcn_global_load_lds((const unsigned*)((const char*)(gbase) + (voff)[_i]), (PG8_LAS unsigned*)(lds + (bufoff) + ldsw + _i * 8192), 16, 0, 0); } while (0)
#define PG8_LDA(dst, b, h) do { _Pragma("unroll") for (int m = 0; m < 4; ++m) _Pragma("unroll") for (int k = 0; k < 2; ++k) dst[m][k] = *(const PG8_LAS bf16x8*)(lds + PG8_SA(b, h) + aoff + m * 2048 + k * 1024); } while (0)
#define PG8_LDB(dst, b, h) do { _Pragma("unroll") for (int n = 0; n < 2; ++n) _Pragma("unroll") for (int k = 0; k < 2; ++k) dst[n][k] = *(const PG8_LAS bf16x8*)(lds + PG8_SB(b, h) + boff + n * 2048 + k * 1024); } while (0)
#define PG8_MMA(ai, bj, At, Bt) do { __builtin_amdgcn_s_setprio(1); _Pragma("unroll") for (int m = 0; m < 4; ++m) _Pragma("unroll") for (int n = 0; n < 2; ++n) _Pragma("unroll") for (int k = 0; k < 2; ++k) \
        acc[ai][bj][m][n] = __builtin_amdgcn_mfma_f32_16x16x32_bf16(Bt[n][k], At[m][k], acc[ai][bj][m][n], 0, 0, 0); __builtin_amdgcn_s_setprio(0); } while (0)
#define PG8_WAIT_V(n) asm volatile("s_waitcnt vmcnt(" #n ")" ::: "memory")
#define PG8_WAIT_L(n) asm volatile("s_waitcnt lgkmcnt(" #n ")" ::: "memory")
#define PG8_BAR __builtin_amdgcn_s_barrier()
#define PG8_SCHED __builtin_amdgcn_sched_barrier(0)
    Unit cur, nxt; int ui = 0;
    if (!S.next(0, cur)) return;
    f32x4 acc[2][2][4][2];
#pragma unroll
    for (int a = 0; a < 2; ++a)
#pragma unroll
        for (int b = 0; b < 2; ++b)
#pragma unroll
            for (int m = 0; m < 4; ++m)
#pragma unroll
                for (int n = 0; n < 2; ++n) acc[a][b][m][n] = (f32x4){0.f, 0.f, 0.f, 0.f};
    bf16x8 At[4][2], B0[2][2], B1[2][2];
    const char* cA = (const char*)g.A + (size_t)cur.pm * tstep; const char* cB = (const char*)g.Bt + (size_t)cur.pn * tstep;
    S.a_ready(cur);
    if constexpr (SP2) {
        PG8_STAGE(PG8_SB(0, 0), cB, voffB); PG8_STAGE(PG8_SB(0, 1), cB + hstep, voffB); PG8_STAGE(PG8_SA(0, 0), cA, voffA); PG8_STAGE(PG8_SA(0, 1), cA + hstep, voffA);
        if (wr == 1) PG8_BAR;
        PG8_WAIT_V(2); PG8_BAR;
        PG8_STAGE(PG8_SB(1, 0), cB + kstep, voffB); PG8_STAGE(PG8_SA(1, 0), cA + kstep, voffA); PG8_STAGE(PG8_SB(1, 1), cB + hstep + kstep, voffB);
        PG8_WAIT_V(6); PG8_BAR;
    } else {
        PG8_STAGE(PG8_SB(0, 0), cB, voffB); PG8_STAGE(PG8_SA(0, 0), cA, voffA); PG8_STAGE(PG8_SB(0, 1), cB + hstep, voffB); PG8_STAGE(PG8_SA(0, 1), cA + hstep, voffA);
        if (wr == 1) PG8_BAR;
        PG8_WAIT_V(4); PG8_BAR;
        PG8_STAGE(PG8_SB(1, 0), cB + kstep, voffB); PG8_STAGE(PG8_SA(1, 0), cA + kstep, voffA); PG8_STAGE(PG8_SB(1, 1), cB + hstep + kstep, voffB);
        PG8_WAIT_V(6); PG8_BAR;
    }
    for (;;) {
        const bool has_next = S.next(ui + 1, nxt);
        const char* nA = has_next ? (const char*)g.A + (size_t)nxt.pm * tstep : cA; const char* nB = has_next ? (const char*)g.Bt + (size_t)nxt.pn * tstep : cB;
        for (int t = 0; t < nt; t += 2) {
            const bool last = (t == nt - 2);
            const char* a1 = cA + (size_t)(t + 1) * kstep;
            const char* a2 = last ? nA : cA + (size_t)(t + 2) * kstep; const char* b2 = last ? nB : cB + (size_t)(t + 2) * kstep;
            const char* a3 = a2 + kstep; const char* b3 = b2 + kstep;
            if (last && has_next) S.a_ready(nxt);
            if constexpr (SP2) {
            PG8_LDB(B0, 0, 0); PG8_LDB(B1, 0, 1); PG8_SCHED; PG8_LDA(At, 0, 0); PG8_STAGE(PG8_SA(1, 1), a1 + hstep, voffA);
            PG8_WAIT_V(8); PG8_WAIT_L(0); PG8_BAR; PG8_MMA(0, 0, At, B0); PG8_MMA(0, 1, At, B1); PG8_BAR; PG8_SCHED;
            PG8_LDA(At, 0, 1); PG8_STAGE(PG8_SB(0, 0), b2, voffB); PG8_STAGE(PG8_SB(0, 1), b2 + hstep, voffB); PG8_STAGE(PG8_SA(0, 0), a2, voffA);
            PG8_WAIT_V(8); PG8_WAIT_L(0); PG8_BAR; PG8_MMA(1, 0, At, B0); PG8_MMA(1, 1, At, B1); PG8_BAR; PG8_SCHED;
            PG8_LDB(B0, 1, 0); PG8_LDB(B1, 1, 1); PG8_SCHED; PG8_LDA(At, 1, 0); PG8_STAGE(PG8_SA(0, 1), a2 + hstep, voffA);
            PG8_WAIT_V(8); PG8_WAIT_L(0); PG8_BAR; PG8_MMA(0, 0, At, B0); PG8_MMA(0, 1, At, B1); PG8_BAR; PG8_SCHED;
            PG8_LDA(At, 1, 1); PG8_STAGE(PG8_SB(1, 0), b3, voffB); PG8_STAGE(PG8_SB(1, 1), b3 + hstep, voffB); PG8_STAGE(PG8_SA(1, 0), a3, voffA);
            PG8_WAIT_V(8); PG8_WAIT_L(0); PG8_BAR; PG8_MMA(1, 0, At, B0); PG8_MMA(1, 1, At, B1); PG8_BAR; PG8_SCHED;
            } else {
            PG8_LDB(B0, 0, 0); PG8_SCHED; PG8_LDA(At, 0, 0); PG8_STAGE(PG8_SA(1, 1), a1 + hstep, voffA);
            PG8_WAIT_L(8); PG8_BAR; PG8_WAIT_L(0); PG8_MMA(0, 0, At, B0); PG8_BAR; PG8_SCHED;
            PG8_LDB(B1, 0, 1); PG8_STAGE(PG8_SB(0, 0), b2, voffB);
            PG8_BAR; PG8_WAIT_L(0); PG8_MMA(0, 1, At, B1); PG8_BAR;
            PG8_LDA(At, 0, 1); PG8_STAGE(PG8_SA(0, 0), a2, voffA);
            PG8_BAR; PG8_WAIT_L(0); PG8_MMA(1, 0, At, B0); PG8_BAR; PG8_SCHED;
            PG8_STAGE(PG8_SB(0, 1), b2 + hstep, voffB);
            PG8_WAIT_V(6); PG8_BAR; PG8_MMA(1, 1, At, B1); PG8_BAR;
            PG8_LDB(B0, 1, 0); PG8_SCHED; PG8_LDA(At, 1, 0); PG8_STAGE(PG8_SA(0, 1), a2 + hstep, voffA);
            PG8_WAIT_L(8); PG8_BAR; PG8_WAIT_L(0); PG8_MMA(0, 0, At, B0); PG8_BAR; PG8_SCHED;
            PG8_LDB(B1, 1, 1); PG8_STAGE(PG8_SB(1, 0), b3, voffB);
            PG8_BAR; PG8_WAIT_L(0); PG8_MMA(0, 1, At, B1); PG8_BAR;
            PG8_LDA(At, 1, 1); PG8_STAGE(PG8_SA(1, 0), a3, voffA);
            PG8_BAR; PG8_WAIT_L(0); PG8_MMA(1, 0, At, B0); PG8_BAR; PG8_SCHED;
            PG8_STAGE(PG8_SB(1, 1), b3 + hstep, voffB);
            PG8_WAIT_V(6); PG8_BAR; PG8_MMA(1, 1, At, B1); PG8_BAR;
            }
        }
        if constexpr (ALIGN_EPI) { if (wr == 0) PG8_BAR; }
        if constexpr (!Epi::AFTER_DRAIN) { E(acc, cur, wr, wc, fr, fq); S.done(cur); }
        if (!has_next) break;
#pragma unroll
        for (int a = 0; a < 2; ++a)
#pragma unroll
            for (int b = 0; b < 2; ++b)
#pragma unroll
                for (int m = 0; m < 4; ++m)
#pragma unroll
                    for (int n = 0; n < 2; ++n) acc[a][b][m][n] = (f32x4){0.f, 0.f, 0.f, 0.f};
        cur = nxt; cA = nA; cB = nB; ++ui;
        if constexpr (ALIGN_EPI) { if (wr == 1) PG8_BAR; }
    }
    PG8_WAIT_V(0);
    if constexpr (!ALIGN_EPI) { if (wr == 0) PG8_BAR; }
    PG8_BAR;
    if constexpr (Epi::AFTER_DRAIN) { E.fused(acc, cur, wr, wc, fr, fq, lds, wid, lane); S.done(cur); }
#undef PG8_SA
#undef PG8_SB
#undef PG8_STAGE
#undef PG8_LDA
#undef PG8_LDB
#undef PG8_MMA
#undef PG8_WAIT_V
#undef PG8_WAIT_L
#undef PG8_BAR
#undef PG8_SCHED
}
}
#ifndef PG8_SP2
#define PG8_SP2 true
#endif
#ifndef PG8_ALIGN
#define PG8_ALIGN false
#endif
#ifndef MK_PER_PHASE
#define MK_PER_PHASE 0
#endif
constexpr int NWAVES = 8;
constexpr int NB = 4, T = 8192, D = 1024, M = NB * T, FF = 4096;
constexpr int NE = 2304;
constexpr int NO = 3328;
constexpr int N_PHASES = 19;
constexpr size_t MiB = 1u << 20;
constexpr size_t WS_CTL = 0, CTL_ZERO_BYTES = 64 * 1024;
constexpr size_t WS_ROPE = 1 * MiB, WS_LORA = 2 * MiB, WS_G0 = 3 * MiB, WS_DT = 4 * MiB, WS_MLS = 5 * MiB, WS_DEC = 6 * MiB;
constexpr size_t WS_WINE = 8 * MiB, WS_WOUTE = 13 * MiB, WS_WUP0 = 15 * MiB, WS_WDN0 = 23 * MiB, WS_WINO = 31 * MiB, WS_WOUTO = 38 * MiB, WS_WUP1 = 40 * MiB, WS_WDN1 = 48 * MiB;
constexpr size_t WS_XN = 56 * MiB;
constexpr size_t WS_R1 = 120 * MiB;
constexpr size_t WS_GF = WS_R1 + 208 * MiB;
constexpr size_t WS_Y = 376 * MiB;
constexpr size_t WS_HS = 440 * MiB;
constexpr size_t WS_END = 504 * MiB;
constexpr int CW_BAR = 1024;
constexpr int LDS_MAIN = 155648, LDSCTL_OFF = LDS_MAIN, LDS_BYTES = LDS_MAIN + 1024;

#define GAS __attribute__((address_space(1)))
#define LAS __attribute__((address_space(3)))
typedef unsigned short bf16;
typedef unsigned v4u __attribute__((ext_vector_type(4)));
typedef unsigned v2u __attribute__((ext_vector_type(2)));
typedef float f32x4 __attribute__((ext_vector_type(4)));
typedef short bf16x8 __attribute__((ext_vector_type(8)));
typedef GAS unsigned gu32;
#define RLX_AGENT __ATOMIC_RELAXED, __HIP_MEMORY_SCOPE_AGENT
#define LDS_WAIT() asm volatile("s_waitcnt lgkmcnt(0)" ::: "memory")
#define VM_WAIT() asm volatile("s_waitcnt vmcnt(0)" ::: "memory")
__device__ __forceinline__ unsigned f2bf(float f) { unsigned u = __builtin_bit_cast(unsigned, f); return (u + 0x7fffu + ((u >> 16) & 1u)) >> 16; }
typedef float f32x2_t __attribute__((ext_vector_type(2)));
typedef __bf16 bf16x2_t __attribute__((ext_vector_type(2)));
__device__ __forceinline__ unsigned pk2(float lo, float hi) { const f32x2_t v = {lo, hi}; const bf16x2_t b = __builtin_convertvector(v, bf16x2_t); return __builtin_bit_cast(unsigned, b); }
__device__ __forceinline__ float bflo(unsigned w) { return __builtin_bit_cast(float, w << 16); }
__device__ __forceinline__ float bfhi(unsigned w) { return __builtin_bit_cast(float, w & 0xffff0000u); }
__device__ __forceinline__ float bf1(bf16 v) { return __builtin_bit_cast(float, (unsigned)v << 16); }
__device__ __forceinline__ void unpack8(const v4u w, float (&x)[8]) { x[0] = bflo(w.x); x[1] = bfhi(w.x); x[2] = bflo(w.y); x[3] = bfhi(w.y); x[4] = bflo(w.z); x[5] = bfhi(w.z); x[6] = bflo(w.w); x[7] = bfhi(w.w); }
__device__ __forceinline__ v4u pack8(const float (&x)[8]) { v4u w; w.x = pk2(x[0], x[1]); w.y = pk2(x[2], x[3]); w.z = pk2(x[4], x[5]); w.w = pk2(x[6], x[7]); return w; }
__device__ __forceinline__ bf16x8 frag8(const f32x4 a, const f32x4 b) { v4u w; w.x = pk2(a[0], a[1]); w.y = pk2(a[2], a[3]); w.z = pk2(b[0], b[1]); w.w = pk2(b[2], b[3]); return __builtin_bit_cast(bf16x8, w); }
__device__ __forceinline__ bf16x8 frag2(const v2u lo, const v2u hi) { v4u w; w.x = lo.x; w.y = lo.y; w.z = hi.x; w.w = hi.y; return __builtin_bit_cast(bf16x8, w); }
__device__ __forceinline__ f32x4 mfma16(bf16x8 a, bf16x8 b, f32x4 c) { return __builtin_amdgcn_mfma_f32_16x16x32_bf16(a, b, c, 0, 0, 0); }
__device__ __forceinline__ float sigmoidf_(float x) { return 1.f / (1.f + __expf(-x)); }
__device__ __forceinline__ float siluf_(float x) { return x / (1.f + __expf(-x)); }
__device__ __forceinline__ float softplusf_(float x) { return fmaxf(x, 0.f) + log1pf(expf(-fabsf(x))); }
__device__ __forceinline__ float wave_sum(float v) {
#pragma unroll
    for (int o = 1; o < 64; o <<= 1) v += __shfl_xor(v, o);
    return v;
}
__device__ __forceinline__ float wave_max(float v) {
#pragma unroll
    for (int o = 1; o < 64; o <<= 1) v = fmaxf(v, __shfl_xor(v, o));
    return v;
}
__device__ __forceinline__ float quad_sum(float v) { v += __shfl_xor(v, 16); v += __shfl_xor(v, 32); return v; }
__device__ __forceinline__ float quad_max(float v) { v = fmaxf(v, __shfl_xor(v, 16)); v = fmaxf(v, __shfl_xor(v, 32)); return v; }
__device__ __forceinline__ float scan_add(float v, int lane) {
#pragma unroll
    for (int o = 1; o < 64; o <<= 1) { const float t = __shfl_up(v, o); if (lane >= o) v += t; }
    return v;
}
__device__ __forceinline__ float scan_max(float v, int lane) {
#pragma unroll
    for (int o = 1; o < 64; o <<= 1) { const float t = __shfl_up(v, o); if (lane >= o) v = fmaxf(v, t); }
    return v;
}

template <int NT> __device__ __forceinline__ void load_rows(const bf16* base, int ld, int tt0, v4u (&raw)[NT + 3]) {
#pragma unroll
    for (int i = 0; i < NT + 3; ++i) { const int t2 = tt0 - 3 + i; raw[i] = (t2 >= 0) ? *(const v4u*)(base + (ptrdiff_t)t2 * ld) : (v4u){0u, 0u, 0u, 0u}; }
}
template <int NT> __device__ __forceinline__ void conv_silu(const v4u (&raw)[NT + 3], const float* convw, int wstride, const float* convb, float (&out)[NT][8]) {
    float w[4][8], bb[8];
#pragma unroll
    for (int tap = 0; tap < 4; ++tap) { const f32x4 w0 = *(const f32x4*)(convw + tap * wstride), w1 = *(const f32x4*)(convw + tap * wstride + 4);
        w[tap][0] = w0.x; w[tap][1] = w0.y; w[tap][2] = w0.z; w[tap][3] = w0.w; w[tap][4] = w1.x; w[tap][5] = w1.y; w[tap][6] = w1.z; w[tap][7] = w1.w; }
    { const f32x4 b0 = *(const f32x4*)convb, b1 = *(const f32x4*)(convb + 4); bb[0] = b0.x; bb[1] = b0.y; bb[2] = b0.z; bb[3] = b0.w; bb[4] = b1.x; bb[5] = b1.y; bb[6] = b1.z; bb[7] = b1.w; }
#pragma unroll
    for (int i = 0; i < NT; ++i)
#pragma unroll
        for (int e = 0; e < 8; ++e) out[i][e] = bb[e];
#pragma unroll
    for (int j = 0; j < NT + 3; ++j) { float x[8]; unpack8(raw[j], x);
#pragma unroll
        for (int tap = 0; tap < 4; ++tap) { const int i = j - tap;
            if (i >= 0 && i < NT) {
#pragma unroll
                for (int e = 0; e < 8; ++e) out[i][e] += x[e] * w[tap][e]; } } }
#pragma unroll
    for (int i = 0; i < NT; ++i)
#pragma unroll
        for (int e = 0; e < 8; ++e) out[i][e] = siluf_(out[i][e]);
}
#define XB_TMO      128
#define XB_XCNT(j)  (256  + 64 * (j))
#define XB_XSUB(j)  (1280 + 64 * (j))
#define XB_XGEN(j)  (2304 + 64 * (j))
#define XB_TOP      3328
#define XB_TOPGEN   3392
#define XCD_BAR_WORDS 3456
#define XB_SPIN_CAP (1u << 18)

__device__ __forceinline__ unsigned xb_ld(unsigned* p)              { return __hip_atomic_load(p, __ATOMIC_RELAXED, __HIP_MEMORY_SCOPE_AGENT); }
__device__ __forceinline__ unsigned xb_add(unsigned* p, unsigned v) { return __hip_atomic_fetch_add(p, v, __ATOMIC_RELAXED, __HIP_MEMORY_SCOPE_AGENT); }
__device__ __forceinline__ unsigned xb_xcc_id() { return (unsigned)__builtin_amdgcn_s_getreg((3 << 11) | 20) & 0xFu; }
#define XB_SPIN(cond, bar) do { unsigned _sp = 0; while (cond) { __builtin_amdgcn_s_sleep(1); \
    if ((++_sp & 255u) == 0u) { if (xb_ld(&(bar)[XB_TMO])) break; if (_sp > XB_SPIN_CAP) { atomicAdd(&(bar)[XB_TMO], 1u); break; } } } } while (0)

struct XcdBarrier {
    unsigned* bar; unsigned x;
    volatile LAS unsigned* st;
};

__device__ __forceinline__ XcdBarrier xcd_barrier_post(unsigned* bar, volatile LAS unsigned* st) {
    XcdBarrier b; b.bar = bar; b.x = xb_xcc_id(); b.st = st;
    if (threadIdx.x == 0) (void)xb_add(&bar[XB_XCNT(b.x)], 1u);
    return b;
}
__device__ __forceinline__ void xcd_barrier_complete(unsigned* bar, unsigned x, unsigned& nloc, unsigned& nx) {
    const unsigned G = gridDim.x * gridDim.y * gridDim.z;
    unsigned sum, cnt, mine, sp = 0u;
    for (;;) {
        sum = 0u; cnt = 0u; mine = 0u;
#pragma unroll
        for (unsigned j = 0; j < 16; ++j) { const unsigned c = xb_ld(&bar[XB_XCNT(j)]); sum += c; cnt += (c > 0u) ? 1u : 0u; mine = (j == x) ? c : mine; }
        if (sum == G) break;
        __builtin_amdgcn_s_sleep(1);
        if ((++sp & 255u) == 0u) { if (xb_ld(&bar[XB_TMO])) break; if (sp > XB_SPIN_CAP) { atomicAdd(&bar[XB_TMO], 1u); break; } }
    }
    nloc = mine > 0u ? mine : 1u; nx = cnt > 0u ? cnt : 1u;
}

__device__ __forceinline__ void xcd_barrier(const XcdBarrier& b) {
    asm volatile("s_waitcnt vmcnt(0)" ::: "memory");
    __syncthreads();
    if (threadIdx.x == 0) {
        unsigned* bar = b.bar;
        __builtin_amdgcn_s_waitcnt(0);
        unsigned nloc = b.st[0], nx = b.st[1];
        if (nloc == 0u) { xcd_barrier_complete(bar, b.x, nloc, nx); b.st[0] = nloc; b.st[1] = nx; }
        const unsigned old = xb_add(&bar[XB_XSUB(b.x)], 1u);
        const unsigned gen = old / nloc;
        if (old + 1u == (gen + 1u) * nloc) {
            __builtin_amdgcn_fence(__ATOMIC_RELEASE, "agent");
            asm volatile("s_waitcnt vmcnt(0)" ::: "memory");
            const unsigned og = xb_add(&bar[XB_TOP], 1u);
            const unsigned tg = og / nx;
            if (og + 1u == (tg + 1u) * nx) xb_add(&bar[XB_TOPGEN], 1u);
            else XB_SPIN(xb_ld(&bar[XB_TOPGEN]) == tg, bar);
            __builtin_amdgcn_fence(__ATOMIC_ACQUIRE, "agent");
            xb_add(&bar[XB_XGEN(b.x)], 1u);
            asm volatile("s_waitcnt vmcnt(0)" ::: "memory");
        } else {
            XB_SPIN(xb_ld(&bar[XB_XGEN(b.x)]) == gen, bar);
            __builtin_amdgcn_fence(__ATOMIC_ACQUIRE, "agent");
            asm volatile("s_waitcnt vmcnt(0)" ::: "memory");
        }
    }
    __syncthreads();
}
__device__ __forceinline__ void p0_transpose_item(const float* W, int K, int ldw, int n_src0, bf16* WT, int row_dst0, int nblk, LAS float* scr, int item, int lane) {
    const int kb = item / nblk, nb = item % nblk, k0 = 64 * kb, n0 = 32 * nb;
#pragma unroll 8
    for (int i = 0; i < 32; ++i) { const int kk = 2 * i + (lane >> 5); scr[kk * 33 + (lane & 31)] = W[(size_t)(k0 + kk) * ldw + n_src0 + n0 + (lane & 31)]; }
    LDS_WAIT(); asm volatile("" ::: "memory");
    const int c = lane & 7;
#pragma unroll
    for (int j = 0; j < 4; ++j) { const int n = (lane >> 3) + 8 * j; const LAS float* s = scr + (8 * c) * 33 + n;
        v4u o; o.x = pk2(s[0 * 33], s[1 * 33]); o.y = pk2(s[2 * 33], s[3 * 33]); o.z = pk2(s[4 * 33], s[5 * 33]); o.w = pk2(s[6 * 33], s[7 * 33]);
        *(GAS v4u*)(WT + (size_t)(row_dst0 + n0 + n) * K + k0 + 8 * c) = o; }
    LDS_WAIT(); asm volatile("" ::: "memory");
}
struct TrJob { const float* W; int K, ldw, n_src0; bf16* WT; int row_dst0, nblk, nitems; };
__device__ __forceinline__ void p0_prologue(const float* const* in, unsigned char* ws, LAS unsigned char* lds, int tid, int G) {
    const int lane = tid & 63, wave = tid >> 6;
    LAS float* scr = (LAS float*)(lds + wave * 16384);
    const int gw = blockIdx.x * NWAVES + wave, NGW = G * NWAVES;
#define TRJ(Wp, K_, ldw_, s0_, dst_, r0_, ncols_) { int nblk_ = (ncols_) / 32; int ni_ = ((K_) / 64) * nblk_; if (it < ni_) { p0_transpose_item(Wp, K_, ldw_, s0_, (bf16*)(ws + dst_), r0_, nblk_, scr, it, lane); continue; } it -= ni_; }
    constexpr int NITEMS = 16 * 72 + 16 * 32 + 2 * 16 * 128 + 2 * 64 * 32 + 16 * 48 + 16 * 56 + 16 * 32;
    for (int it0 = gw; it0 < NITEMS; it0 += NGW) {
        int it = it0;
        TRJ(in[5], 1024, 2312, 0, WS_WINE, 0, 2304)
        TRJ(in[6], 1024, 1024, 0, WS_WOUTE, 0, 1024)
        TRJ(in[3], 1024, 4096, 0, WS_WUP0, 0, 4096)
        TRJ(in[3] + (size_t)1024 * 4096, 1024, 4096, 0, WS_WUP1, 0, 4096)
        TRJ(in[4], 4096, 1024, 0, WS_WDN0, 0, 1024)
        TRJ(in[4] + (size_t)4096 * 1024, 4096, 1024, 0, WS_WDN1, 0, 1024)
        TRJ(in[13], 1024, 3336, 0, WS_WINO, 0, 1536)
        TRJ(in[13], 1024, 3336, 1544, WS_WINO, 1536, 1792)
        TRJ(in[14], 1024, 1024, 0, WS_WOUTO, 0, 1024)
    }
#undef TRJ
    const int gt = blockIdx.x * 512 + tid, NGT = G * 512;
    bf16* w2t = (bf16*)(ws + WS_LORA); bf16* a2t = w2t + 512 * 64; bf16* g2t = a2t + 512 * 64;
    for (int i = gt; i < 512 * 64; i += NGT) { const int n = i >> 6, j = i & 63; w2t[i] = (bf16)f2bf(in[23][j * 512 + n]); a2t[i] = (bf16)f2bf(in[25][j * 512 + n]); }
    for (int i = gt; i < 512 * 128; i += NGT) { const int n = i >> 7, j = i & 127; g2t[i] = (bf16)f2bf(in[26][j * 512 + n]); }
    float2* rope = (float2*)(ws + WS_ROPE);
    for (int i = gt; i < T * 8; i += NGT) { const int t = i >> 3, d = i & 7; const float inv = powf(500000.0f, -(float)d * 0.125f); const float ang = (float)t * inv; rope[i] = make_float2(cosf(ang), sinf(ang)); }
}
template <int MODE>
__device__ __forceinline__ void norm_phase(const float* src, const float* gain, bf16* dst, float* dstf, const float* gw, int ldg, float* gout, LAS unsigned char* lds, int tid, int G) {
    const int lane = tid & 63, wave = tid >> 6;
    LAS float* Wg = (LAS float*)lds;
    if (MODE == 1) { for (int i = tid; i < 8192; i += 512) { const int k = i >> 3, j = i & 7; Wg[j * 1024 + k] = gw[(size_t)k * ldg + j]; } __syncthreads(); }
    f32x4 gv[4];
#pragma unroll
    for (int j = 0; j < 4; ++j) gv[j] = *(const f32x4*)(gain + 4 * lane + 256 * j);
    for (int m = blockIdx.x * NWAVES + wave; m < M; m += G * NWAVES) {
        const f32x4* xr = (const f32x4*)(src + (size_t)m * D) + lane;
        f32x4 v[4]; float s = 0.f;
#pragma unroll
        for (int j = 0; j < 4; ++j) { v[j] = xr[64 * j]; s += (v[j].x * v[j].x + v[j].y * v[j].y) + (v[j].z * v[j].z + v[j].w * v[j].w); }
        const float rs = 1.0f / sqrtf(wave_sum(s) * (1.f / D) + 1e-5f);
#pragma unroll
        for (int j = 0; j < 4; ++j) v[j] = v[j] * rs * gv[j];
        if (MODE == 2) {
            f32x4* o = (f32x4*)(dstf + (size_t)m * D) + lane;
#pragma unroll
            for (int j = 0; j < 4; ++j) o[64 * j] = v[j];
        } else {
            v2u* o = (v2u*)(dst + (size_t)m * D) + lane;
#pragma unroll
            for (int j = 0; j < 4; ++j) { v2u w; w.x = pk2(v[j].x, v[j].y); w.y = pk2(v[j].z, v[j].w); o[64 * j] = w; }
        }
        if (MODE == 1) {
            float g8[8];
#pragma unroll
            for (int q = 0; q < 8; ++q) { float a = 0.f;
#pragma unroll
                for (int j = 0; j < 4; ++j) { const f32x4 w = *(const LAS f32x4*)(Wg + q * 1024 + 4 * lane + 256 * j); a += (v[j].x * w.x + v[j].y * w.y) + (v[j].z * w.z + v[j].w * w.w); }
                g8[q] = wave_sum(a); }
            if (lane == 0) { f32x4* o = (f32x4*)(gout + (size_t)m * 8); o[0] = (f32x4){g8[0], g8[1], g8[2], g8[3]}; o[1] = (f32x4){g8[4], g8[5], g8[6], g8[7]}; }
        }
    }
}
__device__ __forceinline__ void attn_unit(int u, const bf16* P, const float2* rope, const float* sinks, bf16* Y, LAS unsigned char* lds, int tid) {
    asm volatile("" : "+v"(tid));
    const int lane = tid & 63, wave = __builtin_amdgcn_readfirstlane(tid >> 6), fr = lane & 15, fq = lane >> 4;
    const int blk = u & 63, kvh = (u >> 6) & 1, b = u >> 7;
    LAS bf16* Ks = (LAS bf16*)lds;
    LAS bf16* Vt = Ks + 256 * 72;
    const int tok0 = blk * 128 - 128;
    const int g = wave >> 1, half = wave & 1, hq = kvh * 4 + g;
    v4u qn0, qn1, qnp;
    { const int tq = blk * 128 + (half * 4) * 16 + fr; const bf16* qsrc = P + (size_t)(b * T + tq) * NE + hq * 64;
      qn0 = *(const v4u*)(qsrc + 8 * fq); qn1 = *(const v4u*)(qsrc + 32 + 8 * fq); qnp = *(const v4u*)(qsrc + 8 * ((fq ^ 1) & 1)); }
    {
        const int c = tid & 7;
        v4u vv[4], k0[4], k1[4];
#pragma unroll
        for (int j = 0; j < 4; ++j) { const int r = (tid >> 3) + 64 * j, t = tok0 + r; const bf16* src = P + (size_t)(b * T + (t < 0 ? 0 : t)) * NE;
            vv[j] = (v4u){0u, 0u, 0u, 0u}; k0[j] = vv[j]; k1[j] = vv[j];
            if (t >= 0) { vv[j] = *(const v4u*)(src + 640 + kvh * 64 + c * 8); if (c != 1) k0[j] = *(const v4u*)(src + 512 + kvh * 64 + c * 8); if (c == 0) k1[j] = *(const v4u*)(src + 512 + kvh * 64 + 8); } }
#pragma unroll
        for (int j = 0; j < 4; ++j) { const int r = (tid >> 3) + 64 * j, t = tok0 + r;
#pragma unroll
            for (int e = 0; e < 8; ++e) Vt[(c * 8 + e) * 264 + r] = (bf16)(vv[j][e >> 1] >> ((e & 1) * 16));
            if (c == 0) {
                float x1[8], x2[8], o1[8], o2[8]; unpack8(k0[j], x1); unpack8(k1[j], x2);
                const float2* cs = rope + (size_t)(t < 0 ? 0 : t) * 8;
#pragma unroll
                for (int e = 0; e < 8; ++e) { const float2 q = cs[e]; o1[e] = x1[e] * q.x - x2[e] * q.y; o2[e] = x2[e] * q.x + x1[e] * q.y; }
                *(LAS v4u*)(Ks + r * 72) = pack8(o1); *(LAS v4u*)(Ks + r * 72 + 8) = pack8(o2);
            } else if (c != 1) *(LAS v4u*)(Ks + r * 72 + c * 8) = k0[j]; }
    }
    __syncthreads();
    const float sink = sinks[hq];
#pragma unroll 1
    for (int a = 0; a < 4; ++a) {
        const int ag = half * 4 + a, i = ag * 16 + fr, tq = blk * 128 + i;
        float x0[8], x1v[8];
        const v4u qc0 = qn0, qc1 = qn1, qcp = qnp;
        if (a < 3) { const bf16* qsrc = P + (size_t)(b * T + tq + 16) * NE + hq * 64; qn0 = *(const v4u*)(qsrc + 8 * fq); qn1 = *(const v4u*)(qsrc + 32 + 8 * fq); qnp = *(const v4u*)(qsrc + 8 * ((fq ^ 1) & 1)); }
        unpack8(qc0, x0); unpack8(qc1, x1v);
        if (fq < 2) {
            float xp[8]; unpack8(qcp, xp);
            const float2* cs = rope + (size_t)tq * 8;
#pragma unroll
            for (int e = 0; e < 8; ++e) { const float2 q = cs[e]; x0[e] = (fq == 0) ? (x0[e] * q.x - xp[e] * q.y) : (x0[e] * q.x + xp[e] * q.y); }
        }
#pragma unroll
        for (int e = 0; e < 8; ++e) { x0[e] *= 0.125f; x1v[e] *= 0.125f; }
        bf16x8 qf[2]; qf[0] = __builtin_bit_cast(bf16x8, pack8(x0)); qf[1] = __builtin_bit_cast(bf16x8, pack8(x1v));
        const int kt0 = ag < 6 ? ag : 6;
        f32x4 sacc[10];
#pragma unroll
        for (int j = 0; j < 10; ++j) { f32x4 acc = (f32x4){0.f, 0.f, 0.f, 0.f};
#pragma unroll
            for (int s = 0; s < 2; ++s) { const bf16x8 A = *(const LAS bf16x8*)(Ks + (16 * (kt0 + j) + fr) * 72 + 32 * s + 8 * fq); acc = mfma16(A, qf[s], acc); }
            sacc[j] = acc; }
        float mx = sink;
#pragma unroll
        for (int j = 0; j < 10; ++j)
#pragma unroll
            for (int r = 0; r < 4; ++r) { const int key = 16 * (kt0 + j) + 4 * fq + r; const bool valid = (key > i) && (key <= i + 128) && (blk > 0 || key >= 128);
                sacc[j][r] = valid ? sacc[j][r] : -INFINITY; mx = fmaxf(mx, sacc[j][r]); }
        mx = quad_max(mx);
        float sum = 0.f;
#pragma unroll
        for (int j = 0; j < 10; ++j)
#pragma unroll
            for (int r = 0; r < 4; ++r) { const float p = __expf(sacc[j][r] - mx); sacc[j][r] = p; sum += p; }
        sum = quad_sum(sum) + __expf(sink - mx);
        f32x4 o[4];
#pragma unroll
        for (int dt = 0; dt < 4; ++dt) o[dt] = (f32x4){0.f, 0.f, 0.f, 0.f};
#pragma unroll
        for (int jp = 0; jp < 5; ++jp) { const bf16x8 Bf = frag8(sacc[2 * jp], sacc[2 * jp + 1]);
#pragma unroll
            for (int dt = 0; dt < 4; ++dt) { const LAS bf16* vp = Vt + (16 * dt + fr) * 264 + 16 * (kt0 + 2 * jp) + 4 * fq;
                const bf16x8 A = frag2(*(const LAS v2u*)vp, *(const LAS v2u*)(vp + 16)); o[dt] = mfma16(A, Bf, o[dt]); } }
        const float inv = 1.f / sum;
        bf16* yo = Y + (size_t)(b * T + tq) * D + hq * 64 + 4 * fq;
#pragma unroll
        for (int dt = 0; dt < 4; ++dt) { v2u w; w.x = pk2(o[dt][0] * inv, o[dt][1] * inv); w.y = pk2(o[dt][2] * inv, o[dt][3] * inv); *(v2u*)(yo + 16 * dt) = w; }
    }
    __syncthreads();
}
__device__ __forceinline__ void ml_conv8(const bf16* P, int b, int tt, int ch, const float* convw, const float* convb, float (&acc)[8]) {
    { const f32x4 b0 = *(const f32x4*)(convb + ch), b1 = *(const f32x4*)(convb + ch + 4); acc[0] = b0.x; acc[1] = b0.y; acc[2] = b0.z; acc[3] = b0.w; acc[4] = b1.x; acc[5] = b1.y; acc[6] = b1.z; acc[7] = b1.w; }
#pragma unroll
    for (int tap = 0; tap < 4; ++tap) { const int t2 = tt - 3 + tap;
        if (t2 >= 0) { float x[8]; unpack8(*(const v4u*)(P + (size_t)(b * T + t2) * NE + 768 + ch), x);
            const f32x4 w0 = *(const f32x4*)(convw + tap * 512 + ch), w1 = *(const f32x4*)(convw + tap * 512 + ch + 4);
            acc[0] += x[0] * w0.x; acc[1] += x[1] * w0.y; acc[2] += x[2] * w0.z; acc[3] += x[3] * w0.w; acc[4] += x[4] * w1.x; acc[5] += x[5] * w1.y; acc[6] += x[6] * w1.z; acc[7] += x[7] * w1.w; } }
#pragma unroll
    for (int e = 0; e < 8; ++e) acc[e] = siluf_(acc[e]);
}
__device__ __forceinline__ void ml_gates(const float* G0, size_t row0, int h, const float* ibias, const float* fbias, int lane, float& b0, float& b1, float& li0, float& li1, float& bL) {
    const float fb = fbias[h], ib = ibias[h];
    const float f0 = G0[(row0 + 2 * lane) * 8 + 4 + h] + fb, f1 = G0[(row0 + 2 * lane + 1) * 8 + 4 + h] + fb;
    li0 = G0[(row0 + 2 * lane) * 8 + h] + ib; li1 = G0[(row0 + 2 * lane + 1) * 8 + h] + ib;
    const float lf0 = -softplusf_(-f0), lf1 = -softplusf_(-f1);
    const float ps = scan_add(lf0 + lf1, lane);
    b1 = ps; b0 = ps - lf1; bL = __shfl(ps, 63);
}
__device__ __forceinline__ void mlstm_local_unit(int u, const bf16* P, const float* G0, const float* convw, const float* convb, const float* ibias, const float* fbias,
                                                 float* CT, float* NL, float* MLs, LAS unsigned char* lds, int tid) {
    asm volatile("" : "+v"(tid));
    const int lane = tid & 63, wave = __builtin_amdgcn_readfirstlane(tid >> 6), fr = lane & 15, fq = lane >> 4;
    const int c = u & 63, h = (u >> 6) & 3, b = u >> 8, bh = b * 4 + h;
    const size_t row0 = (size_t)b * T + c * 128;
    LAS bf16* kT = (LAS bf16*)lds;
    LAS bf16* vT = kT + 64 * 136;
    LAS float* wg = (LAS float*)(vT + 128 * 136);
    if (wave == 0) {
        float b0, b1, li0, li1, bL; ml_gates(G0, row0, h, ibias, fbias, lane, b0, b1, li0, li1, bL);
        const float a0 = bL - b0 + li0, a1 = bL - b1 + li1; const float ml = wave_max(fmaxf(a0, a1));
        wg[2 * lane] = expf(a0 - ml); wg[2 * lane + 1] = expf(a1 - ml);
        if (lane == 0) { MLs[(bh * 64 + c) * 2] = ml; MLs[(bh * 64 + c) * 2 + 1] = bL; }
    }
    __syncthreads();
    if (tid < 256) {
        const int c8 = tid & 7, tg = tid >> 3, ch = 256 + h * 64 + c8 * 8;
        v4u raw[7]; load_rows<4>(P + (size_t)(b * T) * NE + 768 + ch, NE, c * 128 + 4 * tg, raw);
        float o[4][8]; conv_silu<4>(raw, convw + ch, 512, convb + ch, o);
        const f32x4 sc4 = *(const LAS f32x4*)(wg + 4 * tg);
#pragma unroll
        for (int e = 0; e < 8; ++e) { v2u w; w.x = pk2(o[0][e] * 0.125f * sc4.x, o[1][e] * 0.125f * sc4.y); w.y = pk2(o[2][e] * 0.125f * sc4.z, o[3][e] * 0.125f * sc4.w); *(LAS v2u*)(kT + (c8 * 8 + e) * 136 + 4 * tg) = w; }
    } else {
        const int t2 = tid - 256, c8 = t2 & 15, tq = t2 >> 4;
        v4u raw[8];
#pragma unroll
        for (int i = 0; i < 8; ++i) raw[i] = *(const v4u*)(P + (row0 + 8 * tq + i) * NE + 1280 + h * 128 + c8 * 8);
#pragma unroll
        for (int e = 0; e < 8; ++e) { v4u w;
#pragma unroll
            for (int p = 0; p < 4; ++p) { const unsigned lo = (raw[2 * p][e >> 1] >> ((e & 1) * 16)) & 0xffffu, hi = (raw[2 * p + 1][e >> 1] >> ((e & 1) * 16)) & 0xffffu; w[p] = lo | (hi << 16); }
            *(LAS v4u*)(vT + (c8 * 8 + e) * 136 + 8 * tq) = w; }
    }
    __syncthreads();
    if (tid < 64) { float s = 0.f; for (int t = 0; t < 128; ++t) s += bf1(kT[tid * 136 + t]); NL[(size_t)(bh * 64 + c) * 64 + tid] = s; }
    f32x4 acc[4];
#pragma unroll
    for (int k = 0; k < 4; ++k) acc[k] = (f32x4){0.f, 0.f, 0.f, 0.f};
#pragma unroll
    for (int ks = 0; ks < 4; ++ks) { const bf16x8 A = *(const LAS bf16x8*)(vT + (16 * wave + fr) * 136 + 32 * ks + 8 * fq);
#pragma unroll
        for (int k = 0; k < 4; ++k) { const bf16x8 Bf = *(const LAS bf16x8*)(kT + (16 * k + fr) * 136 + 32 * ks + 8 * fq); acc[k] = mfma16(A, Bf, acc[k]); } }
    float* ct = CT + ((size_t)(bh * 64 + c) * 128 + 16 * wave + 4 * fq) * 64 + fr;
#pragma unroll
    for (int k = 0; k < 4; ++k)
#pragma unroll
        for (int r = 0; r < 4; ++r) ct[r * 64 + 16 * k] = acc[k][r];
    __syncthreads();
}
__device__ __forceinline__ void mlstm_scan_phase(float* CT, float* NL, const float* MLs, float* Mprev, int tid, int G) {
    for (int e = blockIdx.x * 512 + tid; e < 16 * 8192; e += G * 512) {
        const int bh = e >> 13, idx = e & 8191; float C = 0.f, n = 0.f, m = 0.f;
        float* cp = CT + (size_t)bh * 64 * 8192 + idx; float* np = NL + (size_t)bh * 64 * 64 + idx;
#pragma unroll 1
        for (int c0 = 0; c0 < 64; c0 += 32) { float cl[32];
#pragma unroll
            for (int c = 0; c < 32; ++c) cl[c] = cp[(size_t)(c0 + c) * 8192];
#pragma unroll
            for (int c = 0; c < 32; ++c) {
                const float ml = MLs[(bh * 64 + c0 + c) * 2], gl = MLs[(bh * 64 + c0 + c) * 2 + 1];
                const float mn = fmaxf(gl + m, ml), fa = __expf(gl + m - mn), fb = __expf(ml - mn);
                cp[(size_t)(c0 + c) * 8192] = C; C = fa * C + fb * cl[c];
                if (idx < 64) { const float nl = np[(c0 + c) * 64]; np[(c0 + c) * 64] = n; n = fa * n + fb * nl; }
                if (idx == 0) Mprev[bh * 64 + c0 + c] = m;
                m = mn; } }
    }
}
__device__ __forceinline__ void mlstm_out_unit(int u, const bf16* P, const float* G0, const float* convw, const float* convb, const float* ibias, const float* fbias, const float* mlnorm,
                                               const float* CT, const float* NL, const float* Mprev, bf16* Y, LAS unsigned char* lds, int tid) {
    asm volatile("" : "+v"(tid));
    const int lane = tid & 63, wave = __builtin_amdgcn_readfirstlane(tid >> 6), fr = lane & 15, fq = lane >> 4;
    const int c = u & 63, h = (u >> 6) & 3, b = u >> 8, bh = b * 4 + h;
    const size_t row0 = (size_t)b * T + c * 128;
    LAS bf16* qs = (LAS bf16*)lds;
    LAS bf16* ks = qs + 128 * 72;
    LAS bf16* vT = ks + 128 * 72;
    LAS bf16* cts = vT + 128 * 136;
    LAS float* bc = (LAS float*)(cts + 128 * 72);
    LAS float* lis = bc + 128; LAS float* mxs = lis + 128; LAS float* npv = mxs + 128;
    if (wave == 0) {
        float b0, b1, li0, li1, bL; ml_gates(G0, row0, h, ibias, fbias, lane, b0, b1, li0, li1, bL);
        const float d0 = li0 - b0, d1 = li1 - b1; const float sm = scan_max(fmaxf(d0, d1), lane); float ex = __shfl_up(sm, 1); if (lane == 0) ex = -INFINITY;
        const float m0 = fmaxf(ex, d0);
        bc[2 * lane] = b0; bc[2 * lane + 1] = b1; lis[2 * lane] = li0; lis[2 * lane + 1] = li1; mxs[2 * lane] = m0; mxs[2 * lane + 1] = sm;
        npv[lane] = NL[(size_t)(bh * 64 + c) * 64 + lane];
    }
    {
        const int isk = tid >> 8, c8 = tid & 7, tg = (tid >> 3) & 31, ch = isk * 256 + h * 64 + c8 * 8;
        v4u raw[7]; load_rows<4>(P + (size_t)(b * T) * NE + 768 + ch, NE, c * 128 + 4 * tg, raw);
        const int vc8 = tid & 15, vtq = tid >> 4;
        v4u vr[4];
#pragma unroll
        for (int i = 0; i < 4; ++i) vr[i] = *(const v4u*)(P + (row0 + 4 * vtq + i) * NE + 1280 + h * 128 + vc8 * 8);
        f32x4 cr[2][2];
#pragma unroll
        for (int j = 0; j < 2; ++j) { const int it = tid + 512 * j, vd = it >> 3, cc8 = it & 7; const float* sp = CT + ((size_t)(bh * 64 + c) * 128 + vd) * 64 + cc8 * 8; cr[j][0] = *(const f32x4*)sp; cr[j][1] = *(const f32x4*)(sp + 4); }
        float o[4][8]; conv_silu<4>(raw, convw + ch, 512, convb + ch, o);
        const float qs_ = isk ? 0.125f : 1.0f;
#pragma unroll
        for (int i = 0; i < 4; ++i) {
#pragma unroll
            for (int e = 0; e < 8; ++e) o[i][e] *= qs_;
            *(LAS v4u*)((isk ? ks : qs) + (4 * tg + i) * 72 + c8 * 8) = pack8(o[i]); }
#pragma unroll
        for (int e = 0; e < 8; ++e) { v2u w;
#pragma unroll
            for (int p = 0; p < 2; ++p) { const unsigned lo = (vr[2 * p][e >> 1] >> ((e & 1) * 16)) & 0xffffu, hi = (vr[2 * p + 1][e >> 1] >> ((e & 1) * 16)) & 0xffffu; w[p] = lo | (hi << 16); }
            *(LAS v2u*)(vT + (vc8 * 8 + e) * 136 + 4 * vtq) = w; }
#pragma unroll
        for (int j = 0; j < 2; ++j) { const int it = tid + 512 * j, vd = it >> 3, cc8 = it & 7; v4u w; w.x = pk2(cr[j][0].x, cr[j][0].y); w.y = pk2(cr[j][0].z, cr[j][0].w); w.z = pk2(cr[j][1].x, cr[j][1].y); w.w = pk2(cr[j][1].z, cr[j][1].w);
            *(LAS v4u*)(cts + vd * 72 + cc8 * 8) = w; }
    }
    __syncthreads();
    {
        const int w = wave, t = 16 * w + fr;
        const float bt = bc[t], mp = Mprev[bh * 64 + c];
        const float il = bt + mp, mt = fmaxf(il, bt + mxs[t]), winter = __expf(il - mt);
        bf16x8 qf[2]; qf[0] = *(const LAS bf16x8*)(qs + t * 72 + 8 * fq); qf[1] = *(const LAS bf16x8*)(qs + t * 72 + 32 + 8 * fq);
        f32x4 p[8]; float den = 0.f;
#pragma unroll
        for (int st = 0; st < 8; ++st) { p[st] = (f32x4){0.f, 0.f, 0.f, 0.f};
            if (st <= w) { f32x4 acc = (f32x4){0.f, 0.f, 0.f, 0.f};
#pragma unroll
                for (int s2 = 0; s2 < 2; ++s2) { const bf16x8 A = *(const LAS bf16x8*)(ks + (16 * st + fr) * 72 + 32 * s2 + 8 * fq); acc = mfma16(A, qf[s2], acc); }
#pragma unroll
                for (int r = 0; r < 4; ++r) { const int s = 16 * st + 4 * fq + r; const float e = (s <= t) ? __expf(bt - bc[s] + lis[s] - mt) : 0.f; const float val = acc[r] * e; den += val; p[st][r] = val; } } }
        den = quad_sum(den);
        float qn = 0.f;
        { float x[8]; unpack8(__builtin_bit_cast(v4u, qf[0]), x);
#pragma unroll
          for (int e = 0; e < 8; ++e) qn += x[e] * npv[8 * fq + e];
          unpack8(__builtin_bit_cast(v4u, qf[1]), x);
#pragma unroll
          for (int e = 0; e < 8; ++e) qn += x[e] * npv[32 + 8 * fq + e]; }
        qn = quad_sum(qn);
        const float dent = den + winter * qn, inv = 1.f / fmaxf(fabsf(dent), __expf(-mt));
        f32x4 hv[8]; float s1 = 0.f;
#pragma unroll
        for (int vt = 0; vt < 8; ++vt) { f32x4 a2 = (f32x4){0.f, 0.f, 0.f, 0.f}, a3 = a2;
#pragma unroll
            for (int jp = 0; jp < 4; ++jp) if (2 * jp <= w) { const LAS bf16* vp = vT + (16 * vt + fr) * 136 + 32 * jp + 4 * fq;
                const bf16x8 A = frag2(*(const LAS v2u*)vp, *(const LAS v2u*)(vp + 16)); a2 = mfma16(A, frag8(p[2 * jp], p[2 * jp + 1]), a2); }
#pragma unroll
            for (int s2 = 0; s2 < 2; ++s2) { const bf16x8 A = *(const LAS bf16x8*)(cts + (16 * vt + fr) * 72 + 32 * s2 + 8 * fq); a3 = mfma16(A, qf[s2], a3); }
            hv[vt] = (a2 + winter * a3) * inv; s1 += (hv[vt][0] + hv[vt][1]) + (hv[vt][2] + hv[vt][3]); asm volatile("" ::: "memory"); }
        const float mean = quad_sum(s1) * (1.f / 128.f); float s2v = 0.f;
#pragma unroll
        for (int vt = 0; vt < 8; ++vt) { hv[vt] = hv[vt] - mean; s2v += (hv[vt][0] * hv[vt][0] + hv[vt][1] * hv[vt][1]) + (hv[vt][2] * hv[vt][2] + hv[vt][3] * hv[vt][3]); }
        const float rstd = 1.0f / sqrtf(quad_sum(s2v) * (1.f / 128.f) + 1e-6f);
        const bf16* op = P + (row0 + t) * NE + 1792 + h * 128 + 4 * fq; bf16* yo = Y + (row0 + t) * D + 512 + h * 128 + 4 * fq; const float* gn = mlnorm + h * 128 + 4 * fq;
#pragma unroll
        for (int vt = 0; vt < 8; ++vt) { const v2u ov = *(const v2u*)(op + 16 * vt); const f32x4 g4 = *(const f32x4*)(gn + 16 * vt);
            const float y0 = hv[vt][0] * rstd * g4.x * sigmoidf_(bflo(ov.x)), y1 = hv[vt][1] * rstd * g4.y * sigmoidf_(bfhi(ov.x)), y2 = hv[vt][2] * rstd * g4.z * sigmoidf_(bflo(ov.y)), y3 = hv[vt][3] * rstd * g4.w * sigmoidf_(bfhi(ov.y));
            v2u w2; w2.x = pk2(y0, y1); w2.y = pk2(y2, y3); *(v2u*)(yo + 16 * vt) = w2; }
    }
    __syncthreads();
}
__device__ __forceinline__ void ssm_conv8(const bf16* P, int b, int tt, int pcol, int cch, const float* convw, const float* convb, float (&acc)[8]) {
    { const f32x4 b0 = *(const f32x4*)(convb + cch), b1 = *(const f32x4*)(convb + cch + 4); acc[0] = b0.x; acc[1] = b0.y; acc[2] = b0.z; acc[3] = b0.w; acc[4] = b1.x; acc[5] = b1.y; acc[6] = b1.z; acc[7] = b1.w; }
#pragma unroll
    for (int tap = 0; tap < 4; ++tap) { const int t2 = tt - 3 + tap;
        if (t2 >= 0) { float x[8]; unpack8(*(const v4u*)(P + (size_t)(b * T + t2) * NO + pcol), x);
            const f32x4 w0 = *(const f32x4*)(convw + tap * 1024 + cch), w1 = *(const f32x4*)(convw + tap * 1024 + cch + 4);
            acc[0] += x[0] * w0.x; acc[1] += x[1] * w0.y; acc[2] += x[2] * w0.z; acc[3] += x[3] * w0.w; acc[4] += x[4] * w1.x; acc[5] += x[5] * w1.y; acc[6] += x[6] * w1.z; acc[7] += x[7] * w1.w; } }
#pragma unroll
    for (int e = 0; e < 8; ++e) acc[e] = siluf_(acc[e]);
}
__device__ __forceinline__ float ssm_dt_wave(const float* DT, size_t row0, int hd, const float* dtbias, const float* alog, int lane, LAS float* dtv, LAS float* acum) {
    const float db = dtbias[hd], A = -expf(alog[hd]);
    const float d0 = softplusf_(DT[(row0 + 2 * lane) * 8 + hd] + db), d1 = softplusf_(DT[(row0 + 2 * lane + 1) * 8 + hd] + db);
    const float ps = scan_add(d0 * A + d1 * A, lane);
    dtv[2 * lane] = d0; dtv[2 * lane + 1] = d1; acum[2 * lane] = ps - d1 * A; acum[2 * lane + 1] = ps;
    return __shfl(ps, 63);
}
__device__ __forceinline__ void ssd_local_unit(int u, const bf16* P, const float* DT, const float* convw, const float* convb, const float* dtbias, const float* alog,
                                               float* ST, float* DEC, LAS unsigned char* lds, int tid) {
    asm volatile("" : "+v"(tid));
    const int lane = tid & 63, wave = __builtin_amdgcn_readfirstlane(tid >> 6), fr = lane & 15, fq = lane >> 4;
    const int c = u & 63, g = (u >> 6) & 1, b = u >> 7;
    const size_t row0 = (size_t)b * T + c * 128;
    LAS bf16* xT = (LAS bf16*)lds;
    LAS bf16* bT = xT + 256 * 136;
    LAS float* dtv = (LAS float*)(bT + 128 * 136);
    LAS float* acum = dtv + 512;
    if (wave < 4) { const int hd = 4 * g + wave; const float al = ssm_dt_wave(DT, row0, hd, dtbias, alog, lane, dtv + wave * 128, acum + wave * 128);
        if (lane == 0) DEC[(b * 64 + c) * 8 + hd] = expf(al);
        LAS float* ac = acum + wave * 128; LAS float* dv = dtv + wave * 128;
        ac[2 * lane] = dv[2 * lane] * expf(al - ac[2 * lane]); ac[2 * lane + 1] = dv[2 * lane + 1] * expf(al - ac[2 * lane + 1]); }
    __syncthreads();
    {
        const int c8 = tid & 31, tg = tid >> 5, cch = g * 256 + c8 * 8;
        v4u raw[11]; load_rows<8>(P + (size_t)(b * T) * NO + 512 + cch, NO, c * 128 + 8 * tg, raw);
        const int bc8 = tid & 15, btg = tid >> 4, bch = 512 + g * 128 + bc8 * 8;
        v4u rawb[7]; load_rows<4>(P + (size_t)(b * T) * NO + 1024 + g * 128 + bc8 * 8, NO, c * 128 + 4 * btg, rawb);
        { float o[8][8]; conv_silu<8>(raw, convw + cch, 1024, convb + cch, o);
          const LAS float* scp = acum + (c8 >> 3) * 128 + 8 * tg; const f32x4 s0 = *(const LAS f32x4*)scp, s1 = *(const LAS f32x4*)(scp + 4);
#pragma unroll
          for (int e = 0; e < 8; ++e) { v4u w; w.x = pk2(o[0][e] * s0.x, o[1][e] * s0.y); w.y = pk2(o[2][e] * s0.z, o[3][e] * s0.w); w.z = pk2(o[4][e] * s1.x, o[5][e] * s1.y); w.w = pk2(o[6][e] * s1.z, o[7][e] * s1.w);
              *(LAS v4u*)(xT + (c8 * 8 + e) * 136 + 8 * tg) = w; } }
        { float o[4][8]; conv_silu<4>(rawb, convw + bch, 1024, convb + bch, o);
#pragma unroll
          for (int e = 0; e < 8; ++e) { v2u w; w.x = pk2(o[0][e], o[1][e]); w.y = pk2(o[2][e], o[3][e]); *(LAS v2u*)(bT + (bc8 * 8 + e) * 136 + 4 * btg) = w; } }
    }
    __syncthreads();
#pragma unroll
    for (int rr = 0; rr < 2; ++rr) { const int rt = 2 * wave + rr;
        f32x4 acc[8];
#pragma unroll
        for (int nt = 0; nt < 8; ++nt) acc[nt] = (f32x4){0.f, 0.f, 0.f, 0.f};
#pragma unroll
        for (int ks = 0; ks < 4; ++ks) { const bf16x8 A = *(const LAS bf16x8*)(xT + (16 * rt + fr) * 136 + 32 * ks + 8 * fq);
#pragma unroll
            for (int nt = 0; nt < 8; ++nt) { const bf16x8 Bf = *(const LAS bf16x8*)(bT + (16 * nt + fr) * 136 + 32 * ks + 8 * fq); acc[nt] = mfma16(A, Bf, acc[nt]); } }
        const int hd = 4 * g + (rt >> 2), p0 = (rt & 3) * 16 + 4 * fq;
        float* sp = ST + (((size_t)(b * 64 + c) * 8 + hd) * 64 + p0) * 128 + fr;
#pragma unroll
        for (int nt = 0; nt < 8; ++nt)
#pragma unroll
            for (int r = 0; r < 4; ++r) sp[r * 128 + 16 * nt] = acc[nt][r]; }
    __syncthreads();
}
__device__ __forceinline__ void ssd_scan_phase(float* ST, const float* DEC, int tid, int G) {
    const int wave = tid >> 6; if (wave == 0) return;
    for (int e = (blockIdx.x * 7 + wave - 1) * 64 + (tid & 63); e < 4 * 8 * 8192; e += G * 7 * 64) {
        const int b = e >> 16, hd = (e >> 13) & 7, pn = e & 8191; float S = 0.f;
        float* sp = ST + ((size_t)(b * 64) * 8 + hd) * 8192 + pn;
#pragma unroll 1
        for (int c0 = 0; c0 < 64; c0 += 32) { float st[32], dc[32];
#pragma unroll
            for (int c = 0; c < 32; ++c) { st[c] = sp[(size_t)(c0 + c) * 65536]; dc[c] = DEC[(b * 64 + c0 + c) * 8 + hd]; }
#pragma unroll
            for (int c = 0; c < 32; ++c) { sp[(size_t)(c0 + c) * 65536] = S; S = S * dc[c] + st[c]; } }
    }
}
__device__ __forceinline__ void ssd_out_unit(int u, const bf16* P, const float* DT, const float* convw, const float* convb, const float* dtbias, const float* alog, const float* dskip, const float* gnorm,
                                             const float* ST, bf16* Y, LAS unsigned char* lds, int tid) {
    asm volatile("" : "+v"(tid));
    const int lane = tid & 63, wave = __builtin_amdgcn_readfirstlane(tid >> 6), fr = lane & 15, fq = lane >> 4;
    const int c = u & 63, g = (u >> 6) & 1, b = u >> 7;
    const size_t row0 = (size_t)b * T + c * 128;
    LAS bf16* xT = (LAS bf16*)lds;
    LAS bf16* bm = xT + 256 * 136;
    LAS bf16* cm = bm + 128 * 136;
    LAS float* dtv = (LAS float*)(cm + 128 * 136);
    LAS float* acum = dtv + 512;
    if (wave < 4) (void)ssm_dt_wave(DT, row0, 4 * g + wave, dtbias, alog, lane, dtv + wave * 128, acum + wave * 128);
    {
        const int c8 = tid & 31, tg = tid >> 5, cch = g * 256 + c8 * 8;
        v4u raw[11]; load_rows<8>(P + (size_t)(b * T) * NO + 512 + cch, NO, c * 128 + 8 * tg, raw);
        { float o[8][8]; conv_silu<8>(raw, convw + cch, 1024, convb + cch, o);
#pragma unroll
          for (int e = 0; e < 8; ++e) { v4u w; w.x = pk2(o[0][e], o[1][e]); w.y = pk2(o[2][e], o[3][e]); w.z = pk2(o[4][e], o[5][e]); w.w = pk2(o[6][e], o[7][e]); *(LAS v4u*)(xT + (c8 * 8 + e) * 136 + 8 * tg) = w; } }
        const int isc = tid >> 8, bc8 = tid & 15, btg = (tid >> 4) & 15, bch = 512 + isc * 256 + g * 128 + bc8 * 8;
        v4u rawb[11]; load_rows<8>(P + (size_t)(b * T) * NO + 1024 + isc * 256 + g * 128 + bc8 * 8, NO, c * 128 + 8 * btg, rawb);
        { float o[8][8]; conv_silu<8>(rawb, convw + bch, 1024, convb + bch, o);
#pragma unroll
          for (int i = 0; i < 8; ++i) *(LAS v4u*)((isc ? cm : bm) + (8 * btg + i) * 136 + bc8 * 8) = pack8(o[i]); }
    }
    __syncthreads();
    {
        const int w = wave, t = 16 * w + fr;
        bf16x8 cf[4];
#pragma unroll
        for (int ks = 0; ks < 4; ++ks) cf[ks] = *(const LAS bf16x8*)(cm + t * 136 + 32 * ks + 8 * fq);
        f32x4 cb[8];
#pragma unroll
        for (int st = 0; st < 8; ++st) { cb[st] = (f32x4){0.f, 0.f, 0.f, 0.f};
            if (st <= w) {
#pragma unroll
                for (int ks = 0; ks < 4; ++ks) { const bf16x8 A = *(const LAS bf16x8*)(bm + (16 * st + fr) * 136 + 32 * ks + 8 * fq); cb[st] = mfma16(A, cf[ks], cb[st]); } } }
        float ss = 0.f;
        bf16* yo = Y + (row0 + t) * D + g * 256 + 4 * fq; const float* gn = gnorm + g * 256 + 4 * fq;
#pragma unroll 1
        for (int j = 0; j < 4; ++j) {
            const int hd = 4 * g + j; const float at = acum[j * 128 + t], eat = expf(at), dh = dskip[hd];
            bf16x8 pf[4];
#pragma unroll
            for (int jp = 0; jp < 4; ++jp) { f32x4 p0 = (f32x4){0.f, 0.f, 0.f, 0.f}, p1 = p0;
                if (2 * jp <= w) {
#pragma unroll
                    for (int r = 0; r < 4; ++r) { const int s0 = 32 * jp + 4 * fq + r, s1 = s0 + 16;
                        p0[r] = (s0 <= t) ? cb[2 * jp][r] * expf(at - acum[j * 128 + s0]) * dtv[j * 128 + s0] : 0.f;
                        p1[r] = (s1 <= t) ? cb[2 * jp + 1][r] * expf(at - acum[j * 128 + s1]) * dtv[j * 128 + s1] : 0.f; } }
                pf[jp] = frag8(p0, p1); }
            const bf16* zp = P + (row0 + t) * NO + hd * 64 + 4 * fq;
#pragma unroll
            for (int pt = 0; pt < 4; ++pt) { f32x4 a2 = (f32x4){0.f, 0.f, 0.f, 0.f}, a3 = a2;
#pragma unroll
                for (int jp = 0; jp < 4; ++jp) if (2 * jp <= w) { const LAS bf16* xp = xT + (j * 64 + 16 * pt + fr) * 136 + 32 * jp + 4 * fq;
                    a2 = mfma16(frag2(*(const LAS v2u*)xp, *(const LAS v2u*)(xp + 16)), pf[jp], a2); }
                const float* sp = ST + (((size_t)(b * 64 + c) * 8 + hd) * 64 + 16 * pt + fr) * 128 + 8 * fq;
#pragma unroll
                for (int ks = 0; ks < 4; ++ks) { const f32x4 s0 = *(const f32x4*)(sp + 32 * ks), s1 = *(const f32x4*)(sp + 32 * ks + 4); a3 = mfma16(frag8(s0, s1), cf[ks], a3); }
                const v2u zv = *(const v2u*)(zp + 16 * pt); const float zz[4] = {bflo(zv.x), bfhi(zv.x), bflo(zv.y), bfhi(zv.y)};
                float y4[4];
#pragma unroll
                for (int r = 0; r < 4; ++r) { const float xv = bf1(xT[(j * 64 + 16 * pt + 4 * fq + r) * 136 + t]); const float y = (a2[r] + eat * a3[r] + dh * xv) * siluf_(zz[r]); y4[r] = y; ss += y * y; }
                v2u w2; w2.x = pk2(y4[0], y4[1]); w2.y = pk2(y4[2], y4[3]); *(v2u*)(yo + j * 64 + 16 * pt) = w2; }
        }
        const float rs = 1.0f / sqrtf(quad_sum(ss) * (1.f / 256.f) + 1e-5f);
#pragma unroll 4
        for (int q = 0; q < 16; ++q) { const f32x4 g4 = *(const f32x4*)(gn + 16 * q); const v2u yv = *(const v2u*)(yo + 16 * q);
            v2u w2; w2.x = pk2(bflo(yv.x) * rs * g4.x, bfhi(yv.x) * rs * g4.y); w2.y = pk2(bflo(yv.y) * rs * g4.z, bfhi(yv.y) * rs * g4.w); *(v2u*)(yo + 16 * q) = w2; }
    }
    __syncthreads();
}
constexpr int RW_RS = 0, RW_KS = 9216, RW_VS = 18432, RW_AA = 27648, RW_GG = 36864, RW_BON = 46080, RW_X = 46592;
constexpr int RW_TW = RW_X, RW_AD = RW_X + 9216, RW_GD = RW_X + 18432;
constexpr int RW_AR = RW_X, RW_BK = RW_X + 18432;
constexpr int RW_LW = RW_X + 36864, RW_CL = RW_LW + 16384;
constexpr int RW_MK = RW_LW, RW_NN = RW_LW + 3072, RW_MB = RW_NN + 5120, RW_TT = RW_MB + 4096;
constexpr int RW_YO = RW_CL;
constexpr int RW_KB = RW_CL + 16384, RW_VT = RW_KB + 20480, RW_GL = RW_VT + 8192, RW_END = RW_GL + 1024;
constexpr int RW_GT = RW_RS;
static_assert(RW_TT + 3072 <= RW_CL && RW_END <= LDS_MAIN, "rwkv LDS map");
#ifndef RW_R1
#define RW_R1 1
#endif
#ifndef RW_R2
#define RW_R2 1
#endif
#ifndef RW_R3
#define RW_R3 1
#endif
#ifndef RW_R4
#define RW_R4 1
#endif
#ifndef RW_R5
#define RW_R5 1
#endif
constexpr int RW_PAR = RW_END;
static_assert(RW_PAR + 1792 <= LDS_MAIN, "rwkv LDS map");
__device__ __forceinline__ float tanh_fast(float x) { return 1.f - 2.f / (1.f + __expf(2.f * x)); }
template <int MODE>
__device__ __forceinline__ void rwkv_chunk_unit(int u, int& cur_h, const bf16* P, const float* const* in, const bf16* lora, bf16* GF, float* HS, bf16* Y, LAS unsigned char* lds, int tid) {
    asm volatile("" : "+v"(tid));
    const int lane = tid & 63, wave = __builtin_amdgcn_readfirstlane(tid >> 6), fr = lane & 15, fq = lane >> 4;
    const int h = u & 7, c64 = (u >> 3) & 127, b = u >> 10;
    const int su = (b * 8 + h) * 128 + c64;
    const size_t row0 = (size_t)b * T + c64 * 64;
    const float* mu = in[21];
    LAS bf16* RS = (LAS bf16*)(lds + RW_RS); LAS bf16* KS = (LAS bf16*)(lds + RW_KS); LAS bf16* VS = (LAS bf16*)(lds + RW_VS); LAS bf16* AA = (LAS bf16*)(lds + RW_AA); LAS bf16* GG = (LAS bf16*)(lds + RW_GG);
    LAS float* BON = (LAS float*)(lds + RW_BON);
    LAS bf16* TW = (LAS bf16*)(lds + RW_TW); LAS bf16* ADs = (LAS bf16*)(lds + RW_AD); LAS bf16* GD = (LAS bf16*)(lds + RW_GD);
    LAS float* LW = (LAS float*)(lds + RW_LW); LAS float* CL = (LAS float*)(lds + RW_CL); LAS float* PAR = (LAS float*)(lds + RW_PAR);
    if (h != cur_h) { cur_h = h;
        if (tid < 448) { const int a7 = tid >> 6, kh = tid & 63; const int src = (a7 == 0) ? 22 : (a7 == 1) ? 24 : (a7 == 2) ? 27 : (a7 == 3) ? 28 : (a7 == 4) ? 29 : (a7 == 5) ? 30 : 31; PAR[tid] = in[src][h * 64 + kh]; } }
    const bf16* w2t = lora + (size_t)(h * 64) * 64; const bf16* a2t = lora + 512 * 64 + (size_t)(h * 64) * 64; const bf16* g2t = lora + 2 * 512 * 64 + (size_t)(h * 64) * 128;
    bf16x8 bw[2][2], ba[2][2];
#pragma unroll
    for (int ni = 0; ni < 2; ++ni) { const int kh = 16 * (2 * (wave >> 2) + ni) + fr;
#pragma unroll
        for (int ks = 0; ks < 2; ++ks) { bw[ni][ks] = *(const bf16x8*)(w2t + (size_t)kh * 64 + 32 * ks + 8 * fq); ba[ni][ks] = *(const bf16x8*)(a2t + (size_t)kh * 64 + 32 * ks + 8 * fq); }
    }
    f32x4 W[4];
    if (MODE == 1 && wave < 4) {
#pragma unroll
        for (int kt = 0; kt < 4; ++kt) W[kt] = *(const f32x4*)(HS + (((size_t)su * 4 + wave) * 4 + kt) * 256 + lane * 4); }
    for (int rp1 = 0; rp1 < RW_R1; ++rp1) { if (rp1) __syncthreads();
    if (tid < 448) {
        const int q = tid % 56, tg = tid / 56; int pcol, mcol;
        if (q < 24) { const int w3 = q >> 3, c8 = q & 7; pcol = 1536 + w3 * 512 + h * 64 + c8 * 8; mcol = w3 * 512 + h * 64 + c8 * 8; }
        else { pcol = 3072 + (q - 24) * 8; mcol = 1536 + (q - 24) * 8; }
        v4u raw[9];
        const bf16* pp = P + row0 * NO + pcol;
#pragma unroll
        for (int i = 0; i < 9; ++i) { const int tt = tg * 8 - 1 + i; raw[i] = (c64 * 64 + tt >= 0) ? *(const v4u*)(pp + (ptrdiff_t)tt * NO) : (v4u){0u, 0u, 0u, 0u}; }
        const f32x4 m0 = *(const f32x4*)(mu + mcol), m1 = *(const f32x4*)(mu + mcol + 4); const float mm[8] = {m0.x, m0.y, m0.z, m0.w, m1.x, m1.y, m1.z, m1.w};
        if (MODE == 1 || q < 40) {
#pragma unroll
            for (int i = 0; i < 8; ++i) { const int t = tg * 8 + i; float cur[8], prv[8], o[8]; unpack8(raw[i + 1], cur); unpack8(raw[i], prv);
#pragma unroll
                for (int e = 0; e < 8; ++e) o[e] = cur[e] + (prv[e] - cur[e]) * mm[e];
                if (q < 24) { LAS bf16* dst = (q < 8) ? RS : (q < 16 ? KS : VS); *(LAS v4u*)(dst + t * 72 + (q & 7) * 8) = pack8(o); }
                else if (q < 32) {
#pragma unroll
                    for (int e = 0; e < 8; ++e) o[e] = tanh_fast(o[e]);
                    *(LAS v4u*)(TW + t * 72 + (q - 24) * 8) = pack8(o); }
                else if (q < 40) *(LAS v4u*)(ADs + t * 72 + (q - 32) * 8) = pack8(o);
                else {
#pragma unroll
                    for (int e = 0; e < 8; ++e) o[e] = sigmoidf_(o[e]);
                    *(LAS v4u*)(GD + t * 136 + (q - 40) * 8) = pack8(o); } } }
    } }
    __syncthreads();
    for (int rp2 = 0; rp2 < RW_R2; ++rp2) { if (rp2) __syncthreads();
        const int tt = wave & 3;
        bf16x8 bg[2][4];
        if (MODE == 1) {
#pragma unroll
            for (int ni = 0; ni < 2; ++ni)
#pragma unroll
                for (int ks = 0; ks < 4; ++ks) bg[ni][ks] = *(const bf16x8*)(g2t + (size_t)(16 * (2 * (wave >> 2) + ni) + fr) * 128 + 32 * ks + 8 * fq); }
#pragma unroll
        for (int ni = 0; ni < 2; ++ni) { const int nt = 2 * (wave >> 2) + ni, kh = 16 * nt + fr;
            f32x4 aw = (f32x4){0.f, 0.f, 0.f, 0.f}, aa = aw, ag = aw;
#pragma unroll
            for (int ks = 0; ks < 2; ++ks) { const bf16x8 A1 = *(const LAS bf16x8*)(TW + (16 * tt + fr) * 72 + 32 * ks + 8 * fq), A2 = *(const LAS bf16x8*)(ADs + (16 * tt + fr) * 72 + 32 * ks + 8 * fq);
                aw = mfma16(A1, bw[ni][ks], aw); aa = mfma16(A2, ba[ni][ks], aa); }
            if (MODE == 1) {
#pragma unroll
                for (int ks = 0; ks < 4; ++ks) ag = mfma16(*(const LAS bf16x8*)(GD + (16 * tt + fr) * 136 + 32 * ks + 8 * fq), bg[ni][ks], ag); }
            const float w0 = PAR[kh], a0 = PAR[64 + kh];
            float lw[4], cs[4]; float run = 0.f;
#pragma unroll
            for (int r = 0; r < 4; ++r) { const float wlog = -softplusf_(-(w0 + aw[r])) - 0.5f; lw[r] = -__expf(wlog); run += lw[r]; cs[r] = run; }
            float inc = run; { const float t1 = __shfl_up(inc, 16); if (fq >= 1) inc += t1; const float t2 = __shfl_up(inc, 32); if (fq >= 2) inc += t2; }
            const float excl = inc - run;
#pragma unroll
            for (int r = 0; r < 4; ++r) { const int t = 16 * tt + 4 * fq + r;
                CL[t * 64 + kh] = excl + cs[r]; LW[t * 64 + kh] = excl + cs[r] - lw[r];
                AA[t * 72 + kh] = (bf16)f2bf(sigmoidf_(a0 + aa[r]));
                if (MODE == 1) GG[t * 72 + kh] = (bf16)f2bf(ag[r]); } }
    }
    __syncthreads();
    for (int rp3 = 0; rp3 < RW_R3; ++rp3) { if (rp3) __syncthreads();
        LAS bf16* AR = (LAS bf16*)(lds + RW_AR); LAS bf16* BK = (LAS bf16*)(lds + RW_BK); LAS bf16* KB = (LAS bf16*)(lds + RW_KB); LAS bf16* VT = (LAS bf16*)(lds + RW_VT); LAS float* GL = (LAS float*)(lds + RW_GL);
        const int t = tid >> 3, c8 = tid & 7, i = t >> 4, tl = t & 15, kh0 = c8 * 8;
        float rr[8], kk_[8], vv[8], aa[8], kn[8];
        unpack8(*(const LAS v4u*)(RS + t * 72 + kh0), rr); unpack8(*(const LAS v4u*)(KS + t * 72 + kh0), kk_); unpack8(*(const LAS v4u*)(VS + t * 72 + kh0), vv); unpack8(*(const LAS v4u*)(AA + t * 72 + kh0), aa);
        const LAS float* kkp = PAR + 128 + kh0; const LAS float* kap = PAR + 192 + kh0; const LAS float* rkp = PAR + 256 + kh0;
        float ssq = 0.f, bon = 0.f;
#pragma unroll
        for (int e = 0; e < 8; ++e) { kn[e] = kk_[e] * kkp[e]; ssq += kn[e] * kn[e]; }
        ssq += __shfl_xor(ssq, 1); ssq += __shfl_xor(ssq, 2); ssq += __shfl_xor(ssq, 4);
        const float invn = 1.f / fmaxf(sqrtf(ssq), 1e-12f);
        float al[8], be[8], ka[8], rh[8];
#pragma unroll
        for (int e = 0; e < 8; ++e) { const float cl = CL[t * 64 + kh0 + e], clp = LW[t * 64 + kh0 + e]; const float ep = __expf(clp), ec = __expf(cl), em = __expf(-cl);
            const float kkn = kn[e] * invn, kp = kk_[e] * (1.f + (aa[e] - 1.f) * kap[e]);
            al[e] = kkn * ep; be[e] = kkn * aa[e] * em; ka[e] = kp * em; rh[e] = rr[e] * ec; bon += rr[e] * kp * rkp[e];
            if (tl == 15) GL[i * 64 + kh0 + e] = ec; }
        bon += __shfl_xor(bon, 1); bon += __shfl_xor(bon, 2); bon += __shfl_xor(bon, 4);
        if (c8 == 0) BON[t] = bon;
        *(LAS v4u*)(AR + (i * 32 + tl) * 72 + kh0) = pack8(al); *(LAS v4u*)(AR + (i * 32 + 16 + tl) * 72 + kh0) = pack8(rh);
        *(LAS v4u*)(BK + (i * 32 + tl) * 72 + kh0) = pack8(be); *(LAS v4u*)(BK + (i * 32 + 16 + tl) * 72 + kh0) = pack8(ka);
        const int slot = 8 * (tl >> 2) + (tl & 3);
#pragma unroll
        for (int e = 0; e < 8; ++e) { KB[(i * 64 + kh0 + e) * 40 + slot] = (bf16)f2bf(-be[e]); KB[(i * 64 + kh0 + e) * 40 + slot + 4] = (bf16)f2bf(ka[e]); VT[(i * 64 + kh0 + e) * 16 + tl] = (bf16)f2bf(vv[e]); }
    }
    __syncthreads();
    for (int rp4 = 0; rp4 < RW_R4; ++rp4) { if (rp4) __syncthreads();
    if (wave < 4) {
        const int i = wave;
        LAS bf16* AR = (LAS bf16*)(lds + RW_AR) + i * 32 * 72; LAS bf16* BK = (LAS bf16*)(lds + RW_BK) + i * 32 * 72;
        LAS bf16* MK = (LAS bf16*)(lds + RW_MK) + i * 16 * 24; LAS bf16* NN = (LAS bf16*)(lds + RW_NN) + i * 16 * 40; LAS float* MB = (LAS float*)(lds + RW_MB) + i * 256; LAS bf16* TT = (LAS bf16*)(lds + RW_TT) + i * 16 * 24;
        f32x4 pr[2][2];
#pragma unroll
        for (int ra = 0; ra < 2; ++ra)
#pragma unroll
            for (int cbx = 0; cbx < 2; ++cbx) { f32x4 acc = (f32x4){0.f, 0.f, 0.f, 0.f};
#pragma unroll
                for (int ks = 0; ks < 2; ++ks) acc = mfma16(*(const LAS bf16x8*)(AR + (16 * ra + fr) * 72 + 32 * ks + 8 * fq), *(const LAS bf16x8*)(BK + (16 * cbx + fr) * 72 + 32 * ks + 8 * fq), acc);
                pr[ra][cbx] = acc; }
        const int slotc = 8 * (fr >> 2) + (fr & 3);
#pragma unroll
        for (int r = 0; r < 4; ++r) { const int ta = 4 * fq + r, tb = fr;
            const float mb = (tb < ta) ? pr[0][0][r] : 0.f, mk = (tb < ta) ? pr[0][1][r] : 0.f, nb = (tb <= ta) ? pr[1][0][r] : 0.f, nk = (tb <= ta) ? pr[1][1][r] : 0.f;
            MB[ta * 16 + tb] = mb; MK[ta * 24 + tb] = (bf16)f2bf(mk); NN[ta * 40 + slotc] = (bf16)f2bf(-nb); NN[ta * 40 + slotc + 4] = (bf16)f2bf(nk); }
        LDS_WAIT(); asm volatile("" ::: "memory");
        { const int cc = lane & 15; float tc[16];
#pragma unroll
          for (int t = 0; t < 16; ++t) { float s = (t == cc) ? 1.f : 0.f;
#pragma unroll
              for (int j = 0; j < t; ++j) s -= MB[t * 16 + j] * tc[j];
              tc[t] = s; }
          if (lane < 16) {
#pragma unroll
              for (int t = 0; t < 16; ++t) TT[t * 24 + cc] = (bf16)f2bf(tc[t]); } }
    } }
    __syncthreads();
    constexpr int NCW = (MODE == 0) ? 8 : 4;
    LAS float* YO = (LAS float*)(lds + RW_YO);
    for (int rp5 = 0; rp5 < ((MODE == 0) ? RW_R5 : 1); ++rp5) { if (rp5) __syncthreads();
    if (wave < NCW) {
        const bool has_v = (MODE == 1) || (wave >= 4);
        const int vcol = (MODE == 1) ? (16 * wave + fr) : (16 * (wave & 3) + fr);
        if (MODE == 0) {
#pragma unroll
            for (int kt = 0; kt < 4; ++kt)
#pragma unroll
                for (int r = 0; r < 4; ++r) W[kt][r] = (wave < 4 && (16 * kt + 4 * fq + r) == (16 * wave + fr)) ? 1.f : 0.f;
        }
        const bf16x8 zero8 = (bf16x8){0, 0, 0, 0, 0, 0, 0, 0}; const v2u zero2 = (v2u){0u, 0u};
#pragma unroll
        for (int i = 0; i < 4; ++i) {
            LAS bf16* AR = (LAS bf16*)(lds + RW_AR) + i * 32 * 72; LAS bf16* KB = (LAS bf16*)(lds + RW_KB) + i * 64 * 40; LAS bf16* VT = (LAS bf16*)(lds + RW_VT) + i * 64 * 16; LAS float* GL = (LAS float*)(lds + RW_GL) + i * 64;
            LAS bf16* MK = (LAS bf16*)(lds + RW_MK) + i * 16 * 24; LAS bf16* NN = (LAS bf16*)(lds + RW_NN) + i * 16 * 40; LAS bf16* TT = (LAS bf16*)(lds + RW_TT) + i * 16 * 24;
            bf16x8 wf[2]; wf[0] = frag8(W[0], W[1]); wf[1] = frag8(W[2], W[3]);
            f32x4 au = (f32x4){0.f, 0.f, 0.f, 0.f}, ay = au;
#pragma unroll
            for (int s = 0; s < 2; ++s) { const LAS bf16* ap = AR + fr * 72 + 32 * s + 4 * fq; au = mfma16(frag2(*(const LAS v2u*)ap, *(const LAS v2u*)(ap + 16)), wf[s], au);
                if (MODE == 1) { const LAS bf16* rp = AR + (16 + fr) * 72 + 32 * s + 4 * fq; ay = mfma16(frag2(*(const LAS v2u*)rp, *(const LAS v2u*)(rp + 16)), wf[s], ay); } }
            v2u vin = zero2;
            if (has_v) { const bf16x8 A = (fq < 2) ? *(const LAS bf16x8*)(MK + fr * 24 + 8 * fq) : zero8; const bf16x8 Bv = (fq < 2) ? *(const LAS bf16x8*)(VT + vcol * 16 + 8 * fq) : zero8;
                au = mfma16(A, Bv, au); vin = *(const LAS v2u*)(VT + vcol * 16 + 4 * fq); }
            f32x4 U;
            { v4u bw; bw.x = pk2(au[0], au[1]); bw.y = pk2(au[2], au[3]); bw.z = 0u; bw.w = 0u; const v2u tl2 = *(const LAS v2u*)(TT + fr * 24 + 4 * fq);
              U = mfma16(frag2(tl2, zero2), __builtin_bit_cast(bf16x8, bw), (f32x4){0.f, 0.f, 0.f, 0.f}); }
            v4u ubw; ubw.x = pk2(U[0], U[1]); ubw.y = pk2(U[2], U[3]); ubw.z = vin.x; ubw.w = vin.y; const bf16x8 ub = __builtin_bit_cast(bf16x8, ubw);
            if (MODE == 1) { ay = mfma16(*(const LAS bf16x8*)(NN + fr * 40 + 8 * fq), ub, ay);
#pragma unroll
                for (int r = 0; r < 4; ++r) YO[(16 * i + 4 * fq + r) * 64 + vcol] = ay[r]; }
#pragma unroll
            for (int kt = 0; kt < 4; ++kt) { W[kt] = mfma16(*(const LAS bf16x8*)(KB + (16 * kt + fr) * 40 + 8 * fq), ub, W[kt]); const f32x4 g4 = *(const LAS f32x4*)(GL + 16 * kt + 4 * fq); W[kt] = W[kt] * g4; }
        }
        if (MODE == 0) {
            if (wave >= 4) {
#pragma unroll
                for (int kt = 0; kt < 4; ++kt) *(f32x4*)(HS + (((size_t)su * 4 + (wave - 4)) * 4 + kt) * 256 + lane * 4) = W[kt];
            } else { LAS bf16* GT = (LAS bf16*)(lds + RW_GT);
#pragma unroll
                for (int kt = 0; kt < 4; ++kt)
#pragma unroll
                    for (int r = 0; r < 4; ++r) GT[(16 * kt + 4 * fq + r) * 72 + 16 * wave + fr] = (bf16)f2bf(W[kt][r]); }
        }
    } }
    __syncthreads();
    if (MODE == 0) {
        LAS bf16* GT = (LAS bf16*)(lds + RW_GT);
        const int f = wave, kot = f >> 1, s = f & 1; const LAS bf16* gp = GT + (16 * kot + fr) * 72 + 32 * s + 4 * fq;
        const v2u lo = *(const LAS v2u*)gp, hi = *(const LAS v2u*)(gp + 16); v4u o; o.x = lo.x; o.y = lo.y; o.z = hi.x; o.w = hi.y;
        *(v4u*)(GF + ((size_t)su * 8 + f) * 512 + lane * 8) = o;
    } else {
        const int t = tid >> 3, c8 = tid & 7, v0 = c8 * 8;
        float y[8]; float s1 = 0.f;
#pragma unroll
        for (int e = 0; e < 8; ++e) { y[e] = YO[t * 64 + v0 + e]; s1 += y[e]; }
        s1 += __shfl_xor(s1, 1); s1 += __shfl_xor(s1, 2); s1 += __shfl_xor(s1, 4);
        const float mean = s1 * (1.f / 64.f); float s2 = 0.f;
#pragma unroll
        for (int e = 0; e < 8; ++e) { y[e] -= mean; s2 += y[e] * y[e]; }
        s2 += __shfl_xor(s2, 1); s2 += __shfl_xor(s2, 2); s2 += __shfl_xor(s2, 4);
        const float rstd = 1.0f / sqrtf(s2 * (1.f / 64.f) + 64e-5f), bon = BON[t];
        float vv[8], gg[8], o[8]; unpack8(*(const LAS v4u*)(VS + t * 72 + v0), vv); unpack8(*(const LAS v4u*)(GG + t * 72 + v0), gg);
        const LAS float* lw_ = PAR + 320 + v0; const LAS float* lb_ = PAR + 384 + v0;
#pragma unroll
        for (int e = 0; e < 8; ++e) o[e] = (y[e] * rstd * lw_[e] + lb_[e] + bon * vv[e]) * gg[e];
        *(v4u*)(Y + (row0 + t) * D + 512 + h * 64 + v0) = pack8(o);
    }
    __syncthreads();
}
constexpr int RS_SLOT = 12288;
__device__ __forceinline__ void rwkv_scan_issue(const bf16* GF, const float* HS, size_t unit, int vt, LAS unsigned char* slot, int lane) {
#pragma unroll
    for (int f = 0; f < 8; ++f) __builtin_amdgcn_global_load_lds((const unsigned*)(GF + (unit * 8 + f) * 512 + lane * 8), (LAS unsigned*)(slot + f * 1024), 16, 0, 0);
#pragma unroll
    for (int kt = 0; kt < 4; ++kt) __builtin_amdgcn_global_load_lds((const unsigned*)(HS + ((unit * 4 + vt) * 4 + kt) * 256 + lane * 4), (LAS unsigned*)(slot + 8192 + kt * 1024), 16, 0, 0);
}
__device__ __forceinline__ void rwkv_scan_phase(const bf16* GF, float* HS, LAS unsigned char* lds, int tid, int G) {
    if ((tid >> 6) != 0) return;
    const int lane = tid & 63;
    for (int job = blockIdx.x; job < 128; job += G) {
        const int bh = job >> 2, vt = job & 3; const size_t u0 = (size_t)bh * 128;
        f32x4 W[4];
#pragma unroll
        for (int kt = 0; kt < 4; ++kt) W[kt] = (f32x4){0.f, 0.f, 0.f, 0.f};
#pragma unroll
        for (int p = 0; p < 5; ++p) rwkv_scan_issue(GF, HS, u0 + p, vt, lds + p * RS_SLOT, lane);
        for (int c0 = 0; c0 < 128; c0 += 8) {
#pragma unroll
            for (int j = 0; j < 8; ++j) {
                const int c = c0 + j;
                asm volatile("s_waitcnt vmcnt(48)" ::: "memory");
                LAS unsigned char* slot = lds + j * RS_SLOT;
                bf16x8 gc[8]; f32x4 hc[4];
#pragma unroll
                for (int f = 0; f < 8; ++f) gc[f] = *(const LAS bf16x8*)(slot + f * 1024 + lane * 16);
#pragma unroll
                for (int kt = 0; kt < 4; ++kt) hc[kt] = *(const LAS f32x4*)(slot + 8192 + kt * 1024 + lane * 16);
                { const int cn = c + 5 < 128 ? c + 5 : 127;
                  rwkv_scan_issue(GF, HS, u0 + cn, vt, lds + ((j + 5) & 7) * RS_SLOT, lane); }
                if (c >= 122) asm volatile("s_waitcnt vmcnt(0)" ::: "memory");
                const size_t uu = u0 + c;
#pragma unroll
                for (int kt = 0; kt < 4; ++kt) *(f32x4*)(HS + ((uu * 4 + vt) * 4 + kt) * 256 + lane * 4) = W[kt];
                f32x4 Wl[4];
#pragma unroll
                for (int kt = 0; kt < 4; ++kt)
#pragma unroll
                    for (int r = 0; r < 4; ++r) { const float hi = __builtin_bit_cast(float, f2bf(W[kt][r]) << 16); Wl[kt][r] = W[kt][r] - hi; }
                const bf16x8 wh0 = frag8(W[0], W[1]), wh1 = frag8(W[2], W[3]), wl0 = frag8(Wl[0], Wl[1]), wl1 = frag8(Wl[2], Wl[3]);
#pragma unroll
                for (int kt = 0; kt < 4; ++kt) { f32x4 a = hc[kt]; a = mfma16(gc[2 * kt], wh0, a); a = mfma16(gc[2 * kt + 1], wh1, a); a = mfma16(gc[2 * kt], wl0, a); a = mfma16(gc[2 * kt + 1], wl1, a); W[kt] = a; }
            }
        }
        asm volatile("s_waitcnt vmcnt(0)" ::: "memory");
    }
}
struct Args { const float* in[33]; float* out; unsigned char* ws; int ph_lo, ph_hi; };
__global__ void __launch_bounds__(NWAVES * 64, 2) trunk_fwd(Args args) {
    extern __shared__ __attribute__((aligned(16))) unsigned char lds_raw[];
    LAS unsigned char* lds = (LAS unsigned char*)lds_raw;
    const int tid = threadIdx.x, G = gridDim.x;
    unsigned char* ws = args.ws;
    gu32* ctl = (gu32*)(ws + WS_CTL);
    for (int u = tid; u < (LDS_BYTES - LDSCTL_OFF) / 4; u += NWAVES * 64) ((LAS unsigned*)(lds + LDSCTL_OFF))[u] = 0u;
    __syncthreads();
    XcdBarrier bar; bar.bar = (unsigned*)(ctl + CW_BAR); bar.x = 0; bar.st = nullptr;
    if (!MK_PER_PHASE) bar = xcd_barrier_post((unsigned*)(ctl + CW_BAR), (volatile LAS unsigned*)(lds + LDSCTL_OFF + 32));
    const int lo = args.ph_lo, hi = args.ph_hi;
#ifndef RG
#define RG 0
#endif
#ifndef RATT
#define RATT 1
#endif
#ifndef RMLL
#define RMLL 1
#endif
#ifndef RMLO
#define RMLO 1
#endif
#ifndef RSSL
#define RSSL 1
#endif
#ifndef RSSO
#define RSSO 1
#endif
#ifndef RRWA
#define RRWA 1
#endif
#ifndef RRWB
#define RRWB 1
#endif
#ifndef RNORM
#define RNORM 1
#endif
#ifndef NO_SSD
#define NO_SSD 0
#endif
#ifndef NO_RWKV
#define NO_RWKV 0
#endif
#ifndef PHMASK
#define PHMASK 0x7ffffu
#endif
#define IN(k) ((((PHMASK) >> (k)) & 1u) && lo <= (k) && (k) < hi)
#define SEAM(k) do { if (IN(k) && IN((k) + 1)) xcd_barrier(bar); } while (0)
    const float* x = args.in[0]; float* hres = args.out;
    bf16* XN = (bf16*)(ws + WS_XN); bf16* P = (bf16*)(ws + WS_R1); bf16* HB = (bf16*)(ws + WS_R1); bf16* Y = (bf16*)(ws + WS_Y);
    float* G0 = (float*)(ws + WS_G0); float* DT = (float*)(ws + WS_DT);
    float* MLS = (float*)(ws + WS_MLS); float* MPREV = MLS + 4096; float* NL = MLS + 8192;
    float* CT = (float*)(ws + WS_XN); float* ST = (float*)(ws + WS_XN); float* DEC = (float*)(ws + WS_DEC);
    bf16* GF = (bf16*)(ws + WS_GF); float* HS = (float*)(ws + WS_HS);
    const float2* rope = (const float2*)(ws + WS_ROPE); const bf16* lora = (const bf16*)(ws + WS_LORA);

    if (IN(0)) { p0_prologue(args.in, ws, lds, tid, G); __syncthreads();
        for (int rep_ = 0; rep_ < RNORM; ++rep_) norm_phase<1>(x, args.in[1], XN, nullptr, args.in[5] + 2304, 2312, G0, lds, tid, G); }
    SEAM(0);
    if (IN(1)) { pg8::Gemm g{XN, (const bf16*)(ws + WS_WINE), M, NE, D}; pg8::StaticOrder S; S.init(M, NE, G, (int)blockIdx.x); pg8::EpiBf16<0> E{P, NE};
        pg8::gemm_phase<pg8::EpiBf16<0>, pg8::StaticOrder, PG8_ALIGN, PG8_SP2>(lds, g, S, E); }
    SEAM(1);
    if (IN(2)) { for (int rep_ = 0; rep_ < RATT; ++rep_) for (int u = blockIdx.x; u < 512; u += G) attn_unit(u, P, rope, args.in[7], Y, lds, tid);
        for (int rep_ = 0; rep_ < RMLL; ++rep_) for (int u = blockIdx.x; u < 1024; u += G) mlstm_local_unit(u, P, G0, args.in[8], args.in[9], args.in[10], args.in[11], CT, NL, MLS, lds, tid); }
    SEAM(2);
    if (IN(3)) mlstm_scan_phase(CT, NL, MLS, MPREV, tid, G);
    SEAM(3);
    if (IN(4)) { for (int rep_ = 0; rep_ < RMLO; ++rep_) for (int u = blockIdx.x; u < 1024; u += G) mlstm_out_unit(u, P, G0, args.in[8], args.in[9], args.in[10], args.in[11], args.in[12], CT, NL, MPREV, Y, lds, tid); }
    SEAM(4);
    if (IN(5)) { pg8::Gemm g{Y, (const bf16*)(ws + WS_WOUTE), M, D, D}; pg8::StaticOrder S; S.init(M, D, G, (int)blockIdx.x); pg8::EpiF32Res E{x, hres, D};
        pg8::gemm_phase<pg8::EpiF32Res, pg8::StaticOrder, PG8_ALIGN, PG8_SP2>(lds, g, S, E);
        if (RG & 8) pg8::gemm_phase<pg8::EpiF32Res, pg8::StaticOrder, PG8_ALIGN, PG8_SP2>(lds, g, S, E); }
    SEAM(5);
    if (IN(6)) for (int rep_ = 0; rep_ < RNORM; ++rep_) norm_phase<0>(hres, args.in[2], XN, nullptr, nullptr, 0, nullptr, lds, tid, G);
    SEAM(6);
    if (IN(7)) { pg8::Gemm g{XN, (const bf16*)(ws + WS_WUP0), M, FF, D}; pg8::StaticOrder S; S.init(M, FF, G, (int)blockIdx.x); pg8::EpiBf16<2> E{HB, FF};
        pg8::gemm_phase<pg8::EpiBf16<2>, pg8::StaticOrder, PG8_ALIGN, PG8_SP2>(lds, g, S, E);
        if (RG & 2) pg8::gemm_phase<pg8::EpiBf16<2>, pg8::StaticOrder, PG8_ALIGN, PG8_SP2>(lds, g, S, E); }
    SEAM(7);
    if (IN(8)) { pg8::Gemm g{HB, (const bf16*)(ws + WS_WDN0), M, D, FF}; pg8::StaticOrder S; S.init(M, D, G, (int)blockIdx.x); pg8::EpiF32Res E{hres, hres, D};
        pg8::gemm_phase<pg8::EpiF32Res, pg8::StaticOrder, PG8_ALIGN, PG8_SP2>(lds, g, S, E); }
    SEAM(8);
    if (IN(9)) for (int rep_ = 0; rep_ < RNORM; ++rep_) norm_phase<1>(hres, args.in[1] + D, XN, nullptr, args.in[13] + 1536, 3336, DT, lds, tid, G);
    SEAM(9);
    if (IN(10)) { pg8::Gemm g{XN, (const bf16*)(ws + WS_WINO), M, NO, D}; pg8::StaticOrder S; S.init(M, NO, G, (int)blockIdx.x); pg8::EpiBf16<0> E{P, NO};
        pg8::gemm_phase<pg8::EpiBf16<0>, pg8::StaticOrder, PG8_ALIGN, PG8_SP2>(lds, g, S, E);
        if (RG & 4) pg8::gemm_phase<pg8::EpiBf16<0>, pg8::StaticOrder, PG8_ALIGN, PG8_SP2>(lds, g, S, E); }
    SEAM(10);
    int cur_h = -1;
    if (IN(11)) { if (!NO_SSD) for (int rep_ = 0; rep_ < RSSL; ++rep_) for (int u = blockIdx.x; u < 512; u += G) ssd_local_unit(u, P, DT, args.in[15], args.in[16], args.in[17], args.in[18], ST, DEC, lds, tid);
        if (!NO_RWKV) for (int rep_ = 0; rep_ < RRWA; ++rep_) for (int u = blockIdx.x; u < 4096; u += G) rwkv_chunk_unit<0>(u, cur_h, P, args.in, lora, GF, HS, Y, lds, tid); }
    SEAM(11);
    if (IN(12)) { rwkv_scan_phase(GF, HS, lds, tid, G); ssd_scan_phase(ST, DEC, tid, G); }
    SEAM(12);
    cur_h = -1;
    if (IN(13)) { if (!NO_SSD) for (int rep_ = 0; rep_ < RSSO; ++rep_) for (int u = blockIdx.x; u < 512; u += G) ssd_out_unit(u, P, DT, args.in[15], args.in[16], args.in[17], args.in[18], args.in[19], args.in[20], ST, Y, lds, tid);
        if (!NO_RWKV) for (int rep_ = 0; rep_ < RRWB; ++rep_) for (int u = blockIdx.x; u < 4096; u += G) rwkv_chunk_unit<1>(u, cur_h, P, args.in, lora, GF, HS, Y, lds, tid); }
    SEAM(13);
    if (IN(14)) { pg8::Gemm g{Y, (const bf16*)(ws + WS_WOUTO), M, D, D}; pg8::StaticOrder S; S.init(M, D, G, (int)blockIdx.x); pg8::EpiF32Res E{hres, hres, D};
        pg8::gemm_phase<pg8::EpiF32Res, pg8::StaticOrder, PG8_ALIGN, PG8_SP2>(lds, g, S, E); }
    SEAM(14);
    if (IN(15)) for (int rep_ = 0; rep_ < RNORM; ++rep_) norm_phase<0>(hres, args.in[2] + D, XN, nullptr, nullptr, 0, nullptr, lds, tid, G);
    SEAM(15);
    if (IN(16)) { pg8::Gemm g{XN, (const bf16*)(ws + WS_WUP1), M, FF, D}; pg8::StaticOrder S; S.init(M, FF, G, (int)blockIdx.x); pg8::EpiBf16<2> E{HB, FF};
        pg8::gemm_phase<pg8::EpiBf16<2>, pg8::StaticOrder, PG8_ALIGN, PG8_SP2>(lds, g, S, E); }
    SEAM(16);
    if (IN(17)) { pg8::Gemm g{HB, (const bf16*)(ws + WS_WDN1), M, D, FF}; pg8::StaticOrder S; S.init(M, D, G, (int)blockIdx.x); pg8::EpiF32Res E{hres, hres, D};
        pg8::gemm_phase<pg8::EpiF32Res, pg8::StaticOrder, PG8_ALIGN, PG8_SP2>(lds, g, S, E); }
    SEAM(17);
    if (IN(18)) norm_phase<2>(hres, args.in[32], nullptr, hres, nullptr, 0, nullptr, lds, tid, G);
#undef IN
#undef SEAM
}
extern "C" void kernel_launch(void* const* d_in, const int* in_sizes, int n_in, void* d_out, int out_size, void* d_ws, size_t ws_size, hipStream_t stream) {
    static int grid = 0;
    if (grid == 0) {
        if (n_in != 33 || in_sizes[0] != M * D || out_size != M * D || ws_size < WS_END) { fprintf(stderr, "kernel_launch: unexpected shapes (n_in %d, in0 %d, out %d, ws %zu < %zu); nothing launched\n", n_in, n_in > 0 ? in_sizes[0] : -1, out_size, ws_size, (size_t)WS_END); grid = -1; return; }
        int dev = 0, cus = 0, per_cu = 0;
        if (hipGetDevice(&dev) != hipSuccess || hipDeviceGetAttribute(&cus, hipDeviceAttributeMultiprocessorCount, dev) != hipSuccess) { grid = -1; return; }
        if (hipFuncSetAttribute((const void*)trunk_fwd, hipFuncAttributeMaxDynamicSharedMemorySize, LDS_BYTES) != hipSuccess) { fprintf(stderr, "kernel_launch: hipFuncSetAttribute failed\n"); grid = -1; return; }
        if (hipOccupancyMaxActiveBlocksPerMultiprocessor(&per_cu, (const void*)trunk_fwd, NWAVES * 64, LDS_BYTES) != hipSuccess || per_cu < 1) { fprintf(stderr, "kernel_launch: occupancy query reports %d workgroups per CU\n", per_cu); }
        (void)hipGetLastError();
        grid = cus;
    }
    if (grid < 0) return;
    if (hipMemsetAsync((char*)d_ws + WS_CTL, 0, CTL_ZERO_BYTES, stream) != hipSuccess) return;
    Args a{};
    for (int i = 0; i < 33; ++i) a.in[i] = (const float*)d_in[i];
    a.out = (float*)d_out; a.ws = (unsigned char*)d_ws;
#if MK_PER_PHASE
    for (int p = 0; p < N_PHASES; ++p) { a.ph_lo = p; a.ph_hi = p + 1; hipLaunchKernelGGL(trunk_fwd, dim3(grid), dim3(NWAVES * 64), LDS_BYTES, stream, a); }
#else
    a.ph_lo = 0; a.ph_hi = N_PHASES; hipLaunchKernelGGL(trunk_fwd, dim3(grid), dim3(NWAVES * 64), LDS_BYTES, stream, a);
#endif
}
```

```cpp
#include <hip/hip_runtime.h>
#include <cstdio>
#include <cstdint>
namespace pg8 {
#define PG8_LAS __attribute__((address_space(3)))
typedef unsigned short bf16_t;
typedef short bf16x8 __attribute__((ext_vector_type(8)));
typedef float f32x4 __attribute__((ext_vector_type(4)));
typedef unsigned u32x4 __attribute__((ext_vector_type(4)));
constexpr int BM = 256, BK = 64, HALF = 128, HTB = HALF * BK * 2  , STAGE_BYTES = 8 * HTB, NXCD = 8, WGM = 8;

__host__ __device__ __forceinline__ int lds_byte(int r, int c) { const int st = (r >> 4) * 2 + (c >> 5), rr = r & 15, cc = c & 31, ob = rr * 64 + cc * 2; return st * 1024 + (ob ^ (((ob >> 9) & 1) << 5)); }
__host__ __device__ __forceinline__ void stage_rc(int b, int& R, int& C) { const int st = b / 1024, sb = b % 1024, swz = sb ^ (((sb >> 9) & 1) << 5); R = (st >> 1) * 16 + swz / 64; C = (st & 1) * 32 + (swz % 64) / 2; }
__host__ __device__ __forceinline__ int perm32(int rho) { const int n = rho >> 4, i = rho & 15; return 8 * (i >> 2) + 4 * n + (i & 3); }

struct Unit { int pm, pn; };
struct Gemm { const bf16_t* A; const bf16_t* Bt; int M, N, K; };

struct StaticOrder {
    int nM, nN, nwg, G, c;
    __host__ __device__ void init(int M, int N, int G_, int c_) { nM = M / BM; nN = N / BM; nwg = nM * nN; G = G_; c = c_; }
    __host__ __device__ bool next(int i, Unit& u) const {
        const long L = (long)i * G + c; if (L >= nwg) return false;
        int wgid = (int)L; { const int q = nwg / NXCD, r = nwg % NXCD, xcd = wgid % NXCD, off = wgid / NXCD; wgid = (xcd < r ? xcd * (q + 1) : r * (q + 1) + (xcd - r) * q) + off; }
        const int nig = WGM * nN, gid = wgid / nig, fm = gid * WGM, gsz = (nM - fm) < WGM ? (nM - fm) : WGM;
        u.pm = fm + ((wgid % nig) % gsz); u.pn = (wgid % nig) / gsz; return true;
    }
    __device__ __forceinline__ void a_ready(const Unit&) const {}
    __device__ __forceinline__ void done(const Unit&) const {}
};

#ifndef EPI_NT
#define EPI_NT 0
#endif
__device__ __forceinline__ unsigned cvt_pk_bf16(float lo, float hi) { unsigned r; asm volatile("v_cvt_pk_bf16_f32 %0, %1, %2" : "=v"(r) : "v"(lo), "v"(hi)); return r; }
#ifndef K_TWICE
#define K_TWICE 0
#endif
#ifndef EPI_TWICE
#define EPI_TWICE 0
#endif
template <int ACT> struct EpiBf16 {
    static constexpr bool PERM = true, AFTER_DRAIN = false, PROBE_TWICE = (EPI_TWICE != 0), PROBE_KTWICE = (K_TWICE != 0);
    bf16_t* O; int ldc;
    __device__ __forceinline__ void operator()(const f32x4 (&acc)[2][2][4][2], const Unit& u, int wr, int wc, int fr, int fq) const {
        const int row0 = u.pm * BM + wr * 64 + fr; const int col0 = u.pn * BM + wc * 32 + 8 * fq;
#pragma unroll
        for (int ai = 0; ai < 2; ++ai)
#pragma unroll
            for (int m = 0; m < 4; ++m) { bf16_t* rowp = O + (size_t)(row0 + ai * HALF + m * 16) * ldc + col0;
#pragma unroll
                for (int bj = 0; bj < 2; ++bj) { f32x4 v0 = acc[ai][bj][m][0], v1 = acc[ai][bj][m][1];
                    if (ACT == 2) {
#pragma unroll
                        for (int j = 0; j < 4; ++j) { v0[j] = __builtin_amdgcn_fmed3f(v0[j], 0.f, 3.0e38f); v1[j] = __builtin_amdgcn_fmed3f(v1[j], 0.f, 3.0e38f); }
                        v0 = v0 * v0; v1 = v1 * v1; }
                    u32x4 w; w.x = cvt_pk_bf16(v0[0], v0[1]); w.y = cvt_pk_bf16(v0[2], v0[3]); w.z = cvt_pk_bf16(v1[0], v1[1]); w.w = cvt_pk_bf16(v1[2], v1[3]);
                    if (EPI_NT) __builtin_nontemporal_store(w, (u32x4*)(rowp + bj * HALF)); else *(u32x4*)(rowp + bj * HALF) = w; } }
    }
};
struct EpiBf16RS {
    static constexpr bool PERM = true, AFTER_DRAIN = false, PROBE_TWICE = false, PROBE_KTWICE = false;
    bf16_t* O; int ldc; const float* rs;
    __device__ __forceinline__ void operator()(const f32x4 (&acc)[2][2][4][2], const Unit& u, int wr, int wc, int fr, int fq) const {
        const int row0 = u.pm * BM + wr * 64 + fr; const int col0 = u.pn * BM + wc * 32 + 8 * fq;
        float rv[2][4];
#pragma unroll
        for (int ai = 0; ai < 2; ++ai)
#pragma unroll
            for (int m = 0; m < 4; ++m) rv[ai][m] = rs[row0 + ai * HALF + m * 16];
#pragma unroll
        for (int ai = 0; ai < 2; ++ai)
#pragma unroll
            for (int m = 0; m < 4; ++m) { bf16_t* rowp = O + (size_t)(row0 + ai * HALF + m * 16) * ldc + col0; const float r = rv[ai][m];
#pragma unroll
                for (int bj = 0; bj < 2; ++bj) { const f32x4 v0 = acc[ai][bj][m][0] * r, v1 = acc[ai][bj][m][1] * r;
                    u32x4 w; w.x = cvt_pk_bf16(v0[0], v0[1]); w.y = cvt_pk_bf16(v0[2], v0[3]); w.z = cvt_pk_bf16(v1[0], v1[1]); w.w = cvt_pk_bf16(v1[2], v1[3]);
                    *(u32x4*)(rowp + bj * HALF) = w; } }
    }
};
typedef float f32x2_e __attribute__((ext_vector_type(2)));
typedef __bf16 bf16x2_e __attribute__((ext_vector_type(2)));
__device__ __forceinline__ unsigned cvt_pk_bf16_c(float lo, float hi) { const f32x2_e v = {lo, hi}; const bf16x2_e b = __builtin_convertvector(v, bf16x2_e); return __builtin_bit_cast(unsigned, b); }
struct EpiBf16ResScaleDT {
    static constexpr bool PERM = true, AFTER_DRAIN = false, PROBE_TWICE = false, PROBE_KTWICE = false;
    const bf16_t* base; bf16_t* out; int ldc; const float* ssp; float eps; const float* gwt; unsigned* xa; unsigned* tmo; PG8_LAS float* lf; float* rs_out; float* dt_out; float eps_n;
    __device__ __forceinline__ void operator()(const f32x4 (&acc)[2][2][4][2], const Unit& u, int wr, int wc, int fr, int fq) const {
        const int row0 = u.pm * BM + wr * 64 + fr, col0 = u.pn * BM + wc * 32 + 8 * fq;
        const int tid = (wr * 4 + wc) * 64 + fq * 16 + fr, gr = tid >> 1, gh = tid & 1;
        PG8_LAS float* rs2t = lf + 256;
        PG8_LAS float* dtp = lf + 512;
        { const float* sp = ssp + (size_t)(u.pm * BM + gr) * 16 + 8 * gh; const f32x4 t0 = *(const f32x4*)sp, t1 = *(const f32x4*)(sp + 4);
          float t = ((t0[0] + t0[1]) + (t0[2] + t0[3])) + ((t1[0] + t1[1]) + (t1[2] + t1[3])); t += __shfl_xor(t, 1);
          if (gh == 0) rs2t[gr] = 1.0f / (t * (1.0f / 1024.0f) + eps); }
        bf16x8 wb[2][2];
#pragma unroll
        for (int bj = 0; bj < 2; ++bj) { f32x4 w0 = (f32x4){0.f, 0.f, 0.f, 0.f}, w1 = w0;
            if (fr < 8) { const float* wp = gwt + (size_t)fr * 1024 + col0 + bj * HALF; w0 = *(const f32x4*)wp; w1 = *(const f32x4*)(wp + 4); }
            u32x4 hi, lo; f32x4 r0, r1;
            hi.x = cvt_pk_bf16_c(w0[0], w0[1]); hi.y = cvt_pk_bf16_c(w0[2], w0[3]); hi.z = cvt_pk_bf16_c(w1[0], w1[1]); hi.w = cvt_pk_bf16_c(w1[2], w1[3]);
            r0 = w0 - (f32x4){__builtin_bit_cast(float, hi.x << 16), __builtin_bit_cast(float, hi.x & 0xffff0000u), __builtin_bit_cast(float, hi.y << 16), __builtin_bit_cast(float, hi.y & 0xffff0000u)};
            r1 = w1 - (f32x4){__builtin_bit_cast(float, hi.z << 16), __builtin_bit_cast(float, hi.z & 0xffff0000u), __builtin_bit_cast(float, hi.w << 16), __builtin_bit_cast(float, hi.w & 0xffff0000u)};
            lo.x = cvt_pk_bf16_c(r0[0], r0[1]); lo.y = cvt_pk_bf16_c(r0[2], r0[3]); lo.z = cvt_pk_bf16_c(r1[0], r1[1]); lo.w = cvt_pk_bf16_c(r1[2], r1[3]);
            wb[bj][0] = __builtin_bit_cast(bf16x8, hi); wb[bj][1] = __builtin_bit_cast(bf16x8, lo); }
        __syncthreads();
#pragma unroll
        for (int ai = 0; ai < 2; ++ai) {
            u32x4 bw[4][2];
#pragma unroll
            for (int m = 0; m < 4; ++m)
#pragma unroll
                for (int bj = 0; bj < 2; ++bj) bw[m][bj] = *(const u32x4*)(base + (size_t)(row0 + ai * HALF + m * 16) * ldc + col0 + bj * HALF);
#pragma unroll
            for (int m = 0; m < 4; ++m) { const int rl = wr * 64 + m * 16; const size_t off = (size_t)(row0 + ai * HALF + m * 16) * ldc + col0;
                const float rs2 = rs2t[ai * HALF + rl + fr]; float ss = 0.f; f32x4 dacc = (f32x4){0.f, 0.f, 0.f, 0.f};
#pragma unroll
                for (int bj = 0; bj < 2; ++bj) { const u32x4 w = bw[m][bj];
                    const f32x4 b0 = (f32x4){__builtin_bit_cast(float, w.x << 16), __builtin_bit_cast(float, w.x & 0xffff0000u), __builtin_bit_cast(float, w.y << 16), __builtin_bit_cast(float, w.y & 0xffff0000u)};
                    const f32x4 b1 = (f32x4){__builtin_bit_cast(float, w.z << 16), __builtin_bit_cast(float, w.z & 0xffff0000u), __builtin_bit_cast(float, w.w << 16), __builtin_bit_cast(float, w.w & 0xffff0000u)};
                    const f32x4 h0 = b0 + acc[ai][bj][m][0] * rs2, h1 = b1 + acc[ai][bj][m][1] * rs2;
                    u32x4 o; o.x = cvt_pk_bf16_c(h0[0], h0[1]); o.y = cvt_pk_bf16_c(h0[2], h0[3]); o.z = cvt_pk_bf16_c(h1[0], h1[1]); o.w = cvt_pk_bf16_c(h1[2], h1[3]);
                    *(u32x4*)(out + off + bj * HALF) = o;
                    const f32x4 r0 = (f32x4){__builtin_bit_cast(float, o.x << 16), __builtin_bit_cast(float, o.x & 0xffff0000u), __builtin_bit_cast(float, o.y << 16), __builtin_bit_cast(float, o.y & 0xffff0000u)};
                    const f32x4 r1 = (f32x4){__builtin_bit_cast(float, o.z << 16), __builtin_bit_cast(float, o.z & 0xffff0000u), __builtin_bit_cast(float, o.w << 16), __builtin_bit_cast(float, o.w & 0xffff0000u)};
                    ss += ((r0[0] * r0[0] + r0[1] * r0[1]) + (r0[2] * r0[2] + r0[3] * r0[3])) + ((r1[0] * r1[0] + r1[1] * r1[1]) + (r1[2] * r1[2] + r1[3] * r1[3]));
                    const bf16x8 af = __builtin_bit_cast(bf16x8, o);
                    dacc = __builtin_amdgcn_mfma_f32_16x16x32_bf16(af, wb[bj][0], dacc, 0, 0, 0); dacc = __builtin_amdgcn_mfma_f32_16x16x32_bf16(af, wb[bj][1], dacc, 0, 0, 0); }
                ss += __shfl_xor(ss, 16); ss += __shfl_xor(ss, 32);
                if (fq == 0) dtp[(wc * 9 + 8) * 128 + rl + fr] = ss;
                if (fr < 8) *(PG8_LAS f32x4*)(dtp + (wc * 9 + fr) * 128 + rl + 4 * fq) = dacc; }
            __syncthreads();
            for (int e = tid; e < 9 * 128; e += 512) { const int qq = e >> 7, rr = e & 127;
                const float sv = (dtp[(0 * 9 + qq) * 128 + rr] + dtp[(1 * 9 + qq) * 128 + rr]) + (dtp[(2 * 9 + qq) * 128 + rr] + dtp[(3 * 9 + qq) * 128 + rr]);
                __hip_atomic_store(xa + (size_t)(u.pm * BM + ai * HALF + rr) * 36 + u.pn * 9 + qq, __builtin_bit_cast(unsigned, sv) | 1u, __ATOMIC_RELAXED, __HIP_MEMORY_SCOPE_AGENT); }
            __syncthreads(); }
        { typedef unsigned long long u64_;
          u64_* gp = (u64_*)(xa + (size_t)(u.pm * BM + gr) * 36 + 18 * gh);
          u64_ q[9]; unsigned spins = 0;
          for (;;) { bool ok = true;
#pragma unroll
              for (int j = 0; j < 9; ++j) q[j] = __hip_atomic_load(gp + j, __ATOMIC_RELAXED, __HIP_MEMORY_SCOPE_AGENT);
#pragma unroll
              for (int j = 0; j < 9; ++j) ok = ok && ((unsigned)q[j] != 0u) && ((unsigned)(q[j] >> 32) != 0u);
              if (ok) break;
              __builtin_amdgcn_s_sleep(2);
              if ((++spins & 255u) == 0u) { if (spins > (1u << 17) || __hip_atomic_load(tmo, __ATOMIC_RELAXED, __HIP_MEMORY_SCOPE_AGENT) != 0u) { __hip_atomic_store(tmo, 1u, __ATOMIC_RELAXED, __HIP_MEMORY_SCOPE_AGENT); break; } } }
          float v[18];
#pragma unroll
          for (int j = 0; j < 9; ++j) { v[2 * j] = __builtin_bit_cast(float, (unsigned)q[j]); v[2 * j + 1] = __builtin_bit_cast(float, (unsigned)(q[j] >> 32)); }
          float tot[9];
#pragma unroll
          for (int k = 0; k < 9; ++k) { float t = v[k] + v[9 + k]; t += __shfl_xor(t, 1); tot[k] = t; }
          const float rs = 1.0f / sqrtf(tot[8] * (1.0f / 1024.0f) + eps_n); const size_t R = (size_t)(u.pm * BM + gr);
          if (gh == 0) { rs_out[R] = rs; *(f32x4*)(dt_out + R * 8) = (f32x4){tot[0] * rs, tot[1] * rs, tot[2] * rs, tot[3] * rs}; }
          else *(f32x4*)(dt_out + R * 8 + 4) = (f32x4){tot[4] * rs, tot[5] * rs, tot[6] * rs, tot[7] * rs}; }
    }
};
struct EpiFinalNorm {
    static constexpr bool PERM = true, AFTER_DRAIN = false, PROBE_TWICE = false, PROBE_KTWICE = false;
    const bf16_t* base; float* out; int ldc; const float* ssp; float eps; const float* gain; unsigned* xs; unsigned* tmo; PG8_LAS float* rsf;
    __device__ __forceinline__ void operator()(f32x4 (&acc)[2][2][4][2], const Unit& u, int wr, int wc, int fr, int fq) const {
        const int row0 = u.pm * BM + wr * 64 + fr, col0 = u.pn * BM + wc * 32 + 8 * fq;
        const int tid = (wr * 4 + wc) * 64 + fq * 16 + fr, gr = tid >> 1, gh = tid & 1;
        { const float* sp = ssp + (size_t)(u.pm * BM + gr) * 16 + 8 * gh; const f32x4 t0 = *(const f32x4*)sp, t1 = *(const f32x4*)(sp + 4);
          float t = ((t0[0] + t0[1]) + (t0[2] + t0[3])) + ((t1[0] + t1[1]) + (t1[2] + t1[3])); t += __shfl_xor(t, 1);
          if (gh == 0) rsf[256 + gr] = 1.0f / (t * (1.0f / 1024.0f) + eps); }
        __syncthreads();
        float rs2v[2][4];
#pragma unroll
        for (int ai = 0; ai < 2; ++ai)
#pragma unroll
            for (int m = 0; m < 4; ++m) rs2v[ai][m] = rsf[256 + ai * HALF + wr * 64 + m * 16 + fr];
#pragma unroll
        for (int ai = 0; ai < 2; ++ai) {
            u32x4 bw[4][2];
#pragma unroll
            for (int m = 0; m < 4; ++m)
#pragma unroll
                for (int bj = 0; bj < 2; ++bj) bw[m][bj] = *(const u32x4*)(base + (size_t)(row0 + ai * HALF + m * 16) * ldc + col0 + bj * HALF);
#pragma unroll
            for (int m = 0; m < 4; ++m) { const int row = row0 + ai * HALF + m * 16; const float rs2 = rs2v[ai][m]; float ss = 0.f;
#pragma unroll
                for (int bj = 0; bj < 2; ++bj) { const u32x4 w = bw[m][bj];
                    const f32x4 b0 = (f32x4){__builtin_bit_cast(float, w.x << 16), __builtin_bit_cast(float, w.x & 0xffff0000u), __builtin_bit_cast(float, w.y << 16), __builtin_bit_cast(float, w.y & 0xffff0000u)};
                    const f32x4 b1 = (f32x4){__builtin_bit_cast(float, w.z << 16), __builtin_bit_cast(float, w.z & 0xffff0000u), __builtin_bit_cast(float, w.w << 16), __builtin_bit_cast(float, w.w & 0xffff0000u)};
                    const f32x4 h0 = b0 + acc[ai][bj][m][0] * rs2, h1 = b1 + acc[ai][bj][m][1] * rs2;
                    acc[ai][bj][m][0] = h0; acc[ai][bj][m][1] = h1;
                    ss += ((h0[0] * h0[0] + h0[1] * h0[1]) + (h0[2] * h0[2] + h0[3] * h0[3])) + ((h1[0] * h1[0] + h1[1] * h1[1]) + (h1[2] * h1[2] + h1[3] * h1[3])); }
                ss += __shfl_xor(ss, 16); ss += __shfl_xor(ss, 32);
                if (fq == 0) __hip_atomic_store(xs + (size_t)row * 16 + u.pn * 4 + wc, __builtin_bit_cast(unsigned, ss) | 1u, __ATOMIC_RELAXED, __HIP_MEMORY_SCOPE_AGENT); }
#pragma unroll
            for (int bj = 0; bj < 2; ++bj)
#pragma unroll
                for (int m = 0; m < 4; ++m) asm volatile("" : "+v"(acc[ai][bj][m][0]), "+v"(acc[ai][bj][m][1]) :: "memory"); }
        { const int r = gr, h = gh;
          typedef unsigned long long u64_;
          u64_* gp = (u64_*)(xs + (size_t)(u.pm * BM + r) * 16 + 8 * h);
          u64_ q[4]; unsigned spins = 0;
          for (;;) { bool ok = true;
#pragma unroll
              for (int j = 0; j < 4; ++j) q[j] = __hip_atomic_load(gp + j, __ATOMIC_RELAXED, __HIP_MEMORY_SCOPE_AGENT);
#pragma unroll
              for (int j = 0; j < 4; ++j) ok = ok && ((unsigned)q[j] != 0u) && ((unsigned)(q[j] >> 32) != 0u);
              if (ok) break;
              __builtin_amdgcn_s_sleep(2);
              if ((++spins & 255u) == 0u) { if (spins > (1u << 17) || __hip_atomic_load(tmo, __ATOMIC_RELAXED, __HIP_MEMORY_SCOPE_AGENT) != 0u) { __hip_atomic_store(tmo, 1u, __ATOMIC_RELAXED, __HIP_MEMORY_SCOPE_AGENT); break; } } }
          float s = 0.f;
#pragma unroll
          for (int j = 0; j < 4; ++j) s += __builtin_bit_cast(float, (unsigned)q[j]) + __builtin_bit_cast(float, (unsigned)(q[j] >> 32));
          s += __shfl_xor(s, 1);
          if (h == 0) rsf[r] = 1.0f / sqrtf(s * (1.0f / 1024.0f) + eps); }
        __syncthreads();
        f32x4 gv[2][2];
#pragma unroll
        for (int bj = 0; bj < 2; ++bj) { gv[bj][0] = *(const f32x4*)(gain + col0 + bj * HALF); gv[bj][1] = *(const f32x4*)(gain + col0 + bj * HALF + 4); }
#pragma unroll
        for (int ai = 0; ai < 2; ++ai)
#pragma unroll
            for (int m = 0; m < 4; ++m) { const int rl = ai * HALF + wr * 64 + m * 16 + fr; const float rf = rsf[rl]; float* op = out + (size_t)(u.pm * BM + rl) * ldc + col0;
#pragma unroll
                for (int bj = 0; bj < 2; ++bj) { *(f32x4*)(op + bj * HALF) = acc[ai][bj][m][0] * rf * gv[bj][0]; *(f32x4*)(op + bj * HALF + 4) = acc[ai][bj][m][1] * rf * gv[bj][1]; } }
    }
};
struct EpiF32Res {
    static constexpr bool PERM = false, AFTER_DRAIN = false, PROBE_TWICE = false, PROBE_KTWICE = false;
    const float* base; float* out; int ldc;
    __device__ __forceinline__ void operator()(const f32x4 (&acc)[2][2][4][2], const Unit& u, int wr, int wc, int fr, int fq) const {
        const int row0 = u.pm * BM + wr * 64 + fr, col0 = u.pn * BM + wc * 32 + 4 * fq;
#pragma unroll
        for (int ai = 0; ai < 2; ++ai)
#pragma unroll
            for (int m = 0; m < 4; ++m) { const size_t off = (size_t)(row0 + ai * HALF + m * 16) * ldc + col0;
                f32x4 bs[2][2];
#pragma unroll
                for (int bj = 0; bj < 2; ++bj)
#pragma unroll
                    for (int n = 0; n < 2; ++n) bs[bj][n] = *(const f32x4*)(base + off + bj * HALF + n * 16);
#pragma unroll
                for (int bj = 0; bj < 2; ++bj)
#pragma unroll
                    for (int n = 0; n < 2; ++n) *(f32x4*)(out + off + bj * HALF + n * 16) = bs[bj][n] + acc[ai][bj][m][n];
                asm volatile("" ::: "memory"); }
    }
};

struct EpiF32ResNorm {
    static constexpr bool PERM = true, AFTER_DRAIN = false, PROBE_TWICE = false, PROBE_KTWICE = false;
    const float* base; float* out; int ldc; const float* gain; bf16_t* xn; float* ssp;
    __device__ __forceinline__ void operator()(const f32x4 (&acc)[2][2][4][2], const Unit& u, int wr, int wc, int fr, int fq) const {
        const int row0 = u.pm * BM + wr * 64 + fr, col0 = u.pn * BM + wc * 32 + 8 * fq;
        f32x4 gv[2][2];
#pragma unroll
        for (int bj = 0; bj < 2; ++bj)
#pragma unroll
            for (int n = 0; n < 2; ++n) gv[bj][n] = *(const f32x4*)(gain + col0 + bj * HALF + n * 4);
#pragma unroll
        for (int ai = 0; ai < 2; ++ai)
#pragma unroll
            for (int m = 0; m < 4; ++m) { const int row = row0 + ai * HALF + m * 16; const size_t off = (size_t)row * ldc + col0;
                f32x4 bs[2][2];
#pragma unroll
                for (int bj = 0; bj < 2; ++bj)
#pragma unroll
                    for (int n = 0; n < 2; ++n) bs[bj][n] = *(const f32x4*)(base + off + bj * HALF + n * 4);
                float ss = 0.f;
#pragma unroll
                for (int bj = 0; bj < 2; ++bj) { const f32x4 h0 = bs[bj][0] + acc[ai][bj][m][0], h1 = bs[bj][1] + acc[ai][bj][m][1];
                    *(f32x4*)(out + off + bj * HALF) = h0; *(f32x4*)(out + off + bj * HALF + 4) = h1;
                    ss += ((h0[0] * h0[0] + h0[1] * h0[1]) + (h0[2] * h0[2] + h0[3] * h0[3])) + ((h1[0] * h1[0] + h1[1] * h1[1]) + (h1[2] * h1[2] + h1[3] * h1[3]));
                    const f32x4 y0 = h0 * gv[bj][0], y1 = h1 * gv[bj][1];
                    u32x4 w; w.x = cvt_pk_bf16(y0[0], y0[1]); w.y = cvt_pk_bf16(y0[2], y0[3]); w.z = cvt_pk_bf16(y1[0], y1[1]); w.w = cvt_pk_bf16(y1[2], y1[3]);
                    *(u32x4*)(xn + off + bj * HALF) = w; }
                ss += __shfl_xor(ss, 16); ss += __shfl_xor(ss, 32);
                if (fq == 0) ssp[(size_t)row * 16 + u.pn * 4 + wc] = ss;
                asm volatile("" ::: "memory"); }
    }
};
struct EpiF32ResScale {
    static constexpr bool PERM = false, AFTER_DRAIN = false, PROBE_TWICE = false, PROBE_KTWICE = false;
    const float* base; float* out; int ldc; const float* ssp; float eps;
    __device__ __forceinline__ void operator()(const f32x4 (&acc)[2][2][4][2], const Unit& u, int wr, int wc, int fr, int fq) const {
        const int row0 = u.pm * BM + wr * 64 + fr, col0 = u.pn * BM + wc * 32 + 4 * fq;
        float rs2[2][4];
#pragma unroll
        for (int ai = 0; ai < 2; ++ai)
#pragma unroll
            for (int m = 0; m < 4; ++m) { const f32x4* sp = (const f32x4*)(ssp + (size_t)(row0 + ai * HALF + m * 16) * 16); const f32x4 a = sp[0], b = sp[1], c = sp[2], d = sp[3];
                const f32x4 t = (a + b) + (c + d); rs2[ai][m] = 1.0f / (((t[0] + t[1]) + (t[2] + t[3])) * (1.0f / 1024.0f) + eps); }
#pragma unroll
        for (int ai = 0; ai < 2; ++ai)
#pragma unroll
            for (int m = 0; m < 4; ++m) { const size_t off = (size_t)(row0 + ai * HALF + m * 16) * ldc + col0;
                f32x4 bs[2][2];
#pragma unroll
                for (int bj = 0; bj < 2; ++bj)
#pragma unroll
                    for (int n = 0; n < 2; ++n) bs[bj][n] = *(const f32x4*)(base + off + bj * HALF + n * 16);
#pragma unroll
                for (int bj = 0; bj < 2; ++bj)
#pragma unroll
                    for (int n = 0; n < 2; ++n) *(f32x4*)(out + off + bj * HALF + n * 16) = bs[bj][n] + acc[ai][bj][m][n] * rs2[ai][m];
                asm volatile("" ::: "memory"); }
    }
};

template <bool BASE_F32> struct EpiBf16Res {
    static constexpr bool PERM = true, AFTER_DRAIN = false, PROBE_TWICE = false, PROBE_KTWICE = false;
    const void* base; bf16_t* out; int ldc;
    __device__ __forceinline__ void operator()(const f32x4 (&acc)[2][2][4][2], const Unit& u, int wr, int wc, int fr, int fq) const {
        const int row0 = u.pm * BM + wr * 64 + fr, col0 = u.pn * BM + wc * 32 + 8 * fq;
        if (!BASE_F32) {
            u32x4 bw[2][4][2];
#pragma unroll
            for (int ai = 0; ai < 2; ++ai)
#pragma unroll
                for (int m = 0; m < 4; ++m)
#pragma unroll
                    for (int bj = 0; bj < 2; ++bj) bw[ai][m][bj] = *(const u32x4*)((const bf16_t*)base + (size_t)(row0 + ai * HALF + m * 16) * ldc + col0 + bj * HALF);
#pragma unroll
            for (int ai = 0; ai < 2; ++ai)
#pragma unroll
                for (int m = 0; m < 4; ++m) { const size_t off = (size_t)(row0 + ai * HALF + m * 16) * ldc + col0;
#pragma unroll
                    for (int bj = 0; bj < 2; ++bj) { const u32x4 w = bw[ai][m][bj];
                        const f32x4 b0 = (f32x4){__builtin_bit_cast(float, w.x << 16), __builtin_bit_cast(float, w.x & 0xffff0000u), __builtin_bit_cast(float, w.y << 16), __builtin_bit_cast(float, w.y & 0xffff0000u)};
                        const f32x4 b1 = (f32x4){__builtin_bit_cast(float, w.z << 16), __builtin_bit_cast(float, w.z & 0xffff0000u), __builtin_bit_cast(float, w.w << 16), __builtin_bit_cast(float, w.w & 0xffff0000u)};
                        const f32x4 h0 = b0 + acc[ai][bj][m][0], h1 = b1 + acc[ai][bj][m][1];
                        u32x4 o; o.x = cvt_pk_bf16(h0[0], h0[1]); o.y = cvt_pk_bf16(h0[2], h0[3]); o.z = cvt_pk_bf16(h1[0], h1[1]); o.w = cvt_pk_bf16(h1[2], h1[3]);
                        *(u32x4*)(out + off + bj * HALF) = o; } }
        } else {
#pragma unroll
            for (int ai = 0; ai < 2; ++ai) {
                f32x4 bf[4][2][2];
#pragma unroll
                for (int m = 0; m < 4; ++m)
#pragma unroll
                    for (int bj = 0; bj < 2; ++bj) { const float* bp = (const float*)base + (size_t)(row0 + ai * HALF + m * 16) * ldc + col0 + bj * HALF; bf[m][bj][0] = *(const f32x4*)bp; bf[m][bj][1] = *(const f32x4*)(bp + 4); }
#pragma unroll
                for (int m = 0; m < 4; ++m) { const size_t off = (size_t)(row0 + ai * HALF + m * 16) * ldc + col0;
#pragma unroll
                    for (int bj = 0; bj < 2; ++bj) { const f32x4 h0 = bf[m][bj][0] + acc[ai][bj][m][0], h1 = bf[m][bj][1] + acc[ai][bj][m][1];
                        u32x4 o; o.x = cvt_pk_bf16(h0[0], h0[1]); o.y = cvt_pk_bf16(h0[2], h0[3]); o.z = cvt_pk_bf16(h1[0], h1[1]); o.w = cvt_pk_bf16(h1[2], h1[3]);
                        *(u32x4*)(out + off + bj * HALF) = o; } }
                asm volatile("" ::: "memory"); }
        }
    }
};

template <bool BASE_F32> struct EpiBf16ResSS {
    static constexpr bool PERM = true, AFTER_DRAIN = false, PROBE_TWICE = false, PROBE_KTWICE = false;
    const void* base; bf16_t* out; int ldc; float* ssp;
    __device__ __forceinline__ void operator()(const f32x4 (&acc)[2][2][4][2], const Unit& u, int wr, int wc, int fr, int fq) const {
        const int row0 = u.pm * BM + wr * 64 + fr, col0 = u.pn * BM + wc * 32 + 8 * fq;
#pragma unroll
        for (int ai = 0; ai < 2; ++ai) {
            f32x4 bf[4][2][2];
            if (BASE_F32) {
#pragma unroll
                for (int m = 0; m < 4; ++m)
#pragma unroll
                    for (int bj = 0; bj < 2; ++bj) { const float* bp = (const float*)base + (size_t)(row0 + ai * HALF + m * 16) * ldc + col0 + bj * HALF; bf[m][bj][0] = *(const f32x4*)bp; bf[m][bj][1] = *(const f32x4*)(bp + 4); }
            } else {
                u32x4 bw[4][2];
#pragma unroll
                for (int m = 0; m < 4; ++m)
#pragma unroll
                    for (int bj = 0; bj < 2; ++bj) bw[m][bj] = *(const u32x4*)((const bf16_t*)base + (size_t)(row0 + ai * HALF + m * 16) * ldc + col0 + bj * HALF);
#pragma unroll
                for (int m = 0; m < 4; ++m)
#pragma unroll
                    for (int bj = 0; bj < 2; ++bj) { const u32x4 w = bw[m][bj];
                        bf[m][bj][0] = (f32x4){__builtin_bit_cast(float, w.x << 16), __builtin_bit_cast(float, w.x & 0xffff0000u), __builtin_bit_cast(float, w.y << 16), __builtin_bit_cast(float, w.y & 0xffff0000u)};
                        bf[m][bj][1] = (f32x4){__builtin_bit_cast(float, w.z << 16), __builtin_bit_cast(float, w.z & 0xffff0000u), __builtin_bit_cast(float, w.w << 16), __builtin_bit_cast(float, w.w & 0xffff0000u)}; }
            }
#pragma unroll
            for (int m = 0; m < 4; ++m) { const int row = row0 + ai * HALF + m * 16; const size_t off = (size_t)row * ldc + col0; float ss = 0.f;
#pragma unroll
                for (int bj = 0; bj < 2; ++bj) { const f32x4 h0 = bf[m][bj][0] + acc[ai][bj][m][0], h1 = bf[m][bj][1] + acc[ai][bj][m][1];
                    u32x4 o; o.x = cvt_pk_bf16(h0[0], h0[1]); o.y = cvt_pk_bf16(h0[2], h0[3]); o.z = cvt_pk_bf16(h1[0], h1[1]); o.w = cvt_pk_bf16(h1[2], h1[3]);
                    *(u32x4*)(out + off + bj * HALF) = o;
                    const f32x4 r0 = (f32x4){__builtin_bit_cast(float, o.x << 16), __builtin_bit_cast(float, o.x & 0xffff0000u), __builtin_bit_cast(float, o.y << 16), __builtin_bit_cast(float, o.y & 0xffff0000u)};
                    const f32x4 r1 = (f32x4){__builtin_bit_cast(float, o.z << 16), __builtin_bit_cast(float, o.z & 0xffff0000u), __builtin_bit_cast(float, o.w << 16), __builtin_bit_cast(float, o.w & 0xffff0000u)};
                    ss += ((r0[0] * r0[0] + r0[1] * r0[1]) + (r0[2] * r0[2] + r0[3] * r0[3])) + ((r1[0] * r1[0] + r1[1] * r1[1]) + (r1[2] * r1[2] + r1[3] * r1[3])); }
                ss += __shfl_xor(ss, 16); ss += __shfl_xor(ss, 32);
                if (fq == 0) ssp[(size_t)row * 16 + u.pn * 4 + wc] = ss; }
            asm volatile("" ::: "memory"); }
    }
};
struct EpiBf16ResScale {
    static constexpr bool PERM = true, AFTER_DRAIN = false, PROBE_TWICE = false, PROBE_KTWICE = false;
    const bf16_t* base; bf16_t* out; int ldc; const float* ssp; float eps;
    __device__ __forceinline__ void operator()(const f32x4 (&acc)[2][2][4][2], const Unit& u, int wr, int wc, int fr, int fq) const {
        const int row0 = u.pm * BM + wr * 64 + fr, col0 = u.pn * BM + wc * 32 + 8 * fq;
        float rs2v[2][4];
#pragma unroll
        for (int ai = 0; ai < 2; ++ai) { f32x4 sq[4][4];
#pragma unroll
            for (int m = 0; m < 4; ++m)
#pragma unroll
                for (int k = 0; k < 4; ++k) sq[m][k] = *(const f32x4*)(ssp + (size_t)(row0 + ai * HALF + m * 16) * 16 + 4 * k);
#pragma unroll
            for (int m = 0; m < 4; ++m) { const f32x4 t = (sq[m][0] + sq[m][1]) + (sq[m][2] + sq[m][3]); rs2v[ai][m] = 1.0f / (((t[0] + t[1]) + (t[2] + t[3])) * (1.0f / 1024.0f) + eps); }
            asm volatile("" ::: "memory"); }
#pragma unroll
        for (int ai = 0; ai < 2; ++ai) {
            u32x4 bw[4][2];
#pragma unroll
            for (int m = 0; m < 4; ++m)
#pragma unroll
                for (int bj = 0; bj < 2; ++bj) bw[m][bj] = *(const u32x4*)(base + (size_t)(row0 + ai * HALF + m * 16) * ldc + col0 + bj * HALF);
#pragma unroll
            for (int m = 0; m < 4; ++m) { const size_t off = (size_t)(row0 + ai * HALF + m * 16) * ldc + col0;
                const float rs2 = rs2v[ai][m];
#pragma unroll
                for (int bj = 0; bj < 2; ++bj) { const u32x4 w = bw[m][bj];
                    const f32x4 b0 = (f32x4){__builtin_bit_cast(float, w.x << 16), __builtin_bit_cast(float, w.x & 0xffff0000u), __builtin_bit_cast(float, w.y << 16), __builtin_bit_cast(float, w.y & 0xffff0000u)};
                    const f32x4 b1 = (f32x4){__builtin_bit_cast(float, w.z << 16), __builtin_bit_cast(float, w.z & 0xffff0000u), __builtin_bit_cast(float, w.w << 16), __builtin_bit_cast(float, w.w & 0xffff0000u)};
                    const f32x4 h0 = b0 + acc[ai][bj][m][0] * rs2, h1 = b1 + acc[ai][bj][m][1] * rs2;
                    u32x4 o; o.x = cvt_pk_bf16(h0[0], h0[1]); o.y = cvt_pk_bf16(h0[2], h0[3]); o.z = cvt_pk_bf16(h1[0], h1[1]); o.w = cvt_pk_bf16(h1[2], h1[3]);
                    *(u32x4*)(out + off + bj * HALF) = o; } }
            asm volatile("" ::: "memory"); }
    }
};
#ifndef RELAX_EPI_WAIT
#define RELAX_EPI_WAIT 0
#endif
template <class Epi, class Sched, bool ALIGN_EPI = false, bool SP2 = false>
__device__ __forceinline__ void gemm_phase(PG8_LAS unsigned char* lds, const Gemm g, const Sched& S, const Epi& E) {
    int tid_ = threadIdx.x; asm volatile("" : "+v"(tid_));
    const int tid = tid_, wid = __builtin_amdgcn_readfirstlane(tid >> 6), lane = tid & 63, wr = wid >> 2, wc = wid & 3, fr = lane & 15, fq = lane >> 4;
    const int K = g.K, nt = K / BK;
    unsigned voffA[2], voffB[2];
#pragma unroll
    for (int i = 0; i < 2; ++i) { int R, C; stage_rc(tid * 16 + i * 8192, R, C); const int Rb = Epi::PERM ? ((R & ~31) + perm32(R & 31)) : R;
        voffA[i] = (unsigned)(R * K + C) * 2u; voffB[i] = (unsigned)(Rb * K + C) * 2u; }
    const size_t kstep = (size_t)(BK * 2);
    const size_t hstep = (size_t)HALF * K * 2;
    const size_t qstep = (size_t)64 * K * 2;
    const size_t tstep = 2 * hstep;
    const unsigned ldsw = (unsigned)wid * 1024u;
    const int aoff = lds_byte(wr * 64 + fr, fq * 8), boff = lds_byte(wc * 32 + fr, fq * 8);
#define PG8_SA(b, h) (((b) * 2 + (h)) * HTB)
#define PG8_SB(b, h) ((4 + (b) * 2 + (h)) * HTB)
#define PG8_STAGE(bufoff, gbase, voff) do { _Pragma("unroll") for (int _i = 0; _i < 2; ++_i) \
        __builtin_amdgcn_global_load_lds((const unsigned*)((const char*)(gbase) + (size_t)_i * qstep + (voff)[0]), (PG8_LAS unsigned*)(lds + (bufoff) + ldsw + _i * 8192), 16, 0, 0); } while (0)
#define PG8_LDA(dst, b, h) do { _Pragma("unroll") for (int m = 0; m < 4; ++m) _Pragma("unroll") for (int k = 0; k < 2; ++k) dst[m][k] = *(const PG8_LAS bf16x8*)(lds + PG8_SA(b, h) + aoff + m * 2048 + k * 1024); } while (0)
#define PG8_LDB(dst, b, h) do { _Pragma("unroll") for (int n = 0; n < 2; ++n) _Pragma("unroll") for (int k = 0; k < 2; ++k) dst[n][k] = *(const PG8_LAS bf16x8*)(lds + PG8_SB(b, h) + boff + n * 2048 + k * 1024); } while (0)
#define PG8_MMA(ai, bj, At, Bt) do { __builtin_amdgcn_s_setprio(1); _Pragma("unroll") for (int m = 0; m < 4; ++m) _Pragma("unroll") for (int n = 0; n < 2; ++n) _Pragma("unroll") for (int k = 0; k < 2; ++k) \
        acc[ai][bj][m][n] = __builtin_amdgcn_mfma_f32_16x16x32_bf16(Bt[n][k], At[m][k], acc[ai][bj][m][n], 0, 0, 0); __builtin_amdgcn_s_setprio(0); } while (0)
#define PG8_WAIT_V(n) asm volatile("s_waitcnt vmcnt(" #n ")" ::: "memory")
#define PG8_WAIT_L(n) asm volatile("s_waitcnt lgkmcnt(" #n ")" ::: "memory")
#define PG8_BAR __builtin_amdgcn_s_barrier()
#define PG8_SCHED __builtin_amdgcn_sched_barrier(0)
    Unit cur, nxt; int ui = 0;
    constexpr int KT2 = Epi::PROBE_KTWICE ? 1 : 0;
    if (!S.next(0, cur)) return;
    f32x4 acc[2][2][4][2];
#pragma unroll
    for (int a = 0; a < 2; ++a)
#pragma unroll
        for (int b = 0; b < 2; ++b)
#pragma unroll
            for (int m = 0; m < 4; ++m)
#pragma unroll
                for (int n = 0; n < 2; ++n) acc[a][b][m][n] = (f32x4){0.f, 0.f, 0.f, 0.f};
    bf16x8 At[4][2], B0[2][2], B1[2][2];
    const char* cA = (const char*)g.A + (size_t)cur.pm * tstep; const char* cB = (const char*)g.Bt + (size_t)cur.pn * tstep;
    S.a_ready(cur);
    if constexpr (SP2) {
        PG8_STAGE(PG8_SB(0, 0), cB, voffB); PG8_STAGE(PG8_SB(0, 1), cB + hstep, voffB); PG8_STAGE(PG8_SA(0, 0), cA, voffA); PG8_STAGE(PG8_SA(0, 1), cA + hstep, voffA);
        if (wr == 1) PG8_BAR;
        PG8_WAIT_V(2); PG8_BAR;
        PG8_STAGE(PG8_SB(1, 0), cB + kstep, voffB); PG8_STAGE(PG8_SA(1, 0), cA + kstep, voffA); PG8_STAGE(PG8_SB(1, 1), cB + hstep + kstep, voffB);
        PG8_WAIT_V(6); PG8_BAR;
    } else {
        PG8_STAGE(PG8_SB(0, 0), cB, voffB); PG8_STAGE(PG8_SA(0, 0), cA, voffA); PG8_STAGE(PG8_SB(0, 1), cB + hstep, voffB); PG8_STAGE(PG8_SA(0, 1), cA + hstep, voffA);
        if (wr == 1) PG8_BAR;
        PG8_WAIT_V(4); PG8_BAR;
        PG8_STAGE(PG8_SB(1, 0), cB + kstep, voffB); PG8_STAGE(PG8_SA(1, 0), cA + kstep, voffA); PG8_STAGE(PG8_SB(1, 1), cB + hstep + kstep, voffB);
        PG8_WAIT_V(6); PG8_BAR;
    }
#define PG8_ITER(W1) do { \
            PG8_LDB(B0, 0, 0); PG8_LDB(B1, 0, 1); PG8_SCHED; PG8_LDA(At, 0, 0); PG8_STAGE(PG8_SA(1, 1), a1 + hstep, voffA); \
            PG8_WAIT_V(W1); PG8_WAIT_L(0); PG8_BAR; PG8_MMA(0, 0, At, B0); PG8_MMA(0, 1, At, B1); PG8_BAR; PG8_SCHED; \
            PG8_LDA(At, 0, 1); PG8_STAGE(PG8_SB(0, 0), b2, voffB); PG8_STAGE(PG8_SB(0, 1), b2 + hstep, voffB); PG8_STAGE(PG8_SA(0, 0), a2, voffA); \
            PG8_WAIT_V(W1); PG8_WAIT_L(0); PG8_BAR; PG8_MMA(1, 0, At, B0); PG8_MMA(1, 1, At, B1); PG8_BAR; PG8_SCHED; \
            PG8_LDB(B0, 1, 0); PG8_LDB(B1, 1, 1); PG8_SCHED; PG8_LDA(At, 1, 0); PG8_STAGE(PG8_SA(0, 1), a2 + hstep, voffA); \
            PG8_WAIT_V(8); PG8_WAIT_L(0); PG8_BAR; PG8_MMA(0, 0, At, B0); PG8_MMA(0, 1, At, B1); PG8_BAR; PG8_SCHED; \
            PG8_LDA(At, 1, 1); PG8_STAGE(PG8_SB(1, 0), b3, voffB); PG8_STAGE(PG8_SB(1, 1), b3 + hstep, voffB); PG8_STAGE(PG8_SA(1, 0), a3, voffA); \
            PG8_WAIT_V(8); PG8_WAIT_L(0); PG8_BAR; PG8_MMA(1, 0, At, B0); PG8_MMA(1, 1, At, B1); PG8_BAR; PG8_SCHED; } while (0)
    if constexpr (SP2 && RELAX_EPI_WAIT != 0) {
#pragma unroll
        for (int dq = 0; dq < 16; ++dq) __builtin_amdgcn_global_load_lds((const unsigned*)(cA + voffA[0]), (PG8_LAS unsigned*)(lds + STAGE_BYTES + ldsw), 16, 0, 0);
    }
    for (;;) {
        const bool has_next = S.next((ui + 1) >> KT2, nxt);
        const char* nA = has_next ? (const char*)g.A + (size_t)nxt.pm * tstep : cA; const char* nB = has_next ? (const char*)g.Bt + (size_t)nxt.pn * tstep : cB;
        if constexpr (SP2 && RELAX_EPI_WAIT != 0) {
            const char* a1 = cA + kstep; const char* a2 = cA + 2 * kstep; const char* b2 = cB + 2 * kstep; const char* a3 = a2 + kstep; const char* b3 = b2 + kstep;
            PG8_ITER(24);
        }
        for (int t = (SP2 && RELAX_EPI_WAIT != 0) ? 2 : 0; t < nt; t += 2) {
            const bool last = (t == nt - 2);
            const char* a1 = cA + (size_t)(t + 1) * kstep;
            const char* a2 = last ? nA : cA + (size_t)(t + 2) * kstep; const char* b2 = last ? nB : cB + (size_t)(t + 2) * kstep;
            const char* a3 = a2 + kstep; const char* b3 = b2 + kstep;
            if (last && has_next) S.a_ready(nxt);
            if constexpr (SP2) {
            PG8_ITER(8);
            } else {
            PG8_LDB(B0, 0, 0); PG8_SCHED; PG8_LDA(At, 0, 0); PG8_STAGE(PG8_SA(1, 1), a1 + hstep, voffA);
            PG8_WAIT_L(8); PG8_BAR; PG8_WAIT_L(0); PG8_MMA(0, 0, At, B0); PG8_BAR; PG8_SCHED;
            PG8_LDB(B1, 0, 1); PG8_STAGE(PG8_SB(0, 0), b2, voffB);
            PG8_BAR; PG8_WAIT_L(0); PG8_MMA(0, 1, At, B1); PG8_BAR;
            PG8_LDA(At, 0, 1); PG8_STAGE(PG8_SA(0, 0), a2, voffA);
            PG8_BAR; PG8_WAIT_L(0); PG8_MMA(1, 0, At, B0); PG8_BAR; PG8_SCHED;
            PG8_STAGE(PG8_SB(0, 1), b2 + hstep, voffB);
            PG8_WAIT_V(6); PG8_BAR; PG8_MMA(1, 1, At, B1); PG8_BAR;
            PG8_LDB(B0, 1, 0); PG8_SCHED; PG8_LDA(At, 1, 0); PG8_STAGE(PG8_SA(0, 1), a2 + hstep, voffA);
            PG8_WAIT_L(8); PG8_BAR; PG8_WAIT_L(0); PG8_MMA(0, 0, At, B0); PG8_BAR; PG8_SCHED;
            PG8_LDB(B1, 1, 1); PG8_STAGE(PG8_SB(1, 0), b3, voffB);
            PG8_BAR; PG8_WAIT_L(0); PG8_MMA(0, 1, At, B1); PG8_BAR;
            PG8_LDA(At, 1, 1); PG8_STAGE(PG8_SA(1, 0), a3, voffA);
            PG8_BAR; PG8_WAIT_L(0); PG8_MMA(1, 0, At, B0); PG8_BAR; PG8_SCHED;
            PG8_STAGE(PG8_SB(1, 1), b3 + hstep, voffB);
            PG8_WAIT_V(6); PG8_BAR; PG8_MMA(1, 1, At, B1); PG8_BAR;
            }
        }
        if constexpr (ALIGN_EPI) { if (wr == 0) PG8_BAR; }
        if constexpr (!Epi::AFTER_DRAIN) { if (!KT2 || (ui & 1)) E(acc, cur, wr, wc, fr, fq); if constexpr (Epi::PROBE_TWICE) { asm volatile("" ::: "memory"); E(acc, cur, wr, wc, fr, fq); } S.done(cur); }
        if (!has_next) break;
#pragma unroll
        for (int a = 0; a < 2; ++a)
#pragma unroll
            for (int b = 0; b < 2; ++b)
#pragma unroll
                for (int m = 0; m < 4; ++m)
#pragma unroll
                    for (int n = 0; n < 2; ++n) acc[a][b][m][n] = (f32x4){0.f, 0.f, 0.f, 0.f};
        cur = nxt; cA = nA; cB = nB; ++ui;
        if constexpr (ALIGN_EPI) { if (wr == 1) PG8_BAR; }
    }
    PG8_WAIT_V(0);
    if constexpr (!ALIGN_EPI) { if (wr == 0) PG8_BAR; }
    PG8_BAR;
    if constexpr (Epi::AFTER_DRAIN) { E.fused(acc, cur, wr, wc, fr, fq, lds, wid, lane); S.done(cur); }
#undef PG8_SA
#undef PG8_SB
#undef PG8_STAGE
#undef PG8_LDA
#undef PG8_LDB
#undef PG8_MMA
#undef PG8_WAIT_V
#undef PG8_WAIT_L
#undef PG8_BAR
#undef PG8_SCHED
#undef PG8_ITER
}
}
#ifndef PG8_SP2
#define PG8_SP2 true
#endif
#ifndef PG8_ALIGN
#define PG8_ALIGN true
#endif
#ifndef MK_PER_PHASE
#define MK_PER_PHASE 0
#endif
constexpr int NWAVES = 8;
constexpr int NB = 4, T = 8192, D = 1024, M = NB * T, FF = 4096;
constexpr int NE = 2304;
constexpr int NO = 3328;
constexpr int N_PHASES = 19;
constexpr size_t MiB = 1u << 20;
constexpr size_t WS_CTL = 0, CTL_ZERO_BYTES = 3584 * 1024;
constexpr size_t WS_RING = 512 * 1024;
constexpr size_t WS_GWT = 7 * MiB + 768 * 1024;
constexpr size_t WS_XS = 1536 * 1024;
constexpr size_t WS_ROPE = 7 * MiB, WS_LORA = 7 * MiB + 512 * 1024, WS_G0 = 507 * MiB, WS_DT = 4 * MiB, WS_MLS = 5 * MiB, WS_DEC = 6 * MiB;
constexpr size_t WS_WINE = 8 * MiB, WS_WOUTE = 13 * MiB, WS_WUP0 = 15 * MiB, WS_WDN0 = 23 * MiB, WS_WINO = 31 * MiB, WS_WOUTO = 38 * MiB, WS_WUP1 = 40 * MiB, WS_WDN1 = 48 * MiB;
constexpr size_t WS_XN = 56 * MiB;
constexpr size_t WS_R1 = 120 * MiB;
constexpr size_t WS_GF = WS_R1 + 208 * MiB;
constexpr size_t WS_LX = WS_R1 + 240 * MiB;
constexpr size_t WS_Y = 376 * MiB;
constexpr size_t WS_HS = 440 * MiB;
constexpr size_t WS_SSP = 504 * MiB;
constexpr size_t WS_RS = 506 * MiB;
constexpr size_t WS_END = 508 * MiB;
constexpr int CW_BAR = 1024;
constexpr int LDS_MAIN = 155648, LDSCTL_OFF = LDS_MAIN, LDS_BYTES = LDS_MAIN + 1024;

#define GAS __attribute__((address_space(1)))
#define LAS __attribute__((address_space(3)))
typedef unsigned short bf16;
typedef unsigned v4u __attribute__((ext_vector_type(4)));
typedef unsigned v2u __attribute__((ext_vector_type(2)));
typedef float f32x4 __attribute__((ext_vector_type(4)));
typedef short bf16x8 __attribute__((ext_vector_type(8)));
typedef GAS unsigned gu32;
#define RLX_AGENT __ATOMIC_RELAXED, __HIP_MEMORY_SCOPE_AGENT
#define LDS_WAIT() asm volatile("s_waitcnt lgkmcnt(0)" ::: "memory")
#define VM_WAIT() asm volatile("s_waitcnt vmcnt(0)" ::: "memory")
__device__ __forceinline__ unsigned f2bf(float f) { unsigned u = __builtin_bit_cast(unsigned, f); return (u + 0x7fffu + ((u >> 16) & 1u)) >> 16; }
typedef float f32x2_t __attribute__((ext_vector_type(2)));
typedef __bf16 bf16x2_t __attribute__((ext_vector_type(2)));
__device__ __forceinline__ unsigned pk2(float lo, float hi) { const f32x2_t v = {lo, hi}; const bf16x2_t b = __builtin_convertvector(v, bf16x2_t); return __builtin_bit_cast(unsigned, b); }
__device__ __forceinline__ bf16 tobf(float x) { return (bf16)pk2(x, x); }
__device__ __forceinline__ float row16_sum(float x) {
    x += __builtin_bit_cast(float, __builtin_amdgcn_update_dpp(0, __builtin_bit_cast(int, x), 0xB1, 0xF, 0xF, true));
    x += __builtin_bit_cast(float, __builtin_amdgcn_update_dpp(0, __builtin_bit_cast(int, x), 0x4E, 0xF, 0xF, true));
    x += __builtin_bit_cast(float, __builtin_amdgcn_update_dpp(0, __builtin_bit_cast(int, x), 0x141, 0xF, 0xF, true));
    x += __builtin_bit_cast(float, __builtin_amdgcn_update_dpp(0, __builtin_bit_cast(int, x), 0x140, 0xF, 0xF, true));
    return x;
}
__device__ __forceinline__ float bflo(unsigned w) { return __builtin_bit_cast(float, w << 16); }
__device__ __forceinline__ float bfhi(unsigned w) { return __builtin_bit_cast(float, w & 0xffff0000u); }
__device__ __forceinline__ float bf1(bf16 v) { return __builtin_bit_cast(float, (unsigned)v << 16); }
__device__ __forceinline__ void unpack8(const v4u w, float (&x)[8]) { x[0] = bflo(w.x); x[1] = bfhi(w.x); x[2] = bflo(w.y); x[3] = bfhi(w.y); x[4] = bflo(w.z); x[5] = bfhi(w.z); x[6] = bflo(w.w); x[7] = bfhi(w.w); }
__device__ __forceinline__ v4u pack8(const float (&x)[8]) { v4u w; w.x = pk2(x[0], x[1]); w.y = pk2(x[2], x[3]); w.z = pk2(x[4], x[5]); w.w = pk2(x[6], x[7]); return w; }
__device__ __forceinline__ bf16x8 frag8(const f32x4 a, const f32x4 b) { v4u w; w.x = pk2(a[0], a[1]); w.y = pk2(a[2], a[3]); w.z = pk2(b[0], b[1]); w.w = pk2(b[2], b[3]); return __builtin_bit_cast(bf16x8, w); }
__device__ __forceinline__ bf16x8 frag2(const v2u lo, const v2u hi) { v4u w; w.x = lo.x; w.y = lo.y; w.z = hi.x; w.w = hi.y; return __builtin_bit_cast(bf16x8, w); }
__device__ __forceinline__ f32x4 mfma16(bf16x8 a, bf16x8 b, f32x4 c) { return __builtin_amdgcn_mfma_f32_16x16x32_bf16(a, b, c, 0, 0, 0); }
__device__ __forceinline__ float rcpf_(float x) { return __builtin_amdgcn_rcpf(x); }
__device__ __forceinline__ float sigmoidf_(float x) { return rcpf_(1.f + __expf(-x)); }
__device__ __forceinline__ float siluf_(float x) { return x * rcpf_(1.f + __expf(-x)); }
__device__ __forceinline__ float softplus_fast(float x) { return fmaxf(x, 0.f) + 0.69314718f * __builtin_amdgcn_logf(1.f + __expf(-fabsf(x))); }
__device__ __forceinline__ float softplusf_(float x) { return fmaxf(x, 0.f) + log1pf(expf(-fabsf(x))); }
__device__ __forceinline__ float wave_sum(float v) { v = row16_sum(v); v += __shfl_xor(v, 16); v += __shfl_xor(v, 32); return v; }
__device__ __forceinline__ float wave_sum8(const float (&a)[8], int lane) {
    float x = row16_sum(a[0]); const int k = lane & 7;
#pragma unroll
    for (int q = 1; q < 8; ++q) { const float r = row16_sum(a[q]); x = (k == q) ? r : x; }
    x += __shfl_xor(x, 16); x += __shfl_xor(x, 32); return x;
}
__device__ __forceinline__ float wave_max(float v) {
#pragma unroll
    for (int o = 1; o < 64; o <<= 1) v = fmaxf(v, __shfl_xor(v, o));
    return v;
}
__device__ __forceinline__ float quad_sum(float v) { v += __shfl_xor(v, 16); v += __shfl_xor(v, 32); return v; }
__device__ __forceinline__ float quad_max(float v) { v = fmaxf(v, __shfl_xor(v, 16)); v = fmaxf(v, __shfl_xor(v, 32)); return v; }
__device__ __forceinline__ float scan_add(float v, int lane) {
#pragma unroll
    for (int o = 1; o < 64; o <<= 1) { const float t = __shfl_up(v, o); if (lane >= o) v += t; }
    return v;
}
__device__ __forceinline__ float scan_max(float v, int lane) {
#pragma unroll
    for (int o = 1; o < 64; o <<= 1) { const float t = __shfl_up(v, o); if (lane >= o) v = fmaxf(v, t); }
    return v;
}

template <int NT> __device__ __forceinline__ void load_rows(const bf16* base, int ld, int tt0, v4u (&raw)[NT + 3]) {
#pragma unroll
    for (int i = 0; i < NT + 3; ++i) { const int t2 = tt0 - 3 + i; raw[i] = (t2 >= 0) ? *(const v4u*)(base + (ptrdiff_t)t2 * ld) : (v4u){0u, 0u, 0u, 0u}; }
}
template <int NT> __device__ __forceinline__ void conv_silu(const v4u (&raw)[NT + 3], const float* convw, int wstride, const float* convb, float (&out)[NT][8]) {
    float w[4][8], bb[8];
#pragma unroll
    for (int tap = 0; tap < 4; ++tap) { const f32x4 w0 = *(const f32x4*)(convw + tap * wstride), w1 = *(const f32x4*)(convw + tap * wstride + 4);
        w[tap][0] = w0.x; w[tap][1] = w0.y; w[tap][2] = w0.z; w[tap][3] = w0.w; w[tap][4] = w1.x; w[tap][5] = w1.y; w[tap][6] = w1.z; w[tap][7] = w1.w; }
    { const f32x4 b0 = *(const f32x4*)convb, b1 = *(const f32x4*)(convb + 4); bb[0] = b0.x; bb[1] = b0.y; bb[2] = b0.z; bb[3] = b0.w; bb[4] = b1.x; bb[5] = b1.y; bb[6] = b1.z; bb[7] = b1.w; }
#pragma unroll
    for (int i = 0; i < NT; ++i)
#pragma unroll
        for (int e = 0; e < 8; ++e) out[i][e] = bb[e];
#pragma unroll
    for (int j = 0; j < NT + 3; ++j) { float x[8]; unpack8(raw[j], x);
#pragma unroll
        for (int tap = 0; tap < 4; ++tap) { const int i = j - tap;
            if (i >= 0 && i < NT) {
#pragma unroll
                for (int e = 0; e < 8; ++e) out[i][e] += x[e] * w[tap][e]; } } }
#pragma unroll
    for (int i = 0; i < NT; ++i)
#pragma unroll
        for (int e = 0; e < 8; ++e) out[i][e] = siluf_(out[i][e]);
}

__device__ __forceinline__ int tsw(int row, int tok) { return row * 136 + ((((tok >> 3) ^ (row >> 3)) & 15) << 3) + (tok & 7); }
#define XB_TMO      128
#define XB_XCNT(j)  (256  + 64 * (j))
#define XB_XSUB(j)  (1280 + 64 * (j))
#define XB_XGEN(j)  (2304 + 64 * (j))
#define XB_TOP      3328
#define XB_TOPGEN   3392
#define XCD_BAR_WORDS 3456
#define XB_SPIN_CAP (1u << 18)

__device__ __forceinline__ unsigned xb_ld(unsigned* p)              { return __hip_atomic_load(p, __ATOMIC_RELAXED, __HIP_MEMORY_SCOPE_AGENT); }
__device__ __forceinline__ unsigned xb_add(unsigned* p, unsigned v) { return __hip_atomic_fetch_add(p, v, __ATOMIC_RELAXED, __HIP_MEMORY_SCOPE_AGENT); }
__device__ __forceinline__ unsigned xb_xcc_id() { return (unsigned)__builtin_amdgcn_s_getreg((3 << 11) | 20) & 0xFu; }
#define XB_SPIN(cond, bar) do { unsigned _sp = 0; while (cond) { __builtin_amdgcn_s_sleep(1); \
    if ((++_sp & 255u) == 0u) { if (xb_ld(&(bar)[XB_TMO])) break; if (_sp > XB_SPIN_CAP) { atomicAdd(&(bar)[XB_TMO], 1u); break; } } } } while (0)

struct XcdBarrier {
    unsigned* bar; unsigned x;
    volatile LAS unsigned* st;
};

__device__ __forceinline__ XcdBarrier xcd_barrier_post(unsigned* bar, volatile LAS unsigned* st) {
    XcdBarrier b; b.bar = bar; b.x = xb_xcc_id(); b.st = st;
    if (threadIdx.x == 0) (void)xb_add(&bar[XB_XCNT(b.x)], 1u);
    return b;
}
__device__ __forceinline__ void xcd_barrier_complete(unsigned* bar, unsigned x, unsigned& nloc, unsigned& nx) {
    const unsigned G = gridDim.x * gridDim.y * gridDim.z;
    unsigned sum, cnt, mine, sp = 0u;
    for (;;) {
        sum = 0u; cnt = 0u; mine = 0u;
#pragma unroll
        for (unsigned j = 0; j < 16; ++j) { const unsigned c = xb_ld(&bar[XB_XCNT(j)]); sum += c; cnt += (c > 0u) ? 1u : 0u; mine = (j == x) ? c : mine; }
        if (sum == G) break;
        __builtin_amdgcn_s_sleep(1);
        if ((++sp & 255u) == 0u) { if (xb_ld(&bar[XB_TMO])) break; if (sp > XB_SPIN_CAP) { atomicAdd(&bar[XB_TMO], 1u); break; } }
    }
    nloc = mine > 0u ? mine : 1u; nx = cnt > 0u ? cnt : 1u;
}

__device__ __forceinline__ void xcd_barrier(const XcdBarrier& b) {
    asm volatile("s_waitcnt vmcnt(0)" ::: "memory");
    __syncthreads();
    if (threadIdx.x == 0) {
        unsigned* bar = b.bar;
        __builtin_amdgcn_s_waitcnt(0);
        unsigned nloc = b.st[0], nx = b.st[1];
        if (nloc == 0u) { xcd_barrier_complete(bar, b.x, nloc, nx); b.st[0] = nloc; b.st[1] = nx; }
        const unsigned old = xb_add(&bar[XB_XSUB(b.x)], 1u);
        const unsigned gen = old / nloc;
        if (old + 1u == (gen + 1u) * nloc) {
            __builtin_amdgcn_fence(__ATOMIC_RELEASE, "agent");
            asm volatile("s_waitcnt vmcnt(0)" ::: "memory");
            const unsigned og = xb_add(&bar[XB_TOP], 1u);
            const unsigned tg = og / nx;
            if (og + 1u == (tg + 1u) * nx) xb_add(&bar[XB_TOPGEN], 1u);
            else XB_SPIN(xb_ld(&bar[XB_TOPGEN]) == tg, bar);
            __builtin_amdgcn_fence(__ATOMIC_ACQUIRE, "agent");
            xb_add(&bar[XB_XGEN(b.x)], 1u);
            asm volatile("s_waitcnt vmcnt(0)" ::: "memory");
        } else {
            XB_SPIN(xb_ld(&bar[XB_XGEN(b.x)]) == gen, bar);
            __builtin_amdgcn_fence(__ATOMIC_ACQUIRE, "agent");
            asm volatile("s_waitcnt vmcnt(0)" ::: "memory");
        }
    }
    __syncthreads();
}
#ifndef DEFER_MLPW
#define DEFER_MLPW 1
#endif
#ifndef FUSE_MLPNORM
#define FUSE_MLPNORM 1
#endif
#ifndef FUSE_N9
#define FUSE_N9 1
#endif
__device__ __forceinline__ void p0_transpose_item(const float* W, int K, int ldw, int n_src0, bf16* WT, int row_dst0, int nblk, LAS float* scr, int item, int lane, const float* kgain = nullptr) {
    const int kb = item / nblk, nb = item % nblk, k0 = 64 * kb, n0 = 32 * nb;
#pragma unroll 8
    for (int i = 0; i < 32; ++i) { const int kk = 2 * i + (lane >> 5); const float gk = kgain ? kgain[k0 + kk] : 1.0f; scr[kk * 33 + (lane & 31)] = W[(size_t)(k0 + kk) * ldw + n_src0 + n0 + (lane & 31)] * gk; }
    LDS_WAIT(); asm volatile("" ::: "memory");
    const int c = lane & 7;
#pragma unroll
    for (int j = 0; j < 4; ++j) { const int n = (lane >> 3) + 8 * j; const LAS float* s = scr + (8 * c) * 33 + n;
        v4u o; o.x = pk2(s[0 * 33], s[1 * 33]); o.y = pk2(s[2 * 33], s[3 * 33]); o.z = pk2(s[4 * 33], s[5 * 33]); o.w = pk2(s[6 * 33], s[7 * 33]);
        *(GAS v4u*)(WT + (size_t)(row_dst0 + n0 + n) * K + k0 + 8 * c) = o; }
    LDS_WAIT(); asm volatile("" ::: "memory");
}
struct TrJob { const float* W; int K, ldw, n_src0; bf16* WT; int row_dst0, nblk, nitems; };
__device__ __forceinline__ void p0_prologue(const float* const* in, unsigned char* ws, LAS unsigned char* lds, int tid, int G) {
    const int lane = tid & 63, wave = __builtin_amdgcn_readfirstlane(tid >> 6);
    LAS float* scr = (LAS float*)(lds + wave * 16384);
    const int gw = blockIdx.x * NWAVES + wave, NGW = G * NWAVES;
#define TRJG(Wp, K_, ldw_, s0_, dst_, r0_, ncols_, kg_) { int nblk_ = (ncols_) / 32; int ni_ = ((K_) / 64) * nblk_; if (it < ni_) { p0_transpose_item(Wp, K_, ldw_, s0_, (bf16*)(ws + dst_), r0_, nblk_, scr, it, lane, kg_); continue; } it -= ni_; }
#define TRJ(Wp, K_, ldw_, s0_, dst_, r0_, ncols_) TRJG(Wp, K_, ldw_, s0_, dst_, r0_, ncols_, nullptr)
    constexpr int NITEMS = 16 * 72 + 16 * 32 + (DEFER_MLPW ? 0 : 16 * 48 + 16 * 56 + 16 * 32 + 2 * 16 * 128 + 2 * 64 * 32);
    for (int it0 = gw; it0 < NITEMS; it0 += NGW) {
        int it = it0;
        TRJ(in[5], 1024, 2312, 0, WS_WINE, 0, 2304)
        TRJ(in[6], 1024, 1024, 0, WS_WOUTE, 0, 1024)
        if (!DEFER_MLPW) {
        TRJG(in[13], 1024, 3336, 0, WS_WINO, 0, 1536, FUSE_N9 ? in[1] + 1024 : nullptr)
        TRJG(in[13], 1024, 3336, 1544, WS_WINO, 1536, 1792, FUSE_N9 ? in[1] + 1024 : nullptr)
        TRJ(in[14], 1024, 1024, 0, WS_WOUTO, 0, 1024)
        TRJG(in[3], 1024, 4096, 0, WS_WUP0, 0, 4096, FUSE_MLPNORM ? in[2] : nullptr)
        TRJG(in[3] + (size_t)1024 * 4096, 1024, 4096, 0, WS_WUP1, 0, 4096, FUSE_MLPNORM ? in[2] + 1024 : nullptr)
        TRJ(in[4], 4096, 1024, 0, WS_WDN0, 0, 1024)
        TRJ(in[4] + (size_t)4096 * 1024, 4096, 1024, 0, WS_WDN1, 0, 1024)
        }
    }
    const int gt = blockIdx.x * 512 + tid, NGT = G * 512;
    bf16* w2t = (bf16*)(ws + WS_LORA); bf16* a2t = w2t + 512 * 64; bf16* g2t = a2t + 512 * 64;
    for (int i = gt; i < 512 * 64; i += NGT) { const int n = i >> 6, j = i & 63; w2t[i] = tobf(in[23][j * 512 + n]); a2t[i] = tobf(in[25][j * 512 + n]); }
    for (int i = gt; i < 512 * 128; i += NGT) { const int n = i >> 7, j = i & 127; g2t[i] = tobf(in[26][j * 512 + n]); }
    { float* gwt = (float*)(ws + WS_GWT); for (int i = gt; i < 8192; i += NGT) { const int q = i >> 10, k = i & 1023; gwt[i] = in[13][(size_t)k * 3336 + 1536 + q] * in[1][1024 + k]; } }
    float2* rope = (float2*)(ws + WS_ROPE);
    for (int i = gt; i < T * 8; i += NGT) { const int t = i >> 3, d = i & 7; const float inv = powf(500000.0f, -(float)d * 0.125f); const float ang = (float)t * inv; rope[i] = make_float2(cosf(ang), sinf(ang)); }
}
__device__ __forceinline__ void mlp_weights_convert(const float* const* in, unsigned char* ws, int layer, LAS unsigned char* lds, int tid, int b0, int nb) {
    const int lane = tid & 63, wave = __builtin_amdgcn_readfirstlane(tid >> 6);
    LAS float* scr = (LAS float*)(lds + wave * 16384);
    const int gw = ((int)blockIdx.x - b0) * NWAVES + wave, NGW = nb * NWAVES;
    for (int it0 = gw; it0 < 16 * 128 + 64 * 32 + (layer == 0 ? 16 * 48 + 16 * 56 + 16 * 32 : 0); it0 += NGW) {
        int it = it0;
        TRJG(in[3] + (size_t)layer * 1024 * 4096, 1024, 4096, 0, (layer ? WS_WUP1 : WS_WUP0), 0, 4096, FUSE_MLPNORM ? in[2] + layer * 1024 : nullptr)
        TRJ(in[4] + (size_t)layer * 4096 * 1024, 4096, 1024, 0, (layer ? WS_WDN1 : WS_WDN0), 0, 1024)
        if (layer == 0) {
        TRJG(in[13], 1024, 3336, 0, WS_WINO, 0, 1536, FUSE_N9 ? in[1] + 1024 : nullptr)
        TRJG(in[13], 1024, 3336, 1544, WS_WINO, 1536, 1792, FUSE_N9 ? in[1] + 1024 : nullptr)
        TRJ(in[14], 1024, 1024, 0, WS_WOUTO, 0, 1024)
        }
    }
}
#undef TRJ
#undef TRJG
template <int MODE>
__device__ __forceinline__ void norm_phase(const float* src, const float* gain, bf16* dst, float* dstf, const float* gw, int ldg, float* gout, LAS unsigned char* lds, int tid, int G) {
    const int lane = tid & 63, wave = __builtin_amdgcn_readfirstlane(tid >> 6);
    LAS float* Wg = (LAS float*)lds;
    if (MODE == 1) { for (int i = tid; i < 8192; i += 512) { const int k = i >> 3, j = i & 7; Wg[j * 1024 + k] = gw[(size_t)k * ldg + j]; } __syncthreads(); }
    f32x4 gv[4];
#pragma unroll
    for (int j = 0; j < 4; ++j) gv[j] = *(const f32x4*)(gain + 4 * lane + 256 * j);
    f32x4 nv[4];
    { const int m0 = blockIdx.x * NWAVES + wave; if (m0 < M) { const f32x4* xr = (const f32x4*)(src + (size_t)m0 * D) + lane;
#pragma unroll
        for (int j = 0; j < 4; ++j) nv[j] = xr[64 * j]; } }
    for (int m = blockIdx.x * NWAVES + wave; m < M; m += G * NWAVES) {
        f32x4 v[4]; float s = 0.f;
#pragma unroll
        for (int j = 0; j < 4; ++j) v[j] = nv[j];
        if (m + G * NWAVES < M) { const f32x4* xr = (const f32x4*)(src + (size_t)(m + G * NWAVES) * D) + lane;
#pragma unroll
            for (int j = 0; j < 4; ++j) nv[j] = xr[64 * j]; }
#pragma unroll
        for (int j = 0; j < 4; ++j) s += (v[j].x * v[j].x + v[j].y * v[j].y) + (v[j].z * v[j].z + v[j].w * v[j].w);
        const float rs = 1.0f / sqrtf(wave_sum(s) * (1.f / D) + 1e-5f);
#pragma unroll
        for (int j = 0; j < 4; ++j) v[j] = v[j] * rs * gv[j];
        if (MODE == 2) {
            f32x4* o = (f32x4*)(dstf + (size_t)m * D) + lane;
#pragma unroll
            for (int j = 0; j < 4; ++j) o[64 * j] = v[j];
        } else {
            v2u* o = (v2u*)(dst + (size_t)m * D) + lane;
#pragma unroll
            for (int j = 0; j < 4; ++j) { v2u w; w.x = pk2(v[j].x, v[j].y); w.y = pk2(v[j].z, v[j].w); o[64 * j] = w; }
        }
        if (MODE == 1) {
            float g8[8];
#pragma unroll
            for (int q = 0; q < 8; ++q) { float a = 0.f;
#pragma unroll
                for (int j = 0; j < 4; ++j) { const f32x4 w = *(const LAS f32x4*)(Wg + q * 1024 + 4 * lane + 256 * j); a += (v[j].x * w.x + v[j].y * w.y) + (v[j].z * w.z + v[j].w * w.w); }
                g8[q] = a; }
            const float gt = wave_sum8(g8, lane);
            if (lane < 8) gout[(size_t)m * 8 + lane] = gt;
        }
    }
}
template <int MODE>
__device__ __forceinline__ void norm_phase_b(const bf16* src, const float* gain, bf16* dst, float* dstf, const float* gw, int ldg, float* gout, LAS unsigned char* lds, int tid, int G) {
    const int lane = tid & 63, wave = __builtin_amdgcn_readfirstlane(tid >> 6);
    LAS float* Wg = (LAS float*)lds;
    if (MODE == 1 || MODE == 3) { for (int i = tid; i < 8192; i += 512) { const int k = i >> 3, j = i & 7; Wg[j * 1024 + k] = gw[(size_t)k * ldg + j]; } __syncthreads(); }
    float gv[2][8];
#pragma unroll
    for (int j = 0; j < 2; ++j) { const f32x4 g0 = *(const f32x4*)(gain + 8 * lane + 512 * j), g1 = *(const f32x4*)(gain + 8 * lane + 512 * j + 4);
        gv[j][0] = g0.x; gv[j][1] = g0.y; gv[j][2] = g0.z; gv[j][3] = g0.w; gv[j][4] = g1.x; gv[j][5] = g1.y; gv[j][6] = g1.z; gv[j][7] = g1.w; }
    v4u nraw[2];
    { const int m0 = blockIdx.x * NWAVES + wave; if (m0 < M) {
#pragma unroll
        for (int j = 0; j < 2; ++j) nraw[j] = *(const v4u*)(src + (size_t)m0 * D + 8 * lane + 512 * j); } }
    for (int m = blockIdx.x * NWAVES + wave; m < M; m += G * NWAVES) {
        float v[2][8]; float s = 0.f; v4u raw[2];
#pragma unroll
        for (int j = 0; j < 2; ++j) raw[j] = nraw[j];
        if (m + G * NWAVES < M) {
#pragma unroll
            for (int j = 0; j < 2; ++j) nraw[j] = *(const v4u*)(src + (size_t)(m + G * NWAVES) * D + 8 * lane + 512 * j); }
#pragma unroll
        for (int j = 0; j < 2; ++j) { unpack8(raw[j], v[j]);
#pragma unroll
            for (int e = 0; e < 8; ++e) s += v[j][e] * v[j][e]; }
        const float rs = 1.0f / sqrtf(wave_sum(s) * (1.f / D) + 1e-5f);
#pragma unroll
        for (int j = 0; j < 2; ++j)
#pragma unroll
            for (int e = 0; e < 8; ++e) v[j][e] = v[j][e] * rs * gv[j][e];
        if (MODE == 2) {
#pragma unroll
            for (int j = 0; j < 2; ++j) { f32x4* o = (f32x4*)(dstf + (size_t)m * D + 8 * lane + 512 * j); o[0] = (f32x4){v[j][0], v[j][1], v[j][2], v[j][3]}; o[1] = (f32x4){v[j][4], v[j][5], v[j][6], v[j][7]}; }
        } else if (MODE == 3) {
            if (lane == 0) dstf[m] = rs;
        } else {
#pragma unroll
            for (int j = 0; j < 2; ++j) *(v4u*)(dst + (size_t)m * D + 8 * lane + 512 * j) = pack8(v[j]);
        }
        if (MODE == 1 || MODE == 3) {
            float g8[8];
#pragma unroll
            for (int q = 0; q < 8; ++q) { float a = 0.f;
#pragma unroll
                for (int j = 0; j < 2; ++j) { const f32x4 w0 = *(const LAS f32x4*)(Wg + q * 1024 + 8 * lane + 512 * j), w1 = *(const LAS f32x4*)(Wg + q * 1024 + 8 * lane + 512 * j + 4);
                    a += (v[j][0] * w0.x + v[j][1] * w0.y) + (v[j][2] * w0.z + v[j][3] * w0.w) + (v[j][4] * w1.x + v[j][5] * w1.y) + (v[j][6] * w1.z + v[j][7] * w1.w); }
                g8[q] = a; }
            const float gt = wave_sum8(g8, lane);
            if (lane < 8) gout[(size_t)m * 8 + lane] = gt;
        }
    }
}
__device__ __forceinline__ void norm_x_gates_phase(const float* src, const float* gain, bf16* dst, const float* gw, int ldg, float* gout, LAS unsigned char* lds, int tid, int G) {
    const int lane = tid & 63, wave = __builtin_amdgcn_readfirstlane(tid >> 6);
    LAS float* Wg = (LAS float*)lds;
    for (int i = tid; i < 8192; i += 512) { const int k = i >> 3, j = i & 7; Wg[j * 1024 + k] = gw[(size_t)k * ldg + j]; }
    __syncthreads();
    f32x4 gv[4];
#pragma unroll
    for (int j = 0; j < 4; ++j) gv[j] = *(const f32x4*)(gain + 4 * lane + 256 * j);
    const int stride = G * NWAVES;
    for (int m = blockIdx.x * NWAVES + wave; m < M; m += 2 * stride) {
        const int m1 = (m + stride < M) ? m + stride : m;
        f32x4 v[2][4];
#pragma unroll
        for (int rr = 0; rr < 2; ++rr) { const f32x4* xr = (const f32x4*)(src + (size_t)(rr ? m1 : m) * D) + lane;
#pragma unroll
            for (int j = 0; j < 4; ++j) v[rr][j] = xr[64 * j]; }
#pragma unroll
        for (int rr = 0; rr < 2; ++rr) { float s = 0.f;
#pragma unroll
            for (int j = 0; j < 4; ++j) s += (v[rr][j].x * v[rr][j].x + v[rr][j].y * v[rr][j].y) + (v[rr][j].z * v[rr][j].z + v[rr][j].w * v[rr][j].w);
            const float rs = 1.0f / sqrtf(wave_sum(s) * (1.f / D) + 1e-5f);
#pragma unroll
            for (int j = 0; j < 4; ++j) v[rr][j] = v[rr][j] * rs * gv[j];
            if (rr == 0 || m1 != m) { v2u* o = (v2u*)(dst + (size_t)(rr ? m1 : m) * D) + lane;
#pragma unroll
                for (int j = 0; j < 4; ++j) { v2u w; w.x = pk2(v[rr][j].x, v[rr][j].y); w.y = pk2(v[rr][j].z, v[rr][j].w); o[64 * j] = w; } } }
        float g8[2][8];
#pragma unroll
        for (int q = 0; q < 8; ++q) { float a0 = 0.f, a1 = 0.f;
#pragma unroll
            for (int j = 0; j < 4; ++j) { const f32x4 w = *(const LAS f32x4*)(Wg + q * 1024 + 4 * lane + 256 * j);
                a0 += (v[0][j].x * w.x + v[0][j].y * w.y) + (v[0][j].z * w.z + v[0][j].w * w.w); a1 += (v[1][j].x * w.x + v[1][j].y * w.y) + (v[1][j].z * w.z + v[1][j].w * w.w); }
            g8[0][q] = a0; g8[1][q] = a1; }
        const float gt0 = wave_sum8(g8[0], lane), gt1 = wave_sum8(g8[1], lane);
        if (lane < 8) { gout[(size_t)m * 8 + lane] = gt0; if (m1 != m) gout[(size_t)m1 * 8 + lane] = gt1; }
    }
}
__device__ __forceinline__ void norm_rs_dt_phase(const bf16* src, const float* gain, float* rsout, const float* gw, int ldg, float* gout, LAS unsigned char* lds, int tid, int G) {
    const int lane = tid & 63, wave = __builtin_amdgcn_readfirstlane(tid >> 6);
    LAS float* Wg = (LAS float*)lds;
    for (int i = tid; i < 8192; i += 512) { const int k = i >> 3, j = i & 7; Wg[j * 1024 + k] = gw[(size_t)k * ldg + j] * gain[k]; }
    __syncthreads();
    const int stride = G * NWAVES;
    for (int m = blockIdx.x * NWAVES + wave; m < M; m += 2 * stride) {
        const int m1 = (m + stride < M) ? m + stride : m;
        v4u raw[2][2];
#pragma unroll
        for (int rr = 0; rr < 2; ++rr)
#pragma unroll
            for (int j = 0; j < 2; ++j) raw[rr][j] = *(const v4u*)(src + (size_t)(rr ? m1 : m) * D + 8 * lane + 512 * j);
        f32x2_t v[2][2][4]; float rs[2];
#pragma unroll
        for (int rr = 0; rr < 2; ++rr) { f32x2_t s2 = (f32x2_t){0.f, 0.f};
#pragma unroll
            for (int j = 0; j < 2; ++j)
#pragma unroll
                for (int p = 0; p < 4; ++p) { const unsigned w = raw[rr][j][p]; v[rr][j][p] = (f32x2_t){bflo(w), bfhi(w)}; s2 += v[rr][j][p] * v[rr][j][p]; }
            rs[rr] = 1.0f / sqrtf(wave_sum(s2.x + s2.y) * (1.f / D) + 1e-5f);
            if (lane == 0 && (rr == 0 || m1 != m)) rsout[rr ? m1 : m] = rs[rr]; }
        float g8[2][8];
#pragma unroll
        for (int q = 0; q < 8; ++q) { f32x2_t a0 = (f32x2_t){0.f, 0.f}, a1 = a0;
#pragma unroll
            for (int j = 0; j < 2; ++j) { const f32x4 w0 = *(const LAS f32x4*)(Wg + q * 1024 + 8 * lane + 512 * j), w1 = *(const LAS f32x4*)(Wg + q * 1024 + 8 * lane + 512 * j + 4);
                const f32x2_t wa = (f32x2_t){w0.x, w0.y}, wb = (f32x2_t){w0.z, w0.w}, wc = (f32x2_t){w1.x, w1.y}, wd = (f32x2_t){w1.z, w1.w};
                a0 += v[0][j][0] * wa; a0 += v[0][j][1] * wb; a0 += v[0][j][2] * wc; a0 += v[0][j][3] * wd;
                a1 += v[1][j][0] * wa; a1 += v[1][j][1] * wb; a1 += v[1][j][2] * wc; a1 += v[1][j][3] * wd; }
            g8[0][q] = a0.x + a0.y; g8[1][q] = a1.x + a1.y; }
        const float gt0 = wave_sum8(g8[0], lane) * rs[0], gt1 = wave_sum8(g8[1], lane) * rs[1];
        if (lane < 8) { gout[(size_t)m * 8 + lane] = gt0; if (m1 != m) gout[(size_t)m1 * 8 + lane] = gt1; }
    }
}
__device__ __forceinline__ void attn_unit(int u, const bf16* P, const float2* rope, const float* sinks, bf16* Y, LAS unsigned char* lds, int tid) {
    asm volatile("; MARK_BEGIN_attn_unit");
    asm volatile("" : "+v"(tid));
    const int lane = tid & 63, wave = __builtin_amdgcn_readfirstlane(tid >> 6), fr = lane & 15, fq = lane >> 4;
    const int blk = u & 63, kvh = (u >> 6) & 1, b = u >> 7;
    LAS bf16* Ks = (LAS bf16*)lds;
    LAS bf16* Vt = Ks + 256 * 72;
    LAS f32x2_t* rq = (LAS f32x2_t*)(Vt + 64 * 264);
    const int tok0 = blk * 128 - 128;
    const int g = wave >> 1, half = wave & 1, hq = kvh * 4 + g;
    v4u qn0, qn1, qnp;
    { const int tq = blk * 128 + (half * 4) * 16 + fr; const bf16* qsrc = P + (size_t)(b * T + tq) * NE + hq * 64;
      qn0 = *(const v4u*)(qsrc + 8 * fq); qn1 = *(const v4u*)(qsrc + 32 + 8 * fq); qnp = *(const v4u*)(qsrc + 8 * ((fq ^ 1) & 1)); }
    { const f32x4 r4 = *(const f32x4*)((const float*)(rope + (size_t)(blk * 128) * 8) + tid * 4); *(LAS f32x4*)((LAS float*)rq + tid * 4) = r4; }
    {
        const int c = tid & 7;
        v4u vv[4], k0[4], k1[4];
#pragma unroll
        for (int j = 0; j < 4; ++j) { const int r = (tid >> 3) + 64 * j, t = tok0 + r; const bf16* src = P + (size_t)(b * T + (t < 0 ? 0 : t)) * NE;
            vv[j] = (v4u){0u, 0u, 0u, 0u}; k0[j] = vv[j]; k1[j] = vv[j];
            if (t >= 0) { vv[j] = *(const v4u*)(src + 640 + kvh * 64 + c * 8); if (c != 1) k0[j] = *(const v4u*)(src + 512 + kvh * 64 + c * 8); if (c == 0) k1[j] = *(const v4u*)(src + 512 + kvh * 64 + 8); } }
#pragma unroll
        for (int j = 0; j < 4; ++j) { const int r = (tid >> 3) + 64 * j, t = tok0 + r;
#pragma unroll
            for (int e = 0; e < 8; ++e) Vt[(c * 8 + e) * 264 + r] = (bf16)(vv[j][e >> 1] >> ((e & 1) * 16));
            if (c == 0) {
                float x1[8], x2[8], o1[8], o2[8]; unpack8(k0[j], x1); unpack8(k1[j], x2);
                const float2* cs = rope + (size_t)(t < 0 ? 0 : t) * 8;
#pragma unroll
                for (int e = 0; e < 8; ++e) { const float2 q = cs[e]; o1[e] = x1[e] * q.x - x2[e] * q.y; o2[e] = x2[e] * q.x + x1[e] * q.y; }
                *(LAS v4u*)(Ks + r * 72) = pack8(o1); *(LAS v4u*)(Ks + r * 72 + 8) = pack8(o2);
            } else if (c != 1) *(LAS v4u*)(Ks + r * 72 + c * 8) = k0[j]; }
    }
    __syncthreads();
    const float sink = sinks[hq];
#pragma unroll 1
    for (int a = 0; a < 4; ++a) {
        const int ag = half * 4 + a, i = ag * 16 + fr, tq = blk * 128 + i;
        float x0[8], x1v[8];
        const v4u qc0 = qn0, qc1 = qn1, qcp = qnp;
        if (a < 3) { const bf16* qsrc = P + (size_t)(b * T + tq + 16) * NE + hq * 64; qn0 = *(const v4u*)(qsrc + 8 * fq); qn1 = *(const v4u*)(qsrc + 32 + 8 * fq); qnp = *(const v4u*)(qsrc + 8 * ((fq ^ 1) & 1)); }
        unpack8(qc0, x0); unpack8(qc1, x1v);
        if (fq < 2) {
            float xp[8]; unpack8(qcp, xp);
            const LAS f32x2_t* cs = rq + i * 8;
#pragma unroll
            for (int e = 0; e < 8; ++e) { const f32x2_t q = cs[e]; x0[e] = (fq == 0) ? (x0[e] * q.x - xp[e] * q.y) : (x0[e] * q.x + xp[e] * q.y); }
        }
#pragma unroll
        for (int e = 0; e < 8; ++e) { x0[e] *= 0.125f; x1v[e] *= 0.125f; }
        bf16x8 qf[2]; qf[0] = __builtin_bit_cast(bf16x8, pack8(x0)); qf[1] = __builtin_bit_cast(bf16x8, pack8(x1v));
        const int kt0 = ag < 6 ? ag : 6;
        f32x4 sacc[10];
#pragma unroll
        for (int j = 0; j < 10; ++j) { f32x4 acc = (f32x4){0.f, 0.f, 0.f, 0.f};
#pragma unroll
            for (int s = 0; s < 2; ++s) { const bf16x8 A = *(const LAS bf16x8*)(Ks + (16 * (kt0 + j) + fr) * 72 + 32 * s + 8 * fq); acc = mfma16(A, qf[s], acc); }
            sacc[j] = acc; }
        float mx = sink;
#pragma unroll
        for (int j = 0; j < 10; ++j)
#pragma unroll
            for (int r = 0; r < 4; ++r) { const int key = 16 * (kt0 + j) + 4 * fq + r; const bool valid = (key > i) && (key <= i + 128) && (blk > 0 || key >= 128);
                sacc[j][r] = valid ? sacc[j][r] : -INFINITY; mx = fmaxf(mx, sacc[j][r]); }
        mx = quad_max(mx);
        float sum = 0.f;
#pragma unroll
        for (int j = 0; j < 10; ++j)
#pragma unroll
            for (int r = 0; r < 4; ++r) { const float p = __expf(sacc[j][r] - mx); sacc[j][r] = p; sum += p; }
        sum = quad_sum(sum) + __expf(sink - mx);
        f32x4 o[4];
#pragma unroll
        for (int dt = 0; dt < 4; ++dt) o[dt] = (f32x4){0.f, 0.f, 0.f, 0.f};
#pragma unroll
        for (int jp = 0; jp < 5; ++jp) { const bf16x8 Bf = frag8(sacc[2 * jp], sacc[2 * jp + 1]);
#pragma unroll
            for (int dt = 0; dt < 4; ++dt) { const LAS bf16* vp = Vt + (16 * dt + fr) * 264 + 16 * (kt0 + 2 * jp) + 4 * fq;
                const bf16x8 A = frag2(*(const LAS v2u*)vp, *(const LAS v2u*)(vp + 16)); o[dt] = mfma16(A, Bf, o[dt]); } }
        const float inv = 1.f / sum;
        bf16* yo = Y + (size_t)(b * T + tq) * D + hq * 64 + 4 * fq;
#pragma unroll
        for (int dt = 0; dt < 4; ++dt) { v2u w; w.x = pk2(o[dt][0] * inv, o[dt][1] * inv); w.y = pk2(o[dt][2] * inv, o[dt][3] * inv); *(v2u*)(yo + 16 * dt) = w; }
    }
    __syncthreads();
}
__device__ __forceinline__ void ml_conv8(const bf16* P, int b, int tt, int ch, const float* convw, const float* convb, float (&acc)[8]) {
    { const f32x4 b0 = *(const f32x4*)(convb + ch), b1 = *(const f32x4*)(convb + ch + 4); acc[0] = b0.x; acc[1] = b0.y; acc[2] = b0.z; acc[3] = b0.w; acc[4] = b1.x; acc[5] = b1.y; acc[6] = b1.z; acc[7] = b1.w; }
#pragma unroll
    for (int tap = 0; tap < 4; ++tap) { const int t2 = tt - 3 + tap;
        if (t2 >= 0) { float x[8]; unpack8(*(const v4u*)(P + (size_t)(b * T + t2) * NE + 768 + ch), x);
            const f32x4 w0 = *(const f32x4*)(convw + tap * 512 + ch), w1 = *(const f32x4*)(convw + tap * 512 + ch + 4);
            acc[0] += x[0] * w0.x; acc[1] += x[1] * w0.y; acc[2] += x[2] * w0.z; acc[3] += x[3] * w0.w; acc[4] += x[4] * w1.x; acc[5] += x[5] * w1.y; acc[6] += x[6] * w1.z; acc[7] += x[7] * w1.w; } }
#pragma unroll
    for (int e = 0; e < 8; ++e) acc[e] = siluf_(acc[e]);
}
__device__ __forceinline__ void ml_gates(const float* G0, size_t row0, int h, const float* ibias, const float* fbias, int lane, float& b0, float& b1, float& li0, float& li1, float& bL) {
    const float fb = fbias[h], ib = ibias[h];
    const float f0 = G0[(row0 + 2 * lane) * 8 + 4 + h] + fb, f1 = G0[(row0 + 2 * lane + 1) * 8 + 4 + h] + fb;
    li0 = G0[(row0 + 2 * lane) * 8 + h] + ib; li1 = G0[(row0 + 2 * lane + 1) * 8 + h] + ib;
    const float lf0 = -softplusf_(-f0), lf1 = -softplusf_(-f1);
    const float ps = scan_add(lf0 + lf1, lane);
    b1 = ps; b0 = ps - lf1; bL = __shfl(ps, 63);
}
__device__ __forceinline__ void mlstm_local_unit(int u, const bf16* P, const float* G0, const float* convw, const float* convb, const float* ibias, const float* fbias,
                                                 float* CT, float* NL, float* MLs, LAS unsigned char* lds, int tid) {
    asm volatile("; MARK_BEGIN_mlstm_local_unit");
    asm volatile("" : "+v"(tid));
    const int lane = tid & 63, wave = __builtin_amdgcn_readfirstlane(tid >> 6), fr = lane & 15, fq = lane >> 4;
    const int c = u & 63, h = (u >> 6) & 3, b = u >> 8, bh = b * 4 + h;
    const size_t row0 = (size_t)b * T + c * 128;
    LAS bf16* kT = (LAS bf16*)lds;
    LAS bf16* vT = kT + 64 * 136;
    LAS float* wg = (LAS float*)(vT + 128 * 136);
    const int kc8 = tid & 7, ktg = (tid >> 3) & 31, kch = 256 + h * 64 + kc8 * 8;
    const int vt2 = tid - 256, vc8 = vt2 & 15, vtq = (vt2 >> 4) & 15;
    v4u raw[8];
    if (tid < 256) { v4u r7[7]; load_rows<4>(P + (size_t)(b * T) * NE + 768 + kch, NE, c * 128 + 4 * ktg, r7);
#pragma unroll
        for (int i = 0; i < 7; ++i) raw[i] = r7[i]; }
    else {
#pragma unroll
        for (int i = 0; i < 8; ++i) raw[i] = *(const v4u*)(P + (row0 + 8 * vtq + i) * NE + 1280 + h * 128 + vc8 * 8); }
    if (wave == 0) {
        float b0, b1, li0, li1, bL; ml_gates(G0, row0, h, ibias, fbias, lane, b0, b1, li0, li1, bL);
        const float a0 = bL - b0 + li0, a1 = bL - b1 + li1; const float ml = wave_max(fmaxf(a0, a1));
        wg[2 * lane] = expf(a0 - ml); wg[2 * lane + 1] = expf(a1 - ml);
        if (lane == 0) { MLs[(bh * 64 + c) * 2] = ml; MLs[(bh * 64 + c) * 2 + 1] = bL; }
    }
    __syncthreads();
    if (tid < 256) {
        v4u r7[7];
#pragma unroll
        for (int i = 0; i < 7; ++i) r7[i] = raw[i];
        float o[4][8]; conv_silu<4>(r7, convw + kch, 512, convb + kch, o);
        const f32x4 sc4 = *(const LAS f32x4*)(wg + 4 * ktg);
#pragma unroll
        for (int e = 0; e < 8; ++e) { v2u w; w.x = pk2(o[0][e] * 0.125f * sc4.x, o[1][e] * 0.125f * sc4.y); w.y = pk2(o[2][e] * 0.125f * sc4.z, o[3][e] * 0.125f * sc4.w); *(LAS v2u*)(kT + tsw(kc8 * 8 + e, 4 * ktg)) = w; }
    } else {
#pragma unroll
        for (int e = 0; e < 8; ++e) { v4u w;
#pragma unroll
            for (int p = 0; p < 4; ++p) { const unsigned lo = (raw[2 * p][e >> 1] >> ((e & 1) * 16)) & 0xffffu, hi = (raw[2 * p + 1][e >> 1] >> ((e & 1) * 16)) & 0xffffu; w[p] = lo | (hi << 16); }
            *(LAS v4u*)(vT + tsw(vc8 * 8 + e, 8 * vtq)) = w; }
    }
    __syncthreads();
    if (tid < 64) { float s = 0.f;
#pragma unroll
        for (int t8 = 0; t8 < 16; ++t8) { float x[8]; unpack8(*(const LAS v4u*)(kT + tsw(tid, 8 * t8)), x); s += ((x[0] + x[1]) + (x[2] + x[3])) + ((x[4] + x[5]) + (x[6] + x[7])); }
        NL[(size_t)(bh * 64 + c) * 64 + tid] = s; }
    f32x4 acc[4];
#pragma unroll
    for (int k = 0; k < 4; ++k) acc[k] = (f32x4){0.f, 0.f, 0.f, 0.f};
#pragma unroll
    for (int ks = 0; ks < 4; ++ks) { const bf16x8 A = *(const LAS bf16x8*)(vT + tsw(16 * wave + fr, 32 * ks + 8 * fq));
#pragma unroll
        for (int k = 0; k < 4; ++k) { const bf16x8 Bf = *(const LAS bf16x8*)(kT + tsw(16 * k + fr, 32 * ks + 8 * fq)); acc[k] = mfma16(Bf, A, acc[k]); } }
    float* ct = CT + ((size_t)(bh * 64 + c) * 128 + 16 * wave + fr) * 64 + 4 * fq;
#pragma unroll
    for (int k = 0; k < 4; ++k) *(f32x4*)(ct + 16 * k) = acc[k];
    __syncthreads();
}
__device__ __forceinline__ void mlstm_scan_phase(float* CT, float* NL, const float* MLs, float* Mprev, LAS unsigned char* lds, int tid, int G) {
    LAS float* fab = (LAS float*)lds;
    for (int e0 = blockIdx.x * 512; e0 < 16 * 8192; e0 += G * 512) {
        const int e = e0 + tid; const int bh = e0 >> 13, idx = e & 8191;
        if (tid < 64) { const int c = tid;
            const float ml = MLs[(bh * 64 + c) * 2], gl = MLs[(bh * 64 + c) * 2 + 1];
            float A = gl, B = ml;
#pragma unroll
            for (int o = 1; o < 64; o <<= 1) { const float Ap = __shfl_up(A, o), Bp = __shfl_up(B, o); if (c >= o) { B = fmaxf(Bp + A, B); A = Ap + A; } }
            const float mn = fmaxf(A, B);
            float mp = __shfl_up(mn, 1); if (c == 0) mp = 0.f;
            fab[2 * c] = __expf(gl + mp - mn); fab[2 * c + 1] = __expf(ml - mn);
            if ((e0 & 8191) == 0) Mprev[bh * 64 + c] = mp; }
        __syncthreads();
        float C = 0.f, n = 0.f;
        float* cp = CT + (size_t)bh * 64 * 8192 + idx; float* np = NL + (size_t)bh * 64 * 64 + idx; bf16* cb = (bf16*)(CT + (size_t)16 * 64 * 8192) + (size_t)bh * 64 * 8192 + idx;
#pragma unroll 1
        for (int c0 = 0; c0 < 64; c0 += 32) { float cl[32];
#pragma unroll
            for (int c = 0; c < 32; ++c) cl[c] = cp[(size_t)(c0 + c) * 8192];
#pragma unroll
            for (int c = 0; c < 32; ++c) { const f32x2_t f2 = *(const LAS f32x2_t*)(fab + 2 * (c0 + c)); const float fa = f2.x, fb = f2.y;
                cb[(size_t)(c0 + c) * 8192] = tobf(C); C = fa * C + fb * cl[c];
                if (idx < 64) { const float nl = np[(c0 + c) * 64]; np[(c0 + c) * 64] = n; n = fa * n + fb * nl; } } }
        __syncthreads();
    }
}
__device__ __forceinline__ void mlstm_out_unit(int u, const bf16* P, const float* G0, const float* convw, const float* convb, const float* ibias, const float* fbias, const float* mlnorm,
                                               const float* CT, const float* NL, const float* Mprev, bf16* Y, LAS unsigned char* lds, int tid) {
    asm volatile("; MARK_BEGIN_mlstm_out_unit");
    asm volatile("" : "+v"(tid));
    const int lane = tid & 63, wave = __builtin_amdgcn_readfirstlane(tid >> 6), fr = lane & 15, fq = lane >> 4;
    const int c = u & 63, h = (u >> 6) & 3, b = u >> 8, bh = b * 4 + h;
    const size_t row0 = (size_t)b * T + c * 128;
    LAS bf16* qs = (LAS bf16*)lds;
    LAS bf16* ks = qs + 128 * 72;
    LAS bf16* vT = ks + 128 * 72;
    LAS bf16* cts = vT + 128 * 136;
    LAS float* bc = (LAS float*)(cts + 128 * 72);
    LAS float* lis = bc + 128; LAS float* mxs = lis + 128; LAS float* npv = mxs + 128;
    const float mp_pre = Mprev[bh * 64 + c];
    if (wave == 0) {
        float b0, b1, li0, li1, bL; ml_gates(G0, row0, h, ibias, fbias, lane, b0, b1, li0, li1, bL);
        const float d0 = li0 - b0, d1 = li1 - b1; const float sm = scan_max(fmaxf(d0, d1), lane); float ex = __shfl_up(sm, 1); if (lane == 0) ex = -INFINITY;
        const float m0 = fmaxf(ex, d0);
        bc[2 * lane] = b0; bc[2 * lane + 1] = b1; lis[2 * lane] = li0; lis[2 * lane + 1] = li1; mxs[2 * lane] = m0; mxs[2 * lane + 1] = sm;
        npv[lane] = NL[(size_t)(bh * 64 + c) * 64 + lane];
    }
    {
        const int isk = tid >> 8, c8 = tid & 7, tg = (tid >> 3) & 31, ch = isk * 256 + h * 64 + c8 * 8;
        v4u raw[7]; load_rows<4>(P + (size_t)(b * T) * NE + 768 + ch, NE, c * 128 + 4 * tg, raw);
        const int vc8 = tid & 15, vtq = tid >> 4;
        v4u vr[4];
#pragma unroll
        for (int i = 0; i < 4; ++i) vr[i] = *(const v4u*)(P + (row0 + 4 * vtq + i) * NE + 1280 + h * 128 + vc8 * 8);
        v4u cr[2];
#pragma unroll
        for (int j = 0; j < 2; ++j) { const int it = tid + 512 * j, vd = it >> 3, cc8 = it & 7; const bf16* sp = (const bf16*)(CT + (size_t)16 * 64 * 8192) + ((size_t)(bh * 64 + c) * 128 + vd) * 64 + cc8 * 8; cr[j] = *(const v4u*)sp; }
        float o[4][8]; conv_silu<4>(raw, convw + ch, 512, convb + ch, o);
        const float qs_ = isk ? 0.125f : 1.0f;
#pragma unroll
        for (int i = 0; i < 4; ++i) {
#pragma unroll
            for (int e = 0; e < 8; ++e) o[i][e] *= qs_;
            *(LAS v4u*)((isk ? ks : qs) + (4 * tg + i) * 72 + c8 * 8) = pack8(o[i]); }
#pragma unroll
        for (int e = 0; e < 8; ++e) { v2u w;
#pragma unroll
            for (int p = 0; p < 2; ++p) { const unsigned lo = (vr[2 * p][e >> 1] >> ((e & 1) * 16)) & 0xffffu, hi = (vr[2 * p + 1][e >> 1] >> ((e & 1) * 16)) & 0xffffu; w[p] = lo | (hi << 16); }
            *(LAS v2u*)(vT + tsw(vc8 * 8 + e, 4 * vtq)) = w; }
#pragma unroll
        for (int j = 0; j < 2; ++j) { const int it = tid + 512 * j, vd = it >> 3, cc8 = it & 7; *(LAS v4u*)(cts + vd * 72 + cc8 * 8) = cr[j]; }
    }
    __syncthreads();
    {
        const int w = (wave < 4) ? 7 - wave : wave - 4, t = 16 * w + fr;
        v2u oq[8]; f32x4 gq[8];
        { const bf16* op = P + (row0 + t) * NE + 1792 + h * 128 + 4 * fq; const float* gn = mlnorm + h * 128 + 4 * fq;
#pragma unroll
          for (int vt = 0; vt < 8; ++vt) { oq[vt] = *(const v2u*)(op + 16 * vt); gq[vt] = *(const f32x4*)(gn + 16 * vt); } }
        const float bt = bc[t], mp = mp_pre;
        const float il = bt + mp, mt = fmaxf(il, bt + mxs[t]), winter = __expf(il - mt);
        bf16x8 qf[2]; qf[0] = *(const LAS bf16x8*)(qs + t * 72 + 8 * fq); qf[1] = *(const LAS bf16x8*)(qs + t * 72 + 32 + 8 * fq);
        f32x4 p[8]; float den = 0.f;
#pragma unroll
        for (int st = 0; st < 8; ++st) { p[st] = (f32x4){0.f, 0.f, 0.f, 0.f};
            if (st <= w) { f32x4 acc = (f32x4){0.f, 0.f, 0.f, 0.f};
#pragma unroll
                for (int s2 = 0; s2 < 2; ++s2) { const bf16x8 A = *(const LAS bf16x8*)(ks + (16 * st + fr) * 72 + 32 * s2 + 8 * fq); acc = mfma16(A, qf[s2], acc); }
#pragma unroll
                for (int r = 0; r < 4; ++r) { const int s = 16 * st + 4 * fq + r; const float e = (s <= t) ? __expf(bt - bc[s] + lis[s] - mt) : 0.f; const float val = acc[r] * e; den += val; p[st][r] = val; } } }
        den = quad_sum(den);
        float qn = 0.f;
        { float x[8]; unpack8(__builtin_bit_cast(v4u, qf[0]), x);
#pragma unroll
          for (int e = 0; e < 8; ++e) qn += x[e] * npv[8 * fq + e];
          unpack8(__builtin_bit_cast(v4u, qf[1]), x);
#pragma unroll
          for (int e = 0; e < 8; ++e) qn += x[e] * npv[32 + 8 * fq + e]; }
        qn = quad_sum(qn);
        const float dent = den + winter * qn, inv = 1.f / fmaxf(fabsf(dent), __expf(-mt));
        f32x4 hv[8]; float s1 = 0.f;
#pragma unroll
        for (int vt = 0; vt < 8; ++vt) { f32x4 a2 = (f32x4){0.f, 0.f, 0.f, 0.f}, a3 = a2;
#pragma unroll
            for (int jp = 0; jp < 4; ++jp) if (2 * jp <= w) { const int vr = 16 * vt + fr;
                const bf16x8 A = frag2(*(const LAS v2u*)(vT + tsw(vr, 32 * jp + 4 * fq)), *(const LAS v2u*)(vT + tsw(vr, 32 * jp + 16 + 4 * fq))); a2 = mfma16(A, frag8(p[2 * jp], p[2 * jp + 1]), a2); }
#pragma unroll
            for (int s2 = 0; s2 < 2; ++s2) { const bf16x8 A = *(const LAS bf16x8*)(cts + (16 * vt + fr) * 72 + 32 * s2 + 8 * fq); a3 = mfma16(A, qf[s2], a3); }
            hv[vt] = (a2 + winter * a3) * inv; s1 += (hv[vt][0] + hv[vt][1]) + (hv[vt][2] + hv[vt][3]); asm volatile("" ::: "memory"); }
        const float mean = quad_sum(s1) * (1.f / 128.f); float s2v = 0.f;
#pragma unroll
        for (int vt = 0; vt < 8; ++vt) { hv[vt] = hv[vt] - mean; s2v += (hv[vt][0] * hv[vt][0] + hv[vt][1] * hv[vt][1]) + (hv[vt][2] * hv[vt][2] + hv[vt][3] * hv[vt][3]); }
        const float rstd = 1.0f / sqrtf(quad_sum(s2v) * (1.f / 128.f) + 1e-6f);
        bf16* yo = Y + (row0 + t) * D + 512 + h * 128 + 4 * fq;
#pragma unroll
        for (int vt = 0; vt < 8; ++vt) { const v2u ov = oq[vt]; const f32x4 g4 = gq[vt];
            const float y0 = hv[vt][0] * rstd * g4.x * sigmoidf_(bflo(ov.x)), y1 = hv[vt][1] * rstd * g4.y * sigmoidf_(bfhi(ov.x)), y2 = hv[vt][2] * rstd * g4.z * sigmoidf_(bflo(ov.y)), y3 = hv[vt][3] * rstd * g4.w * sigmoidf_(bfhi(ov.y));
            v2u w2; w2.x = pk2(y0, y1); w2.y = pk2(y2, y3); *(v2u*)(yo + 16 * vt) = w2; }
    }
    __syncthreads();
}
__device__ __forceinline__ void ssm_conv8(const bf16* P, int b, int tt, int pcol, int cch, const float* convw, const float* convb, float (&acc)[8]) {
    { const f32x4 b0 = *(const f32x4*)(convb + cch), b1 = *(const f32x4*)(convb + cch + 4); acc[0] = b0.x; acc[1] = b0.y; acc[2] = b0.z; acc[3] = b0.w; acc[4] = b1.x; acc[5] = b1.y; acc[6] = b1.z; acc[7] = b1.w; }
#pragma unroll
    for (int tap = 0; tap < 4; ++tap) { const int t2 = tt - 3 + tap;
        if (t2 >= 0) { float x[8]; unpack8(*(const v4u*)(P + (size_t)(b * T + t2) * NO + pcol), x);
            const f32x4 w0 = *(const f32x4*)(convw + tap * 1024 + cch), w1 = *(const f32x4*)(convw + tap * 1024 + cch + 4);
            acc[0] += x[0] * w0.x; acc[1] += x[1] * w0.y; acc[2] += x[2] * w0.z; acc[3] += x[3] * w0.w; acc[4] += x[4] * w1.x; acc[5] += x[5] * w1.y; acc[6] += x[6] * w1.z; acc[7] += x[7] * w1.w; } }
#pragma unroll
    for (int e = 0; e < 8; ++e) acc[e] = siluf_(acc[e]);
}
__device__ __forceinline__ float ssm_dt_wave(const float* DT, size_t row0, int hd, const float* dtbias, const float* alog, int lane, LAS float* dtv, LAS float* acum) {
    const float db = dtbias[hd], A = -expf(alog[hd]);
    const float d0 = softplusf_(DT[(row0 + 2 * lane) * 8 + hd] + db), d1 = softplusf_(DT[(row0 + 2 * lane + 1) * 8 + hd] + db);
    const float ps = scan_add(d0 * A + d1 * A, lane);
    dtv[2 * lane] = d0; dtv[2 * lane + 1] = d1; acum[2 * lane] = ps - d1 * A; acum[2 * lane + 1] = ps;
    return __shfl(ps, 63);
}
__device__ __forceinline__ void ssd_local_unit(int u, const bf16* P, const float* DT, const float* convw, const float* convb, const float* dtbias, const float* alog,
                                               float* ST, float* DEC, LAS unsigned char* lds, int tid) {
    asm volatile("; MARK_BEGIN_ssd_local_unit");
    asm volatile("" : "+v"(tid));
    const int lane = tid & 63, wave = __builtin_amdgcn_readfirstlane(tid >> 6), fr = lane & 15, fq = lane >> 4;
    const int c = u & 63, g = (u >> 6) & 1, b = u >> 7;
    const size_t row0 = (size_t)b * T + c * 128;
    LAS bf16* xT = (LAS bf16*)lds;
    LAS bf16* bT = xT + 256 * 136;
    LAS float* dtv = (LAS float*)(bT + 128 * 136);
    LAS float* acum = dtv + 512;
    const int c8 = tid & 31, tg = tid >> 5, cch = g * 256 + c8 * 8;
    v4u raw[11]; load_rows<8>(P + (size_t)(b * T) * NO + 512 + cch, NO, c * 128 + 8 * tg, raw);
    const int bc8 = tid & 15, btg = tid >> 4, bch = 512 + g * 128 + bc8 * 8;
    v4u rawb[7]; load_rows<4>(P + (size_t)(b * T) * NO + 1024 + g * 128 + bc8 * 8, NO, c * 128 + 4 * btg, rawb);
    if (wave < 4) { const int hd = 4 * g + wave; const float al = ssm_dt_wave(DT, row0, hd, dtbias, alog, lane, dtv + wave * 128, acum + wave * 128);
        if (lane == 0) DEC[(b * 64 + c) * 8 + hd] = expf(al);
        LAS float* ac = acum + wave * 128; LAS float* dv = dtv + wave * 128;
        ac[2 * lane] = dv[2 * lane] * expf(al - ac[2 * lane]); ac[2 * lane + 1] = dv[2 * lane + 1] * expf(al - ac[2 * lane + 1]); }
    __syncthreads();
    {
        { float o[8][8]; conv_silu<8>(raw, convw + cch, 1024, convb + cch, o);
          const LAS float* scp = acum + (c8 >> 3) * 128 + 8 * tg; const f32x4 s0 = *(const LAS f32x4*)scp, s1 = *(const LAS f32x4*)(scp + 4);
#pragma unroll
          for (int e = 0; e < 8; ++e) { v4u w; w.x = pk2(o[0][e] * s0.x, o[1][e] * s0.y); w.y = pk2(o[2][e] * s0.z, o[3][e] * s0.w); w.z = pk2(o[4][e] * s1.x, o[5][e] * s1.y); w.w = pk2(o[6][e] * s1.z, o[7][e] * s1.w);
              *(LAS v4u*)(xT + tsw(c8 * 8 + e, 8 * tg)) = w; } }
        { float o[4][8]; conv_silu<4>(rawb, convw + bch, 1024, convb + bch, o);
#pragma unroll
          for (int e = 0; e < 8; ++e) { v2u w; w.x = pk2(o[0][e], o[1][e]); w.y = pk2(o[2][e], o[3][e]); *(LAS v2u*)(bT + tsw(bc8 * 8 + e, 4 * btg)) = w; } }
    }
    __syncthreads();
#pragma unroll
    for (int rr = 0; rr < 2; ++rr) { const int rt = 2 * wave + rr;
        f32x4 acc[8];
#pragma unroll
        for (int nt = 0; nt < 8; ++nt) acc[nt] = (f32x4){0.f, 0.f, 0.f, 0.f};
#pragma unroll
        for (int ks = 0; ks < 4; ++ks) { const bf16x8 A = *(const LAS bf16x8*)(xT + tsw(16 * rt + fr, 32 * ks + 8 * fq));
#pragma unroll
            for (int nt = 0; nt < 8; ++nt) { const bf16x8 Bf = *(const LAS bf16x8*)(bT + tsw(16 * nt + fr, 32 * ks + 8 * fq)); acc[nt] = mfma16(Bf, A, acc[nt]); } }
        const int hd = 4 * g + (rt >> 2), p0 = (rt & 3) * 16 + fr;
        float* sp = ST + (((size_t)(b * 64 + c) * 8 + hd) * 64 + p0) * 128 + 4 * fq;
#pragma unroll
        for (int nt = 0; nt < 8; ++nt) *(f32x4*)(sp + 16 * nt) = acc[nt]; }
    __syncthreads();
}
__device__ __forceinline__ void ssd_scan_phase(float* ST, const float* DEC, int tid, int G) {
    const int wave = tid >> 6; if (wave == 0) return;
    for (int e = (blockIdx.x * 7 + wave - 1) * 64 + (tid & 63); e < 4 * 8 * 8192; e += G * 7 * 64) {
        const int b = e >> 16, hd = (e >> 13) & 7, pn = e & 8191; float S = 0.f;
        float* sp = ST + ((size_t)(b * 64) * 8 + hd) * 8192 + pn;
#pragma unroll 1
        for (int c0 = 0; c0 < 64; c0 += 32) { float st[32], dc[32];
#pragma unroll
            for (int c = 0; c < 32; ++c) { st[c] = sp[(size_t)(c0 + c) * 65536]; dc[c] = DEC[(b * 64 + c0 + c) * 8 + hd]; }
#pragma unroll
            for (int c = 0; c < 32; ++c) { sp[(size_t)(c0 + c) * 65536] = S; S = S * dc[c] + st[c]; } }
    }
}
__device__ __forceinline__ void ssd_scan_pair(float* ST, const float* DEC, int pr, int k8, int tid) {
    const int b = pr >> 1, g = pr & 1;
    for (int e = k8 * 512 + tid; e < 4 * 8192; e += 8 * 512) {
        const int hd = 4 * g + (e >> 13), pn = e & 8191; float S = 0.f;
        float* sp = ST + ((size_t)(b * 64) * 8 + hd) * 8192 + pn;
#pragma unroll 1
        for (int c0 = 0; c0 < 64; c0 += 32) { float st[32], dc[32];
#pragma unroll
            for (int c = 0; c < 32; ++c) { st[c] = sp[(size_t)(c0 + c) * 65536]; dc[c] = DEC[(b * 64 + c0 + c) * 8 + hd]; }
#pragma unroll
            for (int c = 0; c < 32; ++c) { sp[(size_t)(c0 + c) * 65536] = S; S = S * dc[c] + st[c]; } }
    }
}
#ifndef SO_R1
#define SO_R1 1
#endif
#ifndef SO_R3
#define SO_R3 1
#endif
__device__ __forceinline__ void ssd_out_unit(int u, const bf16* P, const float* DT, const float* convw, const float* convb, const float* dtbias, const float* alog, const float* dskip, const float* gnorm,
                                             const float* ST, bf16* Y, LAS unsigned char* lds, int tid) {
    asm volatile("; MARK_BEGIN_ssd_out_unit");
    asm volatile("" : "+v"(tid));
    const int lane = tid & 63, wave = __builtin_amdgcn_readfirstlane(tid >> 6), fr = lane & 15, fq = lane >> 4;
    const int c = u & 63, g = (u >> 6) & 1, b = u >> 7;
    const size_t row0 = (size_t)b * T + c * 128;
    LAS bf16* xT = (LAS bf16*)lds;
    LAS bf16* bm = xT + 256 * 136;
    LAS bf16* cm = bm + 128 * 136;
    LAS float* dtv = (LAS float*)(cm + 128 * 136);
    LAS float* acum = dtv + 512;
    if (wave < 4) (void)ssm_dt_wave(DT, row0, 4 * g + wave, dtbias, alog, lane, dtv + wave * 128, acum + wave * 128);
    for (int sp1 = 0; sp1 < SO_R1; ++sp1) {
        const int c8 = tid & 31, tg = tid >> 5, cch = g * 256 + c8 * 8;
        v4u raw[11]; load_rows<8>(P + (size_t)(b * T) * NO + 512 + cch, NO, c * 128 + 8 * tg, raw);
        { float o[8][8]; conv_silu<8>(raw, convw + cch, 1024, convb + cch, o);
#pragma unroll
          for (int e = 0; e < 8; ++e) { v4u w; w.x = pk2(o[0][e], o[1][e]); w.y = pk2(o[2][e], o[3][e]); w.z = pk2(o[4][e], o[5][e]); w.w = pk2(o[6][e], o[7][e]); *(LAS v4u*)(xT + tsw(c8 * 8 + e, 8 * tg)) = w; } }
        const int isc = tid >> 8, bc8 = tid & 15, btg = (tid >> 4) & 15, bch = 512 + isc * 256 + g * 128 + bc8 * 8;
        v4u rawb[11]; load_rows<8>(P + (size_t)(b * T) * NO + 1024 + isc * 256 + g * 128 + bc8 * 8, NO, c * 128 + 8 * btg, rawb);
        { float o[8][8]; conv_silu<8>(rawb, convw + bch, 1024, convb + bch, o);
#pragma unroll
          for (int i = 0; i < 8; ++i) *(LAS v4u*)((isc ? cm : bm) + (8 * btg + i) * 136 + bc8 * 8) = pack8(o[i]); }
    }
    __syncthreads();
    {
        const int w = wave, t = 16 * w + fr;
        const f32x4 dsk4 = *(const f32x4*)(dskip + 4 * g);
        const bf16* zp0 = P + (row0 + t) * NO + 4 * g * 64 + 4 * fq;
        v2u zn[4];
#pragma unroll
        for (int pt = 0; pt < 4; ++pt) zn[pt] = *(const v2u*)(zp0 + 16 * pt);
        f32x4 sraw[16];
        { const float* sp0 = ST + ((size_t)(b * 64 + c) * 8 + 4 * g) * 8192;
#pragma unroll
          for (int i = 0; i < 16; ++i) sraw[i] = *(const f32x4*)(sp0 + (size_t)(tid + 512 * i) * 4); }
        bf16x8 cf[4];
#pragma unroll
        for (int ks = 0; ks < 4; ++ks) cf[ks] = *(const LAS bf16x8*)(cm + t * 136 + 32 * ks + 8 * fq);
        f32x4 cb[8];
#pragma unroll
        for (int st = 0; st < 8; ++st) { cb[st] = (f32x4){0.f, 0.f, 0.f, 0.f};
            if (st <= w) {
#pragma unroll
                for (int ks = 0; ks < 4; ++ks) { const bf16x8 A = *(const LAS bf16x8*)(bm + (16 * st + fr) * 136 + 32 * ks + 8 * fq); cb[st] = mfma16(A, cf[ks], cb[st]); } } }
        __syncthreads();
        LAS bf16* sl = bm;
#pragma unroll
        for (int i = 0; i < 16; ++i) { const int e4 = tid + 512 * i, row = e4 >> 5, c4 = (e4 & 31) * 4;
            v2u wv; wv.x = pk2(sraw[i][0], sraw[i][1]); wv.y = pk2(sraw[i][2], sraw[i][3]); *(LAS v2u*)(sl + row * 136 + c4) = wv; }
        __syncthreads();
        float ss = 0.f;
        bf16* yo = Y + (row0 + t) * D + g * 256 + 4 * fq;
        for (int sp3 = 0; sp3 < SO_R3; ++sp3) { ss = 0.f;
#pragma unroll
        for (int pt = 0; pt < 4; ++pt) zn[pt] = *(const v2u*)(zp0 + 16 * pt);
#pragma unroll 1
        for (int j = 0; j < 4; ++j) {
            v2u zc[4];
#pragma unroll
            for (int pt = 0; pt < 4; ++pt) zc[pt] = zn[pt];
            if (j < 3) {
#pragma unroll
                for (int pt = 0; pt < 4; ++pt) zn[pt] = *(const v2u*)(zp0 + (j + 1) * 64 + 16 * pt); }
            const int hd = 4 * g + j; const float at = acum[j * 128 + t], eat = __expf(at), dh = (j == 0) ? dsk4.x : (j == 1) ? dsk4.y : (j == 2) ? dsk4.z : dsk4.w;
            bf16x8 pf[4];
#pragma unroll
            for (int jp = 0; jp < 4; ++jp) { f32x4 p0 = (f32x4){0.f, 0.f, 0.f, 0.f}, p1 = p0;
                if (2 * jp <= w) {
#pragma unroll
                    for (int r = 0; r < 4; ++r) { const int s0 = 32 * jp + 4 * fq + r, s1 = s0 + 16;
                        p0[r] = (s0 <= t) ? cb[2 * jp][r] * __expf(at - acum[j * 128 + s0]) * dtv[j * 128 + s0] : 0.f;
                        p1[r] = (s1 <= t) ? cb[2 * jp + 1][r] * __expf(at - acum[j * 128 + s1]) * dtv[j * 128 + s1] : 0.f; } }
                pf[jp] = frag8(p0, p1); }
#pragma unroll
            for (int pt = 0; pt < 4; ++pt) { f32x4 a2 = (f32x4){0.f, 0.f, 0.f, 0.f}, a3 = a2;
#pragma unroll
                for (int jp = 0; jp < 4; ++jp) if (2 * jp <= w) { const int xr = j * 64 + 16 * pt + fr;
                    a2 = mfma16(frag2(*(const LAS v2u*)(xT + tsw(xr, 32 * jp + 4 * fq)), *(const LAS v2u*)(xT + tsw(xr, 32 * jp + 16 + 4 * fq))), pf[jp], a2); }
#pragma unroll
                for (int ks = 0; ks < 4; ++ks) a3 = mfma16(*(const LAS bf16x8*)(sl + (j * 64 + 16 * pt + fr) * 136 + 32 * ks + 8 * fq), cf[ks], a3);
                const v2u zv = zc[pt]; const float zz[4] = {bflo(zv.x), bfhi(zv.x), bflo(zv.y), bfhi(zv.y)};
                float y4[4];
#pragma unroll
                for (int r = 0; r < 4; ++r) { const float xv = bf1(xT[tsw(j * 64 + 16 * pt + 4 * fq + r, t)]); const float y = (a2[r] + eat * a3[r] + dh * xv) * siluf_(zz[r]); y4[r] = y; ss += y * y; }
                v2u w2; w2.x = pk2(y4[0], y4[1]); w2.y = pk2(y4[2], y4[3]); *(v2u*)(yo + j * 64 + 16 * pt) = w2; }
        } }
        const float rs = 1.0f / sqrtf(quad_sum(ss) * (1.f / 256.f) + 1e-5f);
        { const float* gn = gnorm + g * 256 + 4 * fq; f32x4 gq[16]; v2u yq[16];
#pragma unroll
          for (int q = 0; q < 16; ++q) { gq[q] = *(const f32x4*)(gn + 16 * q); yq[q] = *(const v2u*)(yo + 16 * q); }
#pragma unroll
          for (int q = 0; q < 16; ++q) { const f32x4 g4 = gq[q]; const v2u yv = yq[q];
              v2u w2; w2.x = pk2(bflo(yv.x) * rs * g4.x, bfhi(yv.x) * rs * g4.y); w2.y = pk2(bflo(yv.y) * rs * g4.z, bfhi(yv.y) * rs * g4.w); *(v2u*)(yo + 16 * q) = w2; } }
    }
    __syncthreads();
}
constexpr int RW_RS = 0, RW_KS = 9216, RW_VS = 18432, RW_GG = 27648;
constexpr int RW_BONP = 36864, RW_SSQ = 37888;
constexpr int RW_X = 39936;
constexpr int RW_TW = RW_X, RW_AD = RW_X + 9216, RW_GD = RW_X + 18432;
constexpr int RW_MK = RW_X, RW_NN = RW_X + 3072, RW_MB = RW_NN + 5120, RW_TT = RW_MB + 4096, RW_YO = RW_X + 16384;
constexpr int RW_AR = RW_X + 35840, RW_BK = RW_AR + 18432;
constexpr int RW_KB = RW_BK + 18432, RW_VT = RW_KB + 20480, RW_GL = RW_VT + 8192, RW_END = RW_GL + 1024;
constexpr int RW_GT = RW_RS;
static_assert(RW_TT + 3072 <= RW_YO && RW_YO + 16384 <= RW_AR && RW_END <= LDS_MAIN, "rwkv LDS map");
#ifndef RW_R1
#define RW_R1 1
#endif
#ifndef RW_R2
#define RW_R2 1
#endif
#ifndef RW_R3
#define RW_R3 1
#endif
#ifndef RW_R4
#define RW_R4 1
#endif
#ifndef RW_R5
#define RW_R5 1
#endif
constexpr int RW_PAR = RW_END;
static_assert(RW_PAR + 1792 <= LDS_MAIN, "rwkv LDS map");
__device__ __forceinline__ float tanh_fast(float x) { return 1.f - 2.f * rcpf_(1.f + __expf(2.f * x)); }
__device__ __forceinline__ void rwkv_lx_phase(const bf16* P, const float* mu, bf16* LX, int tid, int G) {
    for (int id = blockIdx.x * 512 + tid; id < 32 * (M / 8); id += G * 512) {
        const int piece = id & 31, r0 = (id >> 5) * 8;
        v4u raw[9];
#pragma unroll
        for (int i = 0; i < 9; ++i) { const int row = r0 - 1 + i; raw[i] = ((row & (T - 1)) != (T - 1) || i > 0) && row >= 0 ? *(const v4u*)(P + (size_t)row * NO + 3072 + piece * 8) : (v4u){0u, 0u, 0u, 0u}; }
        if ((r0 & (T - 1)) == 0) raw[0] = (v4u){0u, 0u, 0u, 0u};
        const f32x4 m0 = *(const f32x4*)(mu + 1536 + piece * 8), m1 = *(const f32x4*)(mu + 1536 + piece * 8 + 4); const float mm[8] = {m0.x, m0.y, m0.z, m0.w, m1.x, m1.y, m1.z, m1.w};
#pragma unroll
        for (int i = 0; i < 8; ++i) { float cur[8], prv[8], o[8]; unpack8(raw[i + 1], cur); unpack8(raw[i], prv);
#pragma unroll
            for (int e = 0; e < 8; ++e) { const float x = cur[e] + (prv[e] - cur[e]) * mm[e]; o[e] = (piece < 8) ? tanh_fast(x) : (piece < 16 ? x : sigmoidf_(x)); }
            *(v4u*)(LX + (size_t)(r0 + i) * 256 + piece * 8) = pack8(o); }
    }
}
__device__ __forceinline__ void rwkv_rows_load(int u, const bf16* P, int tid, v4u (&raw)[5]) {
    if (tid < 384) {
        const int h = u & 7, c64 = (u >> 3) & 127, b = u >> 10; const size_t row0 = (size_t)b * T + c64 * 64;
        const int q = tid % 24, tg = tid / 24; const int pcol = 1536 + (q >> 3) * 512 + h * 64 + (q & 7) * 8;
        const bf16* pp = P + row0 * NO + pcol;
#pragma unroll
        for (int i = 0; i < 5; ++i) { const int tt = tg * 4 - 1 + i; raw[i] = (c64 * 64 + tt >= 0) ? *(const v4u*)(pp + (ptrdiff_t)tt * NO) : (v4u){0u, 0u, 0u, 0u}; }
    }
}
template <bool WANT_Y>
__device__ __forceinline__ void rwkv_recur(f32x4 (&W)[4], const bool has_v, const int vcol, LAS unsigned char* lds, const int fr, const int fq) {
    LAS float* YO = (LAS float*)(lds + RW_YO);
    const bf16x8 zero8 = (bf16x8){0, 0, 0, 0, 0, 0, 0, 0}; const v2u zero2 = (v2u){0u, 0u};
    f32x4 ys[4];
#pragma unroll
    for (int i = 0; i < 4; ++i) {
        LAS bf16* AR = (LAS bf16*)(lds + RW_AR) + i * 32 * 72; LAS bf16* KB = (LAS bf16*)(lds + RW_KB) + i * 64 * 40; LAS bf16* VT = (LAS bf16*)(lds + RW_VT) + i * 64 * 16; LAS float* GL = (LAS float*)(lds + RW_GL) + i * 64;
        LAS bf16* MK = (LAS bf16*)(lds + RW_MK) + i * 16 * 24; LAS bf16* NN = (LAS bf16*)(lds + RW_NN) + i * 16 * 40; LAS bf16* TT = (LAS bf16*)(lds + RW_TT) + i * 16 * 24;
        bf16x8 wf[2]; wf[0] = frag8(W[0], W[1]); wf[1] = frag8(W[2], W[3]);
        f32x4 au = (f32x4){0.f, 0.f, 0.f, 0.f}, ay = au;
#pragma unroll
        for (int s = 0; s < 2; ++s) { const LAS bf16* ap = AR + fr * 72 + 32 * s + 4 * fq; au = mfma16(frag2(*(const LAS v2u*)ap, *(const LAS v2u*)(ap + 16)), wf[s], au);
            if (WANT_Y) { const LAS bf16* rp = AR + (16 + fr) * 72 + 32 * s + 4 * fq; ay = mfma16(frag2(*(const LAS v2u*)rp, *(const LAS v2u*)(rp + 16)), wf[s], ay); } }
        v2u vin = zero2;
        if (has_v) { const bf16x8 A = (fq < 2) ? *(const LAS bf16x8*)(MK + fr * 24 + 8 * fq) : zero8; const bf16x8 Bv = (fq < 2) ? *(const LAS bf16x8*)(VT + vcol * 16 + 8 * fq) : zero8;
            au = mfma16(A, Bv, au); vin = *(const LAS v2u*)(VT + vcol * 16 + 4 * fq); }
        f32x4 U;
        { v4u bw; bw.x = pk2(au[0], au[1]); bw.y = pk2(au[2], au[3]); bw.z = 0u; bw.w = 0u; const v2u tl2 = *(const LAS v2u*)(TT + fr * 24 + 4 * fq);
          U = mfma16(frag2(tl2, zero2), __builtin_bit_cast(bf16x8, bw), (f32x4){0.f, 0.f, 0.f, 0.f}); }
        v4u ubw; ubw.x = pk2(U[0], U[1]); ubw.y = pk2(U[2], U[3]); ubw.z = vin.x; ubw.w = vin.y; const bf16x8 ub = __builtin_bit_cast(bf16x8, ubw);
        if (WANT_Y) ys[i] = mfma16(*(const LAS bf16x8*)(NN + fr * 40 + 8 * fq), ub, ay);
#pragma unroll
        for (int kt = 0; kt < 4; ++kt) { W[kt] = mfma16(*(const LAS bf16x8*)(KB + (16 * kt + fr) * 40 + 8 * fq), ub, W[kt]); const f32x4 g4 = *(const LAS f32x4*)(GL + 16 * kt + 4 * fq); W[kt] = W[kt] * g4; }
    }
    if (WANT_Y) {
#pragma unroll
        for (int i = 0; i < 4; ++i)
#pragma unroll
            for (int r = 0; r < 4; ++r) YO[(16 * i + 4 * fq + r) * 64 + vcol] = ys[i][r]; }
}
#ifndef CHAIN_PLAIN
#define CHAIN_PLAIN 0
#endif
#ifndef CHAIN_RING
#define CHAIN_RING 1
#endif
#ifndef CHAIN_BACKOFF
#define CHAIN_BACKOFF 8
#endif
#ifndef CHAIN_FLAG_HINT
#define CHAIN_FLAG_HINT 0
#endif
constexpr int RW_SX = RW_PAR + 2048;
static_assert(RW_SX + 8192 <= LDS_MAIN, "rwkv LDS map");
#ifndef CHAIN_HILO
#define CHAIN_HILO 1
#endif
__device__ __forceinline__ void chain_wait(unsigned* flag, unsigned* tmo, int lane) {
    unsigned spins = 0;
    while ((unsigned)__builtin_amdgcn_readfirstlane(__hip_atomic_load(flag, __ATOMIC_RELAXED, __HIP_MEMORY_SCOPE_AGENT)) == 0u) {
        __builtin_amdgcn_s_sleep(1);
        if ((++spins & 1023u) == 0u) { if (spins > (1u << 19) || (unsigned)__builtin_amdgcn_readfirstlane(__hip_atomic_load(tmo, __ATOMIC_RELAXED, __HIP_MEMORY_SCOPE_AGENT)) != 0u) { if (lane == 0) __hip_atomic_store(tmo, 1u, __ATOMIC_RELAXED, __HIP_MEMORY_SCOPE_AGENT); break; } } }
    asm volatile("" ::: "memory");
}
__device__ __forceinline__ void rwkv_consts_load(int h, const float* const* in, int tid, float (&mm)[8], float (&kkw)[8]) {
    const int q = (tid < 384) ? tid % 24 : 0; const int mcol = (q >> 3) * 512 + h * 64 + (q & 7) * 8;
    const f32x4 m0 = *(const f32x4*)(in[21] + mcol), m1 = *(const f32x4*)(in[21] + mcol + 4); mm[0] = m0.x; mm[1] = m0.y; mm[2] = m0.z; mm[3] = m0.w; mm[4] = m1.x; mm[5] = m1.y; mm[6] = m1.z; mm[7] = m1.w;
    const f32x4 k0 = *(const f32x4*)(in[27] + h * 64 + (q & 7) * 8), k1 = *(const f32x4*)(in[27] + h * 64 + (q & 7) * 8 + 4); kkw[0] = k0.x; kkw[1] = k0.y; kkw[2] = k0.z; kkw[3] = k0.w; kkw[4] = k1.x; kkw[5] = k1.y; kkw[6] = k1.z; kkw[7] = k1.w;
}
__device__ __forceinline__ void rwkv_lx_load(int u, const bf16* LX, int tid, bf16x8 (&lxa)[8]) {
    const int lane = tid & 63, wave = tid >> 6, fr = lane & 15, fq = lane >> 4; const int c64 = (u >> 3) & 127, b = u >> 10;
    const bf16* lx = LX + ((size_t)b * T + c64 * 64 + 16 * (wave & 3) + fr) * 256 + 8 * fq;
#pragma unroll
    for (int ks = 0; ks < 2; ++ks) { lxa[ks] = *(const bf16x8*)(lx + 32 * ks); lxa[2 + ks] = *(const bf16x8*)(lx + 64 + 32 * ks); }
#pragma unroll
    for (int ks = 0; ks < 4; ++ks) lxa[4 + ks] = *(const bf16x8*)(lx + 128 + 32 * ks);
}
__device__ __forceinline__ void rwkv_post(int u, bf16* Y, LAS unsigned char* lds, int tid) {
    const int h = u & 7, c64 = (u >> 3) & 127, b = u >> 10; const size_t row0 = (size_t)b * T + c64 * 64;
    LAS float* YO = (LAS float*)(lds + RW_YO); LAS bf16* GG = (LAS bf16*)(lds + RW_GG); LAS float* BONP = (LAS float*)(lds + RW_BONP); LAS bf16* VT = (LAS bf16*)(lds + RW_VT); LAS float* PAR = (LAS float*)(lds + RW_PAR);
    const int t = tid >> 3, c8 = tid & 7, v0 = c8 * 8;
    float y[8]; float s1 = 0.f;
#pragma unroll
    for (int e = 0; e < 8; ++e) { y[e] = YO[t * 64 + v0 + e]; s1 += y[e]; }
    s1 += __shfl_xor(s1, 1); s1 += __shfl_xor(s1, 2); s1 += __shfl_xor(s1, 4);
    const float mean = s1 * (1.f / 64.f); float s2 = 0.f;
#pragma unroll
    for (int e = 0; e < 8; ++e) { y[e] -= mean; s2 += y[e] * y[e]; }
    s2 += __shfl_xor(s2, 1); s2 += __shfl_xor(s2, 2); s2 += __shfl_xor(s2, 4);
    const f32x4 bp = *(const LAS f32x4*)(BONP + t * 4); const float rstd = 1.0f / sqrtf(s2 * (1.f / 64.f) + 64e-5f), bon = (bp.x + bp.y) + (bp.z + bp.w);
    float gg[8], o[8]; unpack8(*(const LAS v4u*)(GG + t * 72 + v0), gg);
    const LAS float* lw_ = PAR + 320 + v0; const LAS float* lb_ = PAR + 384 + v0;
#pragma unroll
    for (int e = 0; e < 8; ++e) { const float vv = bf1(VT[((t >> 4) * 64 + v0 + e) * 16 + (t & 15)]); o[e] = (y[e] * rstd * lw_[e] + lb_[e] + bon * vv) * gg[e]; }
    *(v4u*)(Y + (row0 + t) * D + 512 + h * 64 + v0) = pack8(o);
}
template <int MODE>
__device__ __forceinline__ void rwkv_chunk_unit(int u, int u_next, int u_prev, int& cur_h, v4u (&raw)[5], bf16x8 (&lxa)[8], const float (&mm)[8], const float (&kkw)[8], const bf16* P, const bf16* LX, const float* const* in, const bf16* lora, bf16* GF, float* HS, bf16* Y, gu32* ctlw, LAS unsigned char* lds, int tid) {
    asm volatile("; MARK_BEGIN_rwkv_chunk_unit");
    asm volatile("" : "+v"(tid));
    const int lane = tid & 63, wave = __builtin_amdgcn_readfirstlane(tid >> 6), fr = lane & 15, fq = lane >> 4;
    const int h = u & 7, c64 = (u >> 3) & 127, b = u >> 10;
    const int su = (b * 8 + h) * 128 + c64;
    const size_t row0 = (size_t)b * T + c64 * 64;
    LAS bf16* RS = (LAS bf16*)(lds + RW_RS); LAS bf16* KS = (LAS bf16*)(lds + RW_KS); LAS bf16* VS = (LAS bf16*)(lds + RW_VS); LAS bf16* GG = (LAS bf16*)(lds + RW_GG);
    LAS float* BONP = (LAS float*)(lds + RW_BONP); LAS float* SSQ = (LAS float*)(lds + RW_SSQ);
    LAS float* PAR = (LAS float*)(lds + RW_PAR);
    if (h != cur_h) { cur_h = h;
        if (tid < 448) { const int a7 = tid >> 6, kh = tid & 63; const int src = (a7 == 0) ? 22 : (a7 == 1) ? 24 : (a7 == 2) ? 27 : (a7 == 3) ? 28 : (a7 == 4) ? 29 : (a7 == 5) ? 30 : 31; PAR[tid] = in[src][h * 64 + kh]; } }
    const bf16* w2t = lora + (size_t)(h * 64) * 64; const bf16* a2t = lora + 512 * 64 + (size_t)(h * 64) * 64; const bf16* g2t = lora + 2 * 512 * 64 + (size_t)(h * 64) * 128;
    bf16x8 bw[2][2], ba[2][2];
#pragma unroll
    for (int ni = 0; ni < 2; ++ni) { const int kh = 16 * (2 * (wave >> 2) + ni) + fr;
#pragma unroll
        for (int ks = 0; ks < 2; ++ks) { bw[ni][ks] = *(const bf16x8*)(w2t + (size_t)kh * 64 + 32 * ks + 8 * fq); ba[ni][ks] = *(const bf16x8*)(a2t + (size_t)kh * 64 + 32 * ks + 8 * fq); }
    }
    bf16x8 bg[2][4];
    if (MODE >= 1) {
#pragma unroll
        for (int ni = 0; ni < 2; ++ni)
#pragma unroll
            for (int ks = 0; ks < 4; ++ks) bg[ni][ks] = *(const bf16x8*)(g2t + (size_t)(16 * (2 * (wave >> 2) + ni) + fr) * 128 + 32 * ks + 8 * fq); }
    f32x4 W[4];
    if (MODE == 1 && wave < 4) {
#pragma unroll
        for (int kt = 0; kt < 4; ++kt) W[kt] = *(const f32x4*)(HS + (((size_t)su * 4 + wave) * 4 + kt) * 256 + lane * 4); }
    if (MODE == 2 && u_prev >= 0) rwkv_post(u_prev, Y, lds, tid);
    for (int rp1 = 0; rp1 < RW_R1; ++rp1) { if (rp1) __syncthreads();
    if (tid < 384) {
        const int q = tid % 24, tg = tid / 24;
#pragma unroll
        for (int i = 0; i < 4; ++i) { const int t = tg * 4 + i; float cur[8], prv[8], o[8]; unpack8(raw[i + 1], cur); unpack8(raw[i], prv);
#pragma unroll
            for (int e = 0; e < 8; ++e) o[e] = cur[e] + (prv[e] - cur[e]) * mm[e];
            LAS bf16* dst = (q < 8) ? RS : (q < 16 ? KS : VS); const v4u pk = pack8(o); *(LAS v4u*)(dst + t * 72 + (q & 7) * 8) = pk;
            if (q >= 8 && q < 16) { float kr[8]; unpack8(pk, kr); float sq = 0.f;
#pragma unroll
                for (int e = 0; e < 8; ++e) { const float z = kr[e] * kkw[e]; sq += z * z; }
                SSQ[t * 8 + (q & 7)] = sq; } }
    } }
    __syncthreads();
    if (u_next >= 0) rwkv_rows_load(u_next, P, tid, raw);
#ifdef PROBE_UNIT_SLEEP
    if (MODE == 2) __builtin_amdgcn_s_sleep(PROBE_UNIT_SLEEP);
#endif
    for (int rp2 = 0; rp2 < RW_R2; ++rp2) { if (rp2) __syncthreads();
        LAS bf16* AR = (LAS bf16*)(lds + RW_AR); LAS bf16* BK = (LAS bf16*)(lds + RW_BK); LAS bf16* KB = (LAS bf16*)(lds + RW_KB); LAS bf16* VT = (LAS bf16*)(lds + RW_VT); LAS float* GL = (LAS float*)(lds + RW_GL);
        const int tt = wave & 3, t0 = 16 * tt + 4 * fq;
        float invn[4];
#pragma unroll
        for (int r = 0; r < 4; ++r) { const f32x4 s0 = *(const LAS f32x4*)(SSQ + (t0 + r) * 8), s1 = *(const LAS f32x4*)(SSQ + (t0 + r) * 8 + 4); invn[r] = rcpf_(fmaxf(sqrtf(((s0.x + s0.y) + (s0.z + s0.w)) + ((s1.x + s1.y) + (s1.z + s1.w))), 1e-12f)); }
#pragma unroll
        for (int ni = 0; ni < 2; ++ni) { const int nt = 2 * (wave >> 2) + ni, kh = 16 * nt + fr;
            f32x4 aw = (f32x4){0.f, 0.f, 0.f, 0.f}, aa = aw, ag = aw;
#pragma unroll
            for (int ks = 0; ks < 2; ++ks) { aw = mfma16(lxa[ks], bw[ni][ks], aw); aa = mfma16(lxa[2 + ks], ba[ni][ks], aa); }
            if (MODE >= 1) {
#pragma unroll
                for (int ks = 0; ks < 4; ++ks) ag = mfma16(lxa[4 + ks], bg[ni][ks], ag); }
            const float w0 = PAR[kh], a0 = PAR[64 + kh], kkw = PAR[128 + kh], kaw = PAR[192 + kh], rkw = PAR[256 + kh];
            float lw[4], cs[4]; float run = 0.f;
#pragma unroll
            for (int r = 0; r < 4; ++r) { lw[r] = -0.60653066f * sigmoidf_(w0 + aw[r]); run += lw[r]; cs[r] = run; }
            float inc = run; { const float t1 = __shfl_up(inc, 16); if (fq >= 1) inc += t1; const float t2 = __shfl_up(inc, 32); if (fq >= 2) inc += t2; }
            const float excl = inc - run;
            float al[4], be[4], ka[4], rh[4], vv[4], bon[4];
            float ep = __expf(excl);
#pragma unroll
            for (int r = 0; r < 4; ++r) { const int t = t0 + r;
                const float cl = excl + cs[r];
                const float av = sigmoidf_(a0 + aa[r]);
                const float rv = bf1(RS[t * 72 + kh]), kv = bf1(KS[t * 72 + kh]); vv[r] = bf1(VS[t * 72 + kh]);
                const float ec = __expf(cl), em = rcpf_(ec);
                const float kkn = kv * kkw * invn[r], kp = kv * (1.f + (av - 1.f) * kaw);
                al[r] = kkn * ep; be[r] = kkn * av * em; ka[r] = kp * em; rh[r] = rv * ec; bon[r] = rv * kp * rkw;
                if (r == 3 && fq == 3) GL[tt * 64 + kh] = ec;
                if (MODE >= 1) GG[t * 72 + kh] = tobf(ag[r]);
                ep = ec; }
#pragma unroll
            for (int r = 0; r < 4; ++r) { const float x = row16_sum(bon[r]); if (fr == 0) BONP[(t0 + r) * 4 + nt] = x; }
            LAS bf16* ar = AR + (tt * 32 + 4 * fq) * 72 + kh; LAS bf16* bk = BK + (tt * 32 + 4 * fq) * 72 + kh;
#pragma unroll
            for (int r = 0; r < 4; ++r) { ar[r * 72] = tobf(al[r]); ar[(16 + r) * 72] = tobf(rh[r]); bk[r * 72] = tobf(be[r]); bk[(16 + r) * 72] = tobf(ka[r]); }
            { v4u w; w.x = pk2(-be[0], -be[1]); w.y = pk2(-be[2], -be[3]); w.z = pk2(ka[0], ka[1]); w.w = pk2(ka[2], ka[3]); *(LAS v4u*)(KB + (tt * 64 + kh) * 40 + 8 * fq) = w; }
            { v2u w; w.x = pk2(vv[0], vv[1]); w.y = pk2(vv[2], vv[3]); *(LAS v2u*)(VT + (tt * 64 + kh) * 16 + 4 * fq) = w; } }
    }
    __syncthreads();
    if (u_next >= 0) rwkv_lx_load(u_next, LX, tid, lxa);
    for (int rp4 = 0; rp4 < RW_R4; ++rp4) { if (rp4) __syncthreads();
    {
        const int i = wave & 3; const bool inv_half = wave < 4;
        LAS bf16* AR = (LAS bf16*)(lds + RW_AR) + i * 32 * 72; LAS bf16* BK = (LAS bf16*)(lds + RW_BK) + i * 32 * 72;
        LAS bf16* MK = (LAS bf16*)(lds + RW_MK) + i * 16 * 24; LAS bf16* NN = (LAS bf16*)(lds + RW_NN) + i * 16 * 40; LAS float* MB = (LAS float*)(lds + RW_MB) + i * 256; LAS bf16* TT = (LAS bf16*)(lds + RW_TT) + i * 16 * 24;
        const int slotc = 8 * (fr >> 2) + (fr & 3);
        if (inv_half) {
            f32x4 acc = (f32x4){0.f, 0.f, 0.f, 0.f};
#pragma unroll
            for (int ks = 0; ks < 2; ++ks) acc = mfma16(*(const LAS bf16x8*)(AR + fr * 72 + 32 * ks + 8 * fq), *(const LAS bf16x8*)(BK + fr * 72 + 32 * ks + 8 * fq), acc);
#pragma unroll
            for (int r = 0; r < 4; ++r) { const int ta = 4 * fq + r, tb = fr; MB[ta * 16 + tb] = (tb < ta) ? acc[r] : 0.f; }
            LDS_WAIT(); asm volatile("" ::: "memory");
            { const int cc = lane & 15; float tc[16];
#pragma unroll
              for (int t = 0; t < 16; ++t) { float s0 = (t == cc) ? 1.f : 0.f, s1 = 0.f;
#pragma unroll
                  for (int j = 0; j < t; ++j) { if (j & 1) s1 -= MB[t * 16 + j] * tc[j]; else s0 -= MB[t * 16 + j] * tc[j]; }
                  tc[t] = s0 + s1; }
              if (lane < 16) {
#pragma unroll
                  for (int t = 0; t < 16; ++t) TT[t * 24 + cc] = tobf(tc[t]); } }
        } else {
            f32x4 pr[3];
#pragma unroll
            for (int pi = 0; pi < 3; ++pi) { const int ra = (pi + 1) >> 1, cbx = (pi + 1) & 1; f32x4 acc = (f32x4){0.f, 0.f, 0.f, 0.f};
#pragma unroll
                for (int ks = 0; ks < 2; ++ks) acc = mfma16(*(const LAS bf16x8*)(AR + (16 * ra + fr) * 72 + 32 * ks + 8 * fq), *(const LAS bf16x8*)(BK + (16 * cbx + fr) * 72 + 32 * ks + 8 * fq), acc);
                pr[pi] = acc; }
#pragma unroll
            for (int r = 0; r < 4; ++r) { const int ta = 4 * fq + r, tb = fr;
                const float mk = (tb < ta) ? pr[0][r] : 0.f, nb = (tb <= ta) ? pr[1][r] : 0.f, nk = (tb <= ta) ? pr[2][r] : 0.f;
                MK[ta * 24 + tb] = tobf(mk); NN[ta * 40 + slotc] = tobf(-nb); NN[ta * 40 + slotc + 4] = tobf(nk); }
        }
    } }
    __syncthreads();
    LAS float* YO = (LAS float*)(lds + RW_YO);
    LAS bf16* GT = (LAS bf16*)(lds + RW_GT);
    if (MODE == 1) { if (wave < 4) rwkv_recur<true>(W, true, 16 * wave + fr, lds, fr, fq); }
    else {
#pragma unroll
        for (int kt = 0; kt < 4; ++kt)
#pragma unroll
            for (int r = 0; r < 4; ++r) W[kt][r] = (wave < 4 && (16 * kt + 4 * fq + r) == (16 * wave + fr)) ? 1.f : 0.f;
        rwkv_recur<false>(W, wave >= 4, 16 * (wave & 3) + fr, lds, fr, fq);
        if (wave < 4) {
#pragma unroll
            for (int kt = 0; kt < 4; ++kt)
#pragma unroll
                for (int r = 0; r < 4; ++r) GT[(16 * kt + 4 * fq + r) * 72 + 16 * wave + fr] = tobf(W[kt][r]);
        } else if (MODE == 0) {
#pragma unroll
            for (int kt = 0; kt < 4; ++kt) *(f32x4*)(HS + (((size_t)su * 4 + (wave - 4)) * 4 + kt) * 256 + lane * 4) = W[kt]; }
    }
    __syncthreads();
    if (MODE == 2) {
        unsigned* FL = (unsigned*)ctlw + 16384;
        unsigned* tmo = (unsigned*)ctlw + CW_BAR + XB_TMO;
        const int vt = wave & 3;
#if CHAIN_RING
        typedef unsigned long long u64;
        u64* RING = (u64*)((unsigned char*)ctlw + (WS_RING - WS_CTL));
        LAS v2u* SX = (LAS v2u*)(lds + RW_SX);
        const int seq = su >> 7;
        bf16x8 gc[8]; v2u sb[4];
        if (wave >= 4) {
            if (c64 < 127) {
#pragma unroll
                for (int f = 0; f < 8; ++f) { const LAS bf16* gp = GT + (16 * (f >> 1) + fr) * 72 + 32 * (f & 1) + 4 * fq; gc[f] = frag2(*(const LAS v2u*)gp, *(const LAS v2u*)(gp + 16)); }
                LDS_WAIT(); }
            if (c64 > 0) {
                if (CHAIN_FLAG_HINT) chain_wait(FL + ((size_t)su * 4 + vt) * 4, tmo, lane);
                u64* rp = RING + (size_t)((seq * 4 + vt) * 2 + (c64 & 1)) * 512 + lane; const unsigned tag = (unsigned)c64;
                unsigned spins = 0;
                for (;;) { u64 q[8]; bool ok = true;
#pragma unroll
                    for (int j = 0; j < 8; ++j) q[j] = __hip_atomic_load(rp + j * 64, __ATOMIC_RELAXED, __HIP_MEMORY_SCOPE_AGENT);
#pragma unroll
                    for (int j = 0; j < 8; ++j) ok = ok && ((unsigned)(q[j] >> 32) == tag);
#pragma unroll
                    for (int kt = 0; kt < 4; ++kt) { sb[kt].x = (unsigned)q[2 * kt]; sb[kt].y = (unsigned)q[2 * kt + 1]; }
                    if (__builtin_amdgcn_ballot_w64(!ok) == 0ull) break;
                    if (!CHAIN_FLAG_HINT) __builtin_amdgcn_s_sleep(CHAIN_BACKOFF);
                    if ((++spins & 255u) == 0u) { if (spins > (1u << 17) || (unsigned)__builtin_amdgcn_readfirstlane(__hip_atomic_load(tmo, __ATOMIC_RELAXED, __HIP_MEMORY_SCOPE_AGENT)) != 0u) { if (lane == 0) __hip_atomic_store(tmo, 1u, __ATOMIC_RELAXED, __HIP_MEMORY_SCOPE_AGENT); break; } } }
            } else {
#pragma unroll
                for (int kt = 0; kt < 4; ++kt) sb[kt] = (v2u){0u, 0u}; }
#pragma unroll
            for (int kt = 0; kt < 4; ++kt) SX[(vt * 4 + kt) * 64 + lane] = sb[kt];
        }
        __syncthreads();
        if (wave >= 4) {
            if (c64 < 127) {
                const bf16x8 wh0 = frag2(sb[0], sb[1]), wh1 = frag2(sb[2], sb[3]);
                u64* wp = RING + (size_t)((seq * 4 + vt) * 2 + ((c64 + 1) & 1)) * 512 + lane; const u64 tg = (u64)(unsigned)(c64 + 1) << 32;
#pragma unroll
                for (int kt = 0; kt < 4; ++kt) { f32x4 a = W[kt]; a = mfma16(gc[2 * kt], wh0, a); a = mfma16(gc[2 * kt + 1], wh1, a);
                    __hip_atomic_store(wp + (2 * kt) * 64, tg | (u64)pk2(a[0], a[1]), __ATOMIC_RELAXED, __HIP_MEMORY_SCOPE_AGENT);
                    __hip_atomic_store(wp + (2 * kt + 1) * 64, tg | (u64)pk2(a[2], a[3]), __ATOMIC_RELAXED, __HIP_MEMORY_SCOPE_AGENT); }
#ifdef PROBE_LINK_SLEEP
                __builtin_amdgcn_s_sleep(PROBE_LINK_SLEEP);
#endif
                if (CHAIN_FLAG_HINT && lane == 0) __hip_atomic_store(FL + ((size_t)(su + 1) * 4 + vt) * 4, 1u, __ATOMIC_RELAXED, __HIP_MEMORY_SCOPE_AGENT);
            }
        } else {
#pragma unroll
            for (int kt = 0; kt < 4; ++kt) { const v2u s2 = SX[(wave * 4 + kt) * 64 + lane]; W[kt] = (f32x4){bflo(s2.x), bfhi(s2.x), bflo(s2.y), bfhi(s2.y)}; }
            rwkv_recur<true>(W, true, 16 * wave + fr, lds, fr, fq);
        }
        __syncthreads();
#else
        f32x4 Sc[4];
        bf16x8 gc[8];
        if (wave >= 4 && c64 < 127) {
#pragma unroll
            for (int f = 0; f < 8; ++f) { const LAS bf16* gp = GT + (16 * (f >> 1) + fr) * 72 + 32 * (f & 1) + 4 * fq; gc[f] = frag2(*(const LAS v2u*)gp, *(const LAS v2u*)(gp + 16)); }
            LDS_WAIT(); }
        if (c64 > 0) { chain_wait(FL + ((size_t)su * 4 + vt) * 4, tmo, lane);
            typedef GAS unsigned long long gu64; typedef unsigned long long u64x2 __attribute__((ext_vector_type(2)));
#pragma unroll
            for (int kt = 0; kt < 4; ++kt) { gu64* src = (gu64*)(HS + (((size_t)su * 4 + vt) * 4 + kt) * 256 + lane * 4); u64x2 q;
                if (CHAIN_PLAIN) Sc[kt] = *(const f32x4*)(HS + (((size_t)su * 4 + vt) * 4 + kt) * 256 + lane * 4); else { q[0] = __hip_atomic_load(src, __ATOMIC_RELAXED, __HIP_MEMORY_SCOPE_AGENT); q[1] = __hip_atomic_load(src + 1, __ATOMIC_RELAXED, __HIP_MEMORY_SCOPE_AGENT); Sc[kt] = __builtin_bit_cast(f32x4, q); } }
        } else {
#pragma unroll
            for (int kt = 0; kt < 4; ++kt) Sc[kt] = (f32x4){0.f, 0.f, 0.f, 0.f}; }
        if (wave >= 4) {
            if (c64 < 127) {
                f32x4 Sl[4];
#pragma unroll
                for (int kt = 0; kt < 4; ++kt)
#pragma unroll
                    for (int r = 0; r < 4; ++r) { const float hi = __builtin_bit_cast(float, f2bf(Sc[kt][r]) << 16); Sl[kt][r] = Sc[kt][r] - hi; }
                const bf16x8 wh0 = frag8(Sc[0], Sc[1]), wh1 = frag8(Sc[2], Sc[3]), wl0 = frag8(Sl[0], Sl[1]), wl1 = frag8(Sl[2], Sl[3]);
                typedef GAS unsigned long long gu64;
#pragma unroll
                for (int kt = 0; kt < 4; ++kt) { f32x4 a = W[kt]; a = mfma16(gc[2 * kt], wh0, a); a = mfma16(gc[2 * kt + 1], wh1, a); if (CHAIN_HILO) { a = mfma16(gc[2 * kt], wl0, a); a = mfma16(gc[2 * kt + 1], wl1, a); }
                    gu64* dst = (gu64*)(HS + (((size_t)(su + 1) * 4 + vt) * 4 + kt) * 256 + lane * 4);
                    typedef unsigned long long u64x2 __attribute__((ext_vector_type(2))); const u64x2 q = __builtin_bit_cast(u64x2, a);
                    if (CHAIN_PLAIN) *(f32x4*)(HS + (((size_t)(su + 1) * 4 + vt) * 4 + kt) * 256 + lane * 4) = a; else { __hip_atomic_store(dst, q[0], __ATOMIC_RELAXED, __HIP_MEMORY_SCOPE_AGENT); __hip_atomic_store(dst + 1, q[1], __ATOMIC_RELAXED, __HIP_MEMORY_SCOPE_AGENT); } }
                asm volatile("s_waitcnt vmcnt(0)" ::: "memory");
#ifdef PROBE_LINK_SLEEP
                __builtin_amdgcn_s_sleep(PROBE_LINK_SLEEP);
#endif
                if (lane == 0) __hip_atomic_store(FL + ((size_t)(su + 1) * 4 + vt) * 4, 1u, __ATOMIC_RELAXED, __HIP_MEMORY_SCOPE_AGENT);
            }
        } else {
#pragma unroll
            for (int kt = 0; kt < 4; ++kt) W[kt] = Sc[kt];
            rwkv_recur<true>(W, true, 16 * wave + fr, lds, fr, fq);
        }
        __syncthreads();

#endif
    }
    if (MODE == 0) {
        const int f = wave, kot = f >> 1, s = f & 1; const LAS bf16* gp = GT + (16 * kot + fr) * 72 + 32 * s + 4 * fq;
        const v2u lo = *(const LAS v2u*)gp, hi = *(const LAS v2u*)(gp + 16); v4u o; o.x = lo.x; o.y = lo.y; o.z = hi.x; o.w = hi.y;
        *(v4u*)(GF + ((size_t)su * 8 + f) * 512 + lane * 8) = o;
    } else if (MODE == 1) { rwkv_post(u, Y, lds, tid); }
    if (MODE != 2) __syncthreads();
}
constexpr int RS_SLOT = 12288;
__device__ __forceinline__ void rwkv_scan_issue(const bf16* GF, const float* HS, size_t unit, int vt, LAS unsigned char* slot, int lane) {
#pragma unroll
    for (int f = 0; f < 8; ++f) __builtin_amdgcn_global_load_lds((const unsigned*)(GF + (unit * 8 + f) * 512 + lane * 8), (LAS unsigned*)(slot + f * 1024), 16, 0, 0);
#pragma unroll
    for (int kt = 0; kt < 4; ++kt) __builtin_amdgcn_global_load_lds((const unsigned*)(HS + ((unit * 4 + vt) * 4 + kt) * 256 + lane * 4), (LAS unsigned*)(slot + 8192 + kt * 1024), 16, 0, 0);
}
__device__ __forceinline__ void rwkv_scan_phase(const bf16* GF, float* HS, LAS unsigned char* lds, int tid, int G) {
    if ((tid >> 6) != 0) return;
    const int lane = tid & 63;
    for (int job = blockIdx.x; job < 128; job += G) {
        const int bh = job >> 2, vt = job & 3; const size_t u0 = (size_t)bh * 128;
        f32x4 W[4];
#pragma unroll
        for (int kt = 0; kt < 4; ++kt) W[kt] = (f32x4){0.f, 0.f, 0.f, 0.f};
#pragma unroll
        for (int p = 0; p < 5; ++p) rwkv_scan_issue(GF, HS, u0 + p, vt, lds + p * RS_SLOT, lane);
        for (int c0 = 0; c0 < 128; c0 += 8) {
#pragma unroll
            for (int j = 0; j < 8; ++j) {
                const int c = c0 + j;
                asm volatile("s_waitcnt vmcnt(48)" ::: "memory");
                LAS unsigned char* slot = lds + j * RS_SLOT;
                bf16x8 gc[8]; f32x4 hc[4];
#pragma unroll
                for (int f = 0; f < 8; ++f) gc[f] = *(const LAS bf16x8*)(slot + f * 1024 + lane * 16);
#pragma unroll
                for (int kt = 0; kt < 4; ++kt) hc[kt] = *(const LAS f32x4*)(slot + 8192 + kt * 1024 + lane * 16);
                { const int cn = c + 5 < 128 ? c + 5 : 127;
                  rwkv_scan_issue(GF, HS, u0 + cn, vt, lds + ((j + 5) & 7) * RS_SLOT, lane); }
                if (c >= 122) asm volatile("s_waitcnt vmcnt(0)" ::: "memory");
                const size_t uu = u0 + c;
#pragma unroll
                for (int kt = 0; kt < 4; ++kt) *(f32x4*)(HS + ((uu * 4 + vt) * 4 + kt) * 256 + lane * 4) = W[kt];
                f32x4 Wl[4];
#pragma unroll
                for (int kt = 0; kt < 4; ++kt)
#pragma unroll
                    for (int r = 0; r < 4; ++r) { const float hi = __builtin_bit_cast(float, f2bf(W[kt][r]) << 16); Wl[kt][r] = W[kt][r] - hi; }
                const bf16x8 wh0 = frag8(W[0], W[1]), wh1 = frag8(W[2], W[3]), wl0 = frag8(Wl[0], Wl[1]), wl1 = frag8(Wl[2], Wl[3]);
#pragma unroll
                for (int kt = 0; kt < 4; ++kt) { f32x4 a = hc[kt]; a = mfma16(gc[2 * kt], wh0, a); a = mfma16(gc[2 * kt + 1], wh1, a); a = mfma16(gc[2 * kt], wl0, a); a = mfma16(gc[2 * kt + 1], wl1, a); W[kt] = a; }
            }
        }
        asm volatile("s_waitcnt vmcnt(0)" ::: "memory");
    }
}
struct Args { const float* in[33]; float* out; unsigned char* ws; int ph_lo, ph_hi; };
__global__ void __launch_bounds__(NWAVES * 64, 2) trunk_fwd(Args args) {
    extern __shared__ __attribute__((aligned(16))) unsigned char lds_raw[];
    LAS unsigned char* lds = (LAS unsigned char*)lds_raw;
    const int tid = threadIdx.x, G = gridDim.x;
    unsigned char* ws = args.ws;
    gu32* ctl = (gu32*)(ws + WS_CTL);
    for (int u = tid; u < (LDS_BYTES - LDSCTL_OFF) / 4; u += NWAVES * 64) ((LAS unsigned*)(lds + LDSCTL_OFF))[u] = 0u;
    __syncthreads();
    XcdBarrier bar; bar.bar = (unsigned*)(ctl + CW_BAR); bar.x = 0; bar.st = nullptr;
    if (!MK_PER_PHASE) bar = xcd_barrier_post((unsigned*)(ctl + CW_BAR), (volatile LAS unsigned*)(lds + LDSCTL_OFF + 32));
    const int lo = args.ph_lo, hi = args.ph_hi;
#ifdef SLEEP_US
    { const unsigned long long t0 = __builtin_amdgcn_s_memrealtime(); while (__builtin_amdgcn_s_memrealtime() - t0 < (unsigned long long)SLEEP_US * 100ull) __builtin_amdgcn_s_sleep(64); }
#endif
#ifndef RG
#define RG 0
#endif
#ifndef RATT
#define RATT 1
#endif
#ifndef RMLL
#define RMLL 1
#endif
#ifndef RMLO
#define RMLO 1
#endif
#ifndef RSSL
#define RSSL 1
#endif
#ifndef RSSO
#define RSSO 1
#endif
#ifndef RRWA
#define RRWA 1
#endif
#ifndef RRWB
#define RRWB 1
#endif
#ifndef RNORM
#define RNORM 1
#endif
#ifndef CH_REP
#define CH_REP 0
#endif
#ifndef CHAIN_ON
#define CHAIN_ON 1
#endif
#ifndef STAGGER
#define STAGGER 0
#endif
#ifndef NO_SSD
#define NO_SSD 0
#endif
#ifndef NO_RWKV
#define NO_RWKV 0
#endif
#ifndef FUSE_N9X
#define FUSE_N9X 1
#endif
#ifndef FUSE_FINAL
#define FUSE_FINAL 1
#endif
#ifndef CONV_FIRST
#define CONV_FIRST 1
#endif
#ifndef PHMASK
#define PHMASK 0x7ffffu
#endif
#define IN(k) ((((PHMASK) >> (k)) & 1u) && lo <= (k) && (k) < hi)
#define SEAM(k) do { if (IN(k) && IN((k) + 1)) xcd_barrier(bar); } while (0)
    const float* x = args.in[0]; float* hres = args.out; bf16* hb = (bf16*)args.out + (size_t)M * D;
    bf16* hb2 = (bf16*)(ws + WS_Y);
    bf16* hbx = (bf16*)(ws + WS_XN);
    const bool fuse9 = FUSE_N9X && FUSE_N9 && FUSE_MLPNORM && (G == 256) && !MK_PER_PHASE && lo <= 7 && hi >= 11;
    unsigned* XA = (unsigned*)(ws + WS_Y);
    const bool fuse_final = FUSE_FINAL && FUSE_MLPNORM && (G == 256) && !MK_PER_PHASE && lo <= 14 && hi >= 19;
    bf16* XN = (bf16*)(ws + WS_XN); bf16* P = (bf16*)(ws + WS_R1); bf16* HB = (bf16*)(ws + WS_R1); bf16* Y = (bf16*)(ws + WS_Y);
    float* G0 = (float*)(ws + WS_G0); float* DT = (float*)(ws + WS_DT);
    float* MLS = (float*)(ws + WS_MLS); float* MPREV = MLS + 4096; float* NL = MLS + 8192;
    float* CT = (float*)(ws + WS_XN); float* ST = (float*)(ws + WS_XN); float* DEC = (float*)(ws + WS_DEC);
    bf16* GF = (bf16*)(ws + WS_GF); float* HS = (float*)(ws + WS_HS); bf16* LX = (bf16*)(ws + WS_LX); float* SSP = (float*)(ws + WS_SSP); float* RS = (float*)(ws + WS_RS);
    const float2* rope = (const float2*)(ws + WS_ROPE); const bf16* lora = (const bf16*)(ws + WS_LORA);

    if (IN(0)) { p0_prologue(args.in, ws, lds, tid, G); __syncthreads();
        for (int rep_ = 0; rep_ < RNORM; ++rep_) norm_x_gates_phase(x, args.in[1], XN, args.in[5] + 2304, 2312, G0, lds, tid, G); }
    SEAM(0);
    if (IN(1)) { pg8::Gemm g{XN, (const bf16*)(ws + WS_WINE), M, NE, D}; pg8::StaticOrder S; S.init(M, NE, G, (int)blockIdx.x); pg8::EpiBf16<0> E{P, NE};
        const int nfull = ((M / 256) * (NE / 256)) % G;
        if (DEFER_MLPW && CONV_FIRST && nfull != 0 && (int)blockIdx.x >= nfull) { mlp_weights_convert(args.in, ws, 0, lds, tid, nfull, G - nfull); __syncthreads(); }
        pg8::gemm_phase<pg8::EpiBf16<0>, pg8::StaticOrder, PG8_ALIGN, PG8_SP2>(lds, g, S, E);
        if (DEFER_MLPW) { if (nfull == 0) mlp_weights_convert(args.in, ws, 0, lds, tid, 0, G); else if (!CONV_FIRST && (int)blockIdx.x >= nfull) mlp_weights_convert(args.in, ws, 0, lds, tid, nfull, G - nfull); } }
    SEAM(1);
    if (IN(2)) { for (int rep_ = 0; rep_ < RATT; ++rep_) for (int u = blockIdx.x; u < 512; u += G) attn_unit(u, P, rope, args.in[7], Y, lds, tid);
        for (int rep_ = 0; rep_ < RMLL; ++rep_) for (int u = blockIdx.x; u < 1024; u += G) mlstm_local_unit(u, P, G0, args.in[8], args.in[9], args.in[10], args.in[11], CT, NL, MLS, lds, tid); }
    SEAM(2);
    if (IN(3)) mlstm_scan_phase(CT, NL, MLS, MPREV, lds, tid, G);
    SEAM(3);
    if (IN(4)) { for (int rep_ = 0; rep_ < RMLO; ++rep_) for (int u = blockIdx.x; u < 1024; u += G) mlstm_out_unit(u, P, G0, args.in[8], args.in[9], args.in[10], args.in[11], args.in[12], CT, NL, MPREV, Y, lds, tid); }
    SEAM(4);
    if (IN(5)) { pg8::Gemm g{Y, (const bf16*)(ws + WS_WOUTE), M, D, D}; pg8::StaticOrder S; S.init(M, D, G, (int)blockIdx.x);
        if (FUSE_MLPNORM) { pg8::EpiBf16ResSS<true> E{x, hb, D, SSP}; pg8::gemm_phase<pg8::EpiBf16ResSS<true>, pg8::StaticOrder, PG8_ALIGN, PG8_SP2>(lds, g, S, E); }
        else { pg8::EpiBf16Res<true> E{x, hb, D}; pg8::gemm_phase<pg8::EpiBf16Res<true>, pg8::StaticOrder, PG8_ALIGN, PG8_SP2>(lds, g, S, E); } }
    SEAM(5);
    if (!FUSE_MLPNORM) { if (IN(6)) for (int rep_ = 0; rep_ < RNORM; ++rep_) norm_phase_b<0>(hb, args.in[2], XN, nullptr, nullptr, 0, nullptr, lds, tid, G);
    SEAM(6); }
    if (IN(7)) { if (fuse9) { for (int i = blockIdx.x * 512 + tid; i < M * 36 / 4; i += G * 512) ((v4u*)XA)[i] = (v4u){0u, 0u, 0u, 0u}; }
        if (STAGGER) { const unsigned long long t0 = __builtin_amdgcn_s_memrealtime(); const unsigned long long dl = (unsigned long long)((blockIdx.x >> 3) & 7) * STAGGER; while (__builtin_amdgcn_s_memrealtime() - t0 < dl) __builtin_amdgcn_s_sleep(8); }
        pg8::Gemm g{FUSE_MLPNORM ? hb : XN, (const bf16*)(ws + WS_WUP0), M, FF, D}; pg8::StaticOrder S; S.init(M, FF, G, (int)blockIdx.x); pg8::EpiBf16<2> E{HB, FF};
        pg8::gemm_phase<pg8::EpiBf16<2>, pg8::StaticOrder, PG8_ALIGN, PG8_SP2>(lds, g, S, E);
        if (RG & 2) pg8::gemm_phase<pg8::EpiBf16<2>, pg8::StaticOrder, PG8_ALIGN, PG8_SP2>(lds, g, S, E); }
    SEAM(7);
    if (IN(8)) { pg8::Gemm g{HB, (const bf16*)(ws + WS_WDN0), M, D, FF}; pg8::StaticOrder S; S.init(M, D, G, (int)blockIdx.x);
        if (fuse9) { pg8::EpiBf16ResScaleDT E{hb, hb, D, SSP, 1e-5f, (const float*)(ws + WS_GWT), XA, (unsigned*)ctl + CW_BAR + XB_TMO, (PG8_LAS float*)(lds + pg8::STAGE_BYTES), RS, DT, 1e-5f};
            pg8::gemm_phase<pg8::EpiBf16ResScaleDT, pg8::StaticOrder, PG8_ALIGN, PG8_SP2>(lds, g, S, E); }
        else if (FUSE_MLPNORM) { pg8::EpiBf16ResScale E{hb, hb, D, SSP, 1e-5f}; pg8::gemm_phase<pg8::EpiBf16ResScale, pg8::StaticOrder, PG8_ALIGN, PG8_SP2>(lds, g, S, E); }
        else { pg8::EpiBf16Res<false> E{hb, hb, D}; pg8::gemm_phase<pg8::EpiBf16Res<false>, pg8::StaticOrder, PG8_ALIGN, PG8_SP2>(lds, g, S, E); } }
    SEAM(8);
#ifdef EXTRA_BARS
    if (IN(8) && IN(9)) for (int eb = 0; eb < EXTRA_BARS; ++eb) xcd_barrier(bar);
#endif
    if (IN(9) && !fuse9) for (int rep_ = 0; rep_ < RNORM; ++rep_) { if (FUSE_N9) norm_rs_dt_phase(hb, args.in[1] + D, RS, args.in[13] + 1536, 3336, DT, lds, tid, G); else norm_phase_b<1>(hb, args.in[1] + D, XN, nullptr, args.in[13] + 1536, 3336, DT, lds, tid, G); }
    if (!fuse9) { SEAM(9); }
    if (IN(10)) { pg8::Gemm g{FUSE_N9 ? hb : XN, (const bf16*)(ws + WS_WINO), M, NO, D}; pg8::StaticOrder S; S.init(M, NO, G, (int)blockIdx.x);
        const int nfull = ((M / 256) * (NO / 256)) % G;
        if (DEFER_MLPW && CONV_FIRST && nfull != 0 && (int)blockIdx.x >= nfull) { mlp_weights_convert(args.in, ws, 1, lds, tid, nfull, G - nfull); __syncthreads(); }
        if (FUSE_N9) { pg8::EpiBf16RS E{P, NO, RS}; pg8::gemm_phase<pg8::EpiBf16RS, pg8::StaticOrder, PG8_ALIGN, PG8_SP2>(lds, g, S, E); }
        else { pg8::EpiBf16<0> E{P, NO}; pg8::gemm_phase<pg8::EpiBf16<0>, pg8::StaticOrder, PG8_ALIGN, PG8_SP2>(lds, g, S, E); }
        if (DEFER_MLPW) { if (nfull == 0) mlp_weights_convert(args.in, ws, 1, lds, tid, 0, G); else if (!CONV_FIRST && (int)blockIdx.x >= nfull) mlp_weights_convert(args.in, ws, 1, lds, tid, nfull, G - nfull); } }
    SEAM(10);
    int cur_h = -1;
    if (IN(11)) { rwkv_lx_phase(P, args.in[21], LX, tid, G);
        if (!NO_SSD) for (int rep_ = 0; rep_ < RSSL; ++rep_) for (int u = blockIdx.x; u < 512; u += G) ssd_local_unit(u, P, DT, args.in[15], args.in[16], args.in[17], args.in[18], ST, DEC, lds, tid); }
    if (IN(11) && IN(12)) xcd_barrier(bar);
    const bool chain = (G == 256) && !MK_PER_PHASE && CHAIN_ON;
    if (IN(11)) {
        if (chain) { const int xq = blockIdx.x & 7, mq = blockIdx.x >> 3;
            if (mq < 24) { const int sq = xq * 4 + mq / 6, jj = mq % 6; v4u rraw[5]; float rmm[8], rkk[8]; rwkv_consts_load(sq & 7, args.in, tid, rmm, rkk);
                const int ubase = ((sq >> 3) << 10) | (sq & 7); rwkv_rows_load(ubase | (jj << 3), P, tid, rraw); bf16x8 lxa[8]; rwkv_lx_load(ubase | (jj << 3), LX, tid, lxa);
                int c = jj; for (; c < 128; c += 6) { const int u = ubase | (c << 3); rwkv_chunk_unit<2>(u, (c + 6 < 128) ? (ubase | ((c + 6) << 3)) : -1, (c >= 6) ? (ubase | ((c - 6) << 3)) : -1, cur_h, rraw, lxa, rmm, rkk, P, LX, args.in, lora, GF, HS, Y, ctl, lds, tid); }
                rwkv_post(ubase | ((c - 6) << 3), Y, lds, tid); __syncthreads(); }
            else { const int pr = xq, k8 = mq - 24;
                ssd_scan_pair(ST, DEC, pr, k8, tid);
                asm volatile("s_waitcnt vmcnt(0)" ::: "memory"); __syncthreads();
                if (tid == 0) { unsigned* cnt = (unsigned*)ctl + 90112 + pr * 64; unsigned* tmo = (unsigned*)ctl + CW_BAR + XB_TMO;
                    __builtin_amdgcn_fence(__ATOMIC_RELEASE, "agent"); asm volatile("s_waitcnt vmcnt(0)" ::: "memory");
                    __hip_atomic_fetch_add(cnt, 1u, __ATOMIC_RELAXED, __HIP_MEMORY_SCOPE_AGENT);
                    unsigned spins = 0;
                    while (__hip_atomic_load(cnt, __ATOMIC_RELAXED, __HIP_MEMORY_SCOPE_AGENT) < 8u) { __builtin_amdgcn_s_sleep(4);
                        if ((++spins & 1023u) == 0u) { if (spins > (1u << 19) || __hip_atomic_load(tmo, __ATOMIC_RELAXED, __HIP_MEMORY_SCOPE_AGENT) != 0u) { __hip_atomic_store(tmo, 1u, __ATOMIC_RELAXED, __HIP_MEMORY_SCOPE_AGENT); break; } } }
                    __builtin_amdgcn_fence(__ATOMIC_ACQUIRE, "agent"); asm volatile("s_waitcnt vmcnt(0)" ::: "memory"); }
                __syncthreads();
                for (int c = k8; c < 64; c += 8) ssd_out_unit(pr * 64 + c, P, DT, args.in[15], args.in[16], args.in[17], args.in[18], args.in[19], args.in[20], ST, Y, lds, tid); } }
        else { ssd_scan_phase(ST, DEC, tid, G);
            if (!NO_RWKV) for (int rep_ = 0; rep_ < RRWA; ++rep_) { v4u rraw[5]; float rmm[8], rkk[8]; rwkv_consts_load(blockIdx.x & 7, args.in, tid, rmm, rkk); bf16x8 lxa[8]; if ((int)blockIdx.x < 4096) { rwkv_rows_load(blockIdx.x, P, tid, rraw); rwkv_lx_load(blockIdx.x, LX, tid, lxa); }
                for (int u = blockIdx.x; u < 4096; u += G) { if ((G & 7) != 0) rwkv_consts_load(u & 7, args.in, tid, rmm, rkk); rwkv_chunk_unit<0>(u, (u + G < 4096) ? u + G : -1, -1, cur_h, rraw, lxa, rmm, rkk, P, LX, args.in, lora, GF, HS, Y, ctl, lds, tid); } } } }
    if (!chain) { SEAM(11); }
    if (IN(12) && !chain) { const int nscan = (G >= 256) ? 128 : 0;
        if ((int)blockIdx.x < nscan || nscan == 0) { rwkv_scan_phase(GF, HS, lds, tid, nscan ? nscan : G); __syncthreads(); }
        if (!NO_SSD) for (int rep_ = 0; rep_ < RSSO; ++rep_) {
            if (nscan <= 0) { for (int u = blockIdx.x; u < 512; u += G) ssd_out_unit(u, P, DT, args.in[15], args.in[16], args.in[17], args.in[18], args.in[19], args.in[20], ST, Y, lds, tid); }
            else if ((int)blockIdx.x >= nscan) { for (int u = blockIdx.x - nscan; u < 384; u += G - nscan) ssd_out_unit(u, P, DT, args.in[15], args.in[16], args.in[17], args.in[18], args.in[19], args.in[20], ST, Y, lds, tid); }
            else { for (int u = 384 + blockIdx.x; u < 512; u += nscan) ssd_out_unit(u, P, DT, args.in[15], args.in[16], args.in[17], args.in[18], args.in[19], args.in[20], ST, Y, lds, tid); } } }
    if (!chain) { SEAM(12); }
    cur_h = -1;
    if (IN(13) && !chain) { if (!NO_RWKV) for (int rep_ = 0; rep_ < RRWB; ++rep_) { v4u rraw[5]; float rmm[8], rkk[8]; rwkv_consts_load(blockIdx.x & 7, args.in, tid, rmm, rkk); bf16x8 lxa[8]; if ((int)blockIdx.x < 4096) { rwkv_rows_load(blockIdx.x, P, tid, rraw); rwkv_lx_load(blockIdx.x, LX, tid, lxa); }
            for (int u = blockIdx.x; u < 4096; u += G) { if ((G & 7) != 0) rwkv_consts_load(u & 7, args.in, tid, rmm, rkk); rwkv_chunk_unit<1>(u, (u + G < 4096) ? u + G : -1, -1, cur_h, rraw, lxa, rmm, rkk, P, LX, args.in, lora, GF, HS, Y, ctl, lds, tid); } } }
    SEAM(13);
    if (IN(14)) { pg8::Gemm g{Y, (const bf16*)(ws + WS_WOUTO), M, D, D}; pg8::StaticOrder S; S.init(M, D, G, (int)blockIdx.x);
        if (FUSE_MLPNORM) { pg8::EpiBf16ResSS<false> E{hb, fuse_final ? hbx : hb, D, SSP}; pg8::gemm_phase<pg8::EpiBf16ResSS<false>, pg8::StaticOrder, PG8_ALIGN, PG8_SP2>(lds, g, S, E); }
        else { pg8::EpiBf16Res<false> E{hb, hb, D}; pg8::gemm_phase<pg8::EpiBf16Res<false>, pg8::StaticOrder, PG8_ALIGN, PG8_SP2>(lds, g, S, E); } }
    SEAM(14);
    if (!FUSE_MLPNORM) { if (IN(15)) for (int rep_ = 0; rep_ < RNORM; ++rep_) norm_phase_b<0>(hb, args.in[2] + D, XN, nullptr, nullptr, 0, nullptr, lds, tid, G);
    SEAM(15); }
    if (IN(16)) { if (STAGGER) { const unsigned long long t0 = __builtin_amdgcn_s_memrealtime(); const unsigned long long dl = (unsigned long long)((blockIdx.x >> 3) & 7) * STAGGER; while (__builtin_amdgcn_s_memrealtime() - t0 < dl) __builtin_amdgcn_s_sleep(8); }
        pg8::Gemm g{FUSE_MLPNORM ? (fuse_final ? hbx : hb) : XN, (const bf16*)(ws + WS_WUP1), M, FF, D}; pg8::StaticOrder S; S.init(M, FF, G, (int)blockIdx.x); pg8::EpiBf16<2> E{HB, FF};
        pg8::gemm_phase<pg8::EpiBf16<2>, pg8::StaticOrder, PG8_ALIGN, PG8_SP2>(lds, g, S, E); }
    SEAM(16);
    if (IN(17)) { pg8::Gemm g{HB, (const bf16*)(ws + WS_WDN1), M, D, FF}; pg8::StaticOrder S; S.init(M, D, G, (int)blockIdx.x);
        if (fuse_final) { pg8::EpiFinalNorm E{hbx, hres, D, SSP, 1e-5f, args.in[32], (unsigned*)(ws + WS_XS), (unsigned*)ctl + CW_BAR + XB_TMO, (PG8_LAS float*)(lds + pg8::STAGE_BYTES)};
            pg8::gemm_phase<pg8::EpiFinalNorm, pg8::StaticOrder, PG8_ALIGN, PG8_SP2>(lds, g, S, E); }
        else if (FUSE_MLPNORM) { pg8::EpiBf16ResScale E{hb, hb2, D, SSP, 1e-5f}; pg8::gemm_phase<pg8::EpiBf16ResScale, pg8::StaticOrder, PG8_ALIGN, PG8_SP2>(lds, g, S, E); }
        else { pg8::EpiBf16Res<false> E{hb, hb2, D}; pg8::gemm_phase<pg8::EpiBf16Res<false>, pg8::StaticOrder, PG8_ALIGN, PG8_SP2>(lds, g, S, E); } }
    if (!fuse_final) { SEAM(17);
    if (IN(18)) norm_phase_b<2>(hb2, args.in[32], nullptr, hres, nullptr, 0, nullptr, lds, tid, G); }
#undef IN
#undef SEAM
}
extern "C" void kernel_launch(void* const* d_in, const int* in_sizes, int n_in, void* d_out, int out_size, void* d_ws, size_t ws_size, hipStream_t stream) {
    static int grid = 0;
    if (grid == 0) {
        if (n_in != 33 || in_sizes[0] != M * D || out_size != M * D || ws_size < WS_END) { fprintf(stderr, "kernel_launch: unexpected shapes (n_in %d, in0 %d, out %d, ws %zu < %zu); nothing launched\n", n_in, n_in > 0 ? in_sizes[0] : -1, out_size, ws_size, (size_t)WS_END); grid = -1; return; }
        int dev = 0, cus = 0, per_cu = 0;
        if (hipGetDevice(&dev) != hipSuccess || hipDeviceGetAttribute(&cus, hipDeviceAttributeMultiprocessorCount, dev) != hipSuccess) { grid = -1; return; }
        if (hipFuncSetAttribute((const void*)trunk_fwd, hipFuncAttributeMaxDynamicSharedMemorySize, LDS_BYTES) != hipSuccess) { fprintf(stderr, "kernel_launch: hipFuncSetAttribute failed\n"); grid = -1; return; }
        if (hipOccupancyMaxActiveBlocksPerMultiprocessor(&per_cu, (const void*)trunk_fwd, NWAVES * 64, LDS_BYTES) != hipSuccess || per_cu < 1) { fprintf(stderr, "kernel_launch: occupancy query reports %d workgroups per CU\n", per_cu); }
        (void)hipGetLastError();
        grid = cus;
    }
    if (grid < 0) return;
    if (hipMemsetAsync((char*)d_ws + WS_CTL, 0, CTL_ZERO_BYTES, stream) != hipSuccess) return;
    Args a{};
    for (int i = 0; i < 33; ++i) a.in[i] = (const float*)d_in[i];
    a.out = (float*)d_out; a.ws = (unsigned char*)d_ws;
#if MK_PER_PHASE
    for (int p = 0; p < N_PHASES; ++p) { a.ph_lo = p; a.ph_hi = p + 1; hipLaunchKernelGGL(trunk_fwd, dim3(grid), dim3(NWAVES * 64), LDS_BYTES, stream, a); }
#else
    a.ph_lo = 0; a.ph_hi = N_PHASES; hipLaunchKernelGGL(trunk_fwd, dim3(grid), dim3(NWAVES * 64), LDS_BYTES, stream, a);
#endif
}
```

```cpp
#include <hip/hip_runtime.h>
#include <cstdio>
#include <cstdint>
namespace pg8 {
#define PG8_LAS __attribute__((address_space(3)))
typedef unsigned short bf16_t;
typedef short bf16x8 __attribute__((ext_vector_type(8)));
typedef float f32x4 __attribute__((ext_vector_type(4)));
typedef unsigned u32x4 __attribute__((ext_vector_type(4)));
constexpr int BM = 256, BK = 64, HALF = 128, HTB = HALF * BK * 2  , STAGE_BYTES = 8 * HTB, NXCD = 8, WGM = 8;

__host__ __device__ __forceinline__ int lds_byte(int r, int c) { const int st = (r >> 4) * 2 + (c >> 5), rr = r & 15, cc = c & 31, ob = rr * 64 + cc * 2; return st * 1024 + (ob ^ (((ob >> 9) & 1) << 5)); }
__host__ __device__ __forceinline__ void stage_rc(int b, int& R, int& C) { const int st = b / 1024, sb = b % 1024, swz = sb ^ (((sb >> 9) & 1) << 5); R = (st >> 1) * 16 + swz / 64; C = (st & 1) * 32 + (swz % 64) / 2; }
__host__ __device__ __forceinline__ int perm32(int rho) { const int n = rho >> 4, i = rho & 15; return 8 * (i >> 2) + 4 * n + (i & 3); }

struct Unit { int pm, pn; };
struct Gemm { const bf16_t* A; const bf16_t* Bt; int M, N, K; };

struct StaticOrder {
    int nM, nN, nwg, G, c;
    __host__ __device__ void init(int M, int N, int G_, int c_) { nM = M / BM; nN = N / BM; nwg = nM * nN; G = G_; c = c_; }
    __host__ __device__ bool next(int i, Unit& u) const {
        const long L = (long)i * G + c; if (L >= nwg) return false;
        int wgid = (int)L; { const int q = nwg / NXCD, r = nwg % NXCD, xcd = wgid % NXCD, off = wgid / NXCD; wgid = (xcd < r ? xcd * (q + 1) : r * (q + 1) + (xcd - r) * q) + off; }
        const int nig = WGM * nN, gid = wgid / nig, fm = gid * WGM, gsz = (nM - fm) < WGM ? (nM - fm) : WGM;
        u.pm = fm + ((wgid % nig) % gsz); u.pn = (wgid % nig) / gsz; return true;
    }
    __device__ __forceinline__ void a_ready(const Unit&) const {}
    __device__ __forceinline__ void done(const Unit&) const {}
};

#ifndef EPI_NT
#define EPI_NT 0
#endif
__device__ __forceinline__ unsigned cvt_pk_bf16(float lo, float hi) { unsigned r; asm volatile("v_cvt_pk_bf16_f32 %0, %1, %2" : "=v"(r) : "v"(lo), "v"(hi)); return r; }
#ifndef K_TWICE
#define K_TWICE 0
#endif
#ifndef EPI_TWICE
#define EPI_TWICE 0
#endif
template <int ACT> struct EpiBf16 {
    static constexpr bool PERM = true, AFTER_DRAIN = false, PROBE_TWICE = (EPI_TWICE != 0), PROBE_KTWICE = (K_TWICE != 0);
    bf16_t* O; int ldc;
    __device__ __forceinline__ void operator()(const f32x4 (&acc)[2][2][4][2], const Unit& u, int wr, int wc, int fr, int fq) const {
        const int row0 = u.pm * BM + wr * 64 + fr; const int col0 = u.pn * BM + wc * 32 + 8 * fq;
#pragma unroll
        for (int ai = 0; ai < 2; ++ai)
#pragma unroll
            for (int m = 0; m < 4; ++m) { bf16_t* rowp = O + (size_t)(row0 + ai * HALF + m * 16) * ldc + col0;
#pragma unroll
                for (int bj = 0; bj < 2; ++bj) { f32x4 v0 = acc[ai][bj][m][0], v1 = acc[ai][bj][m][1];
                    if (ACT == 2) {
#pragma unroll
                        for (int j = 0; j < 4; ++j) { v0[j] = __builtin_amdgcn_fmed3f(v0[j], 0.f, 3.0e38f); v1[j] = __builtin_amdgcn_fmed3f(v1[j], 0.f, 3.0e38f); }
                        v0 = v0 * v0; v1 = v1 * v1; }
                    u32x4 w; w.x = cvt_pk_bf16(v0[0], v0[1]); w.y = cvt_pk_bf16(v0[2], v0[3]); w.z = cvt_pk_bf16(v1[0], v1[1]); w.w = cvt_pk_bf16(v1[2], v1[3]);
                    if (EPI_NT) __builtin_nontemporal_store(w, (u32x4*)(rowp + bj * HALF)); else *(u32x4*)(rowp + bj * HALF) = w; } }
    }
};
struct EpiBf16RS {
    static constexpr bool PERM = true, AFTER_DRAIN = false, PROBE_TWICE = false, PROBE_KTWICE = false;
    bf16_t* O; int ldc; const float* rs;
    __device__ __forceinline__ void operator()(const f32x4 (&acc)[2][2][4][2], const Unit& u, int wr, int wc, int fr, int fq) const {
        const int row0 = u.pm * BM + wr * 64 + fr; const int col0 = u.pn * BM + wc * 32 + 8 * fq;
        float rv[2][4];
#pragma unroll
        for (int ai = 0; ai < 2; ++ai)
#pragma unroll
            for (int m = 0; m < 4; ++m) rv[ai][m] = rs[row0 + ai * HALF + m * 16];
#pragma unroll
        for (int ai = 0; ai < 2; ++ai)
#pragma unroll
            for (int m = 0; m < 4; ++m) { bf16_t* rowp = O + (size_t)(row0 + ai * HALF + m * 16) * ldc + col0; const float r = rv[ai][m];
#pragma unroll
                for (int bj = 0; bj < 2; ++bj) { const f32x4 v0 = acc[ai][bj][m][0] * r, v1 = acc[ai][bj][m][1] * r;
                    u32x4 w; w.x = cvt_pk_bf16(v0[0], v0[1]); w.y = cvt_pk_bf16(v0[2], v0[3]); w.z = cvt_pk_bf16(v1[0], v1[1]); w.w = cvt_pk_bf16(v1[2], v1[3]);
                    *(u32x4*)(rowp + bj * HALF) = w; } }
    }
};
struct EpiFinalNorm {
    static constexpr bool PERM = true, AFTER_DRAIN = false, PROBE_TWICE = false, PROBE_KTWICE = false;
    const bf16_t* base; float* out; int ldc; const float* ssp; float eps; const float* gain; unsigned* xs; unsigned* tmo; PG8_LAS float* rsf;
    __device__ __forceinline__ void operator()(f32x4 (&acc)[2][2][4][2], const Unit& u, int wr, int wc, int fr, int fq) const {
        const int row0 = u.pm * BM + wr * 64 + fr, col0 = u.pn * BM + wc * 32 + 8 * fq;
        const int tid = (wr * 4 + wc) * 64 + fq * 16 + fr, gr = tid >> 1, gh = tid & 1;
        u32x4 bw[4][2];
#pragma unroll
        for (int m = 0; m < 4; ++m)
#pragma unroll
            for (int bj = 0; bj < 2; ++bj) bw[m][bj] = *(const u32x4*)(base + (size_t)(row0 + m * 16) * ldc + col0 + bj * HALF);
        { const float* sp = ssp + (size_t)(u.pm * BM + gr) * 16 + 8 * gh; const f32x4 t0 = *(const f32x4*)sp, t1 = *(const f32x4*)(sp + 4);
          float t = ((t0[0] + t0[1]) + (t0[2] + t0[3])) + ((t1[0] + t1[1]) + (t1[2] + t1[3])); t += __shfl_xor(t, 1);
          if (gh == 0) rsf[256 + gr] = 1.0f / (t * (1.0f / 1024.0f) + eps); }
        __syncthreads();
        float rs2v[2][4];
#pragma unroll
        for (int ai = 0; ai < 2; ++ai)
#pragma unroll
            for (int m = 0; m < 4; ++m) rs2v[ai][m] = rsf[256 + ai * HALF + wr * 64 + m * 16 + fr];
#pragma unroll
        for (int ai = 0; ai < 2; ++ai) {
            if (ai == 1) {
#pragma unroll
                for (int m = 0; m < 4; ++m)
#pragma unroll
                    for (int bj = 0; bj < 2; ++bj) bw[m][bj] = *(const u32x4*)(base + (size_t)(row0 + HALF + m * 16) * ldc + col0 + bj * HALF); }
#pragma unroll
            for (int m = 0; m < 4; ++m) { const int row = row0 + ai * HALF + m * 16; const float rs2 = rs2v[ai][m]; float ss = 0.f;
#pragma unroll
                for (int bj = 0; bj < 2; ++bj) { const u32x4 w = bw[m][bj];
                    const f32x4 b0 = (f32x4){__builtin_bit_cast(float, w.x << 16), __builtin_bit_cast(float, w.x & 0xffff0000u), __builtin_bit_cast(float, w.y << 16), __builtin_bit_cast(float, w.y & 0xffff0000u)};
                    const f32x4 b1 = (f32x4){__builtin_bit_cast(float, w.z << 16), __builtin_bit_cast(float, w.z & 0xffff0000u), __builtin_bit_cast(float, w.w << 16), __builtin_bit_cast(float, w.w & 0xffff0000u)};
                    const f32x4 h0 = b0 + acc[ai][bj][m][0] * rs2, h1 = b1 + acc[ai][bj][m][1] * rs2;
                    acc[ai][bj][m][0] = h0; acc[ai][bj][m][1] = h1;
                    ss += ((h0[0] * h0[0] + h0[1] * h0[1]) + (h0[2] * h0[2] + h0[3] * h0[3])) + ((h1[0] * h1[0] + h1[1] * h1[1]) + (h1[2] * h1[2] + h1[3] * h1[3])); }
                ss += __shfl_xor(ss, 16); ss += __shfl_xor(ss, 32);
                if (fq == 0) __hip_atomic_store(xs + (size_t)row * 16 + u.pn * 4 + wc, __builtin_bit_cast(unsigned, ss) | 1u, __ATOMIC_RELAXED, __HIP_MEMORY_SCOPE_AGENT); }
#pragma unroll
            for (int bj = 0; bj < 2; ++bj)
#pragma unroll
                for (int m = 0; m < 4; ++m) asm volatile("" : "+v"(acc[ai][bj][m][0]), "+v"(acc[ai][bj][m][1]) :: "memory"); }
        { const int r = gr, h = gh;
          typedef unsigned long long u64_;
          u64_* gp = (u64_*)(xs + (size_t)(u.pm * BM + r) * 16 + 8 * h);
          u64_ q[4]; unsigned spins = 0;
          for (;;) { bool ok = true;
#pragma unroll
              for (int j = 0; j < 4; ++j) q[j] = __hip_atomic_load(gp + j, __ATOMIC_RELAXED, __HIP_MEMORY_SCOPE_AGENT);
#pragma unroll
              for (int j = 0; j < 4; ++j) ok = ok && ((unsigned)q[j] != 0u) && ((unsigned)(q[j] >> 32) != 0u);
              if (ok) break;
              __builtin_amdgcn_s_sleep(2);
              if ((++spins & 255u) == 0u) { if (spins > (1u << 17) || __hip_atomic_load(tmo, __ATOMIC_RELAXED, __HIP_MEMORY_SCOPE_AGENT) != 0u) { __hip_atomic_store(tmo, 1u, __ATOMIC_RELAXED, __HIP_MEMORY_SCOPE_AGENT); break; } } }
          float s = 0.f;
#pragma unroll
          for (int j = 0; j < 4; ++j) s += __builtin_bit_cast(float, (unsigned)q[j]) + __builtin_bit_cast(float, (unsigned)(q[j] >> 32));
          s += __shfl_xor(s, 1);
          if (h == 0) rsf[r] = 1.0f / sqrtf(s * (1.0f / 1024.0f) + eps); }
        __syncthreads();
        f32x4 gv[2][2];
#pragma unroll
        for (int bj = 0; bj < 2; ++bj) { gv[bj][0] = *(const f32x4*)(gain + col0 + bj * HALF); gv[bj][1] = *(const f32x4*)(gain + col0 + bj * HALF + 4); }
#pragma unroll
        for (int ai = 0; ai < 2; ++ai)
#pragma unroll
            for (int m = 0; m < 4; ++m) { const int rl = ai * HALF + wr * 64 + m * 16 + fr; const float rf = rsf[rl]; float* op = out + (size_t)(u.pm * BM + rl) * ldc + col0;
#pragma unroll
                for (int bj = 0; bj < 2; ++bj) { *(f32x4*)(op + bj * HALF) = acc[ai][bj][m][0] * rf * gv[bj][0]; *(f32x4*)(op + bj * HALF + 4) = acc[ai][bj][m][1] * rf * gv[bj][1]; } }
    }
};
struct EpiF32Res {
    static constexpr bool PERM = false, AFTER_DRAIN = false, PROBE_TWICE = false, PROBE_KTWICE = false;
    const float* base; float* out; int ldc;
    __device__ __forceinline__ void operator()(const f32x4 (&acc)[2][2][4][2], const Unit& u, int wr, int wc, int fr, int fq) const {
        const int row0 = u.pm * BM + wr * 64 + fr, col0 = u.pn * BM + wc * 32 + 4 * fq;
#pragma unroll
        for (int ai = 0; ai < 2; ++ai)
#pragma unroll
            for (int m = 0; m < 4; ++m) { const size_t off = (size_t)(row0 + ai * HALF + m * 16) * ldc + col0;
                f32x4 bs[2][2];
#pragma unroll
                for (int bj = 0; bj < 2; ++bj)
#pragma unroll
                    for (int n = 0; n < 2; ++n) bs[bj][n] = *(const f32x4*)(base + off + bj * HALF + n * 16);
#pragma unroll
                for (int bj = 0; bj < 2; ++bj)
#pragma unroll
                    for (int n = 0; n < 2; ++n) *(f32x4*)(out + off + bj * HALF + n * 16) = bs[bj][n] + acc[ai][bj][m][n];
                asm volatile("" ::: "memory"); }
    }
};

struct EpiF32ResNorm {
    static constexpr bool PERM = true, AFTER_DRAIN = false, PROBE_TWICE = false, PROBE_KTWICE = false;
    const float* base; float* out; int ldc; const float* gain; bf16_t* xn; float* ssp;
    __device__ __forceinline__ void operator()(const f32x4 (&acc)[2][2][4][2], const Unit& u, int wr, int wc, int fr, int fq) const {
        const int row0 = u.pm * BM + wr * 64 + fr, col0 = u.pn * BM + wc * 32 + 8 * fq;
        f32x4 gv[2][2];
#pragma unroll
        for (int bj = 0; bj < 2; ++bj)
#pragma unroll
            for (int n = 0; n < 2; ++n) gv[bj][n] = *(const f32x4*)(gain + col0 + bj * HALF + n * 4);
#pragma unroll
        for (int ai = 0; ai < 2; ++ai)
#pragma unroll
            for (int m = 0; m < 4; ++m) { const int row = row0 + ai * HALF + m * 16; const size_t off = (size_t)row * ldc + col0;
                f32x4 bs[2][2];
#pragma unroll
                for (int bj = 0; bj < 2; ++bj)
#pragma unroll
                    for (int n = 0; n < 2; ++n) bs[bj][n] = *(const f32x4*)(base + off + bj * HALF + n * 4);
                float ss = 0.f;
#pragma unroll
                for (int bj = 0; bj < 2; ++bj) { const f32x4 h0 = bs[bj][0] + acc[ai][bj][m][0], h1 = bs[bj][1] + acc[ai][bj][m][1];
                    *(f32x4*)(out + off + bj * HALF) = h0; *(f32x4*)(out + off + bj * HALF + 4) = h1;
                    ss += ((h0[0] * h0[0] + h0[1] * h0[1]) + (h0[2] * h0[2] + h0[3] * h0[3])) + ((h1[0] * h1[0] + h1[1] * h1[1]) + (h1[2] * h1[2] + h1[3] * h1[3]));
                    const f32x4 y0 = h0 * gv[bj][0], y1 = h1 * gv[bj][1];
                    u32x4 w; w.x = cvt_pk_bf16(y0[0], y0[1]); w.y = cvt_pk_bf16(y0[2], y0[3]); w.z = cvt_pk_bf16(y1[0], y1[1]); w.w = cvt_pk_bf16(y1[2], y1[3]);
                    *(u32x4*)(xn + off + bj * HALF) = w; }
                ss += __shfl_xor(ss, 16); ss += __shfl_xor(ss, 32);
                if (fq == 0) ssp[(size_t)row * 16 + u.pn * 4 + wc] = ss;
                asm volatile("" ::: "memory"); }
    }
};
struct EpiF32ResScale {
    static constexpr bool PERM = false, AFTER_DRAIN = false, PROBE_TWICE = false, PROBE_KTWICE = false;
    const float* base; float* out; int ldc; const float* ssp; float eps;
    __device__ __forceinline__ void operator()(const f32x4 (&acc)[2][2][4][2], const Unit& u, int wr, int wc, int fr, int fq) const {
        const int row0 = u.pm * BM + wr * 64 + fr, col0 = u.pn * BM + wc * 32 + 4 * fq;
        float rs2[2][4];
#pragma unroll
        for (int ai = 0; ai < 2; ++ai)
#pragma unroll
            for (int m = 0; m < 4; ++m) { const f32x4* sp = (const f32x4*)(ssp + (size_t)(row0 + ai * HALF + m * 16) * 16); const f32x4 a = sp[0], b = sp[1], c = sp[2], d = sp[3];
                const f32x4 t = (a + b) + (c + d); rs2[ai][m] = 1.0f / (((t[0] + t[1]) + (t[2] + t[3])) * (1.0f / 1024.0f) + eps); }
#pragma unroll
        for (int ai = 0; ai < 2; ++ai)
#pragma unroll
            for (int m = 0; m < 4; ++m) { const size_t off = (size_t)(row0 + ai * HALF + m * 16) * ldc + col0;
                f32x4 bs[2][2];
#pragma unroll
                for (int bj = 0; bj < 2; ++bj)
#pragma unroll
                    for (int n = 0; n < 2; ++n) bs[bj][n] = *(const f32x4*)(base + off + bj * HALF + n * 16);
#pragma unroll
                for (int bj = 0; bj < 2; ++bj)
#pragma unroll
                    for (int n = 0; n < 2; ++n) *(f32x4*)(out + off + bj * HALF + n * 16) = bs[bj][n] + acc[ai][bj][m][n] * rs2[ai][m];
                asm volatile("" ::: "memory"); }
    }
};

template <bool BASE_F32> struct EpiBf16Res {
    static constexpr bool PERM = true, AFTER_DRAIN = false, PROBE_TWICE = false, PROBE_KTWICE = false;
    const void* base; bf16_t* out; int ldc;
    __device__ __forceinline__ void operator()(const f32x4 (&acc)[2][2][4][2], const Unit& u, int wr, int wc, int fr, int fq) const {
        const int row0 = u.pm * BM + wr * 64 + fr, col0 = u.pn * BM + wc * 32 + 8 * fq;
        if (!BASE_F32) {
            u32x4 bw[2][4][2];
#pragma unroll
            for (int ai = 0; ai < 2; ++ai)
#pragma unroll
                for (int m = 0; m < 4; ++m)
#pragma unroll
                    for (int bj = 0; bj < 2; ++bj) bw[ai][m][bj] = *(const u32x4*)((const bf16_t*)base + (size_t)(row0 + ai * HALF + m * 16) * ldc + col0 + bj * HALF);
#pragma unroll
            for (int ai = 0; ai < 2; ++ai)
#pragma unroll
                for (int m = 0; m < 4; ++m) { const size_t off = (size_t)(row0 + ai * HALF + m * 16) * ldc + col0;
#pragma unroll
                    for (int bj = 0; bj < 2; ++bj) { const u32x4 w = bw[ai][m][bj];
                        const f32x4 b0 = (f32x4){__builtin_bit_cast(float, w.x << 16), __builtin_bit_cast(float, w.x & 0xffff0000u), __builtin_bit_cast(float, w.y << 16), __builtin_bit_cast(float, w.y & 0xffff0000u)};
                        const f32x4 b1 = (f32x4){__builtin_bit_cast(float, w.z << 16), __builtin_bit_cast(float, w.z & 0xffff0000u), __builtin_bit_cast(float, w.w << 16), __builtin_bit_cast(float, w.w & 0xffff0000u)};
                        const f32x4 h0 = b0 + acc[ai][bj][m][0], h1 = b1 + acc[ai][bj][m][1];
                        u32x4 o; o.x = cvt_pk_bf16(h0[0], h0[1]); o.y = cvt_pk_bf16(h0[2], h0[3]); o.z = cvt_pk_bf16(h1[0], h1[1]); o.w = cvt_pk_bf16(h1[2], h1[3]);
                        *(u32x4*)(out + off + bj * HALF) = o; } }
        } else {
#pragma unroll
            for (int ai = 0; ai < 2; ++ai) {
                f32x4 bf[4][2][2];
#pragma unroll
                for (int m = 0; m < 4; ++m)
#pragma unroll
                    for (int bj = 0; bj < 2; ++bj) { const float* bp = (const float*)base + (size_t)(row0 + ai * HALF + m * 16) * ldc + col0 + bj * HALF; bf[m][bj][0] = *(const f32x4*)bp; bf[m][bj][1] = *(const f32x4*)(bp + 4); }
#pragma unroll
                for (int m = 0; m < 4; ++m) { const size_t off = (size_t)(row0 + ai * HALF + m * 16) * ldc + col0;
#pragma unroll
                    for (int bj = 0; bj < 2; ++bj) { const f32x4 h0 = bf[m][bj][0] + acc[ai][bj][m][0], h1 = bf[m][bj][1] + acc[ai][bj][m][1];
                        u32x4 o; o.x = cvt_pk_bf16(h0[0], h0[1]); o.y = cvt_pk_bf16(h0[2], h0[3]); o.z = cvt_pk_bf16(h1[0], h1[1]); o.w = cvt_pk_bf16(h1[2], h1[3]);
                        *(u32x4*)(out + off + bj * HALF) = o; } }
                asm volatile("" ::: "memory"); }
        }
    }
};

template <bool BASE_F32> struct EpiBf16ResSS {
    static constexpr bool PERM = true, AFTER_DRAIN = false, PROBE_TWICE = false, PROBE_KTWICE = false;
    const void* base; bf16_t* out; int ldc; float* ssp;
    __device__ __forceinline__ void operator()(const f32x4 (&acc)[2][2][4][2], const Unit& u, int wr, int wc, int fr, int fq) const {
        const int row0 = u.pm * BM + wr * 64 + fr, col0 = u.pn * BM + wc * 32 + 8 * fq;
#pragma unroll
        for (int ai = 0; ai < 2; ++ai) {
            f32x4 bf[4][2][2];
            if (BASE_F32) {
#pragma unroll
                for (int m = 0; m < 4; ++m)
#pragma unroll
                    for (int bj = 0; bj < 2; ++bj) { const float* bp = (const float*)base + (size_t)(row0 + ai * HALF + m * 16) * ldc + col0 + bj * HALF; bf[m][bj][0] = *(const f32x4*)bp; bf[m][bj][1] = *(const f32x4*)(bp + 4); }
            } else {
                u32x4 bw[4][2];
#pragma unroll
                for (int m = 0; m < 4; ++m)
#pragma unroll
                    for (int bj = 0; bj < 2; ++bj) bw[m][bj] = *(const u32x4*)((const bf16_t*)base + (size_t)(row0 + ai * HALF + m * 16) * ldc + col0 + bj * HALF);
#pragma unroll
                for (int m = 0; m < 4; ++m)
#pragma unroll
                    for (int bj = 0; bj < 2; ++bj) { const u32x4 w = bw[m][bj];
                        bf[m][bj][0] = (f32x4){__builtin_bit_cast(float, w.x << 16), __builtin_bit_cast(float, w.x & 0xffff0000u), __builtin_bit_cast(float, w.y << 16), __builtin_bit_cast(float, w.y & 0xffff0000u)};
                        bf[m][bj][1] = (f32x4){__builtin_bit_cast(float, w.z << 16), __builtin_bit_cast(float, w.z & 0xffff0000u), __builtin_bit_cast(float, w.w << 16), __builtin_bit_cast(float, w.w & 0xffff0000u)}; }
            }
#pragma unroll
            for (int m = 0; m < 4; ++m) { const int row = row0 + ai * HALF + m * 16; const size_t off = (size_t)row * ldc + col0; float ss = 0.f;
#pragma unroll
                for (int bj = 0; bj < 2; ++bj) { const f32x4 h0 = bf[m][bj][0] + acc[ai][bj][m][0], h1 = bf[m][bj][1] + acc[ai][bj][m][1];
                    u32x4 o; o.x = cvt_pk_bf16(h0[0], h0[1]); o.y = cvt_pk_bf16(h0[2], h0[3]); o.z = cvt_pk_bf16(h1[0], h1[1]); o.w = cvt_pk_bf16(h1[2], h1[3]);
                    *(u32x4*)(out + off + bj * HALF) = o;
                    const f32x4 r0 = (f32x4){__builtin_bit_cast(float, o.x << 16), __builtin_bit_cast(float, o.x & 0xffff0000u), __builtin_bit_cast(float, o.y << 16), __builtin_bit_cast(float, o.y & 0xffff0000u)};
                    const f32x4 r1 = (f32x4){__builtin_bit_cast(float, o.z << 16), __builtin_bit_cast(float, o.z & 0xffff0000u), __builtin_bit_cast(float, o.w << 16), __builtin_bit_cast(float, o.w & 0xffff0000u)};
                    ss += ((r0[0] * r0[0] + r0[1] * r0[1]) + (r0[2] * r0[2] + r0[3] * r0[3])) + ((r1[0] * r1[0] + r1[1] * r1[1]) + (r1[2] * r1[2] + r1[3] * r1[3])); }
                ss += __shfl_xor(ss, 16); ss += __shfl_xor(ss, 32);
                if (fq == 0) ssp[(size_t)row * 16 + u.pn * 4 + wc] = ss; }
            asm volatile("" ::: "memory"); }
    }
};
struct EpiBf16ResScale {
    static constexpr bool PERM = true, AFTER_DRAIN = false, PROBE_TWICE = false, PROBE_KTWICE = false;
    const bf16_t* base; bf16_t* out; int ldc; const float* ssp; float eps;
    __device__ __forceinline__ void operator()(const f32x4 (&acc)[2][2][4][2], const Unit& u, int wr, int wc, int fr, int fq) const {
        const int row0 = u.pm * BM + wr * 64 + fr, col0 = u.pn * BM + wc * 32 + 8 * fq;
        float rs2v[2][4];
#pragma unroll
        for (int ai = 0; ai < 2; ++ai) { f32x4 sq[4][4];
#pragma unroll
            for (int m = 0; m < 4; ++m)
#pragma unroll
                for (int k = 0; k < 4; ++k) sq[m][k] = *(const f32x4*)(ssp + (size_t)(row0 + ai * HALF + m * 16) * 16 + 4 * k);
#pragma unroll
            for (int m = 0; m < 4; ++m) { const f32x4 t = (sq[m][0] + sq[m][1]) + (sq[m][2] + sq[m][3]); rs2v[ai][m] = 1.0f / (((t[0] + t[1]) + (t[2] + t[3])) * (1.0f / 1024.0f) + eps); }
            asm volatile("" ::: "memory"); }
#pragma unroll
        for (int ai = 0; ai < 2; ++ai) {
            u32x4 bw[4][2];
#pragma unroll
            for (int m = 0; m < 4; ++m)
#pragma unroll
                for (int bj = 0; bj < 2; ++bj) bw[m][bj] = *(const u32x4*)(base + (size_t)(row0 + ai * HALF + m * 16) * ldc + col0 + bj * HALF);
#pragma unroll
            for (int m = 0; m < 4; ++m) { const size_t off = (size_t)(row0 + ai * HALF + m * 16) * ldc + col0;
                const float rs2 = rs2v[ai][m];
#pragma unroll
                for (int bj = 0; bj < 2; ++bj) { const u32x4 w = bw[m][bj];
                    const f32x4 b0 = (f32x4){__builtin_bit_cast(float, w.x << 16), __builtin_bit_cast(float, w.x & 0xffff0000u), __builtin_bit_cast(float, w.y << 16), __builtin_bit_cast(float, w.y & 0xffff0000u)};
                    const f32x4 b1 = (f32x4){__builtin_bit_cast(float, w.z << 16), __builtin_bit_cast(float, w.z & 0xffff0000u), __builtin_bit_cast(float, w.w << 16), __builtin_bit_cast(float, w.w & 0xffff0000u)};
                    const f32x4 h0 = b0 + acc[ai][bj][m][0] * rs2, h1 = b1 + acc[ai][bj][m][1] * rs2;
                    u32x4 o; o.x = cvt_pk_bf16(h0[0], h0[1]); o.y = cvt_pk_bf16(h0[2], h0[3]); o.z = cvt_pk_bf16(h1[0], h1[1]); o.w = cvt_pk_bf16(h1[2], h1[3]);
                    *(u32x4*)(out + off + bj * HALF) = o; } }
            asm volatile("" ::: "memory"); }
    }
};
#ifndef RELAX_EPI_WAIT
#define RELAX_EPI_WAIT 0
#endif
template <class Epi, class Sched, bool ALIGN_EPI = false, bool SP2 = false>
__device__ __forceinline__ void gemm_phase(PG8_LAS unsigned char* lds, const Gemm g, const Sched& S, const Epi& E) {
    int tid_ = threadIdx.x; asm volatile("" : "+v"(tid_));
    const int tid = tid_, wid = __builtin_amdgcn_readfirstlane(tid >> 6), lane = tid & 63, wr = wid >> 2, wc = wid & 3, fr = lane & 15, fq = lane >> 4;
    const int K = g.K, nt = K / BK;
    unsigned voffA[2], voffB[2];
#pragma unroll
    for (int i = 0; i < 2; ++i) { int R, C; stage_rc(tid * 16 + i * 8192, R, C); const int Rb = Epi::PERM ? ((R & ~31) + perm32(R & 31)) : R;
        voffA[i] = (unsigned)(R * K + C) * 2u; voffB[i] = (unsigned)(Rb * K + C) * 2u; }
    const size_t kstep = (size_t)(BK * 2);
    const size_t hstep = (size_t)HALF * K * 2;
    const size_t qstep = (size_t)64 * K * 2;
    const size_t tstep = 2 * hstep;
    const unsigned ldsw = (unsigned)wid * 1024u;
    const int aoff = lds_byte(wr * 64 + fr, fq * 8), boff = lds_byte(wc * 32 + fr, fq * 8);
#define PG8_SA(b, h) (((b) * 2 + (h)) * HTB)
#define PG8_SB(b, h) ((4 + (b) * 2 + (h)) * HTB)
#define PG8_STAGE(bufoff, gbase, voff) do { _Pragma("unroll") for (int _i = 0; _i < 2; ++_i) \
        __builtin_amdgcn_global_load_lds((const unsigned*)((const char*)(gbase) + (size_t)_i * qstep + (voff)[0]), (PG8_LAS unsigned*)(lds + (bufoff) + ldsw + _i * 8192), 16, 0, 0); } while (0)
#define PG8_LDA(dst, b, h) do { _Pragma("unroll") for (int m = 0; m < 4; ++m) _Pragma("unroll") for (int k = 0; k < 2; ++k) dst[m][k] = *(const PG8_LAS bf16x8*)(lds + PG8_SA(b, h) + aoff + m * 2048 + k * 1024); } while (0)
#define PG8_LDB(dst, b, h) do { _Pragma("unroll") for (int n = 0; n < 2; ++n) _Pragma("unroll") for (int k = 0; k < 2; ++k) dst[n][k] = *(const PG8_LAS bf16x8*)(lds + PG8_SB(b, h) + boff + n * 2048 + k * 1024); } while (0)
#define PG8_MMA(ai, bj, At, Bt) do { __builtin_amdgcn_s_setprio(1); _Pragma("unroll") for (int m = 0; m < 4; ++m) _Pragma("unroll") for (int n = 0; n < 2; ++n) _Pragma("unroll") for (int k = 0; k < 2; ++k) \
        acc[ai][bj][m][n] = __builtin_amdgcn_mfma_f32_16x16x32_bf16(Bt[n][k], At[m][k], acc[ai][bj][m][n], 0, 0, 0); __builtin_amdgcn_s_setprio(0); } while (0)
#define PG8_WAIT_V(n) asm volatile("s_waitcnt vmcnt(" #n ")" ::: "memory")
#define PG8_WAIT_L(n) asm volatile("s_waitcnt lgkmcnt(" #n ")" ::: "memory")
#define PG8_BAR __builtin_amdgcn_s_barrier()
#define PG8_SCHED __builtin_amdgcn_sched_barrier(0)
    Unit cur, nxt; int ui = 0;
    constexpr int KT2 = Epi::PROBE_KTWICE ? 1 : 0;
    if (!S.next(0, cur)) return;
    f32x4 acc[2][2][4][2];
#pragma unroll
    for (int a = 0; a < 2; ++a)
#pragma unroll
        for (int b = 0; b < 2; ++b)
#pragma unroll
            for (int m = 0; m < 4; ++m)
#pragma unroll
                for (int n = 0; n < 2; ++n) acc[a][b][m][n] = (f32x4){0.f, 0.f, 0.f, 0.f};
    bf16x8 At[4][2], B0[2][2], B1[2][2];
    const char* cA = (const char*)g.A + (size_t)cur.pm * tstep; const char* cB = (const char*)g.Bt + (size_t)cur.pn * tstep;
    S.a_ready(cur);
    if constexpr (SP2) {
        PG8_STAGE(PG8_SB(0, 0), cB, voffB); PG8_STAGE(PG8_SB(0, 1), cB + hstep, voffB); PG8_STAGE(PG8_SA(0, 0), cA, voffA); PG8_STAGE(PG8_SA(0, 1), cA + hstep, voffA);
        if (wr == 1) PG8_BAR;
        PG8_WAIT_V(2); PG8_BAR;
        PG8_STAGE(PG8_SB(1, 0), cB + kstep, voffB); PG8_STAGE(PG8_SA(1, 0), cA + kstep, voffA); PG8_STAGE(PG8_SB(1, 1), cB + hstep + kstep, voffB);
        PG8_WAIT_V(6); PG8_BAR;
    } else {
        PG8_STAGE(PG8_SB(0, 0), cB, voffB); PG8_STAGE(PG8_SA(0, 0), cA, voffA); PG8_STAGE(PG8_SB(0, 1), cB + hstep, voffB); PG8_STAGE(PG8_SA(0, 1), cA + hstep, voffA);
        if (wr == 1) PG8_BAR;
        PG8_WAIT_V(4); PG8_BAR;
        PG8_STAGE(PG8_SB(1, 0), cB + kstep, voffB); PG8_STAGE(PG8_SA(1, 0), cA + kstep, voffA); PG8_STAGE(PG8_SB(1, 1), cB + hstep + kstep, voffB);
        PG8_WAIT_V(6); PG8_BAR;
    }
#define PG8_ITER(W1) do { \
            PG8_LDB(B0, 0, 0); PG8_LDB(B1, 0, 1); PG8_SCHED; PG8_LDA(At, 0, 0); PG8_STAGE(PG8_SA(1, 1), a1 + hstep, voffA); \
            PG8_WAIT_V(W1); PG8_WAIT_L(0); PG8_BAR; PG8_MMA(0, 0, At, B0); PG8_MMA(0, 1, At, B1); PG8_BAR; PG8_SCHED; \
            PG8_LDA(At, 0, 1); PG8_STAGE(PG8_SB(0, 0), b2, voffB); PG8_STAGE(PG8_SB(0, 1), b2 + hstep, voffB); PG8_STAGE(PG8_SA(0, 0), a2, voffA); \
            PG8_WAIT_V(W1); PG8_WAIT_L(0); PG8_BAR; PG8_MMA(1, 0, At, B0); PG8_MMA(1, 1, At, B1); PG8_BAR; PG8_SCHED; \
            PG8_LDB(B0, 1, 0); PG8_LDB(B1, 1, 1); PG8_SCHED; PG8_LDA(At, 1, 0); PG8_STAGE(PG8_SA(0, 1), a2 + hstep, voffA); \
            PG8_WAIT_V(8); PG8_WAIT_L(0); PG8_BAR; PG8_MMA(0, 0, At, B0); PG8_MMA(0, 1, At, B1); PG8_BAR; PG8_SCHED; \
            PG8_LDA(At, 1, 1); PG8_STAGE(PG8_SB(1, 0), b3, voffB); PG8_STAGE(PG8_SB(1, 1), b3 + hstep, voffB); PG8_STAGE(PG8_SA(1, 0), a3, voffA); \
            PG8_WAIT_V(8); PG8_WAIT_L(0); PG8_BAR; PG8_MMA(1, 0, At, B0); PG8_MMA(1, 1, At, B1); PG8_BAR; PG8_SCHED; } while (0)
    if constexpr (SP2 && RELAX_EPI_WAIT != 0) {
#pragma unroll
        for (int dq = 0; dq < 16; ++dq) __builtin_amdgcn_global_load_lds((const unsigned*)(cA + voffA[0]), (PG8_LAS unsigned*)(lds + STAGE_BYTES + ldsw), 16, 0, 0);
    }
    for (;;) {
        const bool has_next = S.next((ui + 1) >> KT2, nxt);
        const char* nA = has_next ? (const char*)g.A + (size_t)nxt.pm * tstep : cA; const char* nB = has_next ? (const char*)g.Bt + (size_t)nxt.pn * tstep : cB;
        if constexpr (SP2 && RELAX_EPI_WAIT != 0) {
            const char* a1 = cA + kstep; const char* a2 = cA + 2 * kstep; const char* b2 = cB + 2 * kstep; const char* a3 = a2 + kstep; const char* b3 = b2 + kstep;
            PG8_ITER(24);
        }
        for (int t = (SP2 && RELAX_EPI_WAIT != 0) ? 2 : 0; t < nt; t += 2) {
            const bool last = (t == nt - 2);
            const char* a1 = cA + (size_t)(t + 1) * kstep;
            const char* a2 = last ? nA : cA + (size_t)(t + 2) * kstep; const char* b2 = last ? nB : cB + (size_t)(t + 2) * kstep;
            const char* a3 = a2 + kstep; const char* b3 = b2 + kstep;
            if (last && has_next) S.a_ready(nxt);
            if constexpr (SP2) {
            PG8_ITER(8);
            } else {
            PG8_LDB(B0, 0, 0); PG8_SCHED; PG8_LDA(At, 0, 0); PG8_STAGE(PG8_SA(1, 1), a1 + hstep, voffA);
            PG8_WAIT_L(8); PG8_BAR; PG8_WAIT_L(0); PG8_MMA(0, 0, At, B0); PG8_BAR; PG8_SCHED;
            PG8_LDB(B1, 0, 1); PG8_STAGE(PG8_SB(0, 0), b2, voffB);
            PG8_BAR; PG8_WAIT_L(0); PG8_MMA(0, 1, At, B1); PG8_BAR;
            PG8_LDA(At, 0, 1); PG8_STAGE(PG8_SA(0, 0), a2, voffA);
            PG8_BAR; PG8_WAIT_L(0); PG8_MMA(1, 0, At, B0); PG8_BAR; PG8_SCHED;
            PG8_STAGE(PG8_SB(0, 1), b2 + hstep, voffB);
            PG8_WAIT_V(6); PG8_BAR; PG8_MMA(1, 1, At, B1); PG8_BAR;
            PG8_LDB(B0, 1, 0); PG8_SCHED; PG8_LDA(At, 1, 0); PG8_STAGE(PG8_SA(0, 1), a2 + hstep, voffA);
            PG8_WAIT_L(8); PG8_BAR; PG8_WAIT_L(0); PG8_MMA(0, 0, At, B0); PG8_BAR; PG8_SCHED;
            PG8_LDB(B1, 1, 1); PG8_STAGE(PG8_SB(1, 0), b3, voffB);
            PG8_BAR; PG8_WAIT_L(0); PG8_MMA(0, 1, At, B1); PG8_BAR;
            PG8_LDA(At, 1, 1); PG8_STAGE(PG8_SA(1, 0), a3, voffA);
            PG8_BAR; PG8_WAIT_L(0); PG8_MMA(1, 0, At, B0); PG8_BAR; PG8_SCHED;
            PG8_STAGE(PG8_SB(1, 1), b3 + hstep, voffB);
            PG8_WAIT_V(6); PG8_BAR; PG8_MMA(1, 1, At, B1); PG8_BAR;
            }
        }
        if constexpr (ALIGN_EPI) { if (wr == 0) PG8_BAR; }
        if constexpr (!Epi::AFTER_DRAIN) { if (!KT2 || (ui & 1)) E(acc, cur, wr, wc, fr, fq); if constexpr (Epi::PROBE_TWICE) { asm volatile("" ::: "memory"); E(acc, cur, wr, wc, fr, fq); } S.done(cur); }
        if (!has_next) break;
#pragma unroll
        for (int a = 0; a < 2; ++a)
#pragma unroll
            for (int b = 0; b < 2; ++b)
#pragma unroll
                for (int m = 0; m < 4; ++m)
#pragma unroll
                    for (int n = 0; n < 2; ++n) acc[a][b][m][n] = (f32x4){0.f, 0.f, 0.f, 0.f};
        cur = nxt; cA = nA; cB = nB; ++ui;
        if constexpr (ALIGN_EPI) { if (wr == 1) PG8_BAR; }
    }
    PG8_WAIT_V(0);
    if constexpr (!ALIGN_EPI) { if (wr == 0) PG8_BAR; }
    PG8_BAR;
    if constexpr (Epi::AFTER_DRAIN) { E.fused(acc, cur, wr, wc, fr, fq, lds, wid, lane); S.done(cur); }
#undef PG8_SA
#undef PG8_SB
#undef PG8_STAGE
#undef PG8_LDA
#undef PG8_LDB
#undef PG8_MMA
#undef PG8_WAIT_V
#undef PG8_WAIT_L
#undef PG8_BAR
#undef PG8_SCHED
#undef PG8_ITER
}
}
#ifndef PG8_SP2
#define PG8_SP2 true
#endif
#ifndef PG8_ALIGN
#define PG8_ALIGN true
#endif
#ifndef MK_PER_PHASE
#define MK_PER_PHASE 0
#endif
constexpr int NWAVES = 8;
constexpr int NB = 4, T = 8192, D = 1024, M = NB * T, FF = 4096;
constexpr int NE = 2304;
constexpr int NO = 3328;
constexpr int N_PHASES = 19;
constexpr size_t MiB = 1u << 20;
constexpr size_t WS_CTL = 0, CTL_ZERO_BYTES = 3584 * 1024;
constexpr size_t WS_RING = 512 * 1024;
constexpr size_t WS_XS = 1536 * 1024;
constexpr size_t WS_ROPE = 7 * MiB, WS_LORA = 7 * MiB + 512 * 1024, WS_G0 = 507 * MiB, WS_DT = 4 * MiB, WS_MLS = 5 * MiB, WS_DEC = 6 * MiB;
constexpr size_t WS_WINE = 8 * MiB, WS_WOUTE = 13 * MiB, WS_WUP0 = 15 * MiB, WS_WDN0 = 23 * MiB, WS_WINO = 31 * MiB, WS_WOUTO = 38 * MiB, WS_WUP1 = 40 * MiB, WS_WDN1 = 48 * MiB;
constexpr size_t WS_XN = 56 * MiB;
constexpr size_t WS_R1 = 120 * MiB;
constexpr size_t WS_GF = WS_R1 + 208 * MiB;
constexpr size_t WS_LX = WS_R1 + 240 * MiB;
constexpr size_t WS_Y = 376 * MiB;
constexpr size_t WS_HS = 440 * MiB;
constexpr size_t WS_SSP = 504 * MiB;
constexpr size_t WS_RS = 506 * MiB;
constexpr size_t WS_END = 508 * MiB;
constexpr int CW_BAR = 1024;
constexpr int LDS_MAIN = 155648, LDSCTL_OFF = LDS_MAIN, LDS_BYTES = LDS_MAIN + 1024;

#define GAS __attribute__((address_space(1)))
#define LAS __attribute__((address_space(3)))
typedef unsigned short bf16;
typedef unsigned v4u __attribute__((ext_vector_type(4)));
typedef unsigned v2u __attribute__((ext_vector_type(2)));
typedef float f32x4 __attribute__((ext_vector_type(4)));
typedef short bf16x8 __attribute__((ext_vector_type(8)));
typedef GAS unsigned gu32;
#define RLX_AGENT __ATOMIC_RELAXED, __HIP_MEMORY_SCOPE_AGENT
#define LDS_WAIT() asm volatile("s_waitcnt lgkmcnt(0)" ::: "memory")
#define VM_WAIT() asm volatile("s_waitcnt vmcnt(0)" ::: "memory")
__device__ __forceinline__ unsigned f2bf(float f) { unsigned u = __builtin_bit_cast(unsigned, f); return (u + 0x7fffu + ((u >> 16) & 1u)) >> 16; }
typedef float f32x2_t __attribute__((ext_vector_type(2)));
typedef __bf16 bf16x2_t __attribute__((ext_vector_type(2)));
__device__ __forceinline__ unsigned pk2(float lo, float hi) { const f32x2_t v = {lo, hi}; const bf16x2_t b = __builtin_convertvector(v, bf16x2_t); return __builtin_bit_cast(unsigned, b); }
__device__ __forceinline__ bf16 tobf(float x) { return (bf16)pk2(x, x); }
__device__ __forceinline__ float row16_sum(float x) {
    x += __builtin_bit_cast(float, __builtin_amdgcn_update_dpp(0, __builtin_bit_cast(int, x), 0xB1, 0xF, 0xF, true));
    x += __builtin_bit_cast(float, __builtin_amdgcn_update_dpp(0, __builtin_bit_cast(int, x), 0x4E, 0xF, 0xF, true));
    x += __builtin_bit_cast(float, __builtin_amdgcn_update_dpp(0, __builtin_bit_cast(int, x), 0x141, 0xF, 0xF, true));
    x += __builtin_bit_cast(float, __builtin_amdgcn_update_dpp(0, __builtin_bit_cast(int, x), 0x140, 0xF, 0xF, true));
    return x;
}
__device__ __forceinline__ float bflo(unsigned w) { return __builtin_bit_cast(float, w << 16); }
__device__ __forceinline__ float bfhi(unsigned w) { return __builtin_bit_cast(float, w & 0xffff0000u); }
__device__ __forceinline__ float bf1(bf16 v) { return __builtin_bit_cast(float, (unsigned)v << 16); }
__device__ __forceinline__ void unpack8(const v4u w, float (&x)[8]) { x[0] = bflo(w.x); x[1] = bfhi(w.x); x[2] = bflo(w.y); x[3] = bfhi(w.y); x[4] = bflo(w.z); x[5] = bfhi(w.z); x[6] = bflo(w.w); x[7] = bfhi(w.w); }
__device__ __forceinline__ v4u pack8(const float (&x)[8]) { v4u w; w.x = pk2(x[0], x[1]); w.y = pk2(x[2], x[3]); w.z = pk2(x[4], x[5]); w.w = pk2(x[6], x[7]); return w; }
__device__ __forceinline__ bf16x8 frag8(const f32x4 a, const f32x4 b) { v4u w; w.x = pk2(a[0], a[1]); w.y = pk2(a[2], a[3]); w.z = pk2(b[0], b[1]); w.w = pk2(b[2], b[3]); return __builtin_bit_cast(bf16x8, w); }
__device__ __forceinline__ bf16x8 frag2(const v2u lo, const v2u hi) { v4u w; w.x = lo.x; w.y = lo.y; w.z = hi.x; w.w = hi.y; return __builtin_bit_cast(bf16x8, w); }
__device__ __forceinline__ f32x4 mfma16(bf16x8 a, bf16x8 b, f32x4 c) { return __builtin_amdgcn_mfma_f32_16x16x32_bf16(a, b, c, 0, 0, 0); }
__device__ __forceinline__ float rcpf_(float x) { return __builtin_amdgcn_rcpf(x); }
__device__ __forceinline__ float sigmoidf_(float x) { return rcpf_(1.f + __expf(-x)); }
__device__ __forceinline__ float siluf_(float x) { return x * rcpf_(1.f + __expf(-x)); }
__device__ __forceinline__ float softplus_fast(float x) { return fmaxf(x, 0.f) + 0.69314718f * __builtin_amdgcn_logf(1.f + __expf(-fabsf(x))); }
__device__ __forceinline__ float softplusf_(float x) { return fmaxf(x, 0.f) + log1pf(expf(-fabsf(x))); }
__device__ __forceinline__ float wave_sum(float v) { v = row16_sum(v); v += __shfl_xor(v, 16); v += __shfl_xor(v, 32); return v; }
__device__ __forceinline__ float wave_sum8(const float (&a)[8], int lane) {
    float x = row16_sum(a[0]); const int k = lane & 7;
#pragma unroll
    for (int q = 1; q < 8; ++q) { const float r = row16_sum(a[q]); x = (k == q) ? r : x; }
    x += __shfl_xor(x, 16); x += __shfl_xor(x, 32); return x;
}
__device__ __forceinline__ float wave_max(float v) {
#pragma unroll
    for (int o = 1; o < 64; o <<= 1) v = fmaxf(v, __shfl_xor(v, o));
    return v;
}
__device__ __forceinline__ float quad_sum(float v) { v += __shfl_xor(v, 16); v += __shfl_xor(v, 32); return v; }
__device__ __forceinline__ float quad_max(float v) { v = fmaxf(v, __shfl_xor(v, 16)); v = fmaxf(v, __shfl_xor(v, 32)); return v; }
__device__ __forceinline__ float scan_add(float v, int lane) {
#pragma unroll
    for (int o = 1; o < 64; o <<= 1) { const float t = __shfl_up(v, o); if (lane >= o) v += t; }
    return v;
}
__device__ __forceinline__ float scan_max(float v, int lane) {
#pragma unroll
    for (int o = 1; o < 64; o <<= 1) { const float t = __shfl_up(v, o); if (lane >= o) v = fmaxf(v, t); }
    return v;
}

template <int NT> __device__ __forceinline__ void load_rows(const bf16* base, int ld, int tt0, v4u (&raw)[NT + 3]) {
#pragma unroll
    for (int i = 0; i < NT + 3; ++i) { const int t2 = tt0 - 3 + i; raw[i] = (t2 >= 0) ? *(const v4u*)(base + (ptrdiff_t)t2 * ld) : (v4u){0u, 0u, 0u, 0u}; }
}
template <int NT> __device__ __forceinline__ void conv_silu(const v4u (&raw)[NT + 3], const float* convw, int wstride, const float* convb, float (&out)[NT][8]) {
    float w[4][8], bb[8];
#pragma unroll
    for (int tap = 0; tap < 4; ++tap) { const f32x4 w0 = *(const f32x4*)(convw + tap * wstride), w1 = *(const f32x4*)(convw + tap * wstride + 4);
        w[tap][0] = w0.x; w[tap][1] = w0.y; w[tap][2] = w0.z; w[tap][3] = w0.w; w[tap][4] = w1.x; w[tap][5] = w1.y; w[tap][6] = w1.z; w[tap][7] = w1.w; }
    { const f32x4 b0 = *(const f32x4*)convb, b1 = *(const f32x4*)(convb + 4); bb[0] = b0.x; bb[1] = b0.y; bb[2] = b0.z; bb[3] = b0.w; bb[4] = b1.x; bb[5] = b1.y; bb[6] = b1.z; bb[7] = b1.w; }
#pragma unroll
    for (int i = 0; i < NT; ++i)
#pragma unroll
        for (int e = 0; e < 8; ++e) out[i][e] = bb[e];
#pragma unroll
    for (int j = 0; j < NT + 3; ++j) { float x[8]; unpack8(raw[j], x);
#pragma unroll
        for (int tap = 0; tap < 4; ++tap) { const int i = j - tap;
            if (i >= 0 && i < NT) {
#pragma unroll
                for (int e = 0; e < 8; ++e) out[i][e] += x[e] * w[tap][e]; } } }
#pragma unroll
    for (int i = 0; i < NT; ++i)
#pragma unroll
        for (int e = 0; e < 8; ++e) out[i][e] = siluf_(out[i][e]);
}

__device__ __forceinline__ int tsw(int row, int tok) { return row * 136 + ((((tok >> 3) ^ (row >> 3)) & 15) << 3) + (tok & 7); }
#define XB_TMO      128
#define XB_XCNT(j)  (256  + 64 * (j))
#define XB_XSUB(j)  (1280 + 64 * (j))
#define XB_XGEN(j)  (2304 + 64 * (j))
#define XB_TOP      3328
#define XB_TOPGEN   3392
#define XCD_BAR_WORDS 3456
#define XB_SPIN_CAP (1u << 18)

__device__ __forceinline__ unsigned xb_ld(unsigned* p)              { return __hip_atomic_load(p, __ATOMIC_RELAXED, __HIP_MEMORY_SCOPE_AGENT); }
__device__ __forceinline__ unsigned xb_add(unsigned* p, unsigned v) { return __hip_atomic_fetch_add(p, v, __ATOMIC_RELAXED, __HIP_MEMORY_SCOPE_AGENT); }
__device__ __forceinline__ unsigned xb_xcc_id() { return (unsigned)__builtin_amdgcn_s_getreg((3 << 11) | 20) & 0xFu; }
#define XB_SPIN(cond, bar) do { unsigned _sp = 0; while (cond) { __builtin_amdgcn_s_sleep(1); \
    if ((++_sp & 255u) == 0u) { if (xb_ld(&(bar)[XB_TMO])) break; if (_sp > XB_SPIN_CAP) { atomicAdd(&(bar)[XB_TMO], 1u); break; } } } } while (0)

struct XcdBarrier {
    unsigned* bar; unsigned x;
    volatile LAS unsigned* st;
};

__device__ __forceinline__ XcdBarrier xcd_barrier_post(unsigned* bar, volatile LAS unsigned* st) {
    XcdBarrier b; b.bar = bar; b.x = xb_xcc_id(); b.st = st;
    if (threadIdx.x == 0) (void)xb_add(&bar[XB_XCNT(b.x)], 1u);
    return b;
}
__device__ __forceinline__ void xcd_barrier_complete(unsigned* bar, unsigned x, unsigned& nloc, unsigned& nx) {
    const unsigned G = gridDim.x * gridDim.y * gridDim.z;
    unsigned sum, cnt, mine, sp = 0u;
    for (;;) {
        sum = 0u; cnt = 0u; mine = 0u;
#pragma unroll
        for (unsigned j = 0; j < 16; ++j) { const unsigned c = xb_ld(&bar[XB_XCNT(j)]); sum += c; cnt += (c > 0u) ? 1u : 0u; mine = (j == x) ? c : mine; }
        if (sum == G) break;
        __builtin_amdgcn_s_sleep(1);
        if ((++sp & 255u) == 0u) { if (xb_ld(&bar[XB_TMO])) break; if (sp > XB_SPIN_CAP) { atomicAdd(&bar[XB_TMO], 1u); break; } }
    }
    nloc = mine > 0u ? mine : 1u; nx = cnt > 0u ? cnt : 1u;
}

__device__ __forceinline__ void xcd_barrier(const XcdBarrier& b) {
    asm volatile("s_waitcnt vmcnt(0)" ::: "memory");
    __syncthreads();
    if (threadIdx.x == 0) {
        unsigned* bar = b.bar;
        __builtin_amdgcn_s_waitcnt(0);
        unsigned nloc = b.st[0], nx = b.st[1];
        if (nloc == 0u) { xcd_barrier_complete(bar, b.x, nloc, nx); b.st[0] = nloc; b.st[1] = nx; }
        const unsigned old = xb_add(&bar[XB_XSUB(b.x)], 1u);
        const unsigned gen = old / nloc;
        if (old + 1u == (gen + 1u) * nloc) {
            __builtin_amdgcn_fence(__ATOMIC_RELEASE, "agent");
            asm volatile("s_waitcnt vmcnt(0)" ::: "memory");
            const unsigned og = xb_add(&bar[XB_TOP], 1u);
            const unsigned tg = og / nx;
            if (og + 1u == (tg + 1u) * nx) xb_add(&bar[XB_TOPGEN], 1u);
            else XB_SPIN(xb_ld(&bar[XB_TOPGEN]) == tg, bar);
            __builtin_amdgcn_fence(__ATOMIC_ACQUIRE, "agent");
            xb_add(&bar[XB_XGEN(b.x)], 1u);
            asm volatile("s_waitcnt vmcnt(0)" ::: "memory");
        } else {
            XB_SPIN(xb_ld(&bar[XB_XGEN(b.x)]) == gen, bar);
            __builtin_amdgcn_fence(__ATOMIC_ACQUIRE, "agent");
            asm volatile("s_waitcnt vmcnt(0)" ::: "memory");
        }
    }
    __syncthreads();
}
#ifndef DEFER_MLPW
#define DEFER_MLPW 1
#endif
#ifndef FUSE_MLPNORM
#define FUSE_MLPNORM 1
#endif
#ifndef FUSE_N9
#define FUSE_N9 1
#endif
__device__ __forceinline__ void p0_transpose_item(const float* W, int K, int ldw, int n_src0, bf16* WT, int row_dst0, int nblk, LAS float* scr, int item, int lane, const float* kgain = nullptr) {
    const int kb = item / nblk, nb = item % nblk, k0 = 64 * kb, n0 = 32 * nb;
#pragma unroll 8
    for (int i = 0; i < 32; ++i) { const int kk = 2 * i + (lane >> 5); const float gk = kgain ? kgain[k0 + kk] : 1.0f; scr[kk * 33 + (lane & 31)] = W[(size_t)(k0 + kk) * ldw + n_src0 + n0 + (lane & 31)] * gk; }
    LDS_WAIT(); asm volatile("" ::: "memory");
    const int c = lane & 7;
#pragma unroll
    for (int j = 0; j < 4; ++j) { const int n = (lane >> 3) + 8 * j; const LAS float* s = scr + (8 * c) * 33 + n;
        v4u o; o.x = pk2(s[0 * 33], s[1 * 33]); o.y = pk2(s[2 * 33], s[3 * 33]); o.z = pk2(s[4 * 33], s[5 * 33]); o.w = pk2(s[6 * 33], s[7 * 33]);
        *(GAS v4u*)(WT + (size_t)(row_dst0 + n0 + n) * K + k0 + 8 * c) = o; }
    LDS_WAIT(); asm volatile("" ::: "memory");
}
struct TrJob { const float* W; int K, ldw, n_src0; bf16* WT; int row_dst0, nblk, nitems; };
__device__ __forceinline__ void p0_prologue(const float* const* in, unsigned char* ws, LAS unsigned char* lds, int tid, int G) {
    const int lane = tid & 63, wave = __builtin_amdgcn_readfirstlane(tid >> 6);
    LAS float* scr = (LAS float*)(lds + wave * 16384);
    const int gw = blockIdx.x * NWAVES + wave, NGW = G * NWAVES;
#define TRJG(Wp, K_, ldw_, s0_, dst_, r0_, ncols_, kg_) { int nblk_ = (ncols_) / 32; int ni_ = ((K_) / 64) * nblk_; if (it < ni_) { p0_transpose_item(Wp, K_, ldw_, s0_, (bf16*)(ws + dst_), r0_, nblk_, scr, it, lane, kg_); continue; } it -= ni_; }
#define TRJ(Wp, K_, ldw_, s0_, dst_, r0_, ncols_) TRJG(Wp, K_, ldw_, s0_, dst_, r0_, ncols_, nullptr)
    constexpr int NITEMS = 16 * 72 + 16 * 32 + (DEFER_MLPW ? 0 : 16 * 48 + 16 * 56 + 16 * 32 + 2 * 16 * 128 + 2 * 64 * 32);
    for (int it0 = gw; it0 < NITEMS; it0 += NGW) {
        int it = it0;
        TRJ(in[5], 1024, 2312, 0, WS_WINE, 0, 2304)
        TRJ(in[6], 1024, 1024, 0, WS_WOUTE, 0, 1024)
        if (!DEFER_MLPW) {
        TRJG(in[13], 1024, 3336, 0, WS_WINO, 0, 1536, FUSE_N9 ? in[1] + 1024 : nullptr)
        TRJG(in[13], 1024, 3336, 1544, WS_WINO, 1536, 1792, FUSE_N9 ? in[1] + 1024 : nullptr)
        TRJ(in[14], 1024, 1024, 0, WS_WOUTO, 0, 1024)
        TRJG(in[3], 1024, 4096, 0, WS_WUP0, 0, 4096, FUSE_MLPNORM ? in[2] : nullptr)
        TRJG(in[3] + (size_t)1024 * 4096, 1024, 4096, 0, WS_WUP1, 0, 4096, FUSE_MLPNORM ? in[2] + 1024 : nullptr)
        TRJ(in[4], 4096, 1024, 0, WS_WDN0, 0, 1024)
        TRJ(in[4] + (size_t)4096 * 1024, 4096, 1024, 0, WS_WDN1, 0, 1024)
        }
    }
    const int gt = blockIdx.x * 512 + tid, NGT = G * 512;
    bf16* w2t = (bf16*)(ws + WS_LORA); bf16* a2t = w2t + 512 * 64; bf16* g2t = a2t + 512 * 64;
    for (int i = gt; i < 512 * 64; i += NGT) { const int n = i >> 6, j = i & 63; w2t[i] = tobf(in[23][j * 512 + n]); a2t[i] = tobf(in[25][j * 512 + n]); }
    for (int i = gt; i < 512 * 128; i += NGT) { const int n = i >> 7, j = i & 127; g2t[i] = tobf(in[26][j * 512 + n]); }
    float2* rope = (float2*)(ws + WS_ROPE);
    for (int i = gt; i < T * 8; i += NGT) { const int t = i >> 3, d = i & 7; const float inv = powf(500000.0f, -(float)d * 0.125f); const float ang = (float)t * inv; rope[i] = make_float2(cosf(ang), sinf(ang)); }
}
__device__ __forceinline__ void mlp_weights_convert(const float* const* in, unsigned char* ws, int layer, LAS unsigned char* lds, int tid, int b0, int nb) {
    const int lane = tid & 63, wave = __builtin_amdgcn_readfirstlane(tid >> 6);
    LAS float* scr = (LAS float*)(lds + wave * 16384);
    const int gw = ((int)blockIdx.x - b0) * NWAVES + wave, NGW = nb * NWAVES;
    for (int it0 = gw; it0 < 16 * 128 + 64 * 32 + (layer == 0 ? 16 * 48 + 16 * 56 + 16 * 32 : 0); it0 += NGW) {
        int it = it0;
        TRJG(in[3] + (size_t)layer * 1024 * 4096, 1024, 4096, 0, (layer ? WS_WUP1 : WS_WUP0), 0, 4096, FUSE_MLPNORM ? in[2] + layer * 1024 : nullptr)
        TRJ(in[4] + (size_t)layer * 4096 * 1024, 4096, 1024, 0, (layer ? WS_WDN1 : WS_WDN0), 0, 1024)
        if (layer == 0) {
        TRJG(in[13], 1024, 3336, 0, WS_WINO, 0, 1536, FUSE_N9 ? in[1] + 1024 : nullptr)
        TRJG(in[13], 1024, 3336, 1544, WS_WINO, 1536, 1792, FUSE_N9 ? in[1] + 1024 : nullptr)
        TRJ(in[14], 1024, 1024, 0, WS_WOUTO, 0, 1024)
        }
    }
}
#undef TRJ
#undef TRJG
template <int MODE>
__device__ __forceinline__ void norm_phase(const float* src, const float* gain, bf16* dst, float* dstf, const float* gw, int ldg, float* gout, LAS unsigned char* lds, int tid, int G) {
    const int lane = tid & 63, wave = __builtin_amdgcn_readfirstlane(tid >> 6);
    LAS float* Wg = (LAS float*)lds;
    if (MODE == 1) { for (int i = tid; i < 8192; i += 512) { const int k = i >> 3, j = i & 7; Wg[j * 1024 + k] = gw[(size_t)k * ldg + j]; } __syncthreads(); }
    f32x4 gv[4];
#pragma unroll
    for (int j = 0; j < 4; ++j) gv[j] = *(const f32x4*)(gain + 4 * lane + 256 * j);
    f32x4 nv[4];
    { const int m0 = blockIdx.x * NWAVES + wave; if (m0 < M) { const f32x4* xr = (const f32x4*)(src + (size_t)m0 * D) + lane;
#pragma unroll
        for (int j = 0; j < 4; ++j) nv[j] = xr[64 * j]; } }
    for (int m = blockIdx.x * NWAVES + wave; m < M; m += G * NWAVES) {
        f32x4 v[4]; float s = 0.f;
#pragma unroll
        for (int j = 0; j < 4; ++j) v[j] = nv[j];
        if (m + G * NWAVES < M) { const f32x4* xr = (const f32x4*)(src + (size_t)(m + G * NWAVES) * D) + lane;
#pragma unroll
            for (int j = 0; j < 4; ++j) nv[j] = xr[64 * j]; }
#pragma unroll
        for (int j = 0; j < 4; ++j) s += (v[j].x * v[j].x + v[j].y * v[j].y) + (v[j].z * v[j].z + v[j].w * v[j].w);
        const float rs = 1.0f / sqrtf(wave_sum(s) * (1.f / D) + 1e-5f);
#pragma unroll
        for (int j = 0; j < 4; ++j) v[j] = v[j] * rs * gv[j];
        if (MODE == 2) {
            f32x4* o = (f32x4*)(dstf + (size_t)m * D) + lane;
#pragma unroll
            for (int j = 0; j < 4; ++j) o[64 * j] = v[j];
        } else {
            v2u* o = (v2u*)(dst + (size_t)m * D) + lane;
#pragma unroll
            for (int j = 0; j < 4; ++j) { v2u w; w.x = pk2(v[j].x, v[j].y); w.y = pk2(v[j].z, v[j].w); o[64 * j] = w; }
        }
        if (MODE == 1) {
            float g8[8];
#pragma unroll
            for (int q = 0; q < 8; ++q) { float a = 0.f;
#pragma unroll
                for (int j = 0; j < 4; ++j) { const f32x4 w = *(const LAS f32x4*)(Wg + q * 1024 + 4 * lane + 256 * j); a += (v[j].x * w.x + v[j].y * w.y) + (v[j].z * w.z + v[j].w * w.w); }
                g8[q] = a; }
            const float gt = wave_sum8(g8, lane);
            if (lane < 8) gout[(size_t)m * 8 + lane] = gt;
        }
    }
}
template <int MODE>
__device__ __forceinline__ void norm_phase_b(const bf16* src, const float* gain, bf16* dst, float* dstf, const float* gw, int ldg, float* gout, LAS unsigned char* lds, int tid, int G) {
    const int lane = tid & 63, wave = __builtin_amdgcn_readfirstlane(tid >> 6);
    LAS float* Wg = (LAS float*)lds;
    if (MODE == 1 || MODE == 3) { for (int i = tid; i < 8192; i += 512) { const int k = i >> 3, j = i & 7; Wg[j * 1024 + k] = gw[(size_t)k * ldg + j]; } __syncthreads(); }
    float gv[2][8];
#pragma unroll
    for (int j = 0; j < 2; ++j) { const f32x4 g0 = *(const f32x4*)(gain + 8 * lane + 512 * j), g1 = *(const f32x4*)(gain + 8 * lane + 512 * j + 4);
        gv[j][0] = g0.x; gv[j][1] = g0.y; gv[j][2] = g0.z; gv[j][3] = g0.w; gv[j][4] = g1.x; gv[j][5] = g1.y; gv[j][6] = g1.z; gv[j][7] = g1.w; }
    v4u nraw[2];
    { const int m0 = blockIdx.x * NWAVES + wave; if (m0 < M) {
#pragma unroll
        for (int j = 0; j < 2; ++j) nraw[j] = *(const v4u*)(src + (size_t)m0 * D + 8 * lane + 512 * j); } }
    for (int m = blockIdx.x * NWAVES + wave; m < M; m += G * NWAVES) {
        float v[2][8]; float s = 0.f; v4u raw[2];
#pragma unroll
        for (int j = 0; j < 2; ++j) raw[j] = nraw[j];
        if (m + G * NWAVES < M) {
#pragma unroll
            for (int j = 0; j < 2; ++j) nraw[j] = *(const v4u*)(src + (size_t)(m + G * NWAVES) * D + 8 * lane + 512 * j); }
#pragma unroll
        for (int j = 0; j < 2; ++j) { unpack8(raw[j], v[j]);
#pragma unroll
            for (int e = 0; e < 8; ++e) s += v[j][e] * v[j][e]; }
        const float rs = 1.0f / sqrtf(wave_sum(s) * (1.f / D) + 1e-5f);
#pragma unroll
        for (int j = 0; j < 2; ++j)
#pragma unroll
            for (int e = 0; e < 8; ++e) v[j][e] = v[j][e] * rs * gv[j][e];
        if (MODE == 2) {
#pragma unroll
            for (int j = 0; j < 2; ++j) { f32x4* o = (f32x4*)(dstf + (size_t)m * D + 8 * lane + 512 * j); o[0] = (f32x4){v[j][0], v[j][1], v[j][2], v[j][3]}; o[1] = (f32x4){v[j][4], v[j][5], v[j][6], v[j][7]}; }
        } else if (MODE == 3) {
            if (lane == 0) dstf[m] = rs;
        } else {
#pragma unroll
            for (int j = 0; j < 2; ++j) *(v4u*)(dst + (size_t)m * D + 8 * lane + 512 * j) = pack8(v[j]);
        }
        if (MODE == 1 || MODE == 3) {
            float g8[8];
#pragma unroll
            for (int q = 0; q < 8; ++q) { float a = 0.f;
#pragma unroll
                for (int j = 0; j < 2; ++j) { const f32x4 w0 = *(const LAS f32x4*)(Wg + q * 1024 + 8 * lane + 512 * j), w1 = *(const LAS f32x4*)(Wg + q * 1024 + 8 * lane + 512 * j + 4);
                    a += (v[j][0] * w0.x + v[j][1] * w0.y) + (v[j][2] * w0.z + v[j][3] * w0.w) + (v[j][4] * w1.x + v[j][5] * w1.y) + (v[j][6] * w1.z + v[j][7] * w1.w); }
                g8[q] = a; }
            const float gt = wave_sum8(g8, lane);
            if (lane < 8) gout[(size_t)m * 8 + lane] = gt;
        }
    }
}
__device__ __forceinline__ void norm_x_gates_phase(const float* src, const float* gain, bf16* dst, const float* gw, int ldg, float* gout, LAS unsigned char* lds, int tid, int G) {
    const int lane = tid & 63, wave = __builtin_amdgcn_readfirstlane(tid >> 6);
    LAS float* Wg = (LAS float*)lds;
    for (int i = tid; i < 8192; i += 512) { const int k = i >> 3, j = i & 7; Wg[j * 1024 + k] = gw[(size_t)k * ldg + j]; }
    __syncthreads();
    f32x4 gv[4];
#pragma unroll
    for (int j = 0; j < 4; ++j) gv[j] = *(const f32x4*)(gain + 4 * lane + 256 * j);
    const int stride = G * NWAVES;
    for (int m = blockIdx.x * NWAVES + wave; m < M; m += 2 * stride) {
        const int m1 = (m + stride < M) ? m + stride : m;
        f32x4 v[2][4];
#pragma unroll
        for (int rr = 0; rr < 2; ++rr) { const f32x4* xr = (const f32x4*)(src + (size_t)(rr ? m1 : m) * D) + lane;
#pragma unroll
            for (int j = 0; j < 4; ++j) v[rr][j] = xr[64 * j]; }
#pragma unroll
        for (int rr = 0; rr < 2; ++rr) { float s = 0.f;
#pragma unroll
            for (int j = 0; j < 4; ++j) s += (v[rr][j].x * v[rr][j].x + v[rr][j].y * v[rr][j].y) + (v[rr][j].z * v[rr][j].z + v[rr][j].w * v[rr][j].w);
            const float rs = 1.0f / sqrtf(wave_sum(s) * (1.f / D) + 1e-5f);
#pragma unroll
            for (int j = 0; j < 4; ++j) v[rr][j] = v[rr][j] * rs * gv[j];
            if (rr == 0 || m1 != m) { v2u* o = (v2u*)(dst + (size_t)(rr ? m1 : m) * D) + lane;
#pragma unroll
                for (int j = 0; j < 4; ++j) { v2u w; w.x = pk2(v[rr][j].x, v[rr][j].y); w.y = pk2(v[rr][j].z, v[rr][j].w); o[64 * j] = w; } } }
        float g8[2][8];
#pragma unroll
        for (int q = 0; q < 8; ++q) { float a0 = 0.f, a1 = 0.f;
#pragma unroll
            for (int j = 0; j < 4; ++j) { const f32x4 w = *(const LAS f32x4*)(Wg + q * 1024 + 4 * lane + 256 * j);
                a0 += (v[0][j].x * w.x + v[0][j].y * w.y) + (v[0][j].z * w.z + v[0][j].w * w.w); a1 += (v[1][j].x * w.x + v[1][j].y * w.y) + (v[1][j].z * w.z + v[1][j].w * w.w); }
            g8[0][q] = a0; g8[1][q] = a1; }
        const float gt0 = wave_sum8(g8[0], lane), gt1 = wave_sum8(g8[1], lane);
        if (lane < 8) { gout[(size_t)m * 8 + lane] = gt0; if (m1 != m) gout[(size_t)m1 * 8 + lane] = gt1; }
    }
}
__device__ __forceinline__ void norm_rs_dt_phase(const bf16* src, const float* gain, float* rsout, const float* gw, int ldg, float* gout, LAS unsigned char* lds, int tid, int G) {
    const int lane = tid & 63, wave = __builtin_amdgcn_readfirstlane(tid >> 6);
    LAS float* Wg = (LAS float*)lds;
    for (int i = tid; i < 8192; i += 512) { const int k = i >> 3, j = i & 7; Wg[j * 1024 + k] = gw[(size_t)k * ldg + j] * gain[k]; }
    __syncthreads();
    const int stride = G * NWAVES;
    for (int m = blockIdx.x * NWAVES + wave; m < M; m += 2 * stride) {
        const int m1 = (m + stride < M) ? m + stride : m;
        v4u raw[2][2];
#pragma unroll
        for (int rr = 0; rr < 2; ++rr)
#pragma unroll
            for (int j = 0; j < 2; ++j) raw[rr][j] = *(const v4u*)(src + (size_t)(rr ? m1 : m) * D + 8 * lane + 512 * j);
        f32x2_t v[2][2][4]; float rs[2];
#pragma unroll
        for (int rr = 0; rr < 2; ++rr) { f32x2_t s2 = (f32x2_t){0.f, 0.f};
#pragma unroll
            for (int j = 0; j < 2; ++j)
#pragma unroll
                for (int p = 0; p < 4; ++p) { const unsigned w = raw[rr][j][p]; v[rr][j][p] = (f32x2_t){bflo(w), bfhi(w)}; s2 += v[rr][j][p] * v[rr][j][p]; }
            rs[rr] = 1.0f / sqrtf(wave_sum(s2.x + s2.y) * (1.f / D) + 1e-5f);
            if (lane == 0 && (rr == 0 || m1 != m)) rsout[rr ? m1 : m] = rs[rr]; }
        float g8[2][8];
#pragma unroll
        for (int q = 0; q < 8; ++q) { f32x2_t a0 = (f32x2_t){0.f, 0.f}, a1 = a0;
#pragma unroll
            for (int j = 0; j < 2; ++j) { const f32x4 w0 = *(const LAS f32x4*)(Wg + q * 1024 + 8 * lane + 512 * j), w1 = *(const LAS f32x4*)(Wg + q * 1024 + 8 * lane + 512 * j + 4);
                const f32x2_t wa = (f32x2_t){w0.x, w0.y}, wb = (f32x2_t){w0.z, w0.w}, wc = (f32x2_t){w1.x, w1.y}, wd = (f32x2_t){w1.z, w1.w};
                a0 += v[0][j][0] * wa; a0 += v[0][j][1] * wb; a0 += v[0][j][2] * wc; a0 += v[0][j][3] * wd;
                a1 += v[1][j][0] * wa; a1 += v[1][j][1] * wb; a1 += v[1][j][2] * wc; a1 += v[1][j][3] * wd; }
            g8[0][q] = a0.x + a0.y; g8[1][q] = a1.x + a1.y; }
        const float gt0 = wave_sum8(g8[0], lane) * rs[0], gt1 = wave_sum8(g8[1], lane) * rs[1];
        if (lane < 8) { gout[(size_t)m * 8 + lane] = gt0; if (m1 != m) gout[(size_t)m1 * 8 + lane] = gt1; }
    }
}
__device__ __forceinline__ void attn_unit(int u, const bf16* P, const float2* rope, const float* sinks, bf16* Y, LAS unsigned char* lds, int tid) {
    asm volatile("; MARK_BEGIN_attn_unit");
    asm volatile("" : "+v"(tid));
    const int lane = tid & 63, wave = __builtin_amdgcn_readfirstlane(tid >> 6), fr = lane & 15, fq = lane >> 4;
    const int blk = u & 63, kvh = (u >> 6) & 1, b = u >> 7;
    LAS bf16* Ks = (LAS bf16*)lds;
    LAS bf16* Vt = Ks + 256 * 72;
    LAS f32x2_t* rq = (LAS f32x2_t*)(Vt + 64 * 264);
    const int tok0 = blk * 128 - 128;
    const int g = wave >> 1, half = wave & 1, hq = kvh * 4 + g;
    v4u qn0, qn1, qnp;
    { const int tq = blk * 128 + (half * 4) * 16 + fr; const bf16* qsrc = P + (size_t)(b * T + tq) * NE + hq * 64;
      qn0 = *(const v4u*)(qsrc + 8 * fq); qn1 = *(const v4u*)(qsrc + 32 + 8 * fq); qnp = *(const v4u*)(qsrc + 8 * ((fq ^ 1) & 1)); }
    { const f32x4 r4 = *(const f32x4*)((const float*)(rope + (size_t)(blk * 128) * 8) + tid * 4); *(LAS f32x4*)((LAS float*)rq + tid * 4) = r4; }
    {
        const int c = tid & 7;
        v4u vv[4], k0[4], k1[4];
#pragma unroll
        for (int j = 0; j < 4; ++j) { const int r = (tid >> 3) + 64 * j, t = tok0 + r; const bf16* src = P + (size_t)(b * T + (t < 0 ? 0 : t)) * NE;
            vv[j] = (v4u){0u, 0u, 0u, 0u}; k0[j] = vv[j]; k1[j] = vv[j];
            if (t >= 0) { vv[j] = *(const v4u*)(src + 640 + kvh * 64 + c * 8); if (c != 1) k0[j] = *(const v4u*)(src + 512 + kvh * 64 + c * 8); if (c == 0) k1[j] = *(const v4u*)(src + 512 + kvh * 64 + 8); } }
#pragma unroll
        for (int j = 0; j < 4; ++j) { const int r = (tid >> 3) + 64 * j, t = tok0 + r;
#pragma unroll
            for (int e = 0; e < 8; ++e) Vt[(c * 8 + e) * 264 + r] = (bf16)(vv[j][e >> 1] >> ((e & 1) * 16));
            if (c == 0) {
                float x1[8], x2[8], o1[8], o2[8]; unpack8(k0[j], x1); unpack8(k1[j], x2);
                const float2* cs = rope + (size_t)(t < 0 ? 0 : t) * 8;
#pragma unroll
                for (int e = 0; e < 8; ++e) { const float2 q = cs[e]; o1[e] = x1[e] * q.x - x2[e] * q.y; o2[e] = x2[e] * q.x + x1[e] * q.y; }
                *(LAS v4u*)(Ks + r * 72) = pack8(o1); *(LAS v4u*)(Ks + r * 72 + 8) = pack8(o2);
            } else if (c != 1) *(LAS v4u*)(Ks + r * 72 + c * 8) = k0[j]; }
    }
    __syncthreads();
    const float sink = sinks[hq];
#pragma unroll 1
    for (int a = 0; a < 4; ++a) {
        const int ag = half * 4 + a, i = ag * 16 + fr, tq = blk * 128 + i;
        float x0[8], x1v[8];
        const v4u qc0 = qn0, qc1 = qn1, qcp = qnp;
        if (a < 3) { const bf16* qsrc = P + (size_t)(b * T + tq + 16) * NE + hq * 64; qn0 = *(const v4u*)(qsrc + 8 * fq); qn1 = *(const v4u*)(qsrc + 32 + 8 * fq); qnp = *(const v4u*)(qsrc + 8 * ((fq ^ 1) & 1)); }
        unpack8(qc0, x0); unpack8(qc1, x1v);
        if (fq < 2) {
            float xp[8]; unpack8(qcp, xp);
            const LAS f32x2_t* cs = rq + i * 8;
#pragma unroll
            for (int e = 0; e < 8; ++e) { const f32x2_t q = cs[e]; x0[e] = (fq == 0) ? (x0[e] * q.x - xp[e] * q.y) : (x0[e] * q.x + xp[e] * q.y); }
        }
#pragma unroll
        for (int e = 0; e < 8; ++e) { x0[e] *= 0.125f; x1v[e] *= 0.125f; }
        bf16x8 qf[2]; qf[0] = __builtin_bit_cast(bf16x8, pack8(x0)); qf[1] = __builtin_bit_cast(bf16x8, pack8(x1v));
        const int kt0 = ag < 6 ? ag : 6;
        f32x4 sacc[10];
#pragma unroll
        for (int j = 0; j < 10; ++j) { f32x4 acc = (f32x4){0.f, 0.f, 0.f, 0.f};
#pragma unroll
            for (int s = 0; s < 2; ++s) { const bf16x8 A = *(const LAS bf16x8*)(Ks + (16 * (kt0 + j) + fr) * 72 + 32 * s + 8 * fq); acc = mfma16(A, qf[s], acc); }
            sacc[j] = acc; }
        float mx = sink;
#pragma unroll
        for (int j = 0; j < 10; ++j)
#pragma unroll
            for (int r = 0; r < 4; ++r) { const int key = 16 * (kt0 + j) + 4 * fq + r; const bool valid = (key > i) && (key <= i + 128) && (blk > 0 || key >= 128);
                sacc[j][r] = valid ? sacc[j][r] : -INFINITY; mx = fmaxf(mx, sacc[j][r]); }
        mx = quad_max(mx);
        float sum = 0.f;
#pragma unroll
        for (int j = 0; j < 10; ++j)
#pragma unroll
            for (int r = 0; r < 4; ++r) { const float p = __expf(sacc[j][r] - mx); sacc[j][r] = p; sum += p; }
        sum = quad_sum(sum) + __expf(sink - mx);
        f32x4 o[4];
#pragma unroll
        for (int dt = 0; dt < 4; ++dt) o[dt] = (f32x4){0.f, 0.f, 0.f, 0.f};
#pragma unroll
        for (int jp = 0; jp < 5; ++jp) { const bf16x8 Bf = frag8(sacc[2 * jp], sacc[2 * jp + 1]);
#pragma unroll
            for (int dt = 0; dt < 4; ++dt) { const LAS bf16* vp = Vt + (16 * dt + fr) * 264 + 16 * (kt0 + 2 * jp) + 4 * fq;
                const bf16x8 A = frag2(*(const LAS v2u*)vp, *(const LAS v2u*)(vp + 16)); o[dt] = mfma16(A, Bf, o[dt]); } }
        const float inv = 1.f / sum;
        bf16* yo = Y + (size_t)(b * T + tq) * D + hq * 64 + 4 * fq;
#pragma unroll
        for (int dt = 0; dt < 4; ++dt) { v2u w; w.x = pk2(o[dt][0] * inv, o[dt][1] * inv); w.y = pk2(o[dt][2] * inv, o[dt][3] * inv); *(v2u*)(yo + 16 * dt) = w; }
    }
    __syncthreads();
}
__device__ __forceinline__ void ml_conv8(const bf16* P, int b, int tt, int ch, const float* convw, const float* convb, float (&acc)[8]) {
    { const f32x4 b0 = *(const f32x4*)(convb + ch), b1 = *(const f32x4*)(convb + ch + 4); acc[0] = b0.x; acc[1] = b0.y; acc[2] = b0.z; acc[3] = b0.w; acc[4] = b1.x; acc[5] = b1.y; acc[6] = b1.z; acc[7] = b1.w; }
#pragma unroll
    for (int tap = 0; tap < 4; ++tap) { const int t2 = tt - 3 + tap;
        if (t2 >= 0) { float x[8]; unpack8(*(const v4u*)(P + (size_t)(b * T + t2) * NE + 768 + ch), x);
            const f32x4 w0 = *(const f32x4*)(convw + tap * 512 + ch), w1 = *(const f32x4*)(convw + tap * 512 + ch + 4);
            acc[0] += x[0] * w0.x; acc[1] += x[1] * w0.y; acc[2] += x[2] * w0.z; acc[3] += x[3] * w0.w; acc[4] += x[4] * w1.x; acc[5] += x[5] * w1.y; acc[6] += x[6] * w1.z; acc[7] += x[7] * w1.w; } }
#pragma unroll
    for (int e = 0; e < 8; ++e) acc[e] = siluf_(acc[e]);
}
__device__ __forceinline__ void ml_gates(const float* G0, size_t row0, int h, const float* ibias, const float* fbias, int lane, float& b0, float& b1, float& li0, float& li1, float& bL) {
    const float fb = fbias[h], ib = ibias[h];
    const float f0 = G0[(row0 + 2 * lane) * 8 + 4 + h] + fb, f1 = G0[(row0 + 2 * lane + 1) * 8 + 4 + h] + fb;
    li0 = G0[(row0 + 2 * lane) * 8 + h] + ib; li1 = G0[(row0 + 2 * lane + 1) * 8 + h] + ib;
    const float lf0 = -softplusf_(-f0), lf1 = -softplusf_(-f1);
    const float ps = scan_add(lf0 + lf1, lane);
    b1 = ps; b0 = ps - lf1; bL = __shfl(ps, 63);
}
__device__ __forceinline__ void mlstm_local_unit(int u, const bf16* P, const float* G0, const float* convw, const float* convb, const float* ibias, const float* fbias,
                                                 float* CT, float* NL, float* MLs, LAS unsigned char* lds, int tid) {
    asm volatile("; MARK_BEGIN_mlstm_local_unit");
    asm volatile("" : "+v"(tid));
    const int lane = tid & 63, wave = __builtin_amdgcn_readfirstlane(tid >> 6), fr = lane & 15, fq = lane >> 4;
    const int c = u & 63, h = (u >> 6) & 3, b = u >> 8, bh = b * 4 + h;
    const size_t row0 = (size_t)b * T + c * 128;
    LAS bf16* kT = (LAS bf16*)lds;
    LAS bf16* vT = kT + 64 * 136;
    LAS float* wg = (LAS float*)(vT + 128 * 136);
    const int kc8 = tid & 7, ktg = (tid >> 3) & 31, kch = 256 + h * 64 + kc8 * 8;
    const int vt2 = tid - 256, vc8 = vt2 & 15, vtq = (vt2 >> 4) & 15;
    v4u raw[8];
    if (tid < 256) { v4u r7[7]; load_rows<4>(P + (size_t)(b * T) * NE + 768 + kch, NE, c * 128 + 4 * ktg, r7);
#pragma unroll
        for (int i = 0; i < 7; ++i) raw[i] = r7[i]; }
    else {
#pragma unroll
        for (int i = 0; i < 8; ++i) raw[i] = *(const v4u*)(P + (row0 + 8 * vtq + i) * NE + 1280 + h * 128 + vc8 * 8); }
    if (wave == 0) {
        float b0, b1, li0, li1, bL; ml_gates(G0, row0, h, ibias, fbias, lane, b0, b1, li0, li1, bL);
        const float a0 = bL - b0 + li0, a1 = bL - b1 + li1; const float ml = wave_max(fmaxf(a0, a1));
        wg[2 * lane] = expf(a0 - ml); wg[2 * lane + 1] = expf(a1 - ml);
        if (lane == 0) { MLs[(bh * 64 + c) * 2] = ml; MLs[(bh * 64 + c) * 2 + 1] = bL; }
    }
    __syncthreads();
    if (tid < 256) {
        v4u r7[7];
#pragma unroll
        for (int i = 0; i < 7; ++i) r7[i] = raw[i];
        float o[4][8]; conv_silu<4>(r7, convw + kch, 512, convb + kch, o);
        const f32x4 sc4 = *(const LAS f32x4*)(wg + 4 * ktg);
#pragma unroll
        for (int e = 0; e < 8; ++e) { v2u w; w.x = pk2(o[0][e] * 0.125f * sc4.x, o[1][e] * 0.125f * sc4.y); w.y = pk2(o[2][e] * 0.125f * sc4.z, o[3][e] * 0.125f * sc4.w); *(LAS v2u*)(kT + tsw(kc8 * 8 + e, 4 * ktg)) = w; }
    } else {
#pragma unroll
        for (int e = 0; e < 8; ++e) { v4u w;
#pragma unroll
            for (int p = 0; p < 4; ++p) { const unsigned lo = (raw[2 * p][e >> 1] >> ((e & 1) * 16)) & 0xffffu, hi = (raw[2 * p + 1][e >> 1] >> ((e & 1) * 16)) & 0xffffu; w[p] = lo | (hi << 16); }
            *(LAS v4u*)(vT + tsw(vc8 * 8 + e, 8 * vtq)) = w; }
    }
    __syncthreads();
    if (tid < 64) { float s = 0.f;
#pragma unroll
        for (int t8 = 0; t8 < 16; ++t8) { float x[8]; unpack8(*(const LAS v4u*)(kT + tsw(tid, 8 * t8)), x); s += ((x[0] + x[1]) + (x[2] + x[3])) + ((x[4] + x[5]) + (x[6] + x[7])); }
        NL[(size_t)(bh * 64 + c) * 64 + tid] = s; }
    f32x4 acc[4];
#pragma unroll
    for (int k = 0; k < 4; ++k) acc[k] = (f32x4){0.f, 0.f, 0.f, 0.f};
#pragma unroll
    for (int ks = 0; ks < 4; ++ks) { const bf16x8 A = *(const LAS bf16x8*)(vT + tsw(16 * wave + fr, 32 * ks + 8 * fq));
#pragma unroll
        for (int k = 0; k < 4; ++k) { const bf16x8 Bf = *(const LAS bf16x8*)(kT + tsw(16 * k + fr, 32 * ks + 8 * fq)); acc[k] = mfma16(Bf, A, acc[k]); } }
    float* ct = CT + ((size_t)(bh * 64 + c) * 128 + 16 * wave + fr) * 64 + 4 * fq;
#pragma unroll
    for (int k = 0; k < 4; ++k) *(f32x4*)(ct + 16 * k) = acc[k];
    __syncthreads();
}
__device__ __forceinline__ void mlstm_scan_phase(float* CT, float* NL, const float* MLs, float* Mprev, LAS unsigned char* lds, int tid, int G) {
    LAS float* fab = (LAS float*)lds;
    for (int e0 = blockIdx.x * 512; e0 < 16 * 8192; e0 += G * 512) {
        const int e = e0 + tid; const int bh = e0 >> 13, idx = e & 8191;
        if (tid < 64) { const int c = tid;
            const float ml = MLs[(bh * 64 + c) * 2], gl = MLs[(bh * 64 + c) * 2 + 1];
            float A = gl, B = ml;
#pragma unroll
            for (int o = 1; o < 64; o <<= 1) { const float Ap = __shfl_up(A, o), Bp = __shfl_up(B, o); if (c >= o) { B = fmaxf(Bp + A, B); A = Ap + A; } }
            const float mn = fmaxf(A, B);
            float mp = __shfl_up(mn, 1); if (c == 0) mp = 0.f;
            fab[2 * c] = __expf(gl + mp - mn); fab[2 * c + 1] = __expf(ml - mn);
            if ((e0 & 8191) == 0) Mprev[bh * 64 + c] = mp; }
        __syncthreads();
        float C = 0.f, n = 0.f;
        float* cp = CT + (size_t)bh * 64 * 8192 + idx; float* np = NL + (size_t)bh * 64 * 64 + idx; bf16* cb = (bf16*)(CT + (size_t)16 * 64 * 8192) + (size_t)bh * 64 * 8192 + idx;
#pragma unroll 1
        for (int c0 = 0; c0 < 64; c0 += 32) { float cl[32];
#pragma unroll
            for (int c = 0; c < 32; ++c) cl[c] = cp[(size_t)(c0 + c) * 8192];
#pragma unroll
            for (int c = 0; c < 32; ++c) { const f32x2_t f2 = *(const LAS f32x2_t*)(fab + 2 * (c0 + c)); const float fa = f2.x, fb = f2.y;
                cb[(size_t)(c0 + c) * 8192] = tobf(C); C = fa * C + fb * cl[c];
                if (idx < 64) { const float nl = np[(c0 + c) * 64]; np[(c0 + c) * 64] = n; n = fa * n + fb * nl; } } }
        __syncthreads();
    }
}
__device__ __forceinline__ void mlstm_out_unit(int u, const bf16* P, const float* G0, const float* convw, const float* convb, const float* ibias, const float* fbias, const float* mlnorm,
                                               const float* CT, const float* NL, const float* Mprev, bf16* Y, LAS unsigned char* lds, int tid) {
    asm volatile("; MARK_BEGIN_mlstm_out_unit");
    asm volatile("" : "+v"(tid));
    const int lane = tid & 63, wave = __builtin_amdgcn_readfirstlane(tid >> 6), fr = lane & 15, fq = lane >> 4;
    const int c = u & 63, h = (u >> 6) & 3, b = u >> 8, bh = b * 4 + h;
    const size_t row0 = (size_t)b * T + c * 128;
    LAS bf16* qs = (LAS bf16*)lds;
    LAS bf16* ks = qs + 128 * 72;
    LAS bf16* vT = ks + 128 * 72;
    LAS bf16* cts = vT + 128 * 136;
    LAS float* bc = (LAS float*)(cts + 128 * 72);
    LAS float* lis = bc + 128; LAS float* mxs = lis + 128; LAS float* npv = mxs + 128;
    const float mp_pre = Mprev[bh * 64 + c];
    if (wave == 0) {
        float b0, b1, li0, li1, bL; ml_gates(G0, row0, h, ibias, fbias, lane, b0, b1, li0, li1, bL);
        const float d0 = li0 - b0, d1 = li1 - b1; const float sm = scan_max(fmaxf(d0, d1), lane); float ex = __shfl_up(sm, 1); if (lane == 0) ex = -INFINITY;
        const float m0 = fmaxf(ex, d0);
        bc[2 * lane] = b0; bc[2 * lane + 1] = b1; lis[2 * lane] = li0; lis[2 * lane + 1] = li1; mxs[2 * lane] = m0; mxs[2 * lane + 1] = sm;
        npv[lane] = NL[(size_t)(bh * 64 + c) * 64 + lane];
    }
    {
        const int isk = tid >> 8, c8 = tid & 7, tg = (tid >> 3) & 31, ch = isk * 256 + h * 64 + c8 * 8;
        v4u raw[7]; load_rows<4>(P + (size_t)(b * T) * NE + 768 + ch, NE, c * 128 + 4 * tg, raw);
        const int vc8 = tid & 15, vtq = tid >> 4;
        v4u vr[4];
#pragma unroll
        for (int i = 0; i < 4; ++i) vr[i] = *(const v4u*)(P + (row0 + 4 * vtq + i) * NE + 1280 + h * 128 + vc8 * 8);
        v4u cr[2];
#pragma unroll
        for (int j = 0; j < 2; ++j) { const int it = tid + 512 * j, vd = it >> 3, cc8 = it & 7; const bf16* sp = (const bf16*)(CT + (size_t)16 * 64 * 8192) + ((size_t)(bh * 64 + c) * 128 + vd) * 64 + cc8 * 8; cr[j] = *(const v4u*)sp; }
        float o[4][8]; conv_silu<4>(raw, convw + ch, 512, convb + ch, o);
        const float qs_ = isk ? 0.125f : 1.0f;
#pragma unroll
        for (int i = 0; i < 4; ++i) {
#pragma unroll
            for (int e = 0; e < 8; ++e) o[i][e] *= qs_;
            *(LAS v4u*)((isk ? ks : qs) + (4 * tg + i) * 72 + c8 * 8) = pack8(o[i]); }
#pragma unroll
        for (int e = 0; e < 8; ++e) { v2u w;
#pragma unroll
            for (int p = 0; p < 2; ++p) { const unsigned lo = (vr[2 * p][e >> 1] >> ((e & 1) * 16)) & 0xffffu, hi = (vr[2 * p + 1][e >> 1] >> ((e & 1) * 16)) & 0xffffu; w[p] = lo | (hi << 16); }
            *(LAS v2u*)(vT + tsw(vc8 * 8 + e, 4 * vtq)) = w; }
#pragma unroll
        for (int j = 0; j < 2; ++j) { const int it = tid + 512 * j, vd = it >> 3, cc8 = it & 7; *(LAS v4u*)(cts + vd * 72 + cc8 * 8) = cr[j]; }
    }
    __syncthreads();
    {
        const int w = (wave < 4) ? 7 - wave : wave - 4, t = 16 * w + fr;
        v2u oq[8]; f32x4 gq[8];
        { const bf16* op = P + (row0 + t) * NE + 1792 + h * 128 + 4 * fq; const float* gn = mlnorm + h * 128 + 4 * fq;
#pragma unroll
          for (int vt = 0; vt < 8; ++vt) { oq[vt] = *(const v2u*)(op + 16 * vt); gq[vt] = *(const f32x4*)(gn + 16 * vt); } }
        const float bt = bc[t], mp = mp_pre;
        const float il = bt + mp, mt = fmaxf(il, bt + mxs[t]), winter = __expf(il - mt);
        bf16x8 qf[2]; qf[0] = *(const LAS bf16x8*)(qs + t * 72 + 8 * fq); qf[1] = *(const LAS bf16x8*)(qs + t * 72 + 32 + 8 * fq);
        f32x4 p[8]; float den = 0.f;
#pragma unroll
        for (int st = 0; st < 8; ++st) { p[st] = (f32x4){0.f, 0.f, 0.f, 0.f};
            if (st <= w) { f32x4 acc = (f32x4){0.f, 0.f, 0.f, 0.f};
#pragma unroll
                for (int s2 = 0; s2 < 2; ++s2) { const bf16x8 A = *(const LAS bf16x8*)(ks + (16 * st + fr) * 72 + 32 * s2 + 8 * fq); acc = mfma16(A, qf[s2], acc); }
#pragma unroll
                for (int r = 0; r < 4; ++r) { const int s = 16 * st + 4 * fq + r; const float e = (s <= t) ? __expf(bt - bc[s] + lis[s] - mt) : 0.f; const float val = acc[r] * e; den += val; p[st][r] = val; } } }
        den = quad_sum(den);
        float qn = 0.f;
        { float x[8]; unpack8(__builtin_bit_cast(v4u, qf[0]), x);
#pragma unroll
          for (int e = 0; e < 8; ++e) qn += x[e] * npv[8 * fq + e];
          unpack8(__builtin_bit_cast(v4u, qf[1]), x);
#pragma unroll
          for (int e = 0; e < 8; ++e) qn += x[e] * npv[32 + 8 * fq + e]; }
        qn = quad_sum(qn);
        const float dent = den + winter * qn, inv = 1.f / fmaxf(fabsf(dent), __expf(-mt));
        f32x4 hv[8]; float s1 = 0.f;
#pragma unroll
        for (int vt = 0; vt < 8; ++vt) { f32x4 a2 = (f32x4){0.f, 0.f, 0.f, 0.f}, a3 = a2;
#pragma unroll
            for (int jp = 0; jp < 4; ++jp) if (2 * jp <= w) { const int vr = 16 * vt + fr;
                const bf16x8 A = frag2(*(const LAS v2u*)(vT + tsw(vr, 32 * jp + 4 * fq)), *(const LAS v2u*)(vT + tsw(vr, 32 * jp + 16 + 4 * fq))); a2 = mfma16(A, frag8(p[2 * jp], p[2 * jp + 1]), a2); }
#pragma unroll
            for (int s2 = 0; s2 < 2; ++s2) { const bf16x8 A = *(const LAS bf16x8*)(cts + (16 * vt + fr) * 72 + 32 * s2 + 8 * fq); a3 = mfma16(A, qf[s2], a3); }
            hv[vt] = (a2 + winter * a3) * inv; s1 += (hv[vt][0] + hv[vt][1]) + (hv[vt][2] + hv[vt][3]); asm volatile("" ::: "memory"); }
        const float mean = quad_sum(s1) * (1.f / 128.f); float s2v = 0.f;
#pragma unroll
        for (int vt = 0; vt < 8; ++vt) { hv[vt] = hv[vt] - mean; s2v += (hv[vt][0] * hv[vt][0] + hv[vt][1] * hv[vt][1]) + (hv[vt][2] * hv[vt][2] + hv[vt][3] * hv[vt][3]); }
        const float rstd = 1.0f / sqrtf(quad_sum(s2v) * (1.f / 128.f) + 1e-6f);
        bf16* yo = Y + (row0 + t) * D + 512 + h * 128 + 4 * fq;
#pragma unroll
        for (int vt = 0; vt < 8; ++vt) { const v2u ov = oq[vt]; const f32x4 g4 = gq[vt];
            const float y0 = hv[vt][0] * rstd * g4.x * sigmoidf_(bflo(ov.x)), y1 = hv[vt][1] * rstd * g4.y * sigmoidf_(bfhi(ov.x)), y2 = hv[vt][2] * rstd * g4.z * sigmoidf_(bflo(ov.y)), y3 = hv[vt][3] * rstd * g4.w * sigmoidf_(bfhi(ov.y));
            v2u w2; w2.x = pk2(y0, y1); w2.y = pk2(y2, y3); *(v2u*)(yo + 16 * vt) = w2; }
    }
    __syncthreads();
}
__device__ __forceinline__ void ssm_conv8(const bf16* P, int b, int tt, int pcol, int cch, const float* convw, const float* convb, float (&acc)[8]) {
    { const f32x4 b0 = *(const f32x4*)(convb + cch), b1 = *(const f32x4*)(convb + cch + 4); acc[0] = b0.x; acc[1] = b0.y; acc[2] = b0.z; acc[3] = b0.w; acc[4] = b1.x; acc[5] = b1.y; acc[6] = b1.z; acc[7] = b1.w; }
#pragma unroll
    for (int tap = 0; tap < 4; ++tap) { const int t2 = tt - 3 + tap;
        if (t2 >= 0) { float x[8]; unpack8(*(const v4u*)(P + (size_t)(b * T + t2) * NO + pcol), x);
            const f32x4 w0 = *(const f32x4*)(convw + tap * 1024 + cch), w1 = *(const f32x4*)(convw + tap * 1024 + cch + 4);
            acc[0] += x[0] * w0.x; acc[1] += x[1] * w0.y; acc[2] += x[2] * w0.z; acc[3] += x[3] * w0.w; acc[4] += x[4] * w1.x; acc[5] += x[5] * w1.y; acc[6] += x[6] * w1.z; acc[7] += x[7] * w1.w; } }
#pragma unroll
    for (int e = 0; e < 8; ++e) acc[e] = siluf_(acc[e]);
}
__device__ __forceinline__ float ssm_dt_wave(const float* DT, size_t row0, int hd, const float* dtbias, const float* alog, int lane, LAS float* dtv, LAS float* acum) {
    const float db = dtbias[hd], A = -expf(alog[hd]);
    const float d0 = softplusf_(DT[(row0 + 2 * lane) * 8 + hd] + db), d1 = softplusf_(DT[(row0 + 2 * lane + 1) * 8 + hd] + db);
    const float ps = scan_add(d0 * A + d1 * A, lane);
    dtv[2 * lane] = d0; dtv[2 * lane + 1] = d1; acum[2 * lane] = ps - d1 * A; acum[2 * lane + 1] = ps;
    return __shfl(ps, 63);
}
__device__ __forceinline__ void ssd_local_unit(int u, const bf16* P, const float* DT, const float* convw, const float* convb, const float* dtbias, const float* alog,
                                               float* ST, float* DEC, LAS unsigned char* lds, int tid) {
    asm volatile("; MARK_BEGIN_ssd_local_unit");
    asm volatile("" : "+v"(tid));
    const int lane = tid & 63, wave = __builtin_amdgcn_readfirstlane(tid >> 6), fr = lane & 15, fq = lane >> 4;
    const int c = u & 63, g = (u >> 6) & 1, b = u >> 7;
    const size_t row0 = (size_t)b * T + c * 128;
    LAS bf16* xT = (LAS bf16*)lds;
    LAS bf16* bT = xT + 256 * 136;
    LAS float* dtv = (LAS float*)(bT + 128 * 136);
    LAS float* acum = dtv + 512;
    const int c8 = tid & 31, tg = tid >> 5, cch = g * 256 + c8 * 8;
    v4u raw[11]; load_rows<8>(P + (size_t)(b * T) * NO + 512 + cch, NO, c * 128 + 8 * tg, raw);
    const int bc8 = tid & 15, btg = tid >> 4, bch = 512 + g * 128 + bc8 * 8;
    v4u rawb[7]; load_rows<4>(P + (size_t)(b * T) * NO + 1024 + g * 128 + bc8 * 8, NO, c * 128 + 4 * btg, rawb);
    if (wave < 4) { const int hd = 4 * g + wave; const float al = ssm_dt_wave(DT, row0, hd, dtbias, alog, lane, dtv + wave * 128, acum + wave * 128);
        if (lane == 0) DEC[(b * 64 + c) * 8 + hd] = expf(al);
        LAS float* ac = acum + wave * 128; LAS float* dv = dtv + wave * 128;
        ac[2 * lane] = dv[2 * lane] * expf(al - ac[2 * lane]); ac[2 * lane + 1] = dv[2 * lane + 1] * expf(al - ac[2 * lane + 1]); }
    __syncthreads();
    {
        { float o[8][8]; conv_silu<8>(raw, convw + cch, 1024, convb + cch, o);
          const LAS float* scp = acum + (c8 >> 3) * 128 + 8 * tg; const f32x4 s0 = *(const LAS f32x4*)scp, s1 = *(const LAS f32x4*)(scp + 4);
#pragma unroll
          for (int e = 0; e < 8; ++e) { v4u w; w.x = pk2(o[0][e] * s0.x, o[1][e] * s0.y); w.y = pk2(o[2][e] * s0.z, o[3][e] * s0.w); w.z = pk2(o[4][e] * s1.x, o[5][e] * s1.y); w.w = pk2(o[6][e] * s1.z, o[7][e] * s1.w);
              *(LAS v4u*)(xT + tsw(c8 * 8 + e, 8 * tg)) = w; } }
        { float o[4][8]; conv_silu<4>(rawb, convw + bch, 1024, convb + bch, o);
#pragma unroll
          for (int e = 0; e < 8; ++e) { v2u w; w.x = pk2(o[0][e], o[1][e]); w.y = pk2(o[2][e], o[3][e]); *(LAS v2u*)(bT + tsw(bc8 * 8 + e, 4 * btg)) = w; } }
    }
    __syncthreads();
#pragma unroll
    for (int rr = 0; rr < 2; ++rr) { const int rt = 2 * wave + rr;
        f32x4 acc[8];
#pragma unroll
        for (int nt = 0; nt < 8; ++nt) acc[nt] = (f32x4){0.f, 0.f, 0.f, 0.f};
#pragma unroll
        for (int ks = 0; ks < 4; ++ks) { const bf16x8 A = *(const LAS bf16x8*)(xT + tsw(16 * rt + fr, 32 * ks + 8 * fq));
#pragma unroll
            for (int nt = 0; nt < 8; ++nt) { const bf16x8 Bf = *(const LAS bf16x8*)(bT + tsw(16 * nt + fr, 32 * ks + 8 * fq)); acc[nt] = mfma16(Bf, A, acc[nt]); } }
        const int hd = 4 * g + (rt >> 2), p0 = (rt & 3) * 16 + fr;
        float* sp = ST + (((size_t)(b * 64 + c) * 8 + hd) * 64 + p0) * 128 + 4 * fq;
#pragma unroll
        for (int nt = 0; nt < 8; ++nt) *(f32x4*)(sp + 16 * nt) = acc[nt]; }
    __syncthreads();
}
__device__ __forceinline__ void ssd_scan_phase(float* ST, const float* DEC, int tid, int G) {
    const int wave = tid >> 6; if (wave == 0) return;
    for (int e = (blockIdx.x * 7 + wave - 1) * 64 + (tid & 63); e < 4 * 8 * 8192; e += G * 7 * 64) {
        const int b = e >> 16, hd = (e >> 13) & 7, pn = e & 8191; float S = 0.f;
        float* sp = ST + ((size_t)(b * 64) * 8 + hd) * 8192 + pn;
#pragma unroll 1
        for (int c0 = 0; c0 < 64; c0 += 32) { float st[32], dc[32];
#pragma unroll
            for (int c = 0; c < 32; ++c) { st[c] = sp[(size_t)(c0 + c) * 65536]; dc[c] = DEC[(b * 64 + c0 + c) * 8 + hd]; }
#pragma unroll
            for (int c = 0; c < 32; ++c) { sp[(size_t)(c0 + c) * 65536] = S; S = S * dc[c] + st[c]; } }
    }
}
__device__ __forceinline__ void ssd_scan_pair(float* ST, const float* DEC, int pr, int k8, int tid) {
    const int b = pr >> 1, g = pr & 1;
    for (int e = k8 * 512 + tid; e < 4 * 8192; e += 8 * 512) {
        const int hd = 4 * g + (e >> 13), pn = e & 8191; float S = 0.f;
        float* sp = ST + ((size_t)(b * 64) * 8 + hd) * 8192 + pn;
#pragma unroll 1
        for (int c0 = 0; c0 < 64; c0 += 32) { float st[32], dc[32];
#pragma unroll
            for (int c = 0; c < 32; ++c) { st[c] = sp[(size_t)(c0 + c) * 65536]; dc[c] = DEC[(b * 64 + c0 + c) * 8 + hd]; }
#pragma unroll
            for (int c = 0; c < 32; ++c) { sp[(size_t)(c0 + c) * 65536] = S; S = S * dc[c] + st[c]; } }
    }
}
#ifndef SO_R1
#define SO_R1 1
#endif
#ifndef SO_R3
#define SO_R3 1
#endif
__device__ __forceinline__ void ssd_out_unit(int u, const bf16* P, const float* DT, const float* convw, const float* convb, const float* dtbias, const float* alog, const float* dskip, const float* gnorm,
                                             const float* ST, bf16* Y, LAS unsigned char* lds, int tid) {
    asm volatile("; MARK_BEGIN_ssd_out_unit");
    asm volatile("" : "+v"(tid));
    const int lane = tid & 63, wave = __builtin_amdgcn_readfirstlane(tid >> 6), fr = lane & 15, fq = lane >> 4;
    const int c = u & 63, g = (u >> 6) & 1, b = u >> 7;
    const size_t row0 = (size_t)b * T + c * 128;
    LAS bf16* xT = (LAS bf16*)lds;
    LAS bf16* bm = xT + 256 * 136;
    LAS bf16* cm = bm + 128 * 136;
    LAS float* dtv = (LAS float*)(cm + 128 * 136);
    LAS float* acum = dtv + 512;
    if (wave < 4) (void)ssm_dt_wave(DT, row0, 4 * g + wave, dtbias, alog, lane, dtv + wave * 128, acum + wave * 128);
    for (int sp1 = 0; sp1 < SO_R1; ++sp1) {
        const int c8 = tid & 31, tg = tid >> 5, cch = g * 256 + c8 * 8;
        v4u raw[11]; load_rows<8>(P + (size_t)(b * T) * NO + 512 + cch, NO, c * 128 + 8 * tg, raw);
        { float o[8][8]; conv_silu<8>(raw, convw + cch, 1024, convb + cch, o);
#pragma unroll
          for (int e = 0; e < 8; ++e) { v4u w; w.x = pk2(o[0][e], o[1][e]); w.y = pk2(o[2][e], o[3][e]); w.z = pk2(o[4][e], o[5][e]); w.w = pk2(o[6][e], o[7][e]); *(LAS v4u*)(xT + tsw(c8 * 8 + e, 8 * tg)) = w; } }
        const int isc = tid >> 8, bc8 = tid & 15, btg = (tid >> 4) & 15, bch = 512 + isc * 256 + g * 128 + bc8 * 8;
        v4u rawb[11]; load_rows<8>(P + (size_t)(b * T) * NO + 1024 + isc * 256 + g * 128 + bc8 * 8, NO, c * 128 + 8 * btg, rawb);
        { float o[8][8]; conv_silu<8>(rawb, convw + bch, 1024, convb + bch, o);
#pragma unroll
          for (int i = 0; i < 8; ++i) *(LAS v4u*)((isc ? cm : bm) + (8 * btg + i) * 136 + bc8 * 8) = pack8(o[i]); }
    }
    __syncthreads();
    {
        const int w = wave, t = 16 * w + fr;
        const f32x4 dsk4 = *(const f32x4*)(dskip + 4 * g);
        const bf16* zp0 = P + (row0 + t) * NO + 4 * g * 64 + 4 * fq;
        v2u zn[4];
#pragma unroll
        for (int pt = 0; pt < 4; ++pt) zn[pt] = *(const v2u*)(zp0 + 16 * pt);
        f32x4 sraw[16];
        { const float* sp0 = ST + ((size_t)(b * 64 + c) * 8 + 4 * g) * 8192;
#pragma unroll
          for (int i = 0; i < 16; ++i) sraw[i] = *(const f32x4*)(sp0 + (size_t)(tid + 512 * i) * 4); }
        bf16x8 cf[4];
#pragma unroll
        for (int ks = 0; ks < 4; ++ks) cf[ks] = *(const LAS bf16x8*)(cm + t * 136 + 32 * ks + 8 * fq);
        f32x4 cb[8];
#pragma unroll
        for (int st = 0; st < 8; ++st) { cb[st] = (f32x4){0.f, 0.f, 0.f, 0.f};
            if (st <= w) {
#pragma unroll
                for (int ks = 0; ks < 4; ++ks) { const bf16x8 A = *(const LAS bf16x8*)(bm + (16 * st + fr) * 136 + 32 * ks + 8 * fq); cb[st] = mfma16(A, cf[ks], cb[st]); } } }
        __syncthreads();
        LAS bf16* sl = bm;
#pragma unroll
        for (int i = 0; i < 16; ++i) { const int e4 = tid + 512 * i, row = e4 >> 5, c4 = (e4 & 31) * 4;
            v2u wv; wv.x = pk2(sraw[i][0], sraw[i][1]); wv.y = pk2(sraw[i][2], sraw[i][3]); *(LAS v2u*)(sl + row * 136 + c4) = wv; }
        __syncthreads();
        float ss = 0.f;
        bf16* yo = Y + (row0 + t) * D + g * 256 + 4 * fq;
        for (int sp3 = 0; sp3 < SO_R3; ++sp3) { ss = 0.f;
#pragma unroll
        for (int pt = 0; pt < 4; ++pt) zn[pt] = *(const v2u*)(zp0 + 16 * pt);
#pragma unroll 1
        for (int j = 0; j < 4; ++j) {
            v2u zc[4];
#pragma unroll
            for (int pt = 0; pt < 4; ++pt) zc[pt] = zn[pt];
            if (j < 3) {
#pragma unroll
                for (int pt = 0; pt < 4; ++pt) zn[pt] = *(const v2u*)(zp0 + (j + 1) * 64 + 16 * pt); }
            const int hd = 4 * g + j; const float at = acum[j * 128 + t], eat = __expf(at), dh = (j == 0) ? dsk4.x : (j == 1) ? dsk4.y : (j == 2) ? dsk4.z : dsk4.w;
            bf16x8 pf[4];
#pragma unroll
            for (int jp = 0; jp < 4; ++jp) { f32x4 p0 = (f32x4){0.f, 0.f, 0.f, 0.f}, p1 = p0;
                if (2 * jp <= w) {
#pragma unroll
                    for (int r = 0; r < 4; ++r) { const int s0 = 32 * jp + 4 * fq + r, s1 = s0 + 16;
                        p0[r] = (s0 <= t) ? cb[2 * jp][r] * __expf(at - acum[j * 128 + s0]) * dtv[j * 128 + s0] : 0.f;
                        p1[r] = (s1 <= t) ? cb[2 * jp + 1][r] * __expf(at - acum[j * 128 + s1]) * dtv[j * 128 + s1] : 0.f; } }
                pf[jp] = frag8(p0, p1); }
#pragma unroll
            for (int pt = 0; pt < 4; ++pt) { f32x4 a2 = (f32x4){0.f, 0.f, 0.f, 0.f}, a3 = a2;
#pragma unroll
                for (int jp = 0; jp < 4; ++jp) if (2 * jp <= w) { const int xr = j * 64 + 16 * pt + fr;
                    a2 = mfma16(frag2(*(const LAS v2u*)(xT + tsw(xr, 32 * jp + 4 * fq)), *(const LAS v2u*)(xT + tsw(xr, 32 * jp + 16 + 4 * fq))), pf[jp], a2); }
#pragma unroll
                for (int ks = 0; ks < 4; ++ks) a3 = mfma16(*(const LAS bf16x8*)(sl + (j * 64 + 16 * pt + fr) * 136 + 32 * ks + 8 * fq), cf[ks], a3);
                const v2u zv = zc[pt]; const float zz[4] = {bflo(zv.x), bfhi(zv.x), bflo(zv.y), bfhi(zv.y)};
                float y4[4];
#pragma unroll
                for (int r = 0; r < 4; ++r) { const float xv = bf1(xT[tsw(j * 64 + 16 * pt + 4 * fq + r, t)]); const float y = (a2[r] + eat * a3[r] + dh * xv) * siluf_(zz[r]); y4[r] = y; ss += y * y; }
                v2u w2; w2.x = pk2(y4[0], y4[1]); w2.y = pk2(y4[2], y4[3]); *(v2u*)(yo + j * 64 + 16 * pt) = w2; }
        } }
        const float rs = 1.0f / sqrtf(quad_sum(ss) * (1.f / 256.f) + 1e-5f);
        { const float* gn = gnorm + g * 256 + 4 * fq; f32x4 gq[16]; v2u yq[16];
#pragma unroll
          for (int q = 0; q < 16; ++q) { gq[q] = *(const f32x4*)(gn + 16 * q); yq[q] = *(const v2u*)(yo + 16 * q); }
#pragma unroll
          for (int q = 0; q < 16; ++q) { const f32x4 g4 = gq[q]; const v2u yv = yq[q];
              v2u w2; w2.x = pk2(bflo(yv.x) * rs * g4.x, bfhi(yv.x) * rs * g4.y); w2.y = pk2(bflo(yv.y) * rs * g4.z, bfhi(yv.y) * rs * g4.w); *(v2u*)(yo + 16 * q) = w2; } }
    }
    __syncthreads();
}
constexpr int RW_RS = 0, RW_KS = 9216, RW_VS = 18432, RW_GG = 27648;
constexpr int RW_BONP = 36864, RW_SSQ = 37888;
constexpr int RW_X = 39936;
constexpr int RW_TW = RW_X, RW_AD = RW_X + 9216, RW_GD = RW_X + 18432;
constexpr int RW_MK = RW_X, RW_NN = RW_X + 3072, RW_MB = RW_NN + 5120, RW_TT = RW_MB + 4096, RW_YO = RW_X + 16384;
constexpr int RW_AR = RW_X + 35840, RW_BK = RW_AR + 18432;
constexpr int RW_KB = RW_BK + 18432, RW_VT = RW_KB + 20480, RW_GL = RW_VT + 8192, RW_END = RW_GL + 1024;
constexpr int RW_GT = RW_RS;
static_assert(RW_TT + 3072 <= RW_YO && RW_YO + 16384 <= RW_AR && RW_END <= LDS_MAIN, "rwkv LDS map");
#ifndef RW_R1
#define RW_R1 1
#endif
#ifndef RW_R2
#define RW_R2 1
#endif
#ifndef RW_R3
#define RW_R3 1
#endif
#ifndef RW_R4
#define RW_R4 1
#endif
#ifndef RW_R5
#define RW_R5 1
#endif
constexpr int RW_PAR = RW_END;
static_assert(RW_PAR + 1792 <= LDS_MAIN, "rwkv LDS map");
__device__ __forceinline__ float tanh_fast(float x) { return 1.f - 2.f * rcpf_(1.f + __expf(2.f * x)); }
__device__ __forceinline__ void rwkv_lx_phase(const bf16* P, const float* mu, bf16* LX, int tid, int G) {
    for (int id = blockIdx.x * 512 + tid; id < 32 * (M / 8); id += G * 512) {
        const int piece = id & 31, r0 = (id >> 5) * 8;
        v4u raw[9];
#pragma unroll
        for (int i = 0; i < 9; ++i) { const int row = r0 - 1 + i; raw[i] = ((row & (T - 1)) != (T - 1) || i > 0) && row >= 0 ? *(const v4u*)(P + (size_t)row * NO + 3072 + piece * 8) : (v4u){0u, 0u, 0u, 0u}; }
        if ((r0 & (T - 1)) == 0) raw[0] = (v4u){0u, 0u, 0u, 0u};
        const f32x4 m0 = *(const f32x4*)(mu + 1536 + piece * 8), m1 = *(const f32x4*)(mu + 1536 + piece * 8 + 4); const float mm[8] = {m0.x, m0.y, m0.z, m0.w, m1.x, m1.y, m1.z, m1.w};
#pragma unroll
        for (int i = 0; i < 8; ++i) { float cur[8], prv[8], o[8]; unpack8(raw[i + 1], cur); unpack8(raw[i], prv);
#pragma unroll
            for (int e = 0; e < 8; ++e) { const float x = cur[e] + (prv[e] - cur[e]) * mm[e]; o[e] = (piece < 8) ? tanh_fast(x) : (piece < 16 ? x : sigmoidf_(x)); }
            *(v4u*)(LX + (size_t)(r0 + i) * 256 + piece * 8) = pack8(o); }
    }
}
__device__ __forceinline__ void rwkv_rows_load(int u, const bf16* P, int tid, v4u (&raw)[5]) {
    if (tid < 384) {
        const int h = u & 7, c64 = (u >> 3) & 127, b = u >> 10; const size_t row0 = (size_t)b * T + c64 * 64;
        const int q = tid % 24, tg = tid / 24; const int pcol = 1536 + (q >> 3) * 512 + h * 64 + (q & 7) * 8;
        const bf16* pp = P + row0 * NO + pcol;
#pragma unroll
        for (int i = 0; i < 5; ++i) { const int tt = tg * 4 - 1 + i; raw[i] = (c64 * 64 + tt >= 0) ? *(const v4u*)(pp + (ptrdiff_t)tt * NO) : (v4u){0u, 0u, 0u, 0u}; }
    }
}
template <bool WANT_Y>
__device__ __forceinline__ void rwkv_recur(f32x4 (&W)[4], const bool has_v, const int vcol, LAS unsigned char* lds, const int fr, const int fq) {
    LAS float* YO = (LAS float*)(lds + RW_YO);
    const bf16x8 zero8 = (bf16x8){0, 0, 0, 0, 0, 0, 0, 0}; const v2u zero2 = (v2u){0u, 0u};
    f32x4 ys[4];
#pragma unroll
    for (int i = 0; i < 4; ++i) {
        LAS bf16* AR = (LAS bf16*)(lds + RW_AR) + i * 32 * 72; LAS bf16* KB = (LAS bf16*)(lds + RW_KB) + i * 64 * 40; LAS bf16* VT = (LAS bf16*)(lds + RW_VT) + i * 64 * 16; LAS float* GL = (LAS float*)(lds + RW_GL) + i * 64;
        LAS bf16* MK = (LAS bf16*)(lds + RW_MK) + i * 16 * 24; LAS bf16* NN = (LAS bf16*)(lds + RW_NN) + i * 16 * 40; LAS bf16* TT = (LAS bf16*)(lds + RW_TT) + i * 16 * 24;
        bf16x8 wf[2]; wf[0] = frag8(W[0], W[1]); wf[1] = frag8(W[2], W[3]);
        f32x4 au = (f32x4){0.f, 0.f, 0.f, 0.f}, ay = au;
#pragma unroll
        for (int s = 0; s < 2; ++s) { const LAS bf16* ap = AR + fr * 72 + 32 * s + 4 * fq; au = mfma16(frag2(*(const LAS v2u*)ap, *(const LAS v2u*)(ap + 16)), wf[s], au);
            if (WANT_Y) { const LAS bf16* rp = AR + (16 + fr) * 72 + 32 * s + 4 * fq; ay = mfma16(frag2(*(const LAS v2u*)rp, *(const LAS v2u*)(rp + 16)), wf[s], ay); } }
        v2u vin = zero2;
        if (has_v) { const bf16x8 A = (fq < 2) ? *(const LAS bf16x8*)(MK + fr * 24 + 8 * fq) : zero8; const bf16x8 Bv = (fq < 2) ? *(const LAS bf16x8*)(VT + vcol * 16 + 8 * fq) : zero8;
            au = mfma16(A, Bv, au); vin = *(const LAS v2u*)(VT + vcol * 16 + 4 * fq); }
        f32x4 U;
        { v4u bw; bw.x = pk2(au[0], au[1]); bw.y = pk2(au[2], au[3]); bw.z = 0u; bw.w = 0u; const v2u tl2 = *(const LAS v2u*)(TT + fr * 24 + 4 * fq);
          U = mfma16(frag2(tl2, zero2), __builtin_bit_cast(bf16x8, bw), (f32x4){0.f, 0.f, 0.f, 0.f}); }
        v4u ubw; ubw.x = pk2(U[0], U[1]); ubw.y = pk2(U[2], U[3]); ubw.z = vin.x; ubw.w = vin.y; const bf16x8 ub = __builtin_bit_cast(bf16x8, ubw);
        if (WANT_Y) ys[i] = mfma16(*(const LAS bf16x8*)(NN + fr * 40 + 8 * fq), ub, ay);
#pragma unroll
        for (int kt = 0; kt < 4; ++kt) { W[kt] = mfma16(*(const LAS bf16x8*)(KB + (16 * kt + fr) * 40 + 8 * fq), ub, W[kt]); const f32x4 g4 = *(const LAS f32x4*)(GL + 16 * kt + 4 * fq); W[kt] = W[kt] * g4; }
    }
    if (WANT_Y) {
#pragma unroll
        for (int i = 0; i < 4; ++i)
#pragma unroll
            for (int r = 0; r < 4; ++r) YO[(16 * i + 4 * fq + r) * 64 + vcol] = ys[i][r]; }
}
#ifndef CHAIN_PLAIN
#define CHAIN_PLAIN 0
#endif
#ifndef CHAIN_RING
#define CHAIN_RING 1
#endif
#ifndef CHAIN_BACKOFF
#define CHAIN_BACKOFF 8
#endif
#ifndef CHAIN_FLAG_HINT
#define CHAIN_FLAG_HINT 0
#endif
constexpr int RW_SX = RW_PAR + 2048;
static_assert(RW_SX + 8192 <= LDS_MAIN, "rwkv LDS map");
#ifndef CHAIN_HILO
#define CHAIN_HILO 1
#endif
__device__ __forceinline__ void chain_wait(unsigned* flag, unsigned* tmo, int lane) {
    unsigned spins = 0;
    while ((unsigned)__builtin_amdgcn_readfirstlane(__hip_atomic_load(flag, __ATOMIC_RELAXED, __HIP_MEMORY_SCOPE_AGENT)) == 0u) {
        __builtin_amdgcn_s_sleep(1);
        if ((++spins & 1023u) == 0u) { if (spins > (1u << 19) || (unsigned)__builtin_amdgcn_readfirstlane(__hip_atomic_load(tmo, __ATOMIC_RELAXED, __HIP_MEMORY_SCOPE_AGENT)) != 0u) { if (lane == 0) __hip_atomic_store(tmo, 1u, __ATOMIC_RELAXED, __HIP_MEMORY_SCOPE_AGENT); break; } } }
    asm volatile("" ::: "memory");
}
__device__ __forceinline__ void rwkv_consts_load(int h, const float* const* in, int tid, float (&mm)[8], float (&kkw)[8]) {
    const int q = (tid < 384) ? tid % 24 : 0; const int mcol = (q >> 3) * 512 + h * 64 + (q & 7) * 8;
    const f32x4 m0 = *(const f32x4*)(in[21] + mcol), m1 = *(const f32x4*)(in[21] + mcol + 4); mm[0] = m0.x; mm[1] = m0.y; mm[2] = m0.z; mm[3] = m0.w; mm[4] = m1.x; mm[5] = m1.y; mm[6] = m1.z; mm[7] = m1.w;
    const f32x4 k0 = *(const f32x4*)(in[27] + h * 64 + (q & 7) * 8), k1 = *(const f32x4*)(in[27] + h * 64 + (q & 7) * 8 + 4); kkw[0] = k0.x; kkw[1] = k0.y; kkw[2] = k0.z; kkw[3] = k0.w; kkw[4] = k1.x; kkw[5] = k1.y; kkw[6] = k1.z; kkw[7] = k1.w;
}
__device__ __forceinline__ void rwkv_lx_load(int u, const bf16* LX, int tid, bf16x8 (&lxa)[8]) {
    const int lane = tid & 63, wave = tid >> 6, fr = lane & 15, fq = lane >> 4; const int c64 = (u >> 3) & 127, b = u >> 10;
    const bf16* lx = LX + ((size_t)b * T + c64 * 64 + 16 * (wave & 3) + fr) * 256 + 8 * fq;
#pragma unroll
    for (int ks = 0; ks < 2; ++ks) { lxa[ks] = *(const bf16x8*)(lx + 32 * ks); lxa[2 + ks] = *(const bf16x8*)(lx + 64 + 32 * ks); }
#pragma unroll
    for (int ks = 0; ks < 4; ++ks) lxa[4 + ks] = *(const bf16x8*)(lx + 128 + 32 * ks);
}
__device__ __forceinline__ void rwkv_post(int u, bf16* Y, LAS unsigned char* lds, int tid) {
    const int h = u & 7, c64 = (u >> 3) & 127, b = u >> 10; const size_t row0 = (size_t)b * T + c64 * 64;
    LAS float* YO = (LAS float*)(lds + RW_YO); LAS bf16* GG = (LAS bf16*)(lds + RW_GG); LAS float* BONP = (LAS float*)(lds + RW_BONP); LAS bf16* VT = (LAS bf16*)(lds + RW_VT); LAS float* PAR = (LAS float*)(lds + RW_PAR);
    const int t = tid >> 3, c8 = tid & 7, v0 = c8 * 8;
    float y[8]; float s1 = 0.f;
#pragma unroll
    for (int e = 0; e < 8; ++e) { y[e] = YO[t * 64 + v0 + e]; s1 += y[e]; }
    s1 += __shfl_xor(s1, 1); s1 += __shfl_xor(s1, 2); s1 += __shfl_xor(s1, 4);
    const float mean = s1 * (1.f / 64.f); float s2 = 0.f;
#pragma unroll
    for (int e = 0; e < 8; ++e) { y[e] -= mean; s2 += y[e] * y[e]; }
    s2 += __shfl_xor(s2, 1); s2 += __shfl_xor(s2, 2); s2 += __shfl_xor(s2, 4);
    const f32x4 bp = *(const LAS f32x4*)(BONP + t * 4); const float rstd = 1.0f / sqrtf(s2 * (1.f / 64.f) + 64e-5f), bon = (bp.x + bp.y) + (bp.z + bp.w);
    float gg[8], o[8]; unpack8(*(const LAS v4u*)(GG + t * 72 + v0), gg);
    const LAS float* lw_ = PAR + 320 + v0; const LAS float* lb_ = PAR + 384 + v0;
#pragma unroll
    for (int e = 0; e < 8; ++e) { const float vv = bf1(VT[((t >> 4) * 64 + v0 + e) * 16 + (t & 15)]); o[e] = (y[e] * rstd * lw_[e] + lb_[e] + bon * vv) * gg[e]; }
    *(v4u*)(Y + (row0 + t) * D + 512 + h * 64 + v0) = pack8(o);
}
template <int MODE>
__device__ __forceinline__ void rwkv_chunk_unit(int u, int u_next, int u_prev, int& cur_h, v4u (&raw)[5], bf16x8 (&lxa)[8], const float (&mm)[8], const float (&kkw)[8], const bf16* P, const bf16* LX, const float* const* in, const bf16* lora, bf16* GF, float* HS, bf16* Y, gu32* ctlw, LAS unsigned char* lds, int tid) {
    asm volatile("; MARK_BEGIN_rwkv_chunk_unit");
    asm volatile("" : "+v"(tid));
    const int lane = tid & 63, wave = __builtin_amdgcn_readfirstlane(tid >> 6), fr = lane & 15, fq = lane >> 4;
    const int h = u & 7, c64 = (u >> 3) & 127, b = u >> 10;
    const int su = (b * 8 + h) * 128 + c64;
    const size_t row0 = (size_t)b * T + c64 * 64;
    LAS bf16* RS = (LAS bf16*)(lds + RW_RS); LAS bf16* KS = (LAS bf16*)(lds + RW_KS); LAS bf16* VS = (LAS bf16*)(lds + RW_VS); LAS bf16* GG = (LAS bf16*)(lds + RW_GG);
    LAS float* BONP = (LAS float*)(lds + RW_BONP); LAS float* SSQ = (LAS float*)(lds + RW_SSQ);
    LAS float* PAR = (LAS float*)(lds + RW_PAR);
    if (h != cur_h) { cur_h = h;
        if (tid < 448) { const int a7 = tid >> 6, kh = tid & 63; const int src = (a7 == 0) ? 22 : (a7 == 1) ? 24 : (a7 == 2) ? 27 : (a7 == 3) ? 28 : (a7 == 4) ? 29 : (a7 == 5) ? 30 : 31; PAR[tid] = in[src][h * 64 + kh]; } }
    const bf16* w2t = lora + (size_t)(h * 64) * 64; const bf16* a2t = lora + 512 * 64 + (size_t)(h * 64) * 64; const bf16* g2t = lora + 2 * 512 * 64 + (size_t)(h * 64) * 128;
    bf16x8 bw[2][2], ba[2][2];
#pragma unroll
    for (int ni = 0; ni < 2; ++ni) { const int kh = 16 * (2 * (wave >> 2) + ni) + fr;
#pragma unroll
        for (int ks = 0; ks < 2; ++ks) { bw[ni][ks] = *(const bf16x8*)(w2t + (size_t)kh * 64 + 32 * ks + 8 * fq); ba[ni][ks] = *(const bf16x8*)(a2t + (size_t)kh * 64 + 32 * ks + 8 * fq); }
    }
    bf16x8 bg[2][4];
    if (MODE >= 1) {
#pragma unroll
        for (int ni = 0; ni < 2; ++ni)
#pragma unroll
            for (int ks = 0; ks < 4; ++ks) bg[ni][ks] = *(const bf16x8*)(g2t + (size_t)(16 * (2 * (wave >> 2) + ni) + fr) * 128 + 32 * ks + 8 * fq); }
    f32x4 W[4];
    if (MODE == 1 && wave < 4) {
#pragma unroll
        for (int kt = 0; kt < 4; ++kt) W[kt] = *(const f32x4*)(HS + (((size_t)su * 4 + wave) * 4 + kt) * 256 + lane * 4); }
    if (MODE == 2 && u_prev >= 0) rwkv_post(u_prev, Y, lds, tid);
    for (int rp1 = 0; rp1 < RW_R1; ++rp1) { if (rp1) __syncthreads();
    if (tid < 384) {
        const int q = tid % 24, tg = tid / 24;
#pragma unroll
        for (int i = 0; i < 4; ++i) { const int t = tg * 4 + i; float cur[8], prv[8], o[8]; unpack8(raw[i + 1], cur); unpack8(raw[i], prv);
#pragma unroll
            for (int e = 0; e < 8; ++e) o[e] = cur[e] + (prv[e] - cur[e]) * mm[e];
            LAS bf16* dst = (q < 8) ? RS : (q < 16 ? KS : VS); const v4u pk = pack8(o); *(LAS v4u*)(dst + t * 72 + (q & 7) * 8) = pk;
            if (q >= 8 && q < 16) { float kr[8]; unpack8(pk, kr); float sq = 0.f;
#pragma unroll
                for (int e = 0; e < 8; ++e) { const float z = kr[e] * kkw[e]; sq += z * z; }
                SSQ[t * 8 + (q & 7)] = sq; } }
    } }
    __syncthreads();
    if (u_next >= 0) rwkv_rows_load(u_next, P, tid, raw);
#ifdef PROBE_UNIT_SLEEP
    if (MODE == 2) __builtin_amdgcn_s_sleep(PROBE_UNIT_SLEEP);
#endif
    for (int rp2 = 0; rp2 < RW_R2; ++rp2) { if (rp2) __syncthreads();
        LAS bf16* AR = (LAS bf16*)(lds + RW_AR); LAS bf16* BK = (LAS bf16*)(lds + RW_BK); LAS bf16* KB = (LAS bf16*)(lds + RW_KB); LAS bf16* VT = (LAS bf16*)(lds + RW_VT); LAS float* GL = (LAS float*)(lds + RW_GL);
        const int tt = wave & 3, t0 = 16 * tt + 4 * fq;
        float invn[4];
#pragma unroll
        for (int r = 0; r < 4; ++r) { const f32x4 s0 = *(const LAS f32x4*)(SSQ + (t0 + r) * 8), s1 = *(const LAS f32x4*)(SSQ + (t0 + r) * 8 + 4); invn[r] = rcpf_(fmaxf(sqrtf(((s0.x + s0.y) + (s0.z + s0.w)) + ((s1.x + s1.y) + (s1.z + s1.w))), 1e-12f)); }
#pragma unroll
        for (int ni = 0; ni < 2; ++ni) { const int nt = 2 * (wave >> 2) + ni, kh = 16 * nt + fr;
            f32x4 aw = (f32x4){0.f, 0.f, 0.f, 0.f}, aa = aw, ag = aw;
#pragma unroll
            for (int ks = 0; ks < 2; ++ks) { aw = mfma16(lxa[ks], bw[ni][ks], aw); aa = mfma16(lxa[2 + ks], ba[ni][ks], aa); }
            if (MODE >= 1) {
#pragma unroll
                for (int ks = 0; ks < 4; ++ks) ag = mfma16(lxa[4 + ks], bg[ni][ks], ag); }
            const float w0 = PAR[kh], a0 = PAR[64 + kh], kkw = PAR[128 + kh], kaw = PAR[192 + kh], rkw = PAR[256 + kh];
            float lw[4], cs[4]; float run = 0.f;
#pragma unroll
            for (int r = 0; r < 4; ++r) { lw[r] = -0.60653066f * sigmoidf_(w0 + aw[r]); run += lw[r]; cs[r] = run; }
            float inc = run; { const float t1 = __shfl_up(inc, 16); if (fq >= 1) inc += t1; const float t2 = __shfl_up(inc, 32); if (fq >= 2) inc += t2; }
            const float excl = inc - run;
            float al[4], be[4], ka[4], rh[4], vv[4], bon[4];
            float ep = __expf(excl);
#pragma unroll
            for (int r = 0; r < 4; ++r) { const int t = t0 + r;
                const float cl = excl + cs[r];
                const float av = sigmoidf_(a0 + aa[r]);
                const float rv = bf1(RS[t * 72 + kh]), kv = bf1(KS[t * 72 + kh]); vv[r] = bf1(VS[t * 72 + kh]);
                const float ec = __expf(cl), em = rcpf_(ec);
                const float kkn = kv * kkw * invn[r], kp = kv * (1.f + (av - 1.f) * kaw);
                al[r] = kkn * ep; be[r] = kkn * av * em; ka[r] = kp * em; rh[r] = rv * ec; bon[r] = rv * kp * rkw;
                if (r == 3 && fq == 3) GL[tt * 64 + kh] = ec;
                if (MODE >= 1) GG[t * 72 + kh] = tobf(ag[r]);
                ep = ec; }
#pragma unroll
            for (int r = 0; r < 4; ++r) { const float x = row16_sum(bon[r]); if (fr == 0) BONP[(t0 + r) * 4 + nt] = x; }
            LAS bf16* ar = AR + (tt * 32 + 4 * fq) * 72 + kh; LAS bf16* bk = BK + (tt * 32 + 4 * fq) * 72 + kh;
#pragma unroll
            for (int r = 0; r < 4; ++r) { ar[r * 72] = tobf(al[r]); ar[(16 + r) * 72] = tobf(rh[r]); bk[r * 72] = tobf(be[r]); bk[(16 + r) * 72] = tobf(ka[r]); }
            { v4u w; w.x = pk2(-be[0], -be[1]); w.y = pk2(-be[2], -be[3]); w.z = pk2(ka[0], ka[1]); w.w = pk2(ka[2], ka[3]); *(LAS v4u*)(KB + (tt * 64 + kh) * 40 + 8 * fq) = w; }
            { v2u w; w.x = pk2(vv[0], vv[1]); w.y = pk2(vv[2], vv[3]); *(LAS v2u*)(VT + (tt * 64 + kh) * 16 + 4 * fq) = w; } }
    }
    __syncthreads();
    if (u_next >= 0) rwkv_lx_load(u_next, LX, tid, lxa);
    for (int rp4 = 0; rp4 < RW_R4; ++rp4) { if (rp4) __syncthreads();
    {
        const int i = wave & 3; const bool inv_half = wave < 4;
        LAS bf16* AR = (LAS bf16*)(lds + RW_AR) + i * 32 * 72; LAS bf16* BK = (LAS bf16*)(lds + RW_BK) + i * 32 * 72;
        LAS bf16* MK = (LAS bf16*)(lds + RW_MK) + i * 16 * 24; LAS bf16* NN = (LAS bf16*)(lds + RW_NN) + i * 16 * 40; LAS float* MB = (LAS float*)(lds + RW_MB) + i * 256; LAS bf16* TT = (LAS bf16*)(lds + RW_TT) + i * 16 * 24;
        const int slotc = 8 * (fr >> 2) + (fr & 3);
        if (inv_half) {
            f32x4 acc = (f32x4){0.f, 0.f, 0.f, 0.f};
#pragma unroll
            for (int ks = 0; ks < 2; ++ks) acc = mfma16(*(const LAS bf16x8*)(AR + fr * 72 + 32 * ks + 8 * fq), *(const LAS bf16x8*)(BK + fr * 72 + 32 * ks + 8 * fq), acc);
#pragma unroll
            for (int r = 0; r < 4; ++r) { const int ta = 4 * fq + r, tb = fr; MB[ta * 16 + tb] = (tb < ta) ? acc[r] : 0.f; }
            LDS_WAIT(); asm volatile("" ::: "memory");
            { const int cc = lane & 15; float tc[16];
#pragma unroll
              for (int t = 0; t < 16; ++t) { float s0 = (t == cc) ? 1.f : 0.f, s1 = 0.f;
#pragma unroll
                  for (int j = 0; j < t; ++j) { if (j & 1) s1 -= MB[t * 16 + j] * tc[j]; else s0 -= MB[t * 16 + j] * tc[j]; }
                  tc[t] = s0 + s1; }
              if (lane < 16) {
#pragma unroll
                  for (int t = 0; t < 16; ++t) TT[t * 24 + cc] = tobf(tc[t]); } }
        } else {
            f32x4 pr[3];
#pragma unroll
            for (int pi = 0; pi < 3; ++pi) { const int ra = (pi + 1) >> 1, cbx = (pi + 1) & 1; f32x4 acc = (f32x4){0.f, 0.f, 0.f, 0.f};
#pragma unroll
                for (int ks = 0; ks < 2; ++ks) acc = mfma16(*(const LAS bf16x8*)(AR + (16 * ra + fr) * 72 + 32 * ks + 8 * fq), *(const LAS bf16x8*)(BK + (16 * cbx + fr) * 72 + 32 * ks + 8 * fq), acc);
                pr[pi] = acc; }
#pragma unroll
            for (int r = 0; r < 4; ++r) { const int ta = 4 * fq + r, tb = fr;
                const float mk = (tb < ta) ? pr[0][r] : 0.f, nb = (tb <= ta) ? pr[1][r] : 0.f, nk = (tb <= ta) ? pr[2][r] : 0.f;
                MK[ta * 24 + tb] = tobf(mk); NN[ta * 40 + slotc] = tobf(-nb); NN[ta * 40 + slotc + 4] = tobf(nk); }
        }
    } }
    __syncthreads();
    LAS float* YO = (LAS float*)(lds + RW_YO);
    LAS bf16* GT = (LAS bf16*)(lds + RW_GT);
    if (MODE == 1) { if (wave < 4) rwkv_recur<true>(W, true, 16 * wave + fr, lds, fr, fq); }
    else {
#pragma unroll
        for (int kt = 0; kt < 4; ++kt)
#pragma unroll
            for (int r = 0; r < 4; ++r) W[kt][r] = (wave < 4 && (16 * kt + 4 * fq + r) == (16 * wave + fr)) ? 1.f : 0.f;
        rwkv_recur<false>(W, wave >= 4, 16 * (wave & 3) + fr, lds, fr, fq);
        if (wave < 4) {
#pragma unroll
            for (int kt = 0; kt < 4; ++kt)
#pragma unroll
                for (int r = 0; r < 4; ++r) GT[(16 * kt + 4 * fq + r) * 72 + 16 * wave + fr] = tobf(W[kt][r]);
        } else if (MODE == 0) {
#pragma unroll
            for (int kt = 0; kt < 4; ++kt) *(f32x4*)(HS + (((size_t)su * 4 + (wave - 4)) * 4 + kt) * 256 + lane * 4) = W[kt]; }
    }
    __syncthreads();
    if (MODE == 2) {
        unsigned* FL = (unsigned*)ctlw + 16384;
        unsigned* tmo = (unsigned*)ctlw + CW_BAR + XB_TMO;
        const int vt = wave & 3;
#if CHAIN_RING
        typedef unsigned long long u64;
        u64* RING = (u64*)((unsigned char*)ctlw + (WS_RING - WS_CTL));
        LAS v2u* SX = (LAS v2u*)(lds + RW_SX);
        const int seq = su >> 7;
        bf16x8 gc[8]; v2u sb[4];
        if (wave >= 4) {
            if (c64 < 127) {
#pragma unroll
                for (int f = 0; f < 8; ++f) { const LAS bf16* gp = GT + (16 * (f >> 1) + fr) * 72 + 32 * (f & 1) + 4 * fq; gc[f] = frag2(*(const LAS v2u*)gp, *(const LAS v2u*)(gp + 16)); }
                LDS_WAIT(); }
            if (c64 > 0) {
                if (CHAIN_FLAG_HINT) chain_wait(FL + ((size_t)su * 4 + vt) * 4, tmo, lane);
                u64* rp = RING + (size_t)((seq * 4 + vt) * 2 + (c64 & 1)) * 512 + lane; const unsigned tag = (unsigned)c64;
                unsigned spins = 0;
                for (;;) { u64 q[8]; bool ok = true;
#pragma unroll
                    for (int j = 0; j < 8; ++j) q[j] = __hip_atomic_load(rp + j * 64, __ATOMIC_RELAXED, __HIP_MEMORY_SCOPE_AGENT);
#pragma unroll
                    for (int j = 0; j < 8; ++j) ok = ok && ((unsigned)(q[j] >> 32) == tag);
#pragma unroll
                    for (int kt = 0; kt < 4; ++kt) { sb[kt].x = (unsigned)q[2 * kt]; sb[kt].y = (unsigned)q[2 * kt + 1]; }
                    if (__builtin_amdgcn_ballot_w64(!ok) == 0ull) break;
                    if (!CHAIN_FLAG_HINT) __builtin_amdgcn_s_sleep(CHAIN_BACKOFF);
                    if ((++spins & 255u) == 0u) { if (spins > (1u << 17) || (unsigned)__builtin_amdgcn_readfirstlane(__hip_atomic_load(tmo, __ATOMIC_RELAXED, __HIP_MEMORY_SCOPE_AGENT)) != 0u) { if (lane == 0) __hip_atomic_store(tmo, 1u, __ATOMIC_RELAXED, __HIP_MEMORY_SCOPE_AGENT); break; } } }
            } else {
#pragma unroll
                for (int kt = 0; kt < 4; ++kt) sb[kt] = (v2u){0u, 0u}; }
#pragma unroll
            for (int kt = 0; kt < 4; ++kt) SX[(vt * 4 + kt) * 64 + lane] = sb[kt];
        }
        __syncthreads();
        if (wave >= 4) {
            if (c64 < 127) {
                const bf16x8 wh0 = frag2(sb[0], sb[1]), wh1 = frag2(sb[2], sb[3]);
                u64* wp = RING + (size_t)((seq * 4 + vt) * 2 + ((c64 + 1) & 1)) * 512 + lane; const u64 tg = (u64)(unsigned)(c64 + 1) << 32;
#pragma unroll
                for (int kt = 0; kt < 4; ++kt) { f32x4 a = W[kt]; a = mfma16(gc[2 * kt], wh0, a); a = mfma16(gc[2 * kt + 1], wh1, a);
                    __hip_atomic_store(wp + (2 * kt) * 64, tg | (u64)pk2(a[0], a[1]), __ATOMIC_RELAXED, __HIP_MEMORY_SCOPE_AGENT);
                    __hip_atomic_store(wp + (2 * kt + 1) * 64, tg | (u64)pk2(a[2], a[3]), __ATOMIC_RELAXED, __HIP_MEMORY_SCOPE_AGENT); }
#ifdef PROBE_LINK_SLEEP
                __builtin_amdgcn_s_sleep(PROBE_LINK_SLEEP);
#endif
                if (CHAIN_FLAG_HINT && lane == 0) __hip_atomic_store(FL + ((size_t)(su + 1) * 4 + vt) * 4, 1u, __ATOMIC_RELAXED, __HIP_MEMORY_SCOPE_AGENT);
            }
        } else {
#pragma unroll
            for (int kt = 0; kt < 4; ++kt) { const v2u s2 = SX[(wave * 4 + kt) * 64 + lane]; W[kt] = (f32x4){bflo(s2.x), bfhi(s2.x), bflo(s2.y), bfhi(s2.y)}; }
            rwkv_recur<true>(W, true, 16 * wave + fr, lds, fr, fq);
        }
        __syncthreads();
#else
        f32x4 Sc[4];
        bf16x8 gc[8];
        if (wave >= 4 && c64 < 127) {
#pragma unroll
            for (int f = 0; f < 8; ++f) { const LAS bf16* gp = GT + (16 * (f >> 1) + fr) * 72 + 32 * (f & 1) + 4 * fq; gc[f] = frag2(*(const LAS v2u*)gp, *(const LAS v2u*)(gp + 16)); }
            LDS_WAIT(); }
        if (c64 > 0) { chain_wait(FL + ((size_t)su * 4 + vt) * 4, tmo, lane);
            typedef GAS unsigned long long gu64; typedef unsigned long long u64x2 __attribute__((ext_vector_type(2)));
#pragma unroll
            for (int kt = 0; kt < 4; ++kt) { gu64* src = (gu64*)(HS + (((size_t)su * 4 + vt) * 4 + kt) * 256 + lane * 4); u64x2 q;
                if (CHAIN_PLAIN) Sc[kt] = *(const f32x4*)(HS + (((size_t)su * 4 + vt) * 4 + kt) * 256 + lane * 4); else { q[0] = __hip_atomic_load(src, __ATOMIC_RELAXED, __HIP_MEMORY_SCOPE_AGENT); q[1] = __hip_atomic_load(src + 1, __ATOMIC_RELAXED, __HIP_MEMORY_SCOPE_AGENT); Sc[kt] = __builtin_bit_cast(f32x4, q); } }
        } else {
#pragma unroll
            for (int kt = 0; kt < 4; ++kt) Sc[kt] = (f32x4){0.f, 0.f, 0.f, 0.f}; }
        if (wave >= 4) {
            if (c64 < 127) {
                f32x4 Sl[4];
#pragma unroll
                for (int kt = 0; kt < 4; ++kt)
#pragma unroll
                    for (int r = 0; r < 4; ++r) { const float hi = __builtin_bit_cast(float, f2bf(Sc[kt][r]) << 16); Sl[kt][r] = Sc[kt][r] - hi; }
                const bf16x8 wh0 = frag8(Sc[0], Sc[1]), wh1 = frag8(Sc[2], Sc[3]), wl0 = frag8(Sl[0], Sl[1]), wl1 = frag8(Sl[2], Sl[3]);
                typedef GAS unsigned long long gu64;
#pragma unroll
                for (int kt = 0; kt < 4; ++kt) { f32x4 a = W[kt]; a = mfma16(gc[2 * kt], wh0, a); a = mfma16(gc[2 * kt + 1], wh1, a); if (CHAIN_HILO) { a = mfma16(gc[2 * kt], wl0, a); a = mfma16(gc[2 * kt + 1], wl1, a); }
                    gu64* dst = (gu64*)(HS + (((size_t)(su + 1) * 4 + vt) * 4 + kt) * 256 + lane * 4);
                    typedef unsigned long long u64x2 __attribute__((ext_vector_type(2))); const u64x2 q = __builtin_bit_cast(u64x2, a);
                    if (CHAIN_PLAIN) *(f32x4*)(HS + (((size_t)(su + 1) * 4 + vt) * 4 + kt) * 256 + lane * 4) = a; else { __hip_atomic_store(dst, q[0], __ATOMIC_RELAXED, __HIP_MEMORY_SCOPE_AGENT); __hip_atomic_store(dst + 1, q[1], __ATOMIC_RELAXED, __HIP_MEMORY_SCOPE_AGENT); } }
                asm volatile("s_waitcnt vmcnt(0)" ::: "memory");
#ifdef PROBE_LINK_SLEEP
                __builtin_amdgcn_s_sleep(PROBE_LINK_SLEEP);
#endif
                if (lane == 0) __hip_atomic_store(FL + ((size_t)(su + 1) * 4 + vt) * 4, 1u, __ATOMIC_RELAXED, __HIP_MEMORY_SCOPE_AGENT);
            }
        } else {
#pragma unroll
            for (int kt = 0; kt < 4; ++kt) W[kt] = Sc[kt];
            rwkv_recur<true>(W, true, 16 * wave + fr, lds, fr, fq);
        }
        __syncthreads();

#endif
    }
    if (MODE == 0) {
        const int f = wave, kot = f >> 1, s = f & 1; const LAS bf16* gp = GT + (16 * kot + fr) * 72 + 32 * s + 4 * fq;
        const v2u lo = *(const LAS v2u*)gp, hi = *(const LAS v2u*)(gp + 16); v4u o; o.x = lo.x; o.y = lo.y; o.z = hi.x; o.w = hi.y;
        *(v4u*)(GF + ((size_t)su * 8 + f) * 512 + lane * 8) = o;
    } else if (MODE == 1) { rwkv_post(u, Y, lds, tid); }
    if (MODE != 2) __syncthreads();
}
constexpr int RS_SLOT = 12288;
__device__ __forceinline__ void rwkv_scan_issue(const bf16* GF, const float* HS, size_t unit, int vt, LAS unsigned char* slot, int lane) {
#pragma unroll
    for (int f = 0; f < 8; ++f) __builtin_amdgcn_global_load_lds((const unsigned*)(GF + (unit * 8 + f) * 512 + lane * 8), (LAS unsigned*)(slot + f * 1024), 16, 0, 0);
#pragma unroll
    for (int kt = 0; kt < 4; ++kt) __builtin_amdgcn_global_load_lds((const unsigned*)(HS + ((unit * 4 + vt) * 4 + kt) * 256 + lane * 4), (LAS unsigned*)(slot + 8192 + kt * 1024), 16, 0, 0);
}
__device__ __forceinline__ void rwkv_scan_phase(const bf16* GF, float* HS, LAS unsigned char* lds, int tid, int G) {
    if ((tid >> 6) != 0) return;
    const int lane = tid & 63;
    for (int job = blockIdx.x; job < 128; job += G) {
        const int bh = job >> 2, vt = job & 3; const size_t u0 = (size_t)bh * 128;
        f32x4 W[4];
#pragma unroll
        for (int kt = 0; kt < 4; ++kt) W[kt] = (f32x4){0.f, 0.f, 0.f, 0.f};
#pragma unroll
        for (int p = 0; p < 5; ++p) rwkv_scan_issue(GF, HS, u0 + p, vt, lds + p * RS_SLOT, lane);
        for (int c0 = 0; c0 < 128; c0 += 8) {
#pragma unroll
            for (int j = 0; j < 8; ++j) {
                const int c = c0 + j;
                asm volatile("s_waitcnt vmcnt(48)" ::: "memory");
                LAS unsigned char* slot = lds + j * RS_SLOT;
                bf16x8 gc[8]; f32x4 hc[4];
#pragma unroll
                for (int f = 0; f < 8; ++f) gc[f] = *(const LAS bf16x8*)(slot + f * 1024 + lane * 16);
#pragma unroll
                for (int kt = 0; kt < 4; ++kt) hc[kt] = *(const LAS f32x4*)(slot + 8192 + kt * 1024 + lane * 16);
                { const int cn = c + 5 < 128 ? c + 5 : 127;
                  rwkv_scan_issue(GF, HS, u0 + cn, vt, lds + ((j + 5) & 7) * RS_SLOT, lane); }
                if (c >= 122) asm volatile("s_waitcnt vmcnt(0)" ::: "memory");
                const size_t uu = u0 + c;
#pragma unroll
                for (int kt = 0; kt < 4; ++kt) *(f32x4*)(HS + ((uu * 4 + vt) * 4 + kt) * 256 + lane * 4) = W[kt];
                f32x4 Wl[4];
#pragma unroll
                for (int kt = 0; kt < 4; ++kt)
#pragma unroll
                    for (int r = 0; r < 4; ++r) { const float hi = __builtin_bit_cast(float, f2bf(W[kt][r]) << 16); Wl[kt][r] = W[kt][r] - hi; }
                const bf16x8 wh0 = frag8(W[0], W[1]), wh1 = frag8(W[2], W[3]), wl0 = frag8(Wl[0], Wl[1]), wl1 = frag8(Wl[2], Wl[3]);
#pragma unroll
                for (int kt = 0; kt < 4; ++kt) { f32x4 a = hc[kt]; a = mfma16(gc[2 * kt], wh0, a); a = mfma16(gc[2 * kt + 1], wh1, a); a = mfma16(gc[2 * kt], wl0, a); a = mfma16(gc[2 * kt + 1], wl1, a); W[kt] = a; }
            }
        }
        asm volatile("s_waitcnt vmcnt(0)" ::: "memory");
    }
}
struct Args { const float* in[33]; float* out; unsigned char* ws; int ph_lo, ph_hi; };
__global__ void __launch_bounds__(NWAVES * 64, 2) trunk_fwd(Args args) {
    extern __shared__ __attribute__((aligned(16))) unsigned char lds_raw[];
    LAS unsigned char* lds = (LAS unsigned char*)lds_raw;
    const int tid = threadIdx.x, G = gridDim.x;
    unsigned char* ws = args.ws;
    gu32* ctl = (gu32*)(ws + WS_CTL);
    for (int u = tid; u < (LDS_BYTES - LDSCTL_OFF) / 4; u += NWAVES * 64) ((LAS unsigned*)(lds + LDSCTL_OFF))[u] = 0u;
    __syncthreads();
    XcdBarrier bar; bar.bar = (unsigned*)(ctl + CW_BAR); bar.x = 0; bar.st = nullptr;
    if (!MK_PER_PHASE) bar = xcd_barrier_post((unsigned*)(ctl + CW_BAR), (volatile LAS unsigned*)(lds + LDSCTL_OFF + 32));
    const int lo = args.ph_lo, hi = args.ph_hi;
#ifdef SLEEP_US
    { const unsigned long long t0 = __builtin_amdgcn_s_memrealtime(); while (__builtin_amdgcn_s_memrealtime() - t0 < (unsigned long long)SLEEP_US * 100ull) __builtin_amdgcn_s_sleep(64); }
#endif
#ifndef RG
#define RG 0
#endif
#ifndef RATT
#define RATT 1
#endif
#ifndef RMLL
#define RMLL 1
#endif
#ifndef RMLO
#define RMLO 1
#endif
#ifndef RSSL
#define RSSL 1
#endif
#ifndef RSSO
#define RSSO 1
#endif
#ifndef RRWA
#define RRWA 1
#endif
#ifndef RRWB
#define RRWB 1
#endif
#ifndef RNORM
#define RNORM 1
#endif
#ifndef CH_REP
#define CH_REP 0
#endif
#ifndef CHAIN_ON
#define CHAIN_ON 1
#endif
#ifndef STAGGER
#define STAGGER 0
#endif
#ifndef NO_SSD
#define NO_SSD 0
#endif
#ifndef NO_RWKV
#define NO_RWKV 0
#endif
#ifndef FUSE_FINAL
#define FUSE_FINAL 1
#endif
#ifndef CONV_FIRST
#define CONV_FIRST 1
#endif
#ifndef PHMASK
#define PHMASK 0x7ffffu
#endif
#define IN(k) ((((PHMASK) >> (k)) & 1u) && lo <= (k) && (k) < hi)
#define SEAM(k) do { if (IN(k) && IN((k) + 1)) xcd_barrier(bar); } while (0)
    const float* x = args.in[0]; float* hres = args.out; bf16* hb = (bf16*)args.out + (size_t)M * D;
    bf16* hb2 = (bf16*)(ws + WS_Y);
    bf16* hbx = (bf16*)(ws + WS_XN);
    const bool fuse_final = FUSE_FINAL && FUSE_MLPNORM && (G == 256) && !MK_PER_PHASE && lo <= 14 && hi >= 19;
    bf16* XN = (bf16*)(ws + WS_XN); bf16* P = (bf16*)(ws + WS_R1); bf16* HB = (bf16*)(ws + WS_R1); bf16* Y = (bf16*)(ws + WS_Y);
    float* G0 = (float*)(ws + WS_G0); float* DT = (float*)(ws + WS_DT);
    float* MLS = (float*)(ws + WS_MLS); float* MPREV = MLS + 4096; float* NL = MLS + 8192;
    float* CT = (float*)(ws + WS_XN); float* ST = (float*)(ws + WS_XN); float* DEC = (float*)(ws + WS_DEC);
    bf16* GF = (bf16*)(ws + WS_GF); float* HS = (float*)(ws + WS_HS); bf16* LX = (bf16*)(ws + WS_LX); float* SSP = (float*)(ws + WS_SSP); float* RS = (float*)(ws + WS_RS);
    const float2* rope = (const float2*)(ws + WS_ROPE); const bf16* lora = (const bf16*)(ws + WS_LORA);

    if (IN(0)) { p0_prologue(args.in, ws, lds, tid, G); __syncthreads();
        for (int rep_ = 0; rep_ < RNORM; ++rep_) norm_x_gates_phase(x, args.in[1], XN, args.in[5] + 2304, 2312, G0, lds, tid, G); }
    SEAM(0);
    if (IN(1)) { pg8::Gemm g{XN, (const bf16*)(ws + WS_WINE), M, NE, D}; pg8::StaticOrder S; S.init(M, NE, G, (int)blockIdx.x); pg8::EpiBf16<0> E{P, NE};
        const int nfull = ((M / 256) * (NE / 256)) % G;
        if (DEFER_MLPW && CONV_FIRST && nfull != 0 && (int)blockIdx.x >= nfull) { mlp_weights_convert(args.in, ws, 0, lds, tid, nfull, G - nfull); __syncthreads(); }
        pg8::gemm_phase<pg8::EpiBf16<0>, pg8::StaticOrder, PG8_ALIGN, PG8_SP2>(lds, g, S, E);
        if (DEFER_MLPW) { if (nfull == 0) mlp_weights_convert(args.in, ws, 0, lds, tid, 0, G); else if (!CONV_FIRST && (int)blockIdx.x >= nfull) mlp_weights_convert(args.in, ws, 0, lds, tid, nfull, G - nfull); } }
    SEAM(1);
    if (IN(2)) { for (int rep_ = 0; rep_ < RATT; ++rep_) for (int u = blockIdx.x; u < 512; u += G) attn_unit(u, P, rope, args.in[7], Y, lds, tid);
        for (int rep_ = 0; rep_ < RMLL; ++rep_) for (int u = blockIdx.x; u < 1024; u += G) mlstm_local_unit(u, P, G0, args.in[8], args.in[9], args.in[10], args.in[11], CT, NL, MLS, lds, tid); }
    SEAM(2);
    if (IN(3)) mlstm_scan_phase(CT, NL, MLS, MPREV, lds, tid, G);
    SEAM(3);
    if (IN(4)) { for (int rep_ = 0; rep_ < RMLO; ++rep_) for (int u = blockIdx.x; u < 1024; u += G) mlstm_out_unit(u, P, G0, args.in[8], args.in[9], args.in[10], args.in[11], args.in[12], CT, NL, MPREV, Y, lds, tid); }
    SEAM(4);
    if (IN(5)) { pg8::Gemm g{Y, (const bf16*)(ws + WS_WOUTE), M, D, D}; pg8::StaticOrder S; S.init(M, D, G, (int)blockIdx.x);
        if (FUSE_MLPNORM) { pg8::EpiBf16ResSS<true> E{x, hb, D, SSP}; pg8::gemm_phase<pg8::EpiBf16ResSS<true>, pg8::StaticOrder, PG8_ALIGN, PG8_SP2>(lds, g, S, E); }
        else { pg8::EpiBf16Res<true> E{x, hb, D}; pg8::gemm_phase<pg8::EpiBf16Res<true>, pg8::StaticOrder, PG8_ALIGN, PG8_SP2>(lds, g, S, E); } }
    SEAM(5);
    if (!FUSE_MLPNORM) { if (IN(6)) for (int rep_ = 0; rep_ < RNORM; ++rep_) norm_phase_b<0>(hb, args.in[2], XN, nullptr, nullptr, 0, nullptr, lds, tid, G);
    SEAM(6); }
    if (IN(7)) { if (STAGGER) { const unsigned long long t0 = __builtin_amdgcn_s_memrealtime(); const unsigned long long dl = (unsigned long long)((blockIdx.x >> 3) & 7) * STAGGER; while (__builtin_amdgcn_s_memrealtime() - t0 < dl) __builtin_amdgcn_s_sleep(8); }
        pg8::Gemm g{FUSE_MLPNORM ? hb : XN, (const bf16*)(ws + WS_WUP0), M, FF, D}; pg8::StaticOrder S; S.init(M, FF, G, (int)blockIdx.x); pg8::EpiBf16<2> E{HB, FF};
        pg8::gemm_phase<pg8::EpiBf16<2>, pg8::StaticOrder, PG8_ALIGN, PG8_SP2>(lds, g, S, E);
        if (RG & 2) pg8::gemm_phase<pg8::EpiBf16<2>, pg8::StaticOrder, PG8_ALIGN, PG8_SP2>(lds, g, S, E); }
    SEAM(7);
    if (IN(8)) { pg8::Gemm g{HB, (const bf16*)(ws + WS_WDN0), M, D, FF}; pg8::StaticOrder S; S.init(M, D, G, (int)blockIdx.x);
        if (FUSE_MLPNORM) { pg8::EpiBf16ResScale E{hb, hb, D, SSP, 1e-5f}; pg8::gemm_phase<pg8::EpiBf16ResScale, pg8::StaticOrder, PG8_ALIGN, PG8_SP2>(lds, g, S, E); }
        else { pg8::EpiBf16Res<false> E{hb, hb, D}; pg8::gemm_phase<pg8::EpiBf16Res<false>, pg8::StaticOrder, PG8_ALIGN, PG8_SP2>(lds, g, S, E); } }
    SEAM(8);
#ifdef EXTRA_BARS
    if (IN(8) && IN(9)) for (int eb = 0; eb < EXTRA_BARS; ++eb) xcd_barrier(bar);
#endif
    if (IN(9)) for (int rep_ = 0; rep_ < RNORM; ++rep_) { if (FUSE_N9) norm_rs_dt_phase(hb, args.in[1] + D, RS, args.in[13] + 1536, 3336, DT, lds, tid, G); else norm_phase_b<1>(hb, args.in[1] + D, XN, nullptr, args.in[13] + 1536, 3336, DT, lds, tid, G); }
    SEAM(9);
    if (IN(10)) { pg8::Gemm g{FUSE_N9 ? hb : XN, (const bf16*)(ws + WS_WINO), M, NO, D}; pg8::StaticOrder S; S.init(M, NO, G, (int)blockIdx.x);
        const int nfull = ((M / 256) * (NO / 256)) % G;
        if (DEFER_MLPW && CONV_FIRST && nfull != 0 && (int)blockIdx.x >= nfull) { mlp_weights_convert(args.in, ws, 1, lds, tid, nfull, G - nfull); __syncthreads(); }
        if (FUSE_N9) { pg8::EpiBf16RS E{P, NO, RS}; pg8::gemm_phase<pg8::EpiBf16RS, pg8::StaticOrder, PG8_ALIGN, PG8_SP2>(lds, g, S, E); }
        else { pg8::EpiBf16<0> E{P, NO}; pg8::gemm_phase<pg8::EpiBf16<0>, pg8::StaticOrder, PG8_ALIGN, PG8_SP2>(lds, g, S, E); }
        if (DEFER_MLPW) { if (nfull == 0) mlp_weights_convert(args.in, ws, 1, lds, tid, 0, G); else if (!CONV_FIRST && (int)blockIdx.x >= nfull) mlp_weights_convert(args.in, ws, 1, lds, tid, nfull, G - nfull); } }
    SEAM(10);
    int cur_h = -1;
    if (IN(11)) { rwkv_lx_phase(P, args.in[21], LX, tid, G);
        if (!NO_SSD) for (int rep_ = 0; rep_ < RSSL; ++rep_) for (int u = blockIdx.x; u < 512; u += G) ssd_local_unit(u, P, DT, args.in[15], args.in[16], args.in[17], args.in[18], ST, DEC, lds, tid); }
    if (IN(11) && IN(12)) xcd_barrier(bar);
    const bool chain = (G == 256) && !MK_PER_PHASE && CHAIN_ON;
    if (IN(11)) {
        if (chain) { const int xq = blockIdx.x & 7, mq = blockIdx.x >> 3;
            if (mq < 24) { const int sq = xq * 4 + mq / 6, jj = mq % 6; v4u rraw[5]; float rmm[8], rkk[8]; rwkv_consts_load(sq & 7, args.in, tid, rmm, rkk);
                const int ubase = ((sq >> 3) << 10) | (sq & 7); rwkv_rows_load(ubase | (jj << 3), P, tid, rraw); bf16x8 lxa[8]; rwkv_lx_load(ubase | (jj << 3), LX, tid, lxa);
                int c = jj; for (; c < 128; c += 6) { const int u = ubase | (c << 3); rwkv_chunk_unit<2>(u, (c + 6 < 128) ? (ubase | ((c + 6) << 3)) : -1, (c >= 6) ? (ubase | ((c - 6) << 3)) : -1, cur_h, rraw, lxa, rmm, rkk, P, LX, args.in, lora, GF, HS, Y, ctl, lds, tid); }
                rwkv_post(ubase | ((c - 6) << 3), Y, lds, tid); __syncthreads(); }
            else { const int pr = xq, k8 = mq - 24;
                ssd_scan_pair(ST, DEC, pr, k8, tid);
                asm volatile("s_waitcnt vmcnt(0)" ::: "memory"); __syncthreads();
                if (tid == 0) { unsigned* cnt = (unsigned*)ctl + 90112 + pr * 64; unsigned* tmo = (unsigned*)ctl + CW_BAR + XB_TMO;
                    __builtin_amdgcn_fence(__ATOMIC_RELEASE, "agent"); asm volatile("s_waitcnt vmcnt(0)" ::: "memory");
                    __hip_atomic_fetch_add(cnt, 1u, __ATOMIC_RELAXED, __HIP_MEMORY_SCOPE_AGENT);
                    unsigned spins = 0;
                    while (__hip_atomic_load(cnt, __ATOMIC_RELAXED, __HIP_MEMORY_SCOPE_AGENT) < 8u) { __builtin_amdgcn_s_sleep(4);
                        if ((++spins & 1023u) == 0u) { if (spins > (1u << 19) || __hip_atomic_load(tmo, __ATOMIC_RELAXED, __HIP_MEMORY_SCOPE_AGENT) != 0u) { __hip_atomic_store(tmo, 1u, __ATOMIC_RELAXED, __HIP_MEMORY_SCOPE_AGENT); break; } } }
                    __builtin_amdgcn_fence(__ATOMIC_ACQUIRE, "agent"); asm volatile("s_waitcnt vmcnt(0)" ::: "memory"); }
                __syncthreads();
                for (int c = k8; c < 64; c += 8) ssd_out_unit(pr * 64 + c, P, DT, args.in[15], args.in[16], args.in[17], args.in[18], args.in[19], args.in[20], ST, Y, lds, tid); } }
        else { ssd_scan_phase(ST, DEC, tid, G);
            if (!NO_RWKV) for (int rep_ = 0; rep_ < RRWA; ++rep_) { v4u rraw[5]; float rmm[8], rkk[8]; rwkv_consts_load(blockIdx.x & 7, args.in, tid, rmm, rkk); bf16x8 lxa[8]; if ((int)blockIdx.x < 4096) { rwkv_rows_load(blockIdx.x, P, tid, rraw); rwkv_lx_load(blockIdx.x, LX, tid, lxa); }
                for (int u = blockIdx.x; u < 4096; u += G) { if ((G & 7) != 0) rwkv_consts_load(u & 7, args.in, tid, rmm, rkk); rwkv_chunk_unit<0>(u, (u + G < 4096) ? u + G : -1, -1, cur_h, rraw, lxa, rmm, rkk, P, LX, args.in, lora, GF, HS, Y, ctl, lds, tid); } } } }
    if (!chain) { SEAM(11); }
    if (IN(12) && !chain) { const int nscan = (G >= 256) ? 128 : 0;
        if ((int)blockIdx.x < nscan || nscan == 0) { rwkv_scan_phase(GF, HS, lds, tid, nscan ? nscan : G); __syncthreads(); }
        if (!NO_SSD) for (int rep_ = 0; rep_ < RSSO; ++rep_) {
            if (nscan <= 0) { for (int u = blockIdx.x; u < 512; u += G) ssd_out_unit(u, P, DT, args.in[15], args.in[16], args.in[17], args.in[18], args.in[19], args.in[20], ST, Y, lds, tid); }
            else if ((int)blockIdx.x >= nscan) { for (int u = blockIdx.x - nscan; u < 384; u += G - nscan) ssd_out_unit(u, P, DT, args.in[15], args.in[16], args.in[17], args.in[18], args.in[19], args.in[20], ST, Y, lds, tid); }
            else { for (int u = 384 + blockIdx.x; u < 512; u += nscan) ssd_out_unit(u, P, DT, args.in[15], args.in[16], args.in[17], args.in[18], args.in[19], args.in[20], ST, Y, lds, tid); } } }
    if (!chain) { SEAM(12); }
    cur_h = -1;
    if (IN(13) && !chain) { if (!NO_RWKV) for (int rep_ = 0; rep_ < RRWB; ++rep_) { v4u rraw[5]; float rmm[8], rkk[8]; rwkv_consts_load(blockIdx.x & 7, args.in, tid, rmm, rkk); bf16x8 lxa[8]; if ((int)blockIdx.x < 4096) { rwkv_rows_load(blockIdx.x, P, tid, rraw); rwkv_lx_load(blockIdx.x, LX, tid, lxa); }
            for (int u = blockIdx.x; u < 4096; u += G) { if ((G & 7) != 0) rwkv_consts_load(u & 7, args.in, tid, rmm, rkk); rwkv_chunk_unit<1>(u, (u + G < 4096) ? u + G : -1, -1, cur_h, rraw, lxa, rmm, rkk, P, LX, args.in, lora, GF, HS, Y, ctl, lds, tid); } } }
    SEAM(13);
    if (IN(14)) { pg8::Gemm g{Y, (const bf16*)(ws + WS_WOUTO), M, D, D}; pg8::StaticOrder S; S.init(M, D, G, (int)blockIdx.x);
        if (FUSE_MLPNORM) { pg8::EpiBf16ResSS<false> E{hb, fuse_final ? hbx : hb, D, SSP}; pg8::gemm_phase<pg8::EpiBf16ResSS<false>, pg8::StaticOrder, PG8_ALIGN, PG8_SP2>(lds, g, S, E); }
        else { pg8::EpiBf16Res<false> E{hb, hb, D}; pg8::gemm_phase<pg8::EpiBf16Res<false>, pg8::StaticOrder, PG8_ALIGN, PG8_SP2>(lds, g, S, E); } }
    SEAM(14);
    if (!FUSE_MLPNORM) { if (IN(15)) for (int rep_ = 0; rep_ < RNORM; ++rep_) norm_phase_b<0>(hb, args.in[2] + D, XN, nullptr, nullptr, 0, nullptr, lds, tid, G);
    SEAM(15); }
    if (IN(16)) { if (STAGGER) { const unsigned long long t0 = __builtin_amdgcn_s_memrealtime(); const unsigned long long dl = (unsigned long long)((blockIdx.x >> 3) & 7) * STAGGER; while (__builtin_amdgcn_s_memrealtime() - t0 < dl) __builtin_amdgcn_s_sleep(8); }
        pg8::Gemm g{FUSE_MLPNORM ? (fuse_final ? hbx : hb) : XN, (const bf16*)(ws + WS_WUP1), M, FF, D}; pg8::StaticOrder S; S.init(M, FF, G, (int)blockIdx.x); pg8::EpiBf16<2> E{HB, FF};
        pg8::gemm_phase<pg8::EpiBf16<2>, pg8::StaticOrder, PG8_ALIGN, PG8_SP2>(lds, g, S, E); }
    SEAM(16);
    if (IN(17)) { pg8::Gemm g{HB, (const bf16*)(ws + WS_WDN1), M, D, FF}; pg8::StaticOrder S; S.init(M, D, G, (int)blockIdx.x);
        if (fuse_final) { pg8::EpiFinalNorm E{hbx, hres, D, SSP, 1e-5f, args.in[32], (unsigned*)(ws + WS_XS), (unsigned*)ctl + CW_BAR + XB_TMO, (PG8_LAS float*)(lds + pg8::STAGE_BYTES)};
            pg8::gemm_phase<pg8::EpiFinalNorm, pg8::StaticOrder, PG8_ALIGN, PG8_SP2>(lds, g, S, E); }
        else if (FUSE_MLPNORM) { pg8::EpiBf16ResScale E{hb, hb2, D, SSP, 1e-5f}; pg8::gemm_phase<pg8::EpiBf16ResScale, pg8::StaticOrder, PG8_ALIGN, PG8_SP2>(lds, g, S, E); }
        else { pg8::EpiBf16Res<false> E{hb, hb2, D}; pg8::gemm_phase<pg8::EpiBf16Res<false>, pg8::StaticOrder, PG8_ALIGN, PG8_SP2>(lds, g, S, E); } }
    if (!fuse_final) { SEAM(17);
    if (IN(18)) norm_phase_b<2>(hb2, args.in[32], nullptr, hres, nullptr, 0, nullptr, lds, tid, G); }
#undef IN
#undef SEAM
}
extern "C" void kernel_launch(void* const* d_in, const int* in_sizes, int n_in, void* d_out, int out_size, void* d_ws, size_t ws_size, hipStream_t stream) {
    static int grid = 0;
    if (grid == 0) {
        if (n_in != 33 || in_sizes[0] != M * D || out_size != M * D || ws_size < WS_END) { fprintf(stderr, "kernel_launch: unexpected shapes (n_in %d, in0 %d, out %d, ws %zu < %zu); nothing launched\n", n_in, n_in > 0 ? in_sizes[0] : -1, out_size, ws_size, (size_t)WS_END); grid = -1; return; }
        int dev = 0, cus = 0, per_cu = 0;
        if (hipGetDevice(&dev) != hipSuccess || hipDeviceGetAttribute(&cus, hipDeviceAttributeMultiprocessorCount, dev) != hipSuccess) { grid = -1; return; }
        if (hipFuncSetAttribute((const void*)trunk_fwd, hipFuncAttributeMaxDynamicSharedMemorySize, LDS_BYTES) != hipSuccess) { fprintf(stderr, "kernel_launch: hipFuncSetAttribute failed\n"); grid = -1; return; }
        if (hipOccupancyMaxActiveBlocksPerMultiprocessor(&per_cu, (const void*)trunk_fwd, NWAVES * 64, LDS_BYTES) != hipSuccess || per_cu < 1) { fprintf(stderr, "kernel_launch: occupancy query reports %d workgroups per CU\n", per_cu); }
        (void)hipGetLastError();
        grid = cus;
    }
    if (grid < 0) return;
    if (hipMemsetAsync((char*)d_ws + WS_CTL, 0, CTL_ZERO_BYTES, stream) != hipSuccess) return;
    Args a{};
    for (int i = 0; i < 33; ++i) a.in[i] = (const float*)d_in[i];
    a.out = (float*)d_out; a.ws = (unsigned char*)d_ws;
#if MK_PER_PHASE
    for (int p = 0; p < N_PHASES; ++p) { a.ph_lo = p; a.ph_hi = p + 1; hipLaunchKernelGGL(trunk_fwd, dim3(grid), dim3(NWAVES * 64), LDS_BYTES, stream, a); }
#else
    a.ph_lo = 0; a.ph_hi = N_PHASES; hipLaunchKernelGGL(trunk_fwd, dim3(grid), dim3(NWAVES * 64), LDS_BYTES, stream, a);
#endif
}
```

```cpp
#include <hip/hip_runtime.h>
#include <cstdio>
#include <cstdint>
namespace pg8 {
#define PG8_LAS __attribute__((address_space(3)))
typedef unsigned short bf16_t;
typedef short bf16x8 __attribute__((ext_vector_type(8)));
typedef float f32x4 __attribute__((ext_vector_type(4)));
typedef unsigned u32x4 __attribute__((ext_vector_type(4)));
constexpr int BM = 256, BK = 64, HALF = 128, HTB = HALF * BK * 2  , STAGE_BYTES = 8 * HTB, NXCD = 8, WGM = 8;

__host__ __device__ __forceinline__ int lds_byte(int r, int c) { const int st = (r >> 4) * 2 + (c >> 5), rr = r & 15, cc = c & 31, ob = rr * 64 + cc * 2; return st * 1024 + (ob ^ (((ob >> 9) & 1) << 5)); }
__host__ __device__ __forceinline__ void stage_rc(int b, int& R, int& C) { const int st = b / 1024, sb = b % 1024, swz = sb ^ (((sb >> 9) & 1) << 5); R = (st >> 1) * 16 + swz / 64; C = (st & 1) * 32 + (swz % 64) / 2; }
__host__ __device__ __forceinline__ int perm32(int rho) { const int n = rho >> 4, i = rho & 15; return 8 * (i >> 2) + 4 * n + (i & 3); }

struct Unit { int pm, pn; };
struct Gemm { const bf16_t* A; const bf16_t* Bt; int M, N, K; };

struct StaticOrder {
    int nM, nN, nwg, G, c;
    __host__ __device__ void init(int M, int N, int G_, int c_) { nM = M / BM; nN = N / BM; nwg = nM * nN; G = G_; c = c_; }
    __host__ __device__ bool next(int i, Unit& u) const {
        const long L = (long)i * G + c; if (L >= nwg) return false;
        int wgid = (int)L; { const int q = nwg / NXCD, r = nwg % NXCD, xcd = wgid % NXCD, off = wgid / NXCD; wgid = (xcd < r ? xcd * (q + 1) : r * (q + 1) + (xcd - r) * q) + off; }
        const int nig = WGM * nN, gid = wgid / nig, fm = gid * WGM, gsz = (nM - fm) < WGM ? (nM - fm) : WGM;
        u.pm = fm + ((wgid % nig) % gsz); u.pn = (wgid % nig) / gsz; return true;
    }
    __device__ __forceinline__ void a_ready(const Unit&) const {}
    __device__ __forceinline__ void done(const Unit&) const {}
};

struct StaticOrderRev : StaticOrder {
    int nr; bool rev;
    __host__ __device__ void init(int M, int N, int G_, int c_) { StaticOrder::init(M, N, G_, c_); nr = (nwg + G - 1) / G; rev = (nwg % G) == 0; }
    __host__ __device__ bool next(int i, Unit& u) const { return StaticOrder::next((rev && i < nr) ? nr - 1 - i : i, u); }
};

#ifndef EPI_NT
#define EPI_NT 0
#endif
__device__ __forceinline__ unsigned cvt_pk_bf16(float lo, float hi) { unsigned r; asm volatile("v_cvt_pk_bf16_f32 %0, %1, %2" : "=v"(r) : "v"(lo), "v"(hi)); return r; }
#ifndef K_TWICE
#define K_TWICE 0
#endif
#ifndef EPI_TWICE
#define EPI_TWICE 0
#endif
template <int ACT> struct EpiBf16 {
    static constexpr bool PERM = true, AFTER_DRAIN = false, PROBE_TWICE = (EPI_TWICE != 0), PROBE_KTWICE = (K_TWICE != 0);
    bf16_t* O; int ldc;
    __device__ __forceinline__ void operator()(const f32x4 (&acc)[2][2][4][2], const Unit& u, int wr, int wc, int fr, int fq) const {
        const int row0 = u.pm * BM + wr * 64 + fr; const int col0 = u.pn * BM + wc * 32 + 8 * fq;
#pragma unroll
        for (int ai = 0; ai < 2; ++ai)
#pragma unroll
            for (int m = 0; m < 4; ++m) { bf16_t* rowp = O + (size_t)(row0 + ai * HALF + m * 16) * ldc + col0;
#pragma unroll
                for (int bj = 0; bj < 2; ++bj) { f32x4 v0 = acc[ai][bj][m][0], v1 = acc[ai][bj][m][1];
                    if (ACT == 2) {
#pragma unroll
                        for (int j = 0; j < 4; ++j) { v0[j] = __builtin_amdgcn_fmed3f(v0[j], 0.f, 3.0e38f); v1[j] = __builtin_amdgcn_fmed3f(v1[j], 0.f, 3.0e38f); }
                        v0 = v0 * v0; v1 = v1 * v1; }
                    u32x4 w; w.x = cvt_pk_bf16(v0[0], v0[1]); w.y = cvt_pk_bf16(v0[2], v0[3]); w.z = cvt_pk_bf16(v1[0], v1[1]); w.w = cvt_pk_bf16(v1[2], v1[3]);
                    if (EPI_NT) __builtin_nontemporal_store(w, (u32x4*)(rowp + bj * HALF)); else *(u32x4*)(rowp + bj * HALF) = w; } }
    }
};
struct EpiBf16RS {
    static constexpr bool PERM = true, AFTER_DRAIN = false, PROBE_TWICE = false, PROBE_KTWICE = false;
    bf16_t* O; int ldc; const float* rs;
    __device__ __forceinline__ void operator()(const f32x4 (&acc)[2][2][4][2], const Unit& u, int wr, int wc, int fr, int fq) const {
        const int row0 = u.pm * BM + wr * 64 + fr; const int col0 = u.pn * BM + wc * 32 + 8 * fq;
        float rv[2][4];
#pragma unroll
        for (int ai = 0; ai < 2; ++ai)
#pragma unroll
            for (int m = 0; m < 4; ++m) rv[ai][m] = rs[row0 + ai * HALF + m * 16];
#pragma unroll
        for (int ai = 0; ai < 2; ++ai)
#pragma unroll
            for (int m = 0; m < 4; ++m) { bf16_t* rowp = O + (size_t)(row0 + ai * HALF + m * 16) * ldc + col0; const float r = rv[ai][m];
#pragma unroll
                for (int bj = 0; bj < 2; ++bj) { const f32x4 v0 = acc[ai][bj][m][0] * r, v1 = acc[ai][bj][m][1] * r;
                    u32x4 w; w.x = cvt_pk_bf16(v0[0], v0[1]); w.y = cvt_pk_bf16(v0[2], v0[3]); w.z = cvt_pk_bf16(v1[0], v1[1]); w.w = cvt_pk_bf16(v1[2], v1[3]);
                    *(u32x4*)(rowp + bj * HALF) = w; } }
    }
};
struct EpiFinalNorm {
    static constexpr bool PERM = true, AFTER_DRAIN = false, PROBE_TWICE = false, PROBE_KTWICE = false;
    const bf16_t* base; float* out; int ldc; const float* ssp; float eps; const float* gain; unsigned* xs; unsigned* tmo; PG8_LAS float* rsf;
    __device__ __forceinline__ void operator()(f32x4 (&acc)[2][2][4][2], const Unit& u, int wr, int wc, int fr, int fq) const {
        const int row0 = u.pm * BM + wr * 64 + fr, col0 = u.pn * BM + wc * 32 + 8 * fq;
        const int tid = (wr * 4 + wc) * 64 + fq * 16 + fr, gr = tid >> 1, gh = tid & 1;
        u32x4 bw[4][2];
#pragma unroll
        for (int m = 0; m < 4; ++m)
#pragma unroll
            for (int bj = 0; bj < 2; ++bj) bw[m][bj] = __builtin_nontemporal_load((const u32x4*)(base + (size_t)(row0 + m * 16) * ldc + col0 + bj * HALF));
        { const float* sp = ssp + (size_t)(u.pm * BM + gr) * 16 + 8 * gh; const f32x4 t0 = *(const f32x4*)sp, t1 = *(const f32x4*)(sp + 4);
          float t = ((t0[0] + t0[1]) + (t0[2] + t0[3])) + ((t1[0] + t1[1]) + (t1[2] + t1[3])); t += __shfl_xor(t, 1);
          if (gh == 0) rsf[256 + gr] = 1.0f / (t * (1.0f / 1024.0f) + eps); }
        __syncthreads();
        float rs2v[2][4];
#pragma unroll
        for (int ai = 0; ai < 2; ++ai)
#pragma unroll
            for (int m = 0; m < 4; ++m) rs2v[ai][m] = rsf[256 + ai * HALF + wr * 64 + m * 16 + fr];
#pragma unroll
        for (int ai = 0; ai < 2; ++ai) {
            if (ai == 1) {
#pragma unroll
                for (int m = 0; m < 4; ++m)
#pragma unroll
                    for (int bj = 0; bj < 2; ++bj) bw[m][bj] = __builtin_nontemporal_load((const u32x4*)(base + (size_t)(row0 + HALF + m * 16) * ldc + col0 + bj * HALF)); }
#pragma unroll
            for (int m = 0; m < 4; ++m) { const int row = row0 + ai * HALF + m * 16; const float rs2 = rs2v[ai][m]; float ss = 0.f;
#pragma unroll
                for (int bj = 0; bj < 2; ++bj) { const u32x4 w = bw[m][bj];
                    const f32x4 b0 = (f32x4){__builtin_bit_cast(float, w.x << 16), __builtin_bit_cast(float, w.x & 0xffff0000u), __builtin_bit_cast(float, w.y << 16), __builtin_bit_cast(float, w.y & 0xffff0000u)};
                    const f32x4 b1 = (f32x4){__builtin_bit_cast(float, w.z << 16), __builtin_bit_cast(float, w.z & 0xffff0000u), __builtin_bit_cast(float, w.w << 16), __builtin_bit_cast(float, w.w & 0xffff0000u)};
                    const f32x4 h0 = b0 + acc[ai][bj][m][0] * rs2, h1 = b1 + acc[ai][bj][m][1] * rs2;
                    acc[ai][bj][m][0] = h0; acc[ai][bj][m][1] = h1;
                    ss += ((h0[0] * h0[0] + h0[1] * h0[1]) + (h0[2] * h0[2] + h0[3] * h0[3])) + ((h1[0] * h1[0] + h1[1] * h1[1]) + (h1[2] * h1[2] + h1[3] * h1[3])); }
                ss += __shfl_xor(ss, 16); ss += __shfl_xor(ss, 32);
                if (fq == 0) __hip_atomic_store(xs + (size_t)row * 16 + u.pn * 4 + wc, __builtin_bit_cast(unsigned, ss) | 1u, __ATOMIC_RELAXED, __HIP_MEMORY_SCOPE_AGENT); }
#pragma unroll
            for (int bj = 0; bj < 2; ++bj)
#pragma unroll
                for (int m = 0; m < 4; ++m) asm volatile("" : "+v"(acc[ai][bj][m][0]), "+v"(acc[ai][bj][m][1]) :: "memory"); }
        { const int r = gr, h = gh;
          typedef unsigned long long u64_;
          u64_* gp = (u64_*)(xs + (size_t)(u.pm * BM + r) * 16 + 8 * h);
          u64_ q[4]; unsigned spins = 0;
          for (;;) { bool ok = true;
#pragma unroll
              for (int j = 0; j < 4; ++j) q[j] = __hip_atomic_load(gp + j, __ATOMIC_RELAXED, __HIP_MEMORY_SCOPE_AGENT);
#pragma unroll
              for (int j = 0; j < 4; ++j) ok = ok && ((unsigned)q[j] != 0u) && ((unsigned)(q[j] >> 32) != 0u);
              if (ok) break;
              __builtin_amdgcn_s_sleep(2);
              if ((++spins & 255u) == 0u) { if (spins > (1u << 17) || __hip_atomic_load(tmo, __ATOMIC_RELAXED, __HIP_MEMORY_SCOPE_AGENT) != 0u) { __hip_atomic_store(tmo, 1u, __ATOMIC_RELAXED, __HIP_MEMORY_SCOPE_AGENT); break; } } }
          float s = 0.f;
#pragma unroll
          for (int j = 0; j < 4; ++j) s += __builtin_bit_cast(float, (unsigned)q[j]) + __builtin_bit_cast(float, (unsigned)(q[j] >> 32));
          s += __shfl_xor(s, 1);
          if (h == 0) rsf[r] = 1.0f / sqrtf(s * (1.0f / 1024.0f) + eps); }
        __syncthreads();
        f32x4 gv[2][2];
#pragma unroll
        for (int bj = 0; bj < 2; ++bj) { gv[bj][0] = *(const f32x4*)(gain + col0 + bj * HALF); gv[bj][1] = *(const f32x4*)(gain + col0 + bj * HALF + 4); }
#pragma unroll
        for (int ai = 0; ai < 2; ++ai)
#pragma unroll
            for (int m = 0; m < 4; ++m) { const int rl = ai * HALF + wr * 64 + m * 16 + fr; const float rf = rsf[rl]; float* op = out + (size_t)(u.pm * BM + rl) * ldc + col0;
#pragma unroll
                for (int bj = 0; bj < 2; ++bj) { *(f32x4*)(op + bj * HALF) = acc[ai][bj][m][0] * rf * gv[bj][0]; *(f32x4*)(op + bj * HALF + 4) = acc[ai][bj][m][1] * rf * gv[bj][1]; } }
    }
};
struct EpiF32Res {
    static constexpr bool PERM = false, AFTER_DRAIN = false, PROBE_TWICE = false, PROBE_KTWICE = false;
    const float* base; float* out; int ldc;
    __device__ __forceinline__ void operator()(const f32x4 (&acc)[2][2][4][2], const Unit& u, int wr, int wc, int fr, int fq) const {
        const int row0 = u.pm * BM + wr * 64 + fr, col0 = u.pn * BM + wc * 32 + 4 * fq;
#pragma unroll
        for (int ai = 0; ai < 2; ++ai)
#pragma unroll
            for (int m = 0; m < 4; ++m) { const size_t off = (size_t)(row0 + ai * HALF + m * 16) * ldc + col0;
                f32x4 bs[2][2];
#pragma unroll
                for (int bj = 0; bj < 2; ++bj)
#pragma unroll
                    for (int n = 0; n < 2; ++n) bs[bj][n] = *(const f32x4*)(base + off + bj * HALF + n * 16);
#pragma unroll
                for (int bj = 0; bj < 2; ++bj)
#pragma unroll
                    for (int n = 0; n < 2; ++n) *(f32x4*)(out + off + bj * HALF + n * 16) = bs[bj][n] + acc[ai][bj][m][n];
                asm volatile("" ::: "memory"); }
    }
};

struct EpiF32ResNorm {
    static constexpr bool PERM = true, AFTER_DRAIN = false, PROBE_TWICE = false, PROBE_KTWICE = false;
    const float* base; float* out; int ldc; const float* gain; bf16_t* xn; float* ssp;
    __device__ __forceinline__ void operator()(const f32x4 (&acc)[2][2][4][2], const Unit& u, int wr, int wc, int fr, int fq) const {
        const int row0 = u.pm * BM + wr * 64 + fr, col0 = u.pn * BM + wc * 32 + 8 * fq;
        f32x4 gv[2][2];
#pragma unroll
        for (int bj = 0; bj < 2; ++bj)
#pragma unroll
            for (int n = 0; n < 2; ++n) gv[bj][n] = *(const f32x4*)(gain + col0 + bj * HALF + n * 4);
#pragma unroll
        for (int ai = 0; ai < 2; ++ai)
#pragma unroll
            for (int m = 0; m < 4; ++m) { const int row = row0 + ai * HALF + m * 16; const size_t off = (size_t)row * ldc + col0;
                f32x4 bs[2][2];
#pragma unroll
                for (int bj = 0; bj < 2; ++bj)
#pragma unroll
                    for (int n = 0; n < 2; ++n) bs[bj][n] = *(const f32x4*)(base + off + bj * HALF + n * 4);
                float ss = 0.f;
#pragma unroll
                for (int bj = 0; bj < 2; ++bj) { const f32x4 h0 = bs[bj][0] + acc[ai][bj][m][0], h1 = bs[bj][1] + acc[ai][bj][m][1];
                    *(f32x4*)(out + off + bj * HALF) = h0; *(f32x4*)(out + off + bj * HALF + 4) = h1;
                    ss += ((h0[0] * h0[0] + h0[1] * h0[1]) + (h0[2] * h0[2] + h0[3] * h0[3])) + ((h1[0] * h1[0] + h1[1] * h1[1]) + (h1[2] * h1[2] + h1[3] * h1[3]));
                    const f32x4 y0 = h0 * gv[bj][0], y1 = h1 * gv[bj][1];
                    u32x4 w; w.x = cvt_pk_bf16(y0[0], y0[1]); w.y = cvt_pk_bf16(y0[2], y0[3]); w.z = cvt_pk_bf16(y1[0], y1[1]); w.w = cvt_pk_bf16(y1[2], y1[3]);
                    *(u32x4*)(xn + off + bj * HALF) = w; }
                ss += __shfl_xor(ss, 16); ss += __shfl_xor(ss, 32);
                if (fq == 0) ssp[(size_t)row * 16 + u.pn * 4 + wc] = ss;
                asm volatile("" ::: "memory"); }
    }
};
struct EpiF32ResScale {
    static constexpr bool PERM = false, AFTER_DRAIN = false, PROBE_TWICE = false, PROBE_KTWICE = false;
    const float* base; float* out; int ldc; const float* ssp; float eps;
    __device__ __forceinline__ void operator()(const f32x4 (&acc)[2][2][4][2], const Unit& u, int wr, int wc, int fr, int fq) const {
        const int row0 = u.pm * BM + wr * 64 + fr, col0 = u.pn * BM + wc * 32 + 4 * fq;
        float rs2[2][4];
#pragma unroll
        for (int ai = 0; ai < 2; ++ai)
#pragma unroll
            for (int m = 0; m < 4; ++m) { const f32x4* sp = (const f32x4*)(ssp + (size_t)(row0 + ai * HALF + m * 16) * 16); const f32x4 a = sp[0], b = sp[1], c = sp[2], d = sp[3];
                const f32x4 t = (a + b) + (c + d); rs2[ai][m] = 1.0f / (((t[0] + t[1]) + (t[2] + t[3])) * (1.0f / 1024.0f) + eps); }
#pragma unroll
        for (int ai = 0; ai < 2; ++ai)
#pragma unroll
            for (int m = 0; m < 4; ++m) { const size_t off = (size_t)(row0 + ai * HALF + m * 16) * ldc + col0;
                f32x4 bs[2][2];
#pragma unroll
                for (int bj = 0; bj < 2; ++bj)
#pragma unroll
                    for (int n = 0; n < 2; ++n) bs[bj][n] = *(const f32x4*)(base + off + bj * HALF + n * 16);
#pragma unroll
                for (int bj = 0; bj < 2; ++bj)
#pragma unroll
                    for (int n = 0; n < 2; ++n) *(f32x4*)(out + off + bj * HALF + n * 16) = bs[bj][n] + acc[ai][bj][m][n] * rs2[ai][m];
                asm volatile("" ::: "memory"); }
    }
};

template <bool BASE_F32> struct EpiBf16Res {
    static constexpr bool PERM = true, AFTER_DRAIN = false, PROBE_TWICE = false, PROBE_KTWICE = false;
    const void* base; bf16_t* out; int ldc;
    __device__ __forceinline__ void operator()(const f32x4 (&acc)[2][2][4][2], const Unit& u, int wr, int wc, int fr, int fq) const {
        const int row0 = u.pm * BM + wr * 64 + fr, col0 = u.pn * BM + wc * 32 + 8 * fq;
        if (!BASE_F32) {
            u32x4 bw[2][4][2];
#pragma unroll
            for (int ai = 0; ai < 2; ++ai)
#pragma unroll
                for (int m = 0; m < 4; ++m)
#pragma unroll
                    for (int bj = 0; bj < 2; ++bj) bw[ai][m][bj] = *(const u32x4*)((const bf16_t*)base + (size_t)(row0 + ai * HALF + m * 16) * ldc + col0 + bj * HALF);
#pragma unroll
            for (int ai = 0; ai < 2; ++ai)
#pragma unroll
                for (int m = 0; m < 4; ++m) { const size_t off = (size_t)(row0 + ai * HALF + m * 16) * ldc + col0;
#pragma unroll
                    for (int bj = 0; bj < 2; ++bj) { const u32x4 w = bw[ai][m][bj];
                        const f32x4 b0 = (f32x4){__builtin_bit_cast(float, w.x << 16), __builtin_bit_cast(float, w.x & 0xffff0000u), __builtin_bit_cast(float, w.y << 16), __builtin_bit_cast(float, w.y & 0xffff0000u)};
                        const f32x4 b1 = (f32x4){__builtin_bit_cast(float, w.z << 16), __builtin_bit_cast(float, w.z & 0xffff0000u), __builtin_bit_cast(float, w.w << 16), __builtin_bit_cast(float, w.w & 0xffff0000u)};
                        const f32x4 h0 = b0 + acc[ai][bj][m][0], h1 = b1 + acc[ai][bj][m][1];
                        u32x4 o; o.x = cvt_pk_bf16(h0[0], h0[1]); o.y = cvt_pk_bf16(h0[2], h0[3]); o.z = cvt_pk_bf16(h1[0], h1[1]); o.w = cvt_pk_bf16(h1[2], h1[3]);
                        *(u32x4*)(out + off + bj * HALF) = o; } }
        } else {
#pragma unroll
            for (int ai = 0; ai < 2; ++ai) {
                f32x4 bf[4][2][2];
#pragma unroll
                for (int m = 0; m < 4; ++m)
#pragma unroll
                    for (int bj = 0; bj < 2; ++bj) { const float* bp = (const float*)base + (size_t)(row0 + ai * HALF + m * 16) * ldc + col0 + bj * HALF; bf[m][bj][0] = *(const f32x4*)bp; bf[m][bj][1] = *(const f32x4*)(bp + 4); }
#pragma unroll
                for (int m = 0; m < 4; ++m) { const size_t off = (size_t)(row0 + ai * HALF + m * 16) * ldc + col0;
#pragma unroll
                    for (int bj = 0; bj < 2; ++bj) { const f32x4 h0 = bf[m][bj][0] + acc[ai][bj][m][0], h1 = bf[m][bj][1] + acc[ai][bj][m][1];
                        u32x4 o; o.x = cvt_pk_bf16(h0[0], h0[1]); o.y = cvt_pk_bf16(h0[2], h0[3]); o.z = cvt_pk_bf16(h1[0], h1[1]); o.w = cvt_pk_bf16(h1[2], h1[3]);
                        *(u32x4*)(out + off + bj * HALF) = o; } }
                asm volatile("" ::: "memory"); }
        }
    }
};

template <bool BASE_F32> struct EpiBf16ResSS {
    static constexpr bool PERM = true, AFTER_DRAIN = false, PROBE_TWICE = false, PROBE_KTWICE = false;
    const void* base; bf16_t* out; int ldc; float* ssp;
    __device__ __forceinline__ void operator()(const f32x4 (&acc)[2][2][4][2], const Unit& u, int wr, int wc, int fr, int fq) const {
        const int row0 = u.pm * BM + wr * 64 + fr, col0 = u.pn * BM + wc * 32 + 8 * fq;
#pragma unroll
        for (int ai = 0; ai < 2; ++ai) {
            f32x4 bf[4][2][2];
            if (BASE_F32) {
#pragma unroll
                for (int m = 0; m < 4; ++m)
#pragma unroll
                    for (int bj = 0; bj < 2; ++bj) { const float* bp = (const float*)base + (size_t)(row0 + ai * HALF + m * 16) * ldc + col0 + bj * HALF; bf[m][bj][0] = __builtin_nontemporal_load((const f32x4*)bp); bf[m][bj][1] = __builtin_nontemporal_load((const f32x4*)(bp + 4)); }
            } else {
                u32x4 bw[4][2];
#pragma unroll
                for (int m = 0; m < 4; ++m)
#pragma unroll
                    for (int bj = 0; bj < 2; ++bj) bw[m][bj] = *(const u32x4*)((const bf16_t*)base + (size_t)(row0 + ai * HALF + m * 16) * ldc + col0 + bj * HALF);
#pragma unroll
                for (int m = 0; m < 4; ++m)
#pragma unroll
                    for (int bj = 0; bj < 2; ++bj) { const u32x4 w = bw[m][bj];
                        bf[m][bj][0] = (f32x4){__builtin_bit_cast(float, w.x << 16), __builtin_bit_cast(float, w.x & 0xffff0000u), __builtin_bit_cast(float, w.y << 16), __builtin_bit_cast(float, w.y & 0xffff0000u)};
                        bf[m][bj][1] = (f32x4){__builtin_bit_cast(float, w.z << 16), __builtin_bit_cast(float, w.z & 0xffff0000u), __builtin_bit_cast(float, w.w << 16), __builtin_bit_cast(float, w.w & 0xffff0000u)}; }
            }
#pragma unroll
            for (int m = 0; m < 4; ++m) { const int row = row0 + ai * HALF + m * 16; const size_t off = (size_t)row * ldc + col0; float ss = 0.f;
#pragma unroll
                for (int bj = 0; bj < 2; ++bj) { const f32x4 h0 = bf[m][bj][0] + acc[ai][bj][m][0], h1 = bf[m][bj][1] + acc[ai][bj][m][1];
                    u32x4 o; o.x = cvt_pk_bf16(h0[0], h0[1]); o.y = cvt_pk_bf16(h0[2], h0[3]); o.z = cvt_pk_bf16(h1[0], h1[1]); o.w = cvt_pk_bf16(h1[2], h1[3]);
                    *(u32x4*)(out + off + bj * HALF) = o;
                    const f32x4 r0 = (f32x4){__builtin_bit_cast(float, o.x << 16), __builtin_bit_cast(float, o.x & 0xffff0000u), __builtin_bit_cast(float, o.y << 16), __builtin_bit_cast(float, o.y & 0xffff0000u)};
                    const f32x4 r1 = (f32x4){__builtin_bit_cast(float, o.z << 16), __builtin_bit_cast(float, o.z & 0xffff0000u), __builtin_bit_cast(float, o.w << 16), __builtin_bit_cast(float, o.w & 0xffff0000u)};
                    ss += ((r0[0] * r0[0] + r0[1] * r0[1]) + (r0[2] * r0[2] + r0[3] * r0[3])) + ((r1[0] * r1[0] + r1[1] * r1[1]) + (r1[2] * r1[2] + r1[3] * r1[3])); }
                ss += __shfl_xor(ss, 16); ss += __shfl_xor(ss, 32);
                if (fq == 0) ssp[(size_t)row * 16 + u.pn * 4 + wc] = ss; }
            asm volatile("" ::: "memory"); }
    }
};
struct EpiBf16ResScale {
    static constexpr bool PERM = true, AFTER_DRAIN = false, PROBE_TWICE = false, PROBE_KTWICE = false;
    const bf16_t* base; bf16_t* out; int ldc; const float* ssp; float eps;
    __device__ __forceinline__ void operator()(const f32x4 (&acc)[2][2][4][2], const Unit& u, int wr, int wc, int fr, int fq) const {
        const int row0 = u.pm * BM + wr * 64 + fr, col0 = u.pn * BM + wc * 32 + 8 * fq;
        float rs2v[2][4];
#pragma unroll
        for (int ai = 0; ai < 2; ++ai) { f32x4 sq[4][4];
#pragma unroll
            for (int m = 0; m < 4; ++m)
#pragma unroll
                for (int k = 0; k < 4; ++k) sq[m][k] = *(const f32x4*)(ssp + (size_t)(row0 + ai * HALF + m * 16) * 16 + 4 * k);
#pragma unroll
            for (int m = 0; m < 4; ++m) { const f32x4 t = (sq[m][0] + sq[m][1]) + (sq[m][2] + sq[m][3]); rs2v[ai][m] = 1.0f / (((t[0] + t[1]) + (t[2] + t[3])) * (1.0f / 1024.0f) + eps); }
            asm volatile("" ::: "memory"); }
#pragma unroll
        for (int ai = 0; ai < 2; ++ai) {
            u32x4 bw[4][2];
#pragma unroll
            for (int m = 0; m < 4; ++m)
#pragma unroll
                for (int bj = 0; bj < 2; ++bj) bw[m][bj] = *(const u32x4*)(base + (size_t)(row0 + ai * HALF + m * 16) * ldc + col0 + bj * HALF);
#pragma unroll
            for (int m = 0; m < 4; ++m) { const size_t off = (size_t)(row0 + ai * HALF + m * 16) * ldc + col0;
                const float rs2 = rs2v[ai][m];
#pragma unroll
                for (int bj = 0; bj < 2; ++bj) { const u32x4 w = bw[m][bj];
                    const f32x4 b0 = (f32x4){__builtin_bit_cast(float, w.x << 16), __builtin_bit_cast(float, w.x & 0xffff0000u), __builtin_bit_cast(float, w.y << 16), __builtin_bit_cast(float, w.y & 0xffff0000u)};
                    const f32x4 b1 = (f32x4){__builtin_bit_cast(float, w.z << 16), __builtin_bit_cast(float, w.z & 0xffff0000u), __builtin_bit_cast(float, w.w << 16), __builtin_bit_cast(float, w.w & 0xffff0000u)};
                    const f32x4 h0 = b0 + acc[ai][bj][m][0] * rs2, h1 = b1 + acc[ai][bj][m][1] * rs2;
                    u32x4 o; o.x = cvt_pk_bf16(h0[0], h0[1]); o.y = cvt_pk_bf16(h0[2], h0[3]); o.z = cvt_pk_bf16(h1[0], h1[1]); o.w = cvt_pk_bf16(h1[2], h1[3]);
                    *(u32x4*)(out + off + bj * HALF) = o; } }
            asm volatile("" ::: "memory"); }
    }
};
#ifndef RELAX_EPI_WAIT
#define RELAX_EPI_WAIT 0
#endif
template <class Epi, class Sched, bool ALIGN_EPI = false, bool SP2 = false>
__device__ __forceinline__ void gemm_phase(PG8_LAS unsigned char* lds, const Gemm g, const Sched& S, const Epi& E) {
    int tid_ = threadIdx.x; asm volatile("" : "+v"(tid_));
    const int tid = tid_, wid = __builtin_amdgcn_readfirstlane(tid >> 6), lane = tid & 63, wr = wid >> 2, wc = wid & 3, fr = lane & 15, fq = lane >> 4;
    const int K = g.K, nt = K / BK;
    unsigned voffA[2], voffB[2];
#pragma unroll
    for (int i = 0; i < 2; ++i) { int R, C; stage_rc(tid * 16 + i * 8192, R, C); const int Rb = Epi::PERM ? ((R & ~31) + perm32(R & 31)) : R;
        voffA[i] = (unsigned)(R * K + C) * 2u; voffB[i] = (unsigned)(Rb * K + C) * 2u; }
    const size_t kstep = (size_t)(BK * 2);
    const size_t hstep = (size_t)HALF * K * 2;
    const size_t qstep = (size_t)64 * K * 2;
    const size_t tstep = 2 * hstep;
    const unsigned ldsw = (unsigned)wid * 1024u;
    const int aoff = lds_byte(wr * 64 + fr, fq * 8), boff = lds_byte(wc * 32 + fr, fq * 8);
#define PG8_SA(b, h) (((b) * 2 + (h)) * HTB)
#define PG8_SB(b, h) ((4 + (b) * 2 + (h)) * HTB)
#define PG8_STAGE(bufoff, gbase, voff) do { _Pragma("unroll") for (int _i = 0; _i < 2; ++_i) \
        __builtin_amdgcn_global_load_lds((const unsigned*)((const char*)(gbase) + (size_t)_i * qstep + (voff)[0]), (PG8_LAS unsigned*)(lds + (bufoff) + ldsw + _i * 8192), 16, 0, 0); } while (0)
#define PG8_LDA(dst, b, h) do { _Pragma("unroll") for (int m = 0; m < 4; ++m) _Pragma("unroll") for (int k = 0; k < 2; ++k) dst[m][k] = *(const PG8_LAS bf16x8*)(lds + PG8_SA(b, h) + aoff + m * 2048 + k * 1024); } while (0)
#define PG8_LDB(dst, b, h) do { _Pragma("unroll") for (int n = 0; n < 2; ++n) _Pragma("unroll") for (int k = 0; k < 2; ++k) dst[n][k] = *(const PG8_LAS bf16x8*)(lds + PG8_SB(b, h) + boff + n * 2048 + k * 1024); } while (0)
#define PG8_MMA(ai, bj, At, Bt) do { __builtin_amdgcn_s_setprio(1); _Pragma("unroll") for (int m = 0; m < 4; ++m) _Pragma("unroll") for (int n = 0; n < 2; ++n) _Pragma("unroll") for (int k = 0; k < 2; ++k) \
        acc[ai][bj][m][n] = __builtin_amdgcn_mfma_f32_16x16x32_bf16(Bt[n][k], At[m][k], acc[ai][bj][m][n], 0, 0, 0); __builtin_amdgcn_s_setprio(0); } while (0)
#define PG8_WAIT_V(n) asm volatile("s_waitcnt vmcnt(" #n ")" ::: "memory")
#define PG8_WAIT_L(n) asm volatile("s_waitcnt lgkmcnt(" #n ")" ::: "memory")
#define PG8_BAR __builtin_amdgcn_s_barrier()
#define PG8_SCHED __builtin_amdgcn_sched_barrier(0)
    Unit cur, nxt; int ui = 0;
    constexpr int KT2 = Epi::PROBE_KTWICE ? 1 : 0;
    if (!S.next(0, cur)) return;
    f32x4 acc[2][2][4][2];
#pragma unroll
    for (int a = 0; a < 2; ++a)
#pragma unroll
        for (int b = 0; b < 2; ++b)
#pragma unroll
            for (int m = 0; m < 4; ++m)
#pragma unroll
                for (int n = 0; n < 2; ++n) acc[a][b][m][n] = (f32x4){0.f, 0.f, 0.f, 0.f};
    bf16x8 At[4][2], B0[2][2], B1[2][2];
    const char* cA = (const char*)g.A + (size_t)cur.pm * tstep; const char* cB = (const char*)g.Bt + (size_t)cur.pn * tstep;
    S.a_ready(cur);
    if constexpr (SP2) {
        PG8_STAGE(PG8_SB(0, 0), cB, voffB); PG8_STAGE(PG8_SB(0, 1), cB + hstep, voffB); PG8_STAGE(PG8_SA(0, 0), cA, voffA); PG8_STAGE(PG8_SA(0, 1), cA + hstep, voffA);
        if (wr == 1) PG8_BAR;
        PG8_WAIT_V(2); PG8_BAR;
        PG8_STAGE(PG8_SB(1, 0), cB + kstep, voffB); PG8_STAGE(PG8_SA(1, 0), cA + kstep, voffA); PG8_STAGE(PG8_SB(1, 1), cB + hstep + kstep, voffB);
        PG8_WAIT_V(6); PG8_BAR;
    } else {
        PG8_STAGE(PG8_SB(0, 0), cB, voffB); PG8_STAGE(PG8_SA(0, 0), cA, voffA); PG8_STAGE(PG8_SB(0, 1), cB + hstep, voffB); PG8_STAGE(PG8_SA(0, 1), cA + hstep, voffA);
        if (wr == 1) PG8_BAR;
        PG8_WAIT_V(4); PG8_BAR;
        PG8_STAGE(PG8_SB(1, 0), cB + kstep, voffB); PG8_STAGE(PG8_SA(1, 0), cA + kstep, voffA); PG8_STAGE(PG8_SB(1, 1), cB + hstep + kstep, voffB);
        PG8_WAIT_V(6); PG8_BAR;
    }
#define PG8_ITER(W1) do { \
            PG8_LDB(B0, 0, 0); PG8_LDB(B1, 0, 1); PG8_SCHED; PG8_LDA(At, 0, 0); PG8_STAGE(PG8_SA(1, 1), a1 + hstep, voffA); \
            PG8_WAIT_V(W1); PG8_WAIT_L(0); PG8_BAR; PG8_MMA(0, 0, At, B0); PG8_MMA(0, 1, At, B1); PG8_BAR; PG8_SCHED; \
            PG8_LDA(At, 0, 1); PG8_STAGE(PG8_SB(0, 0), b2, voffB); PG8_STAGE(PG8_SB(0, 1), b2 + hstep, voffB); PG8_STAGE(PG8_SA(0, 0), a2, voffA); \
            PG8_WAIT_V(W1); PG8_WAIT_L(0); PG8_BAR; PG8_MMA(1, 0, At, B0); PG8_MMA(1, 1, At, B1); PG8_BAR; PG8_SCHED; \
            PG8_LDB(B0, 1, 0); PG8_LDB(B1, 1, 1); PG8_SCHED; PG8_LDA(At, 1, 0); PG8_STAGE(PG8_SA(0, 1), a2 + hstep, voffA); \
            PG8_WAIT_V(8); PG8_WAIT_L(0); PG8_BAR; PG8_MMA(0, 0, At, B0); PG8_MMA(0, 1, At, B1); PG8_BAR; PG8_SCHED; \
            PG8_LDA(At, 1, 1); PG8_STAGE(PG8_SB(1, 0), b3, voffB); PG8_STAGE(PG8_SB(1, 1), b3 + hstep, voffB); PG8_STAGE(PG8_SA(1, 0), a3, voffA); \
            PG8_WAIT_V(8); PG8_WAIT_L(0); PG8_BAR; PG8_MMA(1, 0, At, B0); PG8_MMA(1, 1, At, B1); PG8_BAR; PG8_SCHED; } while (0)
    if constexpr (SP2 && RELAX_EPI_WAIT != 0) {
#pragma unroll
        for (int dq = 0; dq < 16; ++dq) __builtin_amdgcn_global_load_lds((const unsigned*)(cA + voffA[0]), (PG8_LAS unsigned*)(lds + STAGE_BYTES + ldsw), 16, 0, 0);
    }
    for (;;) {
        const bool has_next = S.next((ui + 1) >> KT2, nxt);
        const char* nA = has_next ? (const char*)g.A + (size_t)nxt.pm * tstep : cA; const char* nB = has_next ? (const char*)g.Bt + (size_t)nxt.pn * tstep : cB;
        if constexpr (SP2 && RELAX_EPI_WAIT != 0) {
            const char* a1 = cA + kstep; const char* a2 = cA + 2 * kstep; const char* b2 = cB + 2 * kstep; const char* a3 = a2 + kstep; const char* b3 = b2 + kstep;
            PG8_ITER(24);
        }
        for (int t = (SP2 && RELAX_EPI_WAIT != 0) ? 2 : 0; t < nt; t += 2) {
            const bool last = (t == nt - 2);
            const char* a1 = cA + (size_t)(t + 1) * kstep;
            const char* a2 = last ? nA : cA + (size_t)(t + 2) * kstep; const char* b2 = last ? nB : cB + (size_t)(t + 2) * kstep;
            const char* a3 = a2 + kstep; const char* b3 = b2 + kstep;
            if (last && has_next) S.a_ready(nxt);
            if constexpr (SP2) {
            PG8_ITER(8);
            } else {
            PG8_LDB(B0, 0, 0); PG8_SCHED; PG8_LDA(At, 0, 0); PG8_STAGE(PG8_SA(1, 1), a1 + hstep, voffA);
            PG8_WAIT_L(8); PG8_BAR; PG8_WAIT_L(0); PG8_MMA(0, 0, At, B0); PG8_BAR; PG8_SCHED;
            PG8_LDB(B1, 0, 1); PG8_STAGE(PG8_SB(0, 0), b2, voffB);
            PG8_BAR; PG8_WAIT_L(0); PG8_MMA(0, 1, At, B1); PG8_BAR;
            PG8_LDA(At, 0, 1); PG8_STAGE(PG8_SA(0, 0), a2, voffA);
            PG8_BAR; PG8_WAIT_L(0); PG8_MMA(1, 0, At, B0); PG8_BAR; PG8_SCHED;
            PG8_STAGE(PG8_SB(0, 1), b2 + hstep, voffB);
            PG8_WAIT_V(6); PG8_BAR; PG8_MMA(1, 1, At, B1); PG8_BAR;
            PG8_LDB(B0, 1, 0); PG8_SCHED; PG8_LDA(At, 1, 0); PG8_STAGE(PG8_SA(0, 1), a2 + hstep, voffA);
            PG8_WAIT_L(8); PG8_BAR; PG8_WAIT_L(0); PG8_MMA(0, 0, At, B0); PG8_BAR; PG8_SCHED;
            PG8_LDB(B1, 1, 1); PG8_STAGE(PG8_SB(1, 0), b3, voffB);
            PG8_BAR; PG8_WAIT_L(0); PG8_MMA(0, 1, At, B1); PG8_BAR;
            PG8_LDA(At, 1, 1); PG8_STAGE(PG8_SA(1, 0), a3, voffA);
            PG8_BAR; PG8_WAIT_L(0); PG8_MMA(1, 0, At, B0); PG8_BAR; PG8_SCHED;
            PG8_STAGE(PG8_SB(1, 1), b3 + hstep, voffB);
            PG8_WAIT_V(6); PG8_BAR; PG8_MMA(1, 1, At, B1); PG8_BAR;
            }
        }
        if constexpr (ALIGN_EPI) { if (wr == 0) PG8_BAR; }
        if constexpr (!Epi::AFTER_DRAIN) { if (!KT2 || (ui & 1)) E(acc, cur, wr, wc, fr, fq); if constexpr (Epi::PROBE_TWICE) { asm volatile("" ::: "memory"); E(acc, cur, wr, wc, fr, fq); } S.done(cur); }
        if (!has_next) break;
#pragma unroll
        for (int a = 0; a < 2; ++a)
#pragma unroll
            for (int b = 0; b < 2; ++b)
#pragma unroll
                for (int m = 0; m < 4; ++m)
#pragma unroll
                    for (int n = 0; n < 2; ++n) acc[a][b][m][n] = (f32x4){0.f, 0.f, 0.f, 0.f};
        cur = nxt; cA = nA; cB = nB; ++ui;
        if constexpr (ALIGN_EPI) { if (wr == 1) PG8_BAR; }
    }
    PG8_WAIT_V(0);
    if constexpr (!ALIGN_EPI) { if (wr == 0) PG8_BAR; }
    PG8_BAR;
    if constexpr (Epi::AFTER_DRAIN) { E.fused(acc, cur, wr, wc, fr, fq, lds, wid, lane); S.done(cur); }
#undef PG8_SA
#undef PG8_SB
#undef PG8_STAGE
#undef PG8_LDA
#undef PG8_LDB
#undef PG8_MMA
#undef PG8_WAIT_V
#undef PG8_WAIT_L
#undef PG8_BAR
#undef PG8_SCHED
#undef PG8_ITER
}
}
#ifndef PG8_SP2
#define PG8_SP2 true
#endif
#ifndef PG8_ALIGN
#define PG8_ALIGN true
#endif
#ifndef MK_PER_PHASE
#define MK_PER_PHASE 0
#endif
constexpr int NWAVES = 8;
constexpr int NB = 4, T = 8192, D = 1024, M = NB * T, FF = 4096;
constexpr int NE = 2304;
constexpr int NO = 3328;
constexpr int N_PHASES = 19;
constexpr size_t MiB = 1u << 20;
constexpr size_t WS_CTL = 0, CTL_ZERO_BYTES = 3584 * 1024;
constexpr size_t WS_RING = 512 * 1024;
constexpr size_t WS_GWT = 7 * MiB + 768 * 1024;
constexpr size_t WS_XS = 1536 * 1024;
constexpr size_t WS_ROPE = 7 * MiB, WS_LORA = 7 * MiB + 512 * 1024, WS_G0 = 507 * MiB, WS_DT = 4 * MiB, WS_MLS = 5 * MiB, WS_DEC = 6 * MiB;
constexpr size_t WS_WINE = 8 * MiB, WS_WOUTE = 13 * MiB, WS_WUP0 = 15 * MiB, WS_WDN0 = 23 * MiB, WS_WINO = 31 * MiB, WS_WOUTO = 38 * MiB, WS_WUP1 = 40 * MiB, WS_WDN1 = 48 * MiB;
constexpr size_t WS_XN = 56 * MiB;
constexpr size_t WS_R1 = 120 * MiB;
constexpr size_t WS_GF = WS_R1 + 208 * MiB;
constexpr size_t WS_LX = WS_R1 + 240 * MiB;
constexpr size_t WS_Y = 376 * MiB;
constexpr size_t WS_HS = 440 * MiB;
constexpr size_t WS_SSP = 504 * MiB;
constexpr size_t WS_RS = 506 * MiB;
constexpr size_t WS_END = 508 * MiB;
constexpr int CW_BAR = 1024;
constexpr int LDS_MAIN = 155648, LDSCTL_OFF = LDS_MAIN, LDS_BYTES = LDS_MAIN + 1024;

#define GAS __attribute__((address_space(1)))
#define LAS __attribute__((address_space(3)))
typedef unsigned short bf16;
typedef unsigned v4u __attribute__((ext_vector_type(4)));
typedef unsigned v2u __attribute__((ext_vector_type(2)));
typedef float f32x4 __attribute__((ext_vector_type(4)));
typedef short bf16x8 __attribute__((ext_vector_type(8)));
typedef GAS unsigned gu32;
#define RLX_AGENT __ATOMIC_RELAXED, __HIP_MEMORY_SCOPE_AGENT
#define LDS_WAIT() asm volatile("s_waitcnt lgkmcnt(0)" ::: "memory")
#define VM_WAIT() asm volatile("s_waitcnt vmcnt(0)" ::: "memory")
__device__ __forceinline__ unsigned f2bf(float f) { unsigned u = __builtin_bit_cast(unsigned, f); return (u + 0x7fffu + ((u >> 16) & 1u)) >> 16; }
typedef float f32x2_t __attribute__((ext_vector_type(2)));
typedef __bf16 bf16x2_t __attribute__((ext_vector_type(2)));
__device__ __forceinline__ unsigned pk2(float lo, float hi) { const f32x2_t v = {lo, hi}; const bf16x2_t b = __builtin_convertvector(v, bf16x2_t); return __builtin_bit_cast(unsigned, b); }
__device__ __forceinline__ bf16 tobf(float x) { return (bf16)pk2(x, x); }
__device__ __forceinline__ float row16_sum(float x) {
    x += __builtin_bit_cast(float, __builtin_amdgcn_update_dpp(0, __builtin_bit_cast(int, x), 0xB1, 0xF, 0xF, true));
    x += __builtin_bit_cast(float, __builtin_amdgcn_update_dpp(0, __builtin_bit_cast(int, x), 0x4E, 0xF, 0xF, true));
    x += __builtin_bit_cast(float, __builtin_amdgcn_update_dpp(0, __builtin_bit_cast(int, x), 0x141, 0xF, 0xF, true));
    x += __builtin_bit_cast(float, __builtin_amdgcn_update_dpp(0, __builtin_bit_cast(int, x), 0x140, 0xF, 0xF, true));
    return x;
}
__device__ __forceinline__ float bflo(unsigned w) { return __builtin_bit_cast(float, w << 16); }
__device__ __forceinline__ float bfhi(unsigned w) { return __builtin_bit_cast(float, w & 0xffff0000u); }
__device__ __forceinline__ float bf1(bf16 v) { return __builtin_bit_cast(float, (unsigned)v << 16); }
__device__ __forceinline__ void unpack8(const v4u w, float (&x)[8]) { x[0] = bflo(w.x); x[1] = bfhi(w.x); x[2] = bflo(w.y); x[3] = bfhi(w.y); x[4] = bflo(w.z); x[5] = bfhi(w.z); x[6] = bflo(w.w); x[7] = bfhi(w.w); }
__device__ __forceinline__ v4u pack8(const float (&x)[8]) { v4u w; w.x = pk2(x[0], x[1]); w.y = pk2(x[2], x[3]); w.z = pk2(x[4], x[5]); w.w = pk2(x[6], x[7]); return w; }
__device__ __forceinline__ bf16x8 frag8(const f32x4 a, const f32x4 b) { v4u w; w.x = pk2(a[0], a[1]); w.y = pk2(a[2], a[3]); w.z = pk2(b[0], b[1]); w.w = pk2(b[2], b[3]); return __builtin_bit_cast(bf16x8, w); }
__device__ __forceinline__ bf16x8 frag2(const v2u lo, const v2u hi) { v4u w; w.x = lo.x; w.y = lo.y; w.z = hi.x; w.w = hi.y; return __builtin_bit_cast(bf16x8, w); }
__device__ __forceinline__ f32x4 mfma16(bf16x8 a, bf16x8 b, f32x4 c) { return __builtin_amdgcn_mfma_f32_16x16x32_bf16(a, b, c, 0, 0, 0); }
__device__ __forceinline__ float rcpf_(float x) { return __builtin_amdgcn_rcpf(x); }
__device__ __forceinline__ float sigmoidf_(float x) { return rcpf_(1.f + __expf(-x)); }
__device__ __forceinline__ float siluf_(float x) { return x * rcpf_(1.f + __expf(-x)); }
__device__ __forceinline__ float softplus_fast(float x) { return fmaxf(x, 0.f) + 0.69314718f * __builtin_amdgcn_logf(1.f + __expf(-fabsf(x))); }
__device__ __forceinline__ float softplusf_(float x) { return fmaxf(x, 0.f) + log1pf(expf(-fabsf(x))); }
__device__ __forceinline__ float wave_sum(float v) { v = row16_sum(v); v += __shfl_xor(v, 16); v += __shfl_xor(v, 32); return v; }
__device__ __forceinline__ float wave_sum8(const float (&a)[8], int lane) {
    float x = row16_sum(a[0]); const int k = lane & 7;
#pragma unroll
    for (int q = 1; q < 8; ++q) { const float r = row16_sum(a[q]); x = (k == q) ? r : x; }
    x += __shfl_xor(x, 16); x += __shfl_xor(x, 32); return x;
}
__device__ __forceinline__ float wave_max(float v) {
#pragma unroll
    for (int o = 1; o < 64; o <<= 1) v = fmaxf(v, __shfl_xor(v, o));
    return v;
}
__device__ __forceinline__ float quad_sum(float v) { v += __shfl_xor(v, 16); v += __shfl_xor(v, 32); return v; }
__device__ __forceinline__ float quad_max(float v) { v = fmaxf(v, __shfl_xor(v, 16)); v = fmaxf(v, __shfl_xor(v, 32)); return v; }
__device__ __forceinline__ float scan_add(float v, int lane) {
#pragma unroll
    for (int o = 1; o < 64; o <<= 1) { const float t = __shfl_up(v, o); if (lane >= o) v += t; }
    return v;
}
__device__ __forceinline__ float scan_max(float v, int lane) {
#pragma unroll
    for (int o = 1; o < 64; o <<= 1) { const float t = __shfl_up(v, o); if (lane >= o) v = fmaxf(v, t); }
    return v;
}

template <int NT> __device__ __forceinline__ void load_rows(const bf16* base, int ld, int tt0, v4u (&raw)[NT + 3]) {
#pragma unroll
    for (int i = 0; i < NT + 3; ++i) { const int t2 = tt0 - 3 + i; raw[i] = (t2 >= 0) ? *(const v4u*)(base + (ptrdiff_t)t2 * ld) : (v4u){0u, 0u, 0u, 0u}; }
}
template <int NT> __device__ __forceinline__ void conv_silu(const v4u (&raw)[NT + 3], const float* convw, int wstride, const float* convb, float (&out)[NT][8]) {
    float w[4][8], bb[8];
#pragma unroll
    for (int tap = 0; tap < 4; ++tap) { const f32x4 w0 = *(const f32x4*)(convw + tap * wstride), w1 = *(const f32x4*)(convw + tap * wstride + 4);
        w[tap][0] = w0.x; w[tap][1] = w0.y; w[tap][2] = w0.z; w[tap][3] = w0.w; w[tap][4] = w1.x; w[tap][5] = w1.y; w[tap][6] = w1.z; w[tap][7] = w1.w; }
    { const f32x4 b0 = *(const f32x4*)convb, b1 = *(const f32x4*)(convb + 4); bb[0] = b0.x; bb[1] = b0.y; bb[2] = b0.z; bb[3] = b0.w; bb[4] = b1.x; bb[5] = b1.y; bb[6] = b1.z; bb[7] = b1.w; }
#pragma unroll
    for (int i = 0; i < NT; ++i)
#pragma unroll
        for (int e = 0; e < 8; ++e) out[i][e] = bb[e];
#pragma unroll
    for (int j = 0; j < NT + 3; ++j) { float x[8]; unpack8(raw[j], x);
#pragma unroll
        for (int tap = 0; tap < 4; ++tap) { const int i = j - tap;
            if (i >= 0 && i < NT) {
#pragma unroll
                for (int e = 0; e < 8; ++e) out[i][e] += x[e] * w[tap][e]; } } }
#pragma unroll
    for (int i = 0; i < NT; ++i)
#pragma unroll
        for (int e = 0; e < 8; ++e) out[i][e] = siluf_(out[i][e]);
}

__device__ __forceinline__ int tsw(int row, int tok) { return row * 136 + ((((tok >> 3) ^ (row >> 3)) & 15) << 3) + (tok & 7); }
#define XB_TMO      128
#define XB_XCNT(j)  (256  + 64 * (j))
#define XB_XSUB(j)  (1280 + 64 * (j))
#define XB_XGEN(j)  (2304 + 64 * (j))
#define XB_TOP      3328
#define XB_TOPGEN   3392
#define XCD_BAR_WORDS 3456
#define XB_SPIN_CAP (1u << 18)

__device__ __forceinline__ unsigned xb_ld(unsigned* p)              { return __hip_atomic_load(p, __ATOMIC_RELAXED, __HIP_MEMORY_SCOPE_AGENT); }
__device__ __forceinline__ unsigned xb_add(unsigned* p, unsigned v) { return __hip_atomic_fetch_add(p, v, __ATOMIC_RELAXED, __HIP_MEMORY_SCOPE_AGENT); }
__device__ __forceinline__ unsigned xb_xcc_id() { return (unsigned)__builtin_amdgcn_s_getreg((3 << 11) | 20) & 0xFu; }
#define XB_SPIN(cond, bar) do { unsigned _sp = 0; while (cond) { __builtin_amdgcn_s_sleep(1); \
    if ((++_sp & 255u) == 0u) { if (xb_ld(&(bar)[XB_TMO])) break; if (_sp > XB_SPIN_CAP) { atomicAdd(&(bar)[XB_TMO], 1u); break; } } } } while (0)

struct XcdBarrier {
    unsigned* bar; unsigned x;
    volatile LAS unsigned* st;
};

__device__ __forceinline__ XcdBarrier xcd_barrier_post(unsigned* bar, volatile LAS unsigned* st) {
    XcdBarrier b; b.bar = bar; b.x = xb_xcc_id(); b.st = st;
    if (threadIdx.x == 0) (void)xb_add(&bar[XB_XCNT(b.x)], 1u);
    return b;
}
__device__ __forceinline__ void xcd_barrier_complete(unsigned* bar, unsigned x, unsigned& nloc, unsigned& nx) {
    const unsigned G = gridDim.x * gridDim.y * gridDim.z;
    unsigned sum, cnt, mine, sp = 0u;
    for (;;) {
        sum = 0u; cnt = 0u; mine = 0u;
#pragma unroll
        for (unsigned j = 0; j < 16; ++j) { const unsigned c = xb_ld(&bar[XB_XCNT(j)]); sum += c; cnt += (c > 0u) ? 1u : 0u; mine = (j == x) ? c : mine; }
        if (sum == G) break;
        __builtin_amdgcn_s_sleep(1);
        if ((++sp & 255u) == 0u) { if (xb_ld(&bar[XB_TMO])) break; if (sp > XB_SPIN_CAP) { atomicAdd(&bar[XB_TMO], 1u); break; } }
    }
    nloc = mine > 0u ? mine : 1u; nx = cnt > 0u ? cnt : 1u;
}

__device__ __forceinline__ void xcd_barrier(const XcdBarrier& b) {
    asm volatile("s_waitcnt vmcnt(0)" ::: "memory");
    __syncthreads();
    if (threadIdx.x == 0) {
        unsigned* bar = b.bar;
        __builtin_amdgcn_s_waitcnt(0);
        unsigned nloc = b.st[0], nx = b.st[1];
        if (nloc == 0u) { xcd_barrier_complete(bar, b.x, nloc, nx); b.st[0] = nloc; b.st[1] = nx; }
        const unsigned old = xb_add(&bar[XB_XSUB(b.x)], 1u);
        const unsigned gen = old / nloc;
        if (old + 1u == (gen + 1u) * nloc) {
            __builtin_amdgcn_fence(__ATOMIC_RELEASE, "agent");
            asm volatile("s_waitcnt vmcnt(0)" ::: "memory");
            const unsigned og = xb_add(&bar[XB_TOP], 1u);
            const unsigned tg = og / nx;
            if (og + 1u == (tg + 1u) * nx) xb_add(&bar[XB_TOPGEN], 1u);
            else XB_SPIN(xb_ld(&bar[XB_TOPGEN]) == tg, bar);
            __builtin_amdgcn_fence(__ATOMIC_ACQUIRE, "agent");
            xb_add(&bar[XB_XGEN(b.x)], 1u);
            asm volatile("s_waitcnt vmcnt(0)" ::: "memory");
        } else {
            XB_SPIN(xb_ld(&bar[XB_XGEN(b.x)]) == gen, bar);
            __builtin_amdgcn_fence(__ATOMIC_ACQUIRE, "agent");
            asm volatile("s_waitcnt vmcnt(0)" ::: "memory");
        }
    }
    __syncthreads();
}
#ifndef DEFER_MLPW
#define DEFER_MLPW 1
#endif
#ifndef FUSE_MLPNORM
#define FUSE_MLPNORM 1
#endif
#ifndef FUSE_N9
#define FUSE_N9 1
#endif
__device__ __forceinline__ void p0_transpose_item(const float* W, int K, int ldw, int n_src0, bf16* WT, int row_dst0, int nblk, LAS float* scr, int item, int lane, const float* kgain = nullptr) {
    const int kb = item / nblk, nb = item % nblk, k0 = 64 * kb, n0 = 32 * nb;
#pragma unroll 8
    for (int i = 0; i < 32; ++i) { const int kk = 2 * i + (lane >> 5); const float gk = kgain ? kgain[k0 + kk] : 1.0f; scr[kk * 33 + (lane & 31)] = __builtin_nontemporal_load(W + (size_t)(k0 + kk) * ldw + n_src0 + n0 + (lane & 31)) * gk; }
    LDS_WAIT(); asm volatile("" ::: "memory");
    const int c = lane & 7;
#pragma unroll
    for (int j = 0; j < 4; ++j) { const int n = (lane >> 3) + 8 * j; const LAS float* s = scr + (8 * c) * 33 + n;
        v4u o; o.x = pk2(s[0 * 33], s[1 * 33]); o.y = pk2(s[2 * 33], s[3 * 33]); o.z = pk2(s[4 * 33], s[5 * 33]); o.w = pk2(s[6 * 33], s[7 * 33]);
        *(GAS v4u*)(WT + (size_t)(row_dst0 + n0 + n) * K + k0 + 8 * c) = o; }
    LDS_WAIT(); asm volatile("" ::: "memory");
}
struct TrJob { const float* W; int K, ldw, n_src0; bf16* WT; int row_dst0, nblk, nitems; };
__device__ __forceinline__ void p0_prologue(const float* const* in, unsigned char* ws, LAS unsigned char* lds, int tid, int G) {
    const int lane = tid & 63, wave = __builtin_amdgcn_readfirstlane(tid >> 6);
    LAS float* scr = (LAS float*)(lds + wave * 16384);
    const int gw = blockIdx.x * NWAVES + wave, NGW = G * NWAVES;
#define TRJG(Wp, K_, ldw_, s0_, dst_, r0_, ncols_, kg_) { int nblk_ = (ncols_) / 32; int ni_ = ((K_) / 64) * nblk_; if (it < ni_) { p0_transpose_item(Wp, K_, ldw_, s0_, (bf16*)(ws + dst_), r0_, nblk_, scr, it, lane, kg_); continue; } it -= ni_; }
#define TRJ(Wp, K_, ldw_, s0_, dst_, r0_, ncols_) TRJG(Wp, K_, ldw_, s0_, dst_, r0_, ncols_, nullptr)
    constexpr int NITEMS = 16 * 72 + 16 * 32 + (DEFER_MLPW ? 0 : 16 * 48 + 16 * 56 + 16 * 32 + 2 * 16 * 128 + 2 * 64 * 32);
    for (int it0 = gw; it0 < NITEMS; it0 += NGW) {
        int it = it0;
        TRJ(in[5], 1024, 2312, 0, WS_WINE, 0, 2304)
        TRJ(in[6], 1024, 1024, 0, WS_WOUTE, 0, 1024)
        if (!DEFER_MLPW) {
        TRJG(in[13], 1024, 3336, 0, WS_WINO, 0, 1536, FUSE_N9 ? in[1] + 1024 : nullptr)
        TRJG(in[13], 1024, 3336, 1544, WS_WINO, 1536, 1792, FUSE_N9 ? in[1] + 1024 : nullptr)
        TRJ(in[14], 1024, 1024, 0, WS_WOUTO, 0, 1024)
        TRJG(in[3], 1024, 4096, 0, WS_WUP0, 0, 4096, FUSE_MLPNORM ? in[2] : nullptr)
        TRJG(in[3] + (size_t)1024 * 4096, 1024, 4096, 0, WS_WUP1, 0, 4096, FUSE_MLPNORM ? in[2] + 1024 : nullptr)
        TRJ(in[4], 4096, 1024, 0, WS_WDN0, 0, 1024)
        TRJ(in[4] + (size_t)4096 * 1024, 4096, 1024, 0, WS_WDN1, 0, 1024)
        }
    }
    const int gt = blockIdx.x * 512 + tid, NGT = G * 512;
    bf16* w2t = (bf16*)(ws + WS_LORA); bf16* a2t = w2t + 512 * 64; bf16* g2t = a2t + 512 * 64;
    for (int i = gt; i < 512 * 64; i += NGT) { const int n = i >> 6, j = i & 63; w2t[i] = tobf(in[23][j * 512 + n]); a2t[i] = tobf(in[25][j * 512 + n]); }
    for (int i = gt; i < 512 * 128; i += NGT) { const int n = i >> 7, j = i & 127; g2t[i] = tobf(in[26][j * 512 + n]); }
    { float* gwt = (float*)(ws + WS_GWT); for (int i = gt; i < 8192; i += NGT) { const int q = i >> 10, k = i & 1023; gwt[i] = in[13][(size_t)k * 3336 + 1536 + q] * in[1][1024 + k]; } }
    float2* rope = (float2*)(ws + WS_ROPE);
    for (int i = gt; i < T * 8; i += NGT) { const int t = i >> 3, d = i & 7; const float inv = powf(500000.0f, -(float)d * 0.125f); const float ang = (float)t * inv; rope[i] = make_float2(cosf(ang), sinf(ang)); }
}
__device__ __forceinline__ void mlp_weights_convert(const float* const* in, unsigned char* ws, int layer, LAS unsigned char* lds, int tid, int b0, int nb) {
    const int lane = tid & 63, wave = __builtin_amdgcn_readfirstlane(tid >> 6);
    LAS float* scr = (LAS float*)(lds + wave * 16384);
    const int gw = ((int)blockIdx.x - b0) * NWAVES + wave, NGW = nb * NWAVES;
    for (int it0 = gw; it0 < 16 * 128 + 64 * 32 + (layer == 0 ? 16 * 48 + 16 * 56 + 16 * 32 : 0); it0 += NGW) {
        int it = it0;
        TRJG(in[3] + (size_t)layer * 1024 * 4096, 1024, 4096, 0, (layer ? WS_WUP1 : WS_WUP0), 0, 4096, FUSE_MLPNORM ? in[2] + layer * 1024 : nullptr)
        TRJ(in[4] + (size_t)layer * 4096 * 1024, 4096, 1024, 0, (layer ? WS_WDN1 : WS_WDN0), 0, 1024)
        if (layer == 0) {
        TRJG(in[13], 1024, 3336, 0, WS_WINO, 0, 1536, FUSE_N9 ? in[1] + 1024 : nullptr)
        TRJG(in[13], 1024, 3336, 1544, WS_WINO, 1536, 1792, FUSE_N9 ? in[1] + 1024 : nullptr)
        TRJ(in[14], 1024, 1024, 0, WS_WOUTO, 0, 1024)
        }
    }
}
#undef TRJ
#undef TRJG
template <int MODE>
__device__ __forceinline__ void norm_phase(const float* src, const float* gain, bf16* dst, float* dstf, const float* gw, int ldg, float* gout, LAS unsigned char* lds, int tid, int G) {
    const int lane = tid & 63, wave = __builtin_amdgcn_readfirstlane(tid >> 6);
    LAS float* Wg = (LAS float*)lds;
    if (MODE == 1) { for (int i = tid; i < 8192; i += 512) { const int k = i >> 3, j = i & 7; Wg[j * 1024 + k] = gw[(size_t)k * ldg + j]; } __syncthreads(); }
    f32x4 gv[4];
#pragma unroll
    for (int j = 0; j < 4; ++j) gv[j] = *(const f32x4*)(gain + 4 * lane + 256 * j);
    f32x4 nv[4];
    { const int m0 = blockIdx.x * NWAVES + wave; if (m0 < M) { const f32x4* xr = (const f32x4*)(src + (size_t)m0 * D) + lane;
#pragma unroll
        for (int j = 0; j < 4; ++j) nv[j] = xr[64 * j]; } }
    for (int m = blockIdx.x * NWAVES + wave; m < M; m += G * NWAVES) {
        f32x4 v[4]; float s = 0.f;
#pragma unroll
        for (int j = 0; j < 4; ++j) v[j] = nv[j];
        if (m + G * NWAVES < M) { const f32x4* xr = (const f32x4*)(src + (size_t)(m + G * NWAVES) * D) + lane;
#pragma unroll
            for (int j = 0; j < 4; ++j) nv[j] = xr[64 * j]; }
#pragma unroll
        for (int j = 0; j < 4; ++j) s += (v[j].x * v[j].x + v[j].y * v[j].y) + (v[j].z * v[j].z + v[j].w * v[j].w);
        const float rs = 1.0f / sqrtf(wave_sum(s) * (1.f / D) + 1e-5f);
#pragma unroll
        for (int j = 0; j < 4; ++j) v[j] = v[j] * rs * gv[j];
        if (MODE == 2) {
            f32x4* o = (f32x4*)(dstf + (size_t)m * D) + lane;
#pragma unroll
            for (int j = 0; j < 4; ++j) o[64 * j] = v[j];
        } else {
            v2u* o = (v2u*)(dst + (size_t)m * D) + lane;
#pragma unroll
            for (int j = 0; j < 4; ++j) { v2u w; w.x = pk2(v[j].x, v[j].y); w.y = pk2(v[j].z, v[j].w); o[64 * j] = w; }
        }
        if (MODE == 1) {
            float g8[8];
#pragma unroll
            for (int q = 0; q < 8; ++q) { float a = 0.f;
#pragma unroll
                for (int j = 0; j < 4; ++j) { const f32x4 w = *(const LAS f32x4*)(Wg + q * 1024 + 4 * lane + 256 * j); a += (v[j].x * w.x + v[j].y * w.y) + (v[j].z * w.z + v[j].w * w.w); }
                g8[q] = a; }
            const float gt = wave_sum8(g8, lane);
            if (lane < 8) gout[(size_t)m * 8 + lane] = gt;
        }
    }
}
template <int MODE>
__device__ __forceinline__ void norm_phase_b(const bf16* src, const float* gain, bf16* dst, float* dstf, const float* gw, int ldg, float* gout, LAS unsigned char* lds, int tid, int G) {
    const int lane = tid & 63, wave = __builtin_amdgcn_readfirstlane(tid >> 6);
    LAS float* Wg = (LAS float*)lds;
    if (MODE == 1 || MODE == 3) { for (int i = tid; i < 8192; i += 512) { const int k = i >> 3, j = i & 7; Wg[j * 1024 + k] = gw[(size_t)k * ldg + j]; } __syncthreads(); }
    float gv[2][8];
#pragma unroll
    for (int j = 0; j < 2; ++j) { const f32x4 g0 = *(const f32x4*)(gain + 8 * lane + 512 * j), g1 = *(const f32x4*)(gain + 8 * lane + 512 * j + 4);
        gv[j][0] = g0.x; gv[j][1] = g0.y; gv[j][2] = g0.z; gv[j][3] = g0.w; gv[j][4] = g1.x; gv[j][5] = g1.y; gv[j][6] = g1.z; gv[j][7] = g1.w; }
    v4u nraw[2];
    { const int m0 = blockIdx.x * NWAVES + wave; if (m0 < M) {
#pragma unroll
        for (int j = 0; j < 2; ++j) nraw[j] = *(const v4u*)(src + (size_t)m0 * D + 8 * lane + 512 * j); } }
    for (int m = blockIdx.x * NWAVES + wave; m < M; m += G * NWAVES) {
        float v[2][8]; float s = 0.f; v4u raw[2];
#pragma unroll
        for (int j = 0; j < 2; ++j) raw[j] = nraw[j];
        if (m + G * NWAVES < M) {
#pragma unroll
            for (int j = 0; j < 2; ++j) nraw[j] = *(const v4u*)(src + (size_t)(m + G * NWAVES) * D + 8 * lane + 512 * j); }
#pragma unroll
        for (int j = 0; j < 2; ++j) { unpack8(raw[j], v[j]);
#pragma unroll
            for (int e = 0; e < 8; ++e) s += v[j][e] * v[j][e]; }
        const float rs = 1.0f / sqrtf(wave_sum(s) * (1.f / D) + 1e-5f);
#pragma unroll
        for (int j = 0; j < 2; ++j)
#pragma unroll
            for (int e = 0; e < 8; ++e) v[j][e] = v[j][e] * rs * gv[j][e];
        if (MODE == 2) {
#pragma unroll
            for (int j = 0; j < 2; ++j) { f32x4* o = (f32x4*)(dstf + (size_t)m * D + 8 * lane + 512 * j); o[0] = (f32x4){v[j][0], v[j][1], v[j][2], v[j][3]}; o[1] = (f32x4){v[j][4], v[j][5], v[j][6], v[j][7]}; }
        } else if (MODE == 3) {
            if (lane == 0) dstf[m] = rs;
        } else {
#pragma unroll
            for (int j = 0; j < 2; ++j) *(v4u*)(dst + (size_t)m * D + 8 * lane + 512 * j) = pack8(v[j]);
        }
        if (MODE == 1 || MODE == 3) {
            float g8[8];
#pragma unroll
            for (int q = 0; q < 8; ++q) { float a = 0.f;
#pragma unroll
                for (int j = 0; j < 2; ++j) { const f32x4 w0 = *(const LAS f32x4*)(Wg + q * 1024 + 8 * lane + 512 * j), w1 = *(const LAS f32x4*)(Wg + q * 1024 + 8 * lane + 512 * j + 4);
                    a += (v[j][0] * w0.x + v[j][1] * w0.y) + (v[j][2] * w0.z + v[j][3] * w0.w) + (v[j][4] * w1.x + v[j][5] * w1.y) + (v[j][6] * w1.z + v[j][7] * w1.w); }
                g8[q] = a; }
            const float gt = wave_sum8(g8, lane);
            if (lane < 8) gout[(size_t)m * 8 + lane] = gt;
        }
    }
}
__device__ __forceinline__ void norm_x_gates_phase(const float* src, const float* gain, bf16* dst, const float* gw, int ldg, float* gout, LAS unsigned char* lds, int tid, int G) {
    const int lane = tid & 63, wave = __builtin_amdgcn_readfirstlane(tid >> 6);
    LAS float* Wg = (LAS float*)lds;
    for (int i = tid; i < 8192; i += 512) { const int k = i >> 3, j = i & 7; Wg[j * 1024 + k] = gw[(size_t)k * ldg + j]; }
    __syncthreads();
    f32x4 gv[4];
#pragma unroll
    for (int j = 0; j < 4; ++j) gv[j] = *(const f32x4*)(gain + 4 * lane + 256 * j);
    const int stride = G * NWAVES;
    for (int m = blockIdx.x * NWAVES + wave; m < M; m += 2 * stride) {
        const int m1 = (m + stride < M) ? m + stride : m;
        f32x4 v[2][4];
#pragma unroll
        for (int rr = 0; rr < 2; ++rr) { const f32x4* xr = (const f32x4*)(src + (size_t)(rr ? m1 : m) * D) + lane;
#pragma unroll
            for (int j = 0; j < 4; ++j) v[rr][j] = __builtin_nontemporal_load(xr + 64 * j); }
#pragma unroll
        for (int rr = 0; rr < 2; ++rr) { float s = 0.f;
#pragma unroll
            for (int j = 0; j < 4; ++j) s += (v[rr][j].x * v[rr][j].x + v[rr][j].y * v[rr][j].y) + (v[rr][j].z * v[rr][j].z + v[rr][j].w * v[rr][j].w);
            const float rs = 1.0f / sqrtf(wave_sum(s) * (1.f / D) + 1e-5f);
#pragma unroll
            for (int j = 0; j < 4; ++j) v[rr][j] = v[rr][j] * rs * gv[j];
            if (rr == 0 || m1 != m) { v2u* o = (v2u*)(dst + (size_t)(rr ? m1 : m) * D) + lane;
#pragma unroll
                for (int j = 0; j < 4; ++j) { v2u w; w.x = pk2(v[rr][j].x, v[rr][j].y); w.y = pk2(v[rr][j].z, v[rr][j].w); o[64 * j] = w; } } }
        float g8[2][8];
#pragma unroll
        for (int q = 0; q < 8; ++q) { float a0 = 0.f, a1 = 0.f;
#pragma unroll
            for (int j = 0; j < 4; ++j) { const f32x4 w = *(const LAS f32x4*)(Wg + q * 1024 + 4 * lane + 256 * j);
                a0 += (v[0][j].x * w.x + v[0][j].y * w.y) + (v[0][j].z * w.z + v[0][j].w * w.w); a1 += (v[1][j].x * w.x + v[1][j].y * w.y) + (v[1][j].z * w.z + v[1][j].w * w.w); }
            g8[0][q] = a0; g8[1][q] = a1; }
        const float gt0 = wave_sum8(g8[0], lane), gt1 = wave_sum8(g8[1], lane);
        if (lane < 8) { gout[(size_t)m * 8 + lane] = gt0; if (m1 != m) gout[(size_t)m1 * 8 + lane] = gt1; }
    }
}
__device__ __forceinline__ void norm_rs_dt_phase(const bf16* src, const float* gain, float* rsout, const float* gw, int ldg, float* gout, LAS unsigned char* lds, int tid, int G) {
    const int lane = tid & 63, wave = __builtin_amdgcn_readfirstlane(tid >> 6);
    LAS float* Wg = (LAS float*)lds;
    if (ldg == 0) { for (int i = tid; i < 2048; i += 512) *(LAS f32x4*)(Wg + 4 * i) = *(const f32x4*)(gw + 4 * i); }
    else for (int i = tid; i < 8192; i += 512) { const int k = i >> 3, j = i & 7; Wg[j * 1024 + k] = gw[(size_t)k * ldg + j] * gain[k]; }
    __syncthreads();
    const int stride = G * NWAVES;
    for (int m = blockIdx.x * NWAVES + wave; m < M; m += 2 * stride) {
        const int m1 = (m + stride < M) ? m + stride : m;
        v4u raw[2][2];
#pragma unroll
        for (int rr = 0; rr < 2; ++rr)
#pragma unroll
            for (int j = 0; j < 2; ++j) raw[rr][j] = *(const v4u*)(src + (size_t)(rr ? m1 : m) * D + 8 * lane + 512 * j);
        f32x2_t v[2][2][4]; float rs[2];
#pragma unroll
        for (int rr = 0; rr < 2; ++rr) { f32x2_t s2 = (f32x2_t){0.f, 0.f};
#pragma unroll
            for (int j = 0; j < 2; ++j)
#pragma unroll
                for (int p = 0; p < 4; ++p) { const unsigned w = raw[rr][j][p]; v[rr][j][p] = (f32x2_t){bflo(w), bfhi(w)}; s2 += v[rr][j][p] * v[rr][j][p]; }
            rs[rr] = 1.0f / sqrtf(wave_sum(s2.x + s2.y) * (1.f / D) + 1e-5f);
            if (lane == 0 && (rr == 0 || m1 != m)) rsout[rr ? m1 : m] = rs[rr]; }
        float g8[2][8];
#pragma unroll
        for (int q = 0; q < 8; ++q) { f32x2_t a0 = (f32x2_t){0.f, 0.f}, a1 = a0;
#pragma unroll
            for (int j = 0; j < 2; ++j) { const f32x4 w0 = *(const LAS f32x4*)(Wg + q * 1024 + 8 * lane + 512 * j), w1 = *(const LAS f32x4*)(Wg + q * 1024 + 8 * lane + 512 * j + 4);
                const f32x2_t wa = (f32x2_t){w0.x, w0.y}, wb = (f32x2_t){w0.z, w0.w}, wc = (f32x2_t){w1.x, w1.y}, wd = (f32x2_t){w1.z, w1.w};
                a0 += v[0][j][0] * wa; a0 += v[0][j][1] * wb; a0 += v[0][j][2] * wc; a0 += v[0][j][3] * wd;
                a1 += v[1][j][0] * wa; a1 += v[1][j][1] * wb; a1 += v[1][j][2] * wc; a1 += v[1][j][3] * wd; }
            g8[0][q] = a0.x + a0.y; g8[1][q] = a1.x + a1.y; }
        const float gt0 = wave_sum8(g8[0], lane) * rs[0], gt1 = wave_sum8(g8[1], lane) * rs[1];
        if (lane < 8) { gout[(size_t)m * 8 + lane] = gt0; if (m1 != m) gout[(size_t)m1 * 8 + lane] = gt1; }
    }
}
__device__ __forceinline__ void attn_unit(int u, const bf16* P, const float2* rope, const float* sinks, bf16* Y, LAS unsigned char* lds, int tid) {
    asm volatile("; MARK_BEGIN_attn_unit");
    asm volatile("" : "+v"(tid));
    const int lane = tid & 63, wave = __builtin_amdgcn_readfirstlane(tid >> 6), fr = lane & 15, fq = lane >> 4;
    const int blk = u & 63, kvh = (u >> 6) & 1, b = u >> 7;
    LAS bf16* Ks = (LAS bf16*)lds;
    LAS bf16* Vt = Ks + 256 * 72;
    LAS f32x2_t* rq = (LAS f32x2_t*)(Vt + 64 * 264);
    const int tok0 = blk * 128 - 128;
    const int g = wave >> 1, half = wave & 1, hq = kvh * 4 + g;
    v4u qn0, qn1, qnp;
    { const int tq = blk * 128 + (half * 4) * 16 + fr; const bf16* qsrc = P + (size_t)(b * T + tq) * NE + hq * 64;
      qn0 = *(const v4u*)(qsrc + 8 * fq); qn1 = *(const v4u*)(qsrc + 32 + 8 * fq); qnp = *(const v4u*)(qsrc + 8 * ((fq ^ 1) & 1)); }
    { const f32x4 r4 = *(const f32x4*)((const float*)(rope + (size_t)(blk * 128) * 8) + tid * 4); *(LAS f32x4*)((LAS float*)rq + tid * 4) = r4; }
    {
        const int c = tid & 7;
        v4u vv[4], k0[4], k1[4];
#pragma unroll
        for (int j = 0; j < 4; ++j) { const int r = (tid >> 3) + 64 * j, t = tok0 + r; const bf16* src = P + (size_t)(b * T + (t < 0 ? 0 : t)) * NE;
            vv[j] = (v4u){0u, 0u, 0u, 0u}; k0[j] = vv[j]; k1[j] = vv[j];
            if (t >= 0) { vv[j] = *(const v4u*)(src + 640 + kvh * 64 + c * 8); if (c != 1) k0[j] = *(const v4u*)(src + 512 + kvh * 64 + c * 8); if (c == 0) k1[j] = *(const v4u*)(src + 512 + kvh * 64 + 8); } }
#pragma unroll
        for (int j = 0; j < 4; ++j) { const int r = (tid >> 3) + 64 * j, t = tok0 + r;
#pragma unroll
            for (int e = 0; e < 8; ++e) Vt[(c * 8 + e) * 264 + r] = (bf16)(vv[j][e >> 1] >> ((e & 1) * 16));
            if (c == 0) {
                float x1[8], x2[8], o1[8], o2[8]; unpack8(k0[j], x1); unpack8(k1[j], x2);
                const float2* cs = rope + (size_t)(t < 0 ? 0 : t) * 8;
#pragma unroll
                for (int e = 0; e < 8; ++e) { const float2 q = cs[e]; o1[e] = x1[e] * q.x - x2[e] * q.y; o2[e] = x2[e] * q.x + x1[e] * q.y; }
                *(LAS v4u*)(Ks + r * 72) = pack8(o1); *(LAS v4u*)(Ks + r * 72 + 8) = pack8(o2);
            } else if (c != 1) *(LAS v4u*)(Ks + r * 72 + c * 8) = k0[j]; }
    }
    __syncthreads();
    const float sink = sinks[hq];
#pragma unroll 1
    for (int a = 0; a < 4; ++a) {
        const int ag = half * 4 + a, i = ag * 16 + fr, tq = blk * 128 + i;
        float x0[8], x1v[8];
        const v4u qc0 = qn0, qc1 = qn1, qcp = qnp;
        if (a < 3) { const bf16* qsrc = P + (size_t)(b * T + tq + 16) * NE + hq * 64; qn0 = *(const v4u*)(qsrc + 8 * fq); qn1 = *(const v4u*)(qsrc + 32 + 8 * fq); qnp = *(const v4u*)(qsrc + 8 * ((fq ^ 1) & 1)); }
        unpack8(qc0, x0); unpack8(qc1, x1v);
        if (fq < 2) {
            float xp[8]; unpack8(qcp, xp);
            const LAS f32x2_t* cs = rq + i * 8;
#pragma unroll
            for (int e = 0; e < 8; ++e) { const f32x2_t q = cs[e]; x0[e] = (fq == 0) ? (x0[e] * q.x - xp[e] * q.y) : (x0[e] * q.x + xp[e] * q.y); }
        }
#pragma unroll
        for (int e = 0; e < 8; ++e) { x0[e] *= 0.125f; x1v[e] *= 0.125f; }
        bf16x8 qf[2]; qf[0] = __builtin_bit_cast(bf16x8, pack8(x0)); qf[1] = __builtin_bit_cast(bf16x8, pack8(x1v));
        const int kt0 = ag < 6 ? ag : 6;
        f32x4 sacc[10];
#pragma unroll
        for (int j = 0; j < 10; ++j) { f32x4 acc = (f32x4){0.f, 0.f, 0.f, 0.f};
#pragma unroll
            for (int s = 0; s < 2; ++s) { const bf16x8 A = *(const LAS bf16x8*)(Ks + (16 * (kt0 + j) + fr) * 72 + 32 * s + 8 * fq); acc = mfma16(A, qf[s], acc); }
            sacc[j] = acc; }
        float mx = sink;
#pragma unroll
        for (int j = 0; j < 10; ++j)
#pragma unroll
            for (int r = 0; r < 4; ++r) { const int key = 16 * (kt0 + j) + 4 * fq + r; const bool valid = (key > i) && (key <= i + 128) && (blk > 0 || key >= 128);
                sacc[j][r] = valid ? sacc[j][r] : -INFINITY; mx = fmaxf(mx, sacc[j][r]); }
        mx = quad_max(mx);
        float sum = 0.f;
#pragma unroll
        for (int j = 0; j < 10; ++j)
#pragma unroll
            for (int r = 0; r < 4; ++r) { const float p = __expf(sacc[j][r] - mx); sacc[j][r] = p; sum += p; }
        sum = quad_sum(sum) + __expf(sink - mx);
        f32x4 o[4];
#pragma unroll
        for (int dt = 0; dt < 4; ++dt) o[dt] = (f32x4){0.f, 0.f, 0.f, 0.f};
#pragma unroll
        for (int jp = 0; jp < 5; ++jp) { const bf16x8 Bf = frag8(sacc[2 * jp], sacc[2 * jp + 1]);
#pragma unroll
            for (int dt = 0; dt < 4; ++dt) { const LAS bf16* vp = Vt + (16 * dt + fr) * 264 + 16 * (kt0 + 2 * jp) + 4 * fq;
                const bf16x8 A = frag2(*(const LAS v2u*)vp, *(const LAS v2u*)(vp + 16)); o[dt] = mfma16(A, Bf, o[dt]); } }
        const float inv = 1.f / sum;
        bf16* yo = Y + (size_t)(b * T + tq) * D + hq * 64 + 4 * fq;
#pragma unroll
        for (int dt = 0; dt < 4; ++dt) { v2u w; w.x = pk2(o[dt][0] * inv, o[dt][1] * inv); w.y = pk2(o[dt][2] * inv, o[dt][3] * inv); *(v2u*)(yo + 16 * dt) = w; }
    }
    __syncthreads();
}
__device__ __forceinline__ void ml_conv8(const bf16* P, int b, int tt, int ch, const float* convw, const float* convb, float (&acc)[8]) {
    { const f32x4 b0 = *(const f32x4*)(convb + ch), b1 = *(const f32x4*)(convb + ch + 4); acc[0] = b0.x; acc[1] = b0.y; acc[2] = b0.z; acc[3] = b0.w; acc[4] = b1.x; acc[5] = b1.y; acc[6] = b1.z; acc[7] = b1.w; }
#pragma unroll
    for (int tap = 0; tap < 4; ++tap) { const int t2 = tt - 3 + tap;
        if (t2 >= 0) { float x[8]; unpack8(*(const v4u*)(P + (size_t)(b * T + t2) * NE + 768 + ch), x);
            const f32x4 w0 = *(const f32x4*)(convw + tap * 512 + ch), w1 = *(const f32x4*)(convw + tap * 512 + ch + 4);
            acc[0] += x[0] * w0.x; acc[1] += x[1] * w0.y; acc[2] += x[2] * w0.z; acc[3] += x[3] * w0.w; acc[4] += x[4] * w1.x; acc[5] += x[5] * w1.y; acc[6] += x[6] * w1.z; acc[7] += x[7] * w1.w; } }
#pragma unroll
    for (int e = 0; e < 8; ++e) acc[e] = siluf_(acc[e]);
}
__device__ __forceinline__ void ml_gates(const float* G0, size_t row0, int h, const float* ibias, const float* fbias, int lane, float& b0, float& b1, float& li0, float& li1, float& bL) {
    const float fb = fbias[h], ib = ibias[h];
    const float f0 = G0[(row0 + 2 * lane) * 8 + 4 + h] + fb, f1 = G0[(row0 + 2 * lane + 1) * 8 + 4 + h] + fb;
    li0 = G0[(row0 + 2 * lane) * 8 + h] + ib; li1 = G0[(row0 + 2 * lane + 1) * 8 + h] + ib;
    const float lf0 = -softplusf_(-f0), lf1 = -softplusf_(-f1);
    const float ps = scan_add(lf0 + lf1, lane);
    b1 = ps; b0 = ps - lf1; bL = __shfl(ps, 63);
}
__device__ __forceinline__ void mlstm_local_unit(int u, const bf16* P, const float* G0, const float* convw, const float* convb, const float* ibias, const float* fbias,
                                                 float* CT, float* NL, float* MLs, LAS unsigned char* lds, int tid) {
    asm volatile("; MARK_BEGIN_mlstm_local_unit");
    asm volatile("" : "+v"(tid));
    const int lane = tid & 63, wave = __builtin_amdgcn_readfirstlane(tid >> 6), fr = lane & 15, fq = lane >> 4;
    const int c = u & 63, h = (u >> 6) & 3, b = u >> 8, bh = b * 4 + h;
    const size_t row0 = (size_t)b * T + c * 128;
    LAS bf16* kT = (LAS bf16*)lds;
    LAS bf16* vT = kT + 64 * 136;
    LAS float* wg = (LAS float*)(vT + 128 * 136);
    const int kc8 = tid & 7, ktg = (tid >> 3) & 31, kch = 256 + h * 64 + kc8 * 8;
    const int vt2 = tid - 256, vc8 = vt2 & 15, vtq = (vt2 >> 4) & 15;
    v4u raw[8];
    if (tid < 256) { v4u r7[7]; load_rows<4>(P + (size_t)(b * T) * NE + 768 + kch, NE, c * 128 + 4 * ktg, r7);
#pragma unroll
        for (int i = 0; i < 7; ++i) raw[i] = r7[i]; }
    else {
#pragma unroll
        for (int i = 0; i < 8; ++i) raw[i] = *(const v4u*)(P + (row0 + 8 * vtq + i) * NE + 1280 + h * 128 + vc8 * 8); }
    if (wave == 0) {
        float b0, b1, li0, li1, bL; ml_gates(G0, row0, h, ibias, fbias, lane, b0, b1, li0, li1, bL);
        const float a0 = bL - b0 + li0, a1 = bL - b1 + li1; const float ml = wave_max(fmaxf(a0, a1));
        wg[2 * lane] = expf(a0 - ml); wg[2 * lane + 1] = expf(a1 - ml);
        if (lane == 0) { MLs[(bh * 64 + c) * 2] = ml; MLs[(bh * 64 + c) * 2 + 1] = bL; }
    }
    __syncthreads();
    if (tid < 256) {
        v4u r7[7];
#pragma unroll
        for (int i = 0; i < 7; ++i) r7[i] = raw[i];
        float o[4][8]; conv_silu<4>(r7, convw + kch, 512, convb + kch, o);
        const f32x4 sc4 = *(const LAS f32x4*)(wg + 4 * ktg);
#pragma unroll
        for (int e = 0; e < 8; ++e) { v2u w; w.x = pk2(o[0][e] * 0.125f * sc4.x, o[1][e] * 0.125f * sc4.y); w.y = pk2(o[2][e] * 0.125f * sc4.z, o[3][e] * 0.125f * sc4.w); *(LAS v2u*)(kT + tsw(kc8 * 8 + e, 4 * ktg)) = w; }
    } else {
#pragma unroll
        for (int e = 0; e < 8; ++e) { v4u w;
#pragma unroll
            for (int p = 0; p < 4; ++p) { const unsigned lo = (raw[2 * p][e >> 1] >> ((e & 1) * 16)) & 0xffffu, hi = (raw[2 * p + 1][e >> 1] >> ((e & 1) * 16)) & 0xffffu; w[p] = lo | (hi << 16); }
            *(LAS v4u*)(vT + tsw(vc8 * 8 + e, 8 * vtq)) = w; }
    }
    __syncthreads();
    if (tid < 64) { float s = 0.f;
#pragma unroll
        for (int t8 = 0; t8 < 16; ++t8) { float x[8]; unpack8(*(const LAS v4u*)(kT + tsw(tid, 8 * t8)), x); s += ((x[0] + x[1]) + (x[2] + x[3])) + ((x[4] + x[5]) + (x[6] + x[7])); }
        NL[(size_t)(bh * 64 + c) * 64 + tid] = s; }
    f32x4 acc[4];
#pragma unroll
    for (int k = 0; k < 4; ++k) acc[k] = (f32x4){0.f, 0.f, 0.f, 0.f};
#pragma unroll
    for (int ks = 0; ks < 4; ++ks) { const bf16x8 A = *(const LAS bf16x8*)(vT + tsw(16 * wave + fr, 32 * ks + 8 * fq));
#pragma unroll
        for (int k = 0; k < 4; ++k) { const bf16x8 Bf = *(const LAS bf16x8*)(kT + tsw(16 * k + fr, 32 * ks + 8 * fq)); acc[k] = mfma16(Bf, A, acc[k]); } }
    bf16* ct = (bf16*)CT + ((size_t)(bh * 64 + c) * 128 + 16 * wave + fr) * 64 + 4 * fq;
#pragma unroll
    for (int k = 0; k < 4; ++k) { v2u w; w.x = pk2(acc[k][0], acc[k][1]); w.y = pk2(acc[k][2], acc[k][3]); *(v2u*)(ct + 16 * k) = w; }
    __syncthreads();
}
__device__ __forceinline__ void mlstm_scan_phase(float* CT, float* NL, const float* MLs, float* Mprev, LAS unsigned char* lds, int tid, int G) {
    LAS float* fab = (LAS float*)lds;
    for (int e0 = blockIdx.x * 512; e0 < 16 * 8192; e0 += G * 512) {
        const int e = e0 + tid; const int bh = e0 >> 13, idx = e & 8191;
        if (tid < 64) { const int c = tid;
            const float ml = MLs[(bh * 64 + c) * 2], gl = MLs[(bh * 64 + c) * 2 + 1];
            float A = gl, B = ml;
#pragma unroll
            for (int o = 1; o < 64; o <<= 1) { const float Ap = __shfl_up(A, o), Bp = __shfl_up(B, o); if (c >= o) { B = fmaxf(Bp + A, B); A = Ap + A; } }
            const float mn = fmaxf(A, B);
            float mp = __shfl_up(mn, 1); if (c == 0) mp = 0.f;
            fab[2 * c] = __expf(gl + mp - mn); fab[2 * c + 1] = __expf(ml - mn);
            if ((e0 & 8191) == 0) Mprev[bh * 64 + c] = mp; }
        __syncthreads();
        float C = 0.f, n = 0.f;
        const bf16* cp = (const bf16*)CT + (size_t)bh * 64 * 8192 + idx; float* np = NL + (size_t)bh * 64 * 64 + idx; bf16* cb = (bf16*)(CT + (size_t)16 * 64 * 8192) + (size_t)bh * 64 * 8192 + idx;
#pragma unroll 1
        for (int c0 = 0; c0 < 64; c0 += 32) { float cl[32];
#pragma unroll
            for (int c = 0; c < 32; ++c) cl[c] = bf1(cp[(size_t)(c0 + c) * 8192]);
#pragma unroll
            for (int c = 0; c < 32; ++c) { const f32x2_t f2 = *(const LAS f32x2_t*)(fab + 2 * (c0 + c)); const float fa = f2.x, fb = f2.y;
                cb[(size_t)(c0 + c) * 8192] = tobf(C); C = fa * C + fb * cl[c];
                if (idx < 64) { const float nl = np[(c0 + c) * 64]; np[(c0 + c) * 64] = n; n = fa * n + fb * nl; } } }
        __syncthreads();
    }
}
__device__ __forceinline__ void mlstm_out_unit(int u, const bf16* P, const float* G0, const float* convw, const float* convb, const float* ibias, const float* fbias, const float* mlnorm,
                                               const float* CT, const float* NL, const float* Mprev, bf16* Y, LAS unsigned char* lds, int tid) {
    asm volatile("; MARK_BEGIN_mlstm_out_unit");
    asm volatile("" : "+v"(tid));
    const int lane = tid & 63, wave = __builtin_amdgcn_readfirstlane(tid >> 6), fr = lane & 15, fq = lane >> 4;
    const int c = u & 63, h = (u >> 6) & 3, b = u >> 8, bh = b * 4 + h;
    const size_t row0 = (size_t)b * T + c * 128;
    LAS bf16* qs = (LAS bf16*)lds;
    LAS bf16* ks = qs + 128 * 72;
    LAS bf16* vT = ks + 128 * 72;
    LAS bf16* cts = vT + 128 * 136;
    LAS float* bc = (LAS float*)(cts + 128 * 72);
    LAS float* lis = bc + 128; LAS float* mxs = lis + 128; LAS float* npv = mxs + 128;
    const float mp_pre = Mprev[bh * 64 + c];
    if (wave == 0) {
        float b0, b1, li0, li1, bL; ml_gates(G0, row0, h, ibias, fbias, lane, b0, b1, li0, li1, bL);
        const float d0 = li0 - b0, d1 = li1 - b1; const float sm = scan_max(fmaxf(d0, d1), lane); float ex = __shfl_up(sm, 1); if (lane == 0) ex = -INFINITY;
        const float m0 = fmaxf(ex, d0);
        bc[2 * lane] = b0; bc[2 * lane + 1] = b1; lis[2 * lane] = li0; lis[2 * lane + 1] = li1; mxs[2 * lane] = m0; mxs[2 * lane + 1] = sm;
        npv[lane] = NL[(size_t)(bh * 64 + c) * 64 + lane];
    }
    {
        const int isk = tid >> 8, c8 = tid & 7, tg = (tid >> 3) & 31, ch = isk * 256 + h * 64 + c8 * 8;
        v4u raw[7]; load_rows<4>(P + (size_t)(b * T) * NE + 768 + ch, NE, c * 128 + 4 * tg, raw);
        const int vc8 = tid & 15, vtq = tid >> 4;
        v4u vr[4];
#pragma unroll
        for (int i = 0; i < 4; ++i) vr[i] = *(const v4u*)(P + (row0 + 4 * vtq + i) * NE + 1280 + h * 128 + vc8 * 8);
        v4u cr[2];
#pragma unroll
        for (int j = 0; j < 2; ++j) { const int it = tid + 512 * j, vd = it >> 3, cc8 = it & 7; const bf16* sp = (const bf16*)(CT + (size_t)16 * 64 * 8192) + ((size_t)(bh * 64 + c) * 128 + vd) * 64 + cc8 * 8; cr[j] = *(const v4u*)sp; }
        float o[4][8]; conv_silu<4>(raw, convw + ch, 512, convb + ch, o);
        const float qs_ = isk ? 0.125f : 1.0f;
#pragma unroll
        for (int i = 0; i < 4; ++i) {
#pragma unroll
            for (int e = 0; e < 8; ++e) o[i][e] *= qs_;
            *(LAS v4u*)((isk ? ks : qs) + (4 * tg + i) * 72 + c8 * 8) = pack8(o[i]); }
#pragma unroll
        for (int e = 0; e < 8; ++e) { v2u w;
#pragma unroll
            for (int p = 0; p < 2; ++p) { const unsigned lo = (vr[2 * p][e >> 1] >> ((e & 1) * 16)) & 0xffffu, hi = (vr[2 * p + 1][e >> 1] >> ((e & 1) * 16)) & 0xffffu; w[p] = lo | (hi << 16); }
            *(LAS v2u*)(vT + tsw(vc8 * 8 + e, 4 * vtq)) = w; }
#pragma unroll
        for (int j = 0; j < 2; ++j) { const int it = tid + 512 * j, vd = it >> 3, cc8 = it & 7; *(LAS v4u*)(cts + vd * 72 + cc8 * 8) = cr[j]; }
    }
    __syncthreads();
    {
        const int w = (wave < 4) ? 7 - wave : wave - 4, t = 16 * w + fr;
        v2u oq[8]; f32x4 gq[8];
        { const bf16* op = P + (row0 + t) * NE + 1792 + h * 128 + 4 * fq; const float* gn = mlnorm + h * 128 + 4 * fq;
#pragma unroll
          for (int vt = 0; vt < 8; ++vt) { oq[vt] = *(const v2u*)(op + 16 * vt); gq[vt] = *(const f32x4*)(gn + 16 * vt); } }
        const float bt = bc[t], mp = mp_pre;
        const float il = bt + mp, mt = fmaxf(il, bt + mxs[t]), winter = __expf(il - mt);
        bf16x8 qf[2]; qf[0] = *(const LAS bf16x8*)(qs + t * 72 + 8 * fq); qf[1] = *(const LAS bf16x8*)(qs + t * 72 + 32 + 8 * fq);
        f32x4 p[8]; float den = 0.f;
#pragma unroll
        for (int st = 0; st < 8; ++st) { p[st] = (f32x4){0.f, 0.f, 0.f, 0.f};
            if (st <= w) { f32x4 acc = (f32x4){0.f, 0.f, 0.f, 0.f};
#pragma unroll
                for (int s2 = 0; s2 < 2; ++s2) { const bf16x8 A = *(const LAS bf16x8*)(ks + (16 * st + fr) * 72 + 32 * s2 + 8 * fq); acc = mfma16(A, qf[s2], acc); }
#pragma unroll
                for (int r = 0; r < 4; ++r) { const int s = 16 * st + 4 * fq + r; const float e = (s <= t) ? __expf(bt - bc[s] + lis[s] - mt) : 0.f; const float val = acc[r] * e; den += val; p[st][r] = val; } } }
        den = quad_sum(den);
        float qn = 0.f;
        { float x[8]; unpack8(__builtin_bit_cast(v4u, qf[0]), x);
#pragma unroll
          for (int e = 0; e < 8; ++e) qn += x[e] * npv[8 * fq + e];
          unpack8(__builtin_bit_cast(v4u, qf[1]), x);
#pragma unroll
          for (int e = 0; e < 8; ++e) qn += x[e] * npv[32 + 8 * fq + e]; }
        qn = quad_sum(qn);
        const float dent = den + winter * qn, inv = 1.f / fmaxf(fabsf(dent), __expf(-mt));
        f32x4 hv[8]; float s1 = 0.f;
#pragma unroll
        for (int vt = 0; vt < 8; ++vt) { f32x4 a2 = (f32x4){0.f, 0.f, 0.f, 0.f}, a3 = a2;
#pragma unroll
            for (int jp = 0; jp < 4; ++jp) if (2 * jp <= w) { const int vr = 16 * vt + fr;
                const bf16x8 A = frag2(*(const LAS v2u*)(vT + tsw(vr, 32 * jp + 4 * fq)), *(const LAS v2u*)(vT + tsw(vr, 32 * jp + 16 + 4 * fq))); a2 = mfma16(A, frag8(p[2 * jp], p[2 * jp + 1]), a2); }
#pragma unroll
            for (int s2 = 0; s2 < 2; ++s2) { const bf16x8 A = *(const LAS bf16x8*)(cts + (16 * vt + fr) * 72 + 32 * s2 + 8 * fq); a3 = mfma16(A, qf[s2], a3); }
            hv[vt] = (a2 + winter * a3) * inv; s1 += (hv[vt][0] + hv[vt][1]) + (hv[vt][2] + hv[vt][3]); asm volatile("" ::: "memory"); }
        const float mean = quad_sum(s1) * (1.f / 128.f); float s2v = 0.f;
#pragma unroll
        for (int vt = 0; vt < 8; ++vt) { hv[vt] = hv[vt] - mean; s2v += (hv[vt][0] * hv[vt][0] + hv[vt][1] * hv[vt][1]) + (hv[vt][2] * hv[vt][2] + hv[vt][3] * hv[vt][3]); }
        const float rstd = 1.0f / sqrtf(quad_sum(s2v) * (1.f / 128.f) + 1e-6f);
        bf16* yo = Y + (row0 + t) * D + 512 + h * 128 + 4 * fq;
#pragma unroll
        for (int vt = 0; vt < 8; ++vt) { const v2u ov = oq[vt]; const f32x4 g4 = gq[vt];
            const float y0 = hv[vt][0] * rstd * g4.x * sigmoidf_(bflo(ov.x)), y1 = hv[vt][1] * rstd * g4.y * sigmoidf_(bfhi(ov.x)), y2 = hv[vt][2] * rstd * g4.z * sigmoidf_(bflo(ov.y)), y3 = hv[vt][3] * rstd * g4.w * sigmoidf_(bfhi(ov.y));
            v2u w2; w2.x = pk2(y0, y1); w2.y = pk2(y2, y3); *(v2u*)(yo + 16 * vt) = w2; }
    }
    __syncthreads();
}
__device__ __forceinline__ void ssm_conv8(const bf16* P, int b, int tt, int pcol, int cch, const float* convw, const float* convb, float (&acc)[8]) {
    { const f32x4 b0 = *(const f32x4*)(convb + cch), b1 = *(const f32x4*)(convb + cch + 4); acc[0] = b0.x; acc[1] = b0.y; acc[2] = b0.z; acc[3] = b0.w; acc[4] = b1.x; acc[5] = b1.y; acc[6] = b1.z; acc[7] = b1.w; }
#pragma unroll
    for (int tap = 0; tap < 4; ++tap) { const int t2 = tt - 3 + tap;
        if (t2 >= 0) { float x[8]; unpack8(*(const v4u*)(P + (size_t)(b * T + t2) * NO + pcol), x);
            const f32x4 w0 = *(const f32x4*)(convw + tap * 1024 + cch), w1 = *(const f32x4*)(convw + tap * 1024 + cch + 4);
            acc[0] += x[0] * w0.x; acc[1] += x[1] * w0.y; acc[2] += x[2] * w0.z; acc[3] += x[3] * w0.w; acc[4] += x[4] * w1.x; acc[5] += x[5] * w1.y; acc[6] += x[6] * w1.z; acc[7] += x[7] * w1.w; } }
#pragma unroll
    for (int e = 0; e < 8; ++e) acc[e] = siluf_(acc[e]);
}
__device__ __forceinline__ float ssm_dt_wave(const float* DT, size_t row0, int hd, const float* dtbias, const float* alog, int lane, LAS float* dtv, LAS float* acum) {
    const float db = dtbias[hd], A = -expf(alog[hd]);
    const float d0 = softplusf_(DT[(row0 + 2 * lane) * 8 + hd] + db), d1 = softplusf_(DT[(row0 + 2 * lane + 1) * 8 + hd] + db);
    const float ps = scan_add(d0 * A + d1 * A, lane);
    dtv[2 * lane] = d0; dtv[2 * lane + 1] = d1; acum[2 * lane] = ps - d1 * A; acum[2 * lane + 1] = ps;
    return __shfl(ps, 63);
}
__device__ __forceinline__ void ssd_local_unit(int u, const bf16* P, const float* DT, const float* convw, const float* convb, const float* dtbias, const float* alog,
                                               float* ST, float* DEC, LAS unsigned char* lds, int tid) {
    asm volatile("; MARK_BEGIN_ssd_local_unit");
    asm volatile("" : "+v"(tid));
    const int lane = tid & 63, wave = __builtin_amdgcn_readfirstlane(tid >> 6), fr = lane & 15, fq = lane >> 4;
    const int c = u & 63, g = (u >> 6) & 1, b = u >> 7;
    const size_t row0 = (size_t)b * T + c * 128;
    LAS bf16* xT = (LAS bf16*)lds;
    LAS bf16* bT = xT + 256 * 136;
    LAS float* dtv = (LAS float*)(bT + 128 * 136);
    LAS float* acum = dtv + 512;
    const int c8 = tid & 31, tg = tid >> 5, cch = g * 256 + c8 * 8;
    v4u raw[11]; load_rows<8>(P + (size_t)(b * T) * NO + 512 + cch, NO, c * 128 + 8 * tg, raw);
    const int bc8 = tid & 15, btg = tid >> 4, bch = 512 + g * 128 + bc8 * 8;
    v4u rawb[7]; load_rows<4>(P + (size_t)(b * T) * NO + 1024 + g * 128 + bc8 * 8, NO, c * 128 + 4 * btg, rawb);
    if (wave < 4) { const int hd = 4 * g + wave; const float al = ssm_dt_wave(DT, row0, hd, dtbias, alog, lane, dtv + wave * 128, acum + wave * 128);
        if (lane == 0) DEC[(b * 64 + c) * 8 + hd] = expf(al);
        LAS float* ac = acum + wave * 128; LAS float* dv = dtv + wave * 128;
        ac[2 * lane] = dv[2 * lane] * expf(al - ac[2 * lane]); ac[2 * lane + 1] = dv[2 * lane + 1] * expf(al - ac[2 * lane + 1]); }
    __syncthreads();
    {
        { float o[8][8]; conv_silu<8>(raw, convw + cch, 1024, convb + cch, o);
          const LAS float* scp = acum + (c8 >> 3) * 128 + 8 * tg; const f32x4 s0 = *(const LAS f32x4*)scp, s1 = *(const LAS f32x4*)(scp + 4);
#pragma unroll
          for (int e = 0; e < 8; ++e) { v4u w; w.x = pk2(o[0][e] * s0.x, o[1][e] * s0.y); w.y = pk2(o[2][e] * s0.z, o[3][e] * s0.w); w.z = pk2(o[4][e] * s1.x, o[5][e] * s1.y); w.w = pk2(o[6][e] * s1.z, o[7][e] * s1.w);
              *(LAS v4u*)(xT + tsw(c8 * 8 + e, 8 * tg)) = w; } }
        { float o[4][8]; conv_silu<4>(rawb, convw + bch, 1024, convb + bch, o);
#pragma unroll
          for (int e = 0; e < 8; ++e) { v2u w; w.x = pk2(o[0][e], o[1][e]); w.y = pk2(o[2][e], o[3][e]); *(LAS v2u*)(bT + tsw(bc8 * 8 + e, 4 * btg)) = w; } }
    }
    __syncthreads();
#pragma unroll
    for (int rr = 0; rr < 2; ++rr) { const int rt = 2 * wave + rr;
        f32x4 acc[8];
#pragma unroll
        for (int nt = 0; nt < 8; ++nt) acc[nt] = (f32x4){0.f, 0.f, 0.f, 0.f};
#pragma unroll
        for (int ks = 0; ks < 4; ++ks) { const bf16x8 A = *(const LAS bf16x8*)(xT + tsw(16 * rt + fr, 32 * ks + 8 * fq));
#pragma unroll
            for (int nt = 0; nt < 8; ++nt) { const bf16x8 Bf = *(const LAS bf16x8*)(bT + tsw(16 * nt + fr, 32 * ks + 8 * fq)); acc[nt] = mfma16(Bf, A, acc[nt]); } }
        const int hd = 4 * g + (rt >> 2), p0 = (rt & 3) * 16 + fr;
        bf16* sp = (bf16*)ST + (((size_t)(b * 64 + c) * 8 + hd) * 64 + p0) * 128 + 4 * fq;
#pragma unroll
        for (int nt = 0; nt < 8; ++nt) { v2u w; w.x = pk2(acc[nt][0], acc[nt][1]); w.y = pk2(acc[nt][2], acc[nt][3]); *(v2u*)(sp + 16 * nt) = w; } }
    __syncthreads();
}
__device__ __forceinline__ void ssd_scan_phase(float* ST, const float* DEC, int tid, int G) {
    const int wave = tid >> 6; if (wave == 0) return;
    for (int e = (blockIdx.x * 7 + wave - 1) * 64 + (tid & 63); e < 4 * 8 * 8192; e += G * 7 * 64) {
        const int b = e >> 16, hd = (e >> 13) & 7, pn = e & 8191; float S = 0.f;
        bf16* sp = (bf16*)ST + ((size_t)(b * 64) * 8 + hd) * 8192 + pn;
#pragma unroll 1
        for (int c0 = 0; c0 < 64; c0 += 32) { float st[32], dc[32];
#pragma unroll
            for (int c = 0; c < 32; ++c) { st[c] = bf1(sp[(size_t)(c0 + c) * 65536]); dc[c] = DEC[(b * 64 + c0 + c) * 8 + hd]; }
#pragma unroll
            for (int c = 0; c < 32; ++c) { sp[(size_t)(c0 + c) * 65536] = tobf(S); S = S * dc[c] + st[c]; } }
    }
}
__device__ __forceinline__ void ssd_scan_pair(float* ST, const float* DEC, int pr, int k8, int tid) {
    const int b = pr >> 1, g = pr & 1;
    for (int e = k8 * 512 + tid; e < 4 * 8192; e += 8 * 512) {
        const int hd = 4 * g + (e >> 13), pn = e & 8191; float S = 0.f;
        bf16* sp = (bf16*)ST + ((size_t)(b * 64) * 8 + hd) * 8192 + pn;
#pragma unroll 1
        for (int c0 = 0; c0 < 64; c0 += 32) { float st[32], dc[32];
#pragma unroll
            for (int c = 0; c < 32; ++c) { st[c] = bf1(sp[(size_t)(c0 + c) * 65536]); dc[c] = DEC[(b * 64 + c0 + c) * 8 + hd]; }
#pragma unroll
            for (int c = 0; c < 32; ++c) { sp[(size_t)(c0 + c) * 65536] = tobf(S); S = S * dc[c] + st[c]; } }
    }
}
#ifndef SO_R1
#define SO_R1 1
#endif
#ifndef SO_R3
#define SO_R3 1
#endif
__device__ __forceinline__ void ssd_out_unit(int u, const bf16* P, const float* DT, const float* convw, const float* convb, const float* dtbias, const float* alog, const float* dskip, const float* gnorm,
                                             const float* ST, bf16* Y, LAS unsigned char* lds, int tid) {
    asm volatile("; MARK_BEGIN_ssd_out_unit");
    asm volatile("" : "+v"(tid));
    const int lane = tid & 63, wave = __builtin_amdgcn_readfirstlane(tid >> 6), fr = lane & 15, fq = lane >> 4;
    const int c = u & 63, g = (u >> 6) & 1, b = u >> 7;
    const size_t row0 = (size_t)b * T + c * 128;
    LAS bf16* xT = (LAS bf16*)lds;
    LAS bf16* bm = xT + 256 * 136;
    LAS bf16* cm = bm + 128 * 136;
    LAS float* dtv = (LAS float*)(cm + 128 * 136);
    LAS float* acum = dtv + 512;
    if (wave < 4) (void)ssm_dt_wave(DT, row0, 4 * g + wave, dtbias, alog, lane, dtv + wave * 128, acum + wave * 128);
    for (int sp1 = 0; sp1 < SO_R1; ++sp1) {
        const int c8 = tid & 31, tg = tid >> 5, cch = g * 256 + c8 * 8;
        v4u raw[11]; load_rows<8>(P + (size_t)(b * T) * NO + 512 + cch, NO, c * 128 + 8 * tg, raw);
        { float o[8][8]; conv_silu<8>(raw, convw + cch, 1024, convb + cch, o);
#pragma unroll
          for (int e = 0; e < 8; ++e) { v4u w; w.x = pk2(o[0][e], o[1][e]); w.y = pk2(o[2][e], o[3][e]); w.z = pk2(o[4][e], o[5][e]); w.w = pk2(o[6][e], o[7][e]); *(LAS v4u*)(xT + tsw(c8 * 8 + e, 8 * tg)) = w; } }
        const int isc = tid >> 8, bc8 = tid & 15, btg = (tid >> 4) & 15, bch = 512 + isc * 256 + g * 128 + bc8 * 8;
        v4u rawb[11]; load_rows<8>(P + (size_t)(b * T) * NO + 1024 + isc * 256 + g * 128 + bc8 * 8, NO, c * 128 + 8 * btg, rawb);
        { float o[8][8]; conv_silu<8>(rawb, convw + bch, 1024, convb + bch, o);
#pragma unroll
          for (int i = 0; i < 8; ++i) *(LAS v4u*)((isc ? cm : bm) + (8 * btg + i) * 136 + bc8 * 8) = pack8(o[i]); }
    }
    __syncthreads();
    {
        const int w = wave, t = 16 * w + fr;
        const f32x4 dsk4 = *(const f32x4*)(dskip + 4 * g);
        const bf16* zp0 = P + (row0 + t) * NO + 4 * g * 64 + 4 * fq;
        v2u zn[4];
#pragma unroll
        for (int pt = 0; pt < 4; ++pt) zn[pt] = *(const v2u*)(zp0 + 16 * pt);
        v4u sraw[8];
        { const bf16* sp0 = (const bf16*)ST + ((size_t)(b * 64 + c) * 8 + 4 * g) * 8192;
#pragma unroll
          for (int i = 0; i < 8; ++i) sraw[i] = *(const v4u*)(sp0 + (size_t)(tid + 512 * i) * 8); }
        bf16x8 cf[4];
#pragma unroll
        for (int ks = 0; ks < 4; ++ks) cf[ks] = *(const LAS bf16x8*)(cm + t * 136 + 32 * ks + 8 * fq);
        f32x4 cb[8];
#pragma unroll
        for (int st = 0; st < 8; ++st) { cb[st] = (f32x4){0.f, 0.f, 0.f, 0.f};
            if (st <= w) {
#pragma unroll
                for (int ks = 0; ks < 4; ++ks) { const bf16x8 A = *(const LAS bf16x8*)(bm + (16 * st + fr) * 136 + 32 * ks + 8 * fq); cb[st] = mfma16(A, cf[ks], cb[st]); } } }
        __syncthreads();
        LAS bf16* sl = bm;
#pragma unroll
        for (int i = 0; i < 8; ++i) { const int e8 = tid + 512 * i, row = e8 >> 4, c8 = (e8 & 15) * 8;
            *(LAS v4u*)(sl + row * 136 + c8) = sraw[i]; }
        __syncthreads();
        float ss = 0.f;
        bf16* yo = Y + (row0 + t) * D + g * 256 + 4 * fq;
        for (int sp3 = 0; sp3 < SO_R3; ++sp3) { ss = 0.f;
#pragma unroll
        for (int pt = 0; pt < 4; ++pt) zn[pt] = *(const v2u*)(zp0 + 16 * pt);
#pragma unroll 1
        for (int j = 0; j < 4; ++j) {
            v2u zc[4];
#pragma unroll
            for (int pt = 0; pt < 4; ++pt) zc[pt] = zn[pt];
            if (j < 3) {
#pragma unroll
                for (int pt = 0; pt < 4; ++pt) zn[pt] = *(const v2u*)(zp0 + (j + 1) * 64 + 16 * pt); }
            const int hd = 4 * g + j; const float at = acum[j * 128 + t], eat = __expf(at), dh = (j == 0) ? dsk4.x : (j == 1) ? dsk4.y : (j == 2) ? dsk4.z : dsk4.w;
            bf16x8 pf[4];
#pragma unroll
            for (int jp = 0; jp < 4; ++jp) { f32x4 p0 = (f32x4){0.f, 0.f, 0.f, 0.f}, p1 = p0;
                if (2 * jp <= w) {
#pragma unroll
                    for (int r = 0; r < 4; ++r) { const int s0 = 32 * jp + 4 * fq + r, s1 = s0 + 16;
                        p0[r] = (s0 <= t) ? cb[2 * jp][r] * __expf(at - acum[j * 128 + s0]) * dtv[j * 128 + s0] : 0.f;
                        p1[r] = (s1 <= t) ? cb[2 * jp + 1][r] * __expf(at - acum[j * 128 + s1]) * dtv[j * 128 + s1] : 0.f; } }
                pf[jp] = frag8(p0, p1); }
#pragma unroll
            for (int pt = 0; pt < 4; ++pt) { f32x4 a2 = (f32x4){0.f, 0.f, 0.f, 0.f}, a3 = a2;
#pragma unroll
                for (int jp = 0; jp < 4; ++jp) if (2 * jp <= w) { const int xr = j * 64 + 16 * pt + fr;
                    a2 = mfma16(frag2(*(const LAS v2u*)(xT + tsw(xr, 32 * jp + 4 * fq)), *(const LAS v2u*)(xT + tsw(xr, 32 * jp + 16 + 4 * fq))), pf[jp], a2); }
#pragma unroll
                for (int ks = 0; ks < 4; ++ks) a3 = mfma16(*(const LAS bf16x8*)(sl + (j * 64 + 16 * pt + fr) * 136 + 32 * ks + 8 * fq), cf[ks], a3);
                const v2u zv = zc[pt]; const float zz[4] = {bflo(zv.x), bfhi(zv.x), bflo(zv.y), bfhi(zv.y)};
                float y4[4];
#pragma unroll
                for (int r = 0; r < 4; ++r) { const float xv = bf1(xT[tsw(j * 64 + 16 * pt + 4 * fq + r, t)]); const float y = (a2[r] + eat * a3[r] + dh * xv) * siluf_(zz[r]); y4[r] = y; ss += y * y; }
                v2u w2; w2.x = pk2(y4[0], y4[1]); w2.y = pk2(y4[2], y4[3]); *(v2u*)(yo + j * 64 + 16 * pt) = w2; }
        } }
        const float rs = 1.0f / sqrtf(quad_sum(ss) * (1.f / 256.f) + 1e-5f);
        { const float* gn = gnorm + g * 256 + 4 * fq; f32x4 gq[16]; v2u yq[16];
#pragma unroll
          for (int q = 0; q < 16; ++q) { gq[q] = *(const f32x4*)(gn + 16 * q); yq[q] = *(const v2u*)(yo + 16 * q); }
#pragma unroll
          for (int q = 0; q < 16; ++q) { const f32x4 g4 = gq[q]; const v2u yv = yq[q];
              v2u w2; w2.x = pk2(bflo(yv.x) * rs * g4.x, bfhi(yv.x) * rs * g4.y); w2.y = pk2(bflo(yv.y) * rs * g4.z, bfhi(yv.y) * rs * g4.w); *(v2u*)(yo + 16 * q) = w2; } }
    }
    __syncthreads();
}
constexpr int RW_RS = 0, RW_KS = 9216, RW_VS = 18432, RW_GG = 27648;
constexpr int RW_BONP = 36864, RW_SSQ = 37888;
constexpr int RW_X = 39936;
constexpr int RW_TW = RW_X, RW_AD = RW_X + 9216, RW_GD = RW_X + 18432;
constexpr int RW_MK = RW_X, RW_NN = RW_X + 3072, RW_MB = RW_NN + 5120, RW_TT = RW_MB + 4096, RW_YO = RW_X + 16384;
constexpr int RW_AR = RW_X + 35840, RW_BK = RW_AR + 18432;
constexpr int RW_KB = RW_BK + 18432, RW_VT = RW_KB + 20480, RW_GL = RW_VT + 8192, RW_END = RW_GL + 1024;
constexpr int RW_GT = RW_RS;
static_assert(RW_TT + 3072 <= RW_YO && RW_YO + 16384 <= RW_AR && RW_END <= LDS_MAIN, "rwkv LDS map");
#ifndef RW_R1
#define RW_R1 1
#endif
#ifndef RW_R2
#define RW_R2 1
#endif
#ifndef RW_R3
#define RW_R3 1
#endif
#ifndef RW_R4
#define RW_R4 1
#endif
#ifndef RW_R5
#define RW_R5 1
#endif
constexpr int RW_PAR = RW_END;
static_assert(RW_PAR + 1792 <= LDS_MAIN, "rwkv LDS map");
__device__ __forceinline__ float tanh_fast(float x) { return 1.f - 2.f * rcpf_(1.f + __expf(2.f * x)); }
__device__ __forceinline__ void rwkv_lx_phase(const bf16* P, const float* mu, bf16* LX, int tid, int G) {
    for (int id = blockIdx.x * 512 + tid; id < 32 * (M / 8); id += G * 512) {
        const int piece = id & 31, r0 = (id >> 5) * 8;
        v4u raw[9];
#pragma unroll
        for (int i = 0; i < 9; ++i) { const int row = r0 - 1 + i; raw[i] = ((row & (T - 1)) != (T - 1) || i > 0) && row >= 0 ? *(const v4u*)(P + (size_t)row * NO + 3072 + piece * 8) : (v4u){0u, 0u, 0u, 0u}; }
        if ((r0 & (T - 1)) == 0) raw[0] = (v4u){0u, 0u, 0u, 0u};
        const f32x4 m0 = *(const f32x4*)(mu + 1536 + piece * 8), m1 = *(const f32x4*)(mu + 1536 + piece * 8 + 4); const float mm[8] = {m0.x, m0.y, m0.z, m0.w, m1.x, m1.y, m1.z, m1.w};
#pragma unroll
        for (int i = 0; i < 8; ++i) { float cur[8], prv[8], o[8]; unpack8(raw[i + 1], cur); unpack8(raw[i], prv);
#pragma unroll
            for (int e = 0; e < 8; ++e) { const float x = cur[e] + (prv[e] - cur[e]) * mm[e]; o[e] = (piece < 8) ? tanh_fast(x) : (piece < 16 ? x : sigmoidf_(x)); }
            *(v4u*)(LX + (size_t)(r0 + i) * 256 + piece * 8) = pack8(o); }
    }
}
__device__ __forceinline__ void rwkv_rows_load(int u, const bf16* P, int tid, v4u (&raw)[5]) {
    if (tid < 384) {
        const int h = u & 7, c64 = (u >> 3) & 127, b = u >> 10; const size_t row0 = (size_t)b * T + c64 * 64;
        const int q = tid % 24, tg = tid / 24; const int pcol = 1536 + (q >> 3) * 512 + h * 64 + (q & 7) * 8;
        const bf16* pp = P + row0 * NO + pcol;
#pragma unroll
        for (int i = 0; i < 5; ++i) { const int tt = tg * 4 - 1 + i; raw[i] = (c64 * 64 + tt >= 0) ? *(const v4u*)(pp + (ptrdiff_t)tt * NO) : (v4u){0u, 0u, 0u, 0u}; }
    }
}
template <bool WANT_Y>
__device__ __forceinline__ void rwkv_recur(f32x4 (&W)[4], const bool has_v, const int vcol, LAS unsigned char* lds, const int fr, const int fq) {
    LAS float* YO = (LAS float*)(lds + RW_YO);
    const bf16x8 zero8 = (bf16x8){0, 0, 0, 0, 0, 0, 0, 0}; const v2u zero2 = (v2u){0u, 0u};
    f32x4 ys[4];
#pragma unroll
    for (int i = 0; i < 4; ++i) {
        LAS bf16* AR = (LAS bf16*)(lds + RW_AR) + i * 32 * 72; LAS bf16* KB = (LAS bf16*)(lds + RW_KB) + i * 64 * 40; LAS bf16* VT = (LAS bf16*)(lds + RW_VT) + i * 64 * 16; LAS float* GL = (LAS float*)(lds + RW_GL) + i * 64;
        LAS bf16* MK = (LAS bf16*)(lds + RW_MK) + i * 16 * 24; LAS bf16* NN = (LAS bf16*)(lds + RW_NN) + i * 16 * 40; LAS bf16* TT = (LAS bf16*)(lds + RW_TT) + i * 16 * 24;
        bf16x8 wf[2]; wf[0] = frag8(W[0], W[1]); wf[1] = frag8(W[2], W[3]);
        f32x4 au = (f32x4){0.f, 0.f, 0.f, 0.f}, ay = au;
#pragma unroll
        for (int s = 0; s < 2; ++s) { const LAS bf16* ap = AR + fr * 72 + 32 * s + 4 * fq; au = mfma16(frag2(*(const LAS v2u*)ap, *(const LAS v2u*)(ap + 16)), wf[s], au);
            if (WANT_Y) { const LAS bf16* rp = AR + (16 + fr) * 72 + 32 * s + 4 * fq; ay = mfma16(frag2(*(const LAS v2u*)rp, *(const LAS v2u*)(rp + 16)), wf[s], ay); } }
        v2u vin = zero2;
        if (has_v) { const bf16x8 A = (fq < 2) ? *(const LAS bf16x8*)(MK + fr * 24 + 8 * fq) : zero8; const bf16x8 Bv = (fq < 2) ? *(const LAS bf16x8*)(VT + vcol * 16 + 8 * fq) : zero8;
            au = mfma16(A, Bv, au); vin = *(const LAS v2u*)(VT + vcol * 16 + 4 * fq); }
        f32x4 U;
        { v4u bw; bw.x = pk2(au[0], au[1]); bw.y = pk2(au[2], au[3]); bw.z = 0u; bw.w = 0u; const v2u tl2 = *(const LAS v2u*)(TT + fr * 24 + 4 * fq);
          U = mfma16(frag2(tl2, zero2), __builtin_bit_cast(bf16x8, bw), (f32x4){0.f, 0.f, 0.f, 0.f}); }
        v4u ubw; ubw.x = pk2(U[0], U[1]); ubw.y = pk2(U[2], U[3]); ubw.z = vin.x; ubw.w = vin.y; const bf16x8 ub = __builtin_bit_cast(bf16x8, ubw);
        if (WANT_Y) ys[i] = mfma16(*(const LAS bf16x8*)(NN + fr * 40 + 8 * fq), ub, ay);
#pragma unroll
        for (int kt = 0; kt < 4; ++kt) { W[kt] = mfma16(*(const LAS bf16x8*)(KB + (16 * kt + fr) * 40 + 8 * fq), ub, W[kt]); const f32x4 g4 = *(const LAS f32x4*)(GL + 16 * kt + 4 * fq); W[kt] = W[kt] * g4; }
    }
    if (WANT_Y) {
#pragma unroll
        for (int i = 0; i < 4; ++i)
#pragma unroll
            for (int r = 0; r < 4; ++r) YO[(16 * i + 4 * fq + r) * 64 + vcol] = ys[i][r]; }
}
#ifndef CHAIN_PLAIN
#define CHAIN_PLAIN 0
#endif
#ifndef CHAIN_RING
#define CHAIN_RING 1
#endif
#ifndef CHAIN_BACKOFF
#define CHAIN_BACKOFF 8
#endif
#ifndef CHAIN_FLAG_HINT
#define CHAIN_FLAG_HINT 0
#endif
constexpr int RW_SX = RW_PAR + 2048;
static_assert(RW_SX + 8192 <= LDS_MAIN, "rwkv LDS map");
#ifndef CHAIN_HILO
#define CHAIN_HILO 1
#endif
__device__ __forceinline__ void chain_wait(unsigned* flag, unsigned* tmo, int lane) {
    unsigned spins = 0;
    while ((unsigned)__builtin_amdgcn_readfirstlane(__hip_atomic_load(flag, __ATOMIC_RELAXED, __HIP_MEMORY_SCOPE_AGENT)) == 0u) {
        __builtin_amdgcn_s_sleep(1);
        if ((++spins & 1023u) == 0u) { if (spins > (1u << 19) || (unsigned)__builtin_amdgcn_readfirstlane(__hip_atomic_load(tmo, __ATOMIC_RELAXED, __HIP_MEMORY_SCOPE_AGENT)) != 0u) { if (lane == 0) __hip_atomic_store(tmo, 1u, __ATOMIC_RELAXED, __HIP_MEMORY_SCOPE_AGENT); break; } } }
    asm volatile("" ::: "memory");
}
__device__ __forceinline__ void rwkv_consts_load(int h, const float* const* in, int tid, float (&mm)[8], float (&kkw)[8]) {
    const int q = (tid < 384) ? tid % 24 : 0; const int mcol = (q >> 3) * 512 + h * 64 + (q & 7) * 8;
    const f32x4 m0 = *(const f32x4*)(in[21] + mcol), m1 = *(const f32x4*)(in[21] + mcol + 4); mm[0] = m0.x; mm[1] = m0.y; mm[2] = m0.z; mm[3] = m0.w; mm[4] = m1.x; mm[5] = m1.y; mm[6] = m1.z; mm[7] = m1.w;
    const f32x4 k0 = *(const f32x4*)(in[27] + h * 64 + (q & 7) * 8), k1 = *(const f32x4*)(in[27] + h * 64 + (q & 7) * 8 + 4); kkw[0] = k0.x; kkw[1] = k0.y; kkw[2] = k0.z; kkw[3] = k0.w; kkw[4] = k1.x; kkw[5] = k1.y; kkw[6] = k1.z; kkw[7] = k1.w;
}
__device__ __forceinline__ void rwkv_lx_load(int u, const bf16* LX, int tid, bf16x8 (&lxa)[8]) {
    const int lane = tid & 63, wave = tid >> 6, fr = lane & 15, fq = lane >> 4; const int c64 = (u >> 3) & 127, b = u >> 10;
    const bf16* lx = LX + ((size_t)b * T + c64 * 64 + 16 * (wave & 3) + fr) * 256 + 8 * fq;
#pragma unroll
    for (int ks = 0; ks < 2; ++ks) { lxa[ks] = *(const bf16x8*)(lx + 32 * ks); lxa[2 + ks] = *(const bf16x8*)(lx + 64 + 32 * ks); }
#pragma unroll
    for (int ks = 0; ks < 4; ++ks) lxa[4 + ks] = *(const bf16x8*)(lx + 128 + 32 * ks);
}
__device__ __forceinline__ void rwkv_post(int u, bf16* Y, LAS unsigned char* lds, int tid) {
    const int h = u & 7, c64 = (u >> 3) & 127, b = u >> 10; const size_t row0 = (size_t)b * T + c64 * 64;
    LAS float* YO = (LAS float*)(lds + RW_YO); LAS bf16* GG = (LAS bf16*)(lds + RW_GG); LAS float* BONP = (LAS float*)(lds + RW_BONP); LAS bf16* VT = (LAS bf16*)(lds + RW_VT); LAS float* PAR = (LAS float*)(lds + RW_PAR);
    const int t = tid >> 3, c8 = tid & 7, v0 = c8 * 8;
    float y[8]; float s1 = 0.f;
#pragma unroll
    for (int e = 0; e < 8; ++e) { y[e] = YO[t * 64 + v0 + e]; s1 += y[e]; }
    s1 += __shfl_xor(s1, 1); s1 += __shfl_xor(s1, 2); s1 += __shfl_xor(s1, 4);
    const float mean = s1 * (1.f / 64.f); float s2 = 0.f;
#pragma unroll
    for (int e = 0; e < 8; ++e) { y[e] -= mean; s2 += y[e] * y[e]; }
    s2 += __shfl_xor(s2, 1); s2 += __shfl_xor(s2, 2); s2 += __shfl_xor(s2, 4);
    const f32x4 bp = *(const LAS f32x4*)(BONP + t * 4); const float rstd = 1.0f / sqrtf(s2 * (1.f / 64.f) + 64e-5f), bon = (bp.x + bp.y) + (bp.z + bp.w);
    float gg[8], o[8]; unpack8(*(const LAS v4u*)(GG + t * 72 + v0), gg);
    const LAS float* lw_ = PAR + 320 + v0; const LAS float* lb_ = PAR + 384 + v0;
#pragma unroll
    for (int e = 0; e < 8; ++e) { const float vv = bf1(VT[((t >> 4) * 64 + v0 + e) * 16 + (t & 15)]); o[e] = (y[e] * rstd * lw_[e] + lb_[e] + bon * vv) * gg[e]; }
    *(v4u*)(Y + (row0 + t) * D + 512 + h * 64 + v0) = pack8(o);
}
template <int MODE>
__device__ __forceinline__ void rwkv_chunk_unit(int u, int u_next, int u_prev, int& cur_h, v4u (&raw)[5], bf16x8 (&lxa)[8], const float (&mm)[8], const float (&kkw)[8], const bf16* P, const bf16* LX, const float* const* in, const bf16* lora, bf16* GF, float* HS, bf16* Y, gu32* ctlw, LAS unsigned char* lds, int tid) {
    asm volatile("; MARK_BEGIN_rwkv_chunk_unit");
    asm volatile("" : "+v"(tid));
    const int lane = tid & 63, wave = __builtin_amdgcn_readfirstlane(tid >> 6), fr = lane & 15, fq = lane >> 4;
    const int h = u & 7, c64 = (u >> 3) & 127, b = u >> 10;
    const int su = (b * 8 + h) * 128 + c64;
    const size_t row0 = (size_t)b * T + c64 * 64;
    LAS bf16* RS = (LAS bf16*)(lds + RW_RS); LAS bf16* KS = (LAS bf16*)(lds + RW_KS); LAS bf16* VS = (LAS bf16*)(lds + RW_VS); LAS bf16* GG = (LAS bf16*)(lds + RW_GG);
    LAS float* BONP = (LAS float*)(lds + RW_BONP); LAS float* SSQ = (LAS float*)(lds + RW_SSQ);
    LAS float* PAR = (LAS float*)(lds + RW_PAR);
    if (h != cur_h) { cur_h = h;
        if (tid < 448) { const int a7 = tid >> 6, kh = tid & 63; const int src = (a7 == 0) ? 22 : (a7 == 1) ? 24 : (a7 == 2) ? 27 : (a7 == 3) ? 28 : (a7 == 4) ? 29 : (a7 == 5) ? 30 : 31; PAR[tid] = in[src][h * 64 + kh]; } }
    const bf16* w2t = lora + (size_t)(h * 64) * 64; const bf16* a2t = lora + 512 * 64 + (size_t)(h * 64) * 64; const bf16* g2t = lora + 2 * 512 * 64 + (size_t)(h * 64) * 128;
    bf16x8 bw[2][2], ba[2][2];
#pragma unroll
    for (int ni = 0; ni < 2; ++ni) { const int kh = 16 * (2 * (wave >> 2) + ni) + fr;
#pragma unroll
        for (int ks = 0; ks < 2; ++ks) { bw[ni][ks] = *(const bf16x8*)(w2t + (size_t)kh * 64 + 32 * ks + 8 * fq); ba[ni][ks] = *(const bf16x8*)(a2t + (size_t)kh * 64 + 32 * ks + 8 * fq); }
    }
    bf16x8 bg[2][4];
    if (MODE >= 1) {
#pragma unroll
        for (int ni = 0; ni < 2; ++ni)
#pragma unroll
            for (int ks = 0; ks < 4; ++ks) bg[ni][ks] = *(const bf16x8*)(g2t + (size_t)(16 * (2 * (wave >> 2) + ni) + fr) * 128 + 32 * ks + 8 * fq); }
    f32x4 W[4];
    if (MODE == 1 && wave < 4) {
#pragma unroll
        for (int kt = 0; kt < 4; ++kt) W[kt] = *(const f32x4*)(HS + (((size_t)su * 4 + wave) * 4 + kt) * 256 + lane * 4); }
    if (MODE == 2 && u_prev >= 0) rwkv_post(u_prev, Y, lds, tid);
    for (int rp1 = 0; rp1 < RW_R1; ++rp1) { if (rp1) __syncthreads();
    if (tid < 384) {
        const int q = tid % 24, tg = tid / 24;
#pragma unroll
        for (int i = 0; i < 4; ++i) { const int t = tg * 4 + i; float cur[8], prv[8], o[8]; unpack8(raw[i + 1], cur); unpack8(raw[i], prv);
#pragma unroll
            for (int e = 0; e < 8; ++e) o[e] = cur[e] + (prv[e] - cur[e]) * mm[e];
            LAS bf16* dst = (q < 8) ? RS : (q < 16 ? KS : VS); const v4u pk = pack8(o); *(LAS v4u*)(dst + t * 72 + (q & 7) * 8) = pk;
            if (q >= 8 && q < 16) { float kr[8]; unpack8(pk, kr); float sq = 0.f;
#pragma unroll
                for (int e = 0; e < 8; ++e) { const float z = kr[e] * kkw[e]; sq += z * z; }
                SSQ[t * 8 + (q & 7)] = sq; } }
    } }
    __syncthreads();
    if (u_next >= 0) rwkv_rows_load(u_next, P, tid, raw);
#ifdef PROBE_UNIT_SLEEP
    if (MODE == 2) __builtin_amdgcn_s_sleep(PROBE_UNIT_SLEEP);
#endif
    for (int rp2 = 0; rp2 < RW_R2; ++rp2) { if (rp2) __syncthreads();
        LAS bf16* AR = (LAS bf16*)(lds + RW_AR); LAS bf16* BK = (LAS bf16*)(lds + RW_BK); LAS bf16* KB = (LAS bf16*)(lds + RW_KB); LAS bf16* VT = (LAS bf16*)(lds + RW_VT); LAS float* GL = (LAS float*)(lds + RW_GL);
        const int tt = wave & 3, t0 = 16 * tt + 4 * fq;
        float invn[4];
#pragma unroll
        for (int r = 0; r < 4; ++r) { const f32x4 s0 = *(const LAS f32x4*)(SSQ + (t0 + r) * 8), s1 = *(const LAS f32x4*)(SSQ + (t0 + r) * 8 + 4); invn[r] = rcpf_(fmaxf(sqrtf(((s0.x + s0.y) + (s0.z + s0.w)) + ((s1.x + s1.y) + (s1.z + s1.w))), 1e-12f)); }
#pragma unroll
        for (int ni = 0; ni < 2; ++ni) { const int nt = 2 * (wave >> 2) + ni, kh = 16 * nt + fr;
            f32x4 aw = (f32x4){0.f, 0.f, 0.f, 0.f}, aa = aw, ag = aw;
#pragma unroll
            for (int ks = 0; ks < 2; ++ks) { aw = mfma16(lxa[ks], bw[ni][ks], aw); aa = mfma16(lxa[2 + ks], ba[ni][ks], aa); }
            if (MODE >= 1) {
#pragma unroll
                for (int ks = 0; ks < 4; ++ks) ag = mfma16(lxa[4 + ks], bg[ni][ks], ag); }
            const float w0 = PAR[kh], a0 = PAR[64 + kh], kkw = PAR[128 + kh], kaw = PAR[192 + kh], rkw = PAR[256 + kh];
            float lw[4], cs[4]; float run = 0.f;
#pragma unroll
            for (int r = 0; r < 4; ++r) { lw[r] = -0.60653066f * sigmoidf_(w0 + aw[r]); run += lw[r]; cs[r] = run; }
            float inc = run; { const float t1 = __shfl_up(inc, 16); if (fq >= 1) inc += t1; const float t2 = __shfl_up(inc, 32); if (fq >= 2) inc += t2; }
            const float excl = inc - run;
            float al[4], be[4], ka[4], rh[4], vv[4], bon[4];
            float ep = __expf(excl);
#pragma unroll
            for (int r = 0; r < 4; ++r) { const int t = t0 + r;
                const float cl = excl + cs[r];
                const float av = sigmoidf_(a0 + aa[r]);
                const float rv = bf1(RS[t * 72 + kh]), kv = bf1(KS[t * 72 + kh]); vv[r] = bf1(VS[t * 72 + kh]);
                const float ec = __expf(cl), em = rcpf_(ec);
                const float kkn = kv * kkw * invn[r], kp = kv * (1.f + (av - 1.f) * kaw);
                al[r] = kkn * ep; be[r] = kkn * av * em; ka[r] = kp * em; rh[r] = rv * ec; bon[r] = rv * kp * rkw;
                if (r == 3 && fq == 3) GL[tt * 64 + kh] = ec;
                if (MODE >= 1) GG[t * 72 + kh] = tobf(ag[r]);
                ep = ec; }
#pragma unroll
            for (int r = 0; r < 4; ++r) { const float x = row16_sum(bon[r]); if (fr == 0) BONP[(t0 + r) * 4 + nt] = x; }
            LAS bf16* ar = AR + (tt * 32 + 4 * fq) * 72 + kh; LAS bf16* bk = BK + (tt * 32 + 4 * fq) * 72 + kh;
#pragma unroll
            for (int r = 0; r < 4; ++r) { ar[r * 72] = tobf(al[r]); ar[(16 + r) * 72] = tobf(rh[r]); bk[r * 72] = tobf(be[r]); bk[(16 + r) * 72] = tobf(ka[r]); }
            { v4u w; w.x = pk2(-be[0], -be[1]); w.y = pk2(-be[2], -be[3]); w.z = pk2(ka[0], ka[1]); w.w = pk2(ka[2], ka[3]); *(LAS v4u*)(KB + (tt * 64 + kh) * 40 + 8 * fq) = w; }
            { v2u w; w.x = pk2(vv[0], vv[1]); w.y = pk2(vv[2], vv[3]); *(LAS v2u*)(VT + (tt * 64 + kh) * 16 + 4 * fq) = w; } }
    }
    __syncthreads();
    if (u_next >= 0) rwkv_lx_load(u_next, LX, tid, lxa);
    for (int rp4 = 0; rp4 < RW_R4; ++rp4) { if (rp4) __syncthreads();
    {
        const int i = wave & 3; const bool inv_half = wave < 4;
        LAS bf16* AR = (LAS bf16*)(lds + RW_AR) + i * 32 * 72; LAS bf16* BK = (LAS bf16*)(lds + RW_BK) + i * 32 * 72;
        LAS bf16* MK = (LAS bf16*)(lds + RW_MK) + i * 16 * 24; LAS bf16* NN = (LAS bf16*)(lds + RW_NN) + i * 16 * 40; LAS float* MB = (LAS float*)(lds + RW_MB) + i * 256; LAS bf16* TT = (LAS bf16*)(lds + RW_TT) + i * 16 * 24;
        const int slotc = 8 * (fr >> 2) + (fr & 3);
        if (inv_half) {
            f32x4 acc = (f32x4){0.f, 0.f, 0.f, 0.f};
#pragma unroll
            for (int ks = 0; ks < 2; ++ks) acc = mfma16(*(const LAS bf16x8*)(AR + fr * 72 + 32 * ks + 8 * fq), *(const LAS bf16x8*)(BK + fr * 72 + 32 * ks + 8 * fq), acc);
#pragma unroll
            for (int r = 0; r < 4; ++r) { const int ta = 4 * fq + r, tb = fr; MB[ta * 16 + tb] = (tb < ta) ? acc[r] : 0.f; }
            LDS_WAIT(); asm volatile("" ::: "memory");
            { const int cc = lane & 15; float tc[16];
#pragma unroll
              for (int t = 0; t < 16; ++t) { float s0 = (t == cc) ? 1.f : 0.f, s1 = 0.f;
#pragma unroll
                  for (int j = 0; j < t; ++j) { if (j & 1) s1 -= MB[t * 16 + j] * tc[j]; else s0 -= MB[t * 16 + j] * tc[j]; }
                  tc[t] = s0 + s1; }
              if (lane < 16) {
#pragma unroll
                  for (int t = 0; t < 16; ++t) TT[t * 24 + cc] = tobf(tc[t]); } }
        } else {
            f32x4 pr[3];
#pragma unroll
            for (int pi = 0; pi < 3; ++pi) { const int ra = (pi + 1) >> 1, cbx = (pi + 1) & 1; f32x4 acc = (f32x4){0.f, 0.f, 0.f, 0.f};
#pragma unroll
                for (int ks = 0; ks < 2; ++ks) acc = mfma16(*(const LAS bf16x8*)(AR + (16 * ra + fr) * 72 + 32 * ks + 8 * fq), *(const LAS bf16x8*)(BK + (16 * cbx + fr) * 72 + 32 * ks + 8 * fq), acc);
                pr[pi] = acc; }
#pragma unroll
            for (int r = 0; r < 4; ++r) { const int ta = 4 * fq + r, tb = fr;
                const float mk = (tb < ta) ? pr[0][r] : 0.f, nb = (tb <= ta) ? pr[1][r] : 0.f, nk = (tb <= ta) ? pr[2][r] : 0.f;
                MK[ta * 24 + tb] = tobf(mk); NN[ta * 40 + slotc] = tobf(-nb); NN[ta * 40 + slotc + 4] = tobf(nk); }
        }
    } }
    __syncthreads();
    LAS float* YO = (LAS float*)(lds + RW_YO);
    LAS bf16* GT = (LAS bf16*)(lds + RW_GT);
    if (MODE == 1) { if (wave < 4) rwkv_recur<true>(W, true, 16 * wave + fr, lds, fr, fq); }
    else {
#pragma unroll
        for (int kt = 0; kt < 4; ++kt)
#pragma unroll
            for (int r = 0; r < 4; ++r) W[kt][r] = (wave < 4 && (16 * kt + 4 * fq + r) == (16 * wave + fr)) ? 1.f : 0.f;
        rwkv_recur<false>(W, wave >= 4, 16 * (wave & 3) + fr, lds, fr, fq);
        if (wave < 4) {
#pragma unroll
            for (int kt = 0; kt < 4; ++kt)
#pragma unroll
                for (int r = 0; r < 4; ++r) GT[(16 * kt + 4 * fq + r) * 72 + 16 * wave + fr] = tobf(W[kt][r]);
        } else if (MODE == 0) {
#pragma unroll
            for (int kt = 0; kt < 4; ++kt) *(f32x4*)(HS + (((size_t)su * 4 + (wave - 4)) * 4 + kt) * 256 + lane * 4) = W[kt]; }
    }
    __syncthreads();
    if (MODE == 2) {
        unsigned* FL = (unsigned*)ctlw + 16384;
        unsigned* tmo = (unsigned*)ctlw + CW_BAR + XB_TMO;
        const int vt = wave & 3;
#if CHAIN_RING
        typedef unsigned long long u64;
        u64* RING = (u64*)((unsigned char*)ctlw + (WS_RING - WS_CTL));
        LAS v2u* SX = (LAS v2u*)(lds + RW_SX);
        const int seq = su >> 7;
        bf16x8 gc[8]; v2u sb[4];
        if (wave >= 4) {
            if (c64 < 127) {
#pragma unroll
                for (int f = 0; f < 8; ++f) { const LAS bf16* gp = GT + (16 * (f >> 1) + fr) * 72 + 32 * (f & 1) + 4 * fq; gc[f] = frag2(*(const LAS v2u*)gp, *(const LAS v2u*)(gp + 16)); }
                LDS_WAIT(); }
            if (c64 > 0) {
                if (CHAIN_FLAG_HINT) chain_wait(FL + ((size_t)su * 4 + vt) * 4, tmo, lane);
                u64* rp = RING + (size_t)((seq * 4 + vt) * 2 + (c64 & 1)) * 512 + lane; const unsigned tag = (unsigned)c64;
                unsigned spins = 0;
                for (;;) { u64 q[8]; bool ok = true;
#pragma unroll
                    for (int j = 0; j < 8; ++j) q[j] = __hip_atomic_load(rp + j * 64, __ATOMIC_RELAXED, __HIP_MEMORY_SCOPE_AGENT);
#pragma unroll
                    for (int j = 0; j < 8; ++j) ok = ok && ((unsigned)(q[j] >> 32) == tag);
#pragma unroll
                    for (int kt = 0; kt < 4; ++kt) { sb[kt].x = (unsigned)q[2 * kt]; sb[kt].y = (unsigned)q[2 * kt + 1]; }
                    if (__builtin_amdgcn_ballot_w64(!ok) == 0ull) break;
                    if (!CHAIN_FLAG_HINT) __builtin_amdgcn_s_sleep(CHAIN_BACKOFF);
                    if ((++spins & 255u) == 0u) { if (spins > (1u << 17) || (unsigned)__builtin_amdgcn_readfirstlane(__hip_atomic_load(tmo, __ATOMIC_RELAXED, __HIP_MEMORY_SCOPE_AGENT)) != 0u) { if (lane == 0) __hip_atomic_store(tmo, 1u, __ATOMIC_RELAXED, __HIP_MEMORY_SCOPE_AGENT); break; } } }
            } else {
#pragma unroll
                for (int kt = 0; kt < 4; ++kt) sb[kt] = (v2u){0u, 0u}; }
#pragma unroll
            for (int kt = 0; kt < 4; ++kt) SX[(vt * 4 + kt) * 64 + lane] = sb[kt];
        }
        __syncthreads();
        if (wave >= 4) {
            if (c64 < 127) {
                const bf16x8 wh0 = frag2(sb[0], sb[1]), wh1 = frag2(sb[2], sb[3]);
                u64* wp = RING + (size_t)((seq * 4 + vt) * 2 + ((c64 + 1) & 1)) * 512 + lane; const u64 tg = (u64)(unsigned)(c64 + 1) << 32;
#pragma unroll
                for (int kt = 0; kt < 4; ++kt) { f32x4 a = W[kt]; a = mfma16(gc[2 * kt], wh0, a); a = mfma16(gc[2 * kt + 1], wh1, a);
                    __hip_atomic_store(wp + (2 * kt) * 64, tg | (u64)pk2(a[0], a[1]), __ATOMIC_RELAXED, __HIP_MEMORY_SCOPE_AGENT);
                    __hip_atomic_store(wp + (2 * kt + 1) * 64, tg | (u64)pk2(a[2], a[3]), __ATOMIC_RELAXED, __HIP_MEMORY_SCOPE_AGENT); }
#ifdef PROBE_LINK_SLEEP
                __builtin_amdgcn_s_sleep(PROBE_LINK_SLEEP);
#endif
                if (CHAIN_FLAG_HINT && lane == 0) __hip_atomic_store(FL + ((size_t)(su + 1) * 4 + vt) * 4, 1u, __ATOMIC_RELAXED, __HIP_MEMORY_SCOPE_AGENT);
            }
        } else {
#pragma unroll
            for (int kt = 0; kt < 4; ++kt) { const v2u s2 = SX[(wave * 4 + kt) * 64 + lane]; W[kt] = (f32x4){bflo(s2.x), bfhi(s2.x), bflo(s2.y), bfhi(s2.y)}; }
            rwkv_recur<true>(W, true, 16 * wave + fr, lds, fr, fq);
        }
        __syncthreads();
#else
        f32x4 Sc[4];
        bf16x8 gc[8];
        if (wave >= 4 && c64 < 127) {
#pragma unroll
            for (int f = 0; f < 8; ++f) { const LAS bf16* gp = GT + (16 * (f >> 1) + fr) * 72 + 32 * (f & 1) + 4 * fq; gc[f] = frag2(*(const LAS v2u*)gp, *(const LAS v2u*)(gp + 16)); }
            LDS_WAIT(); }
        if (c64 > 0) { chain_wait(FL + ((size_t)su * 4 + vt) * 4, tmo, lane);
            typedef GAS unsigned long long gu64; typedef unsigned long long u64x2 __attribute__((ext_vector_type(2)));
#pragma unroll
            for (int kt = 0; kt < 4; ++kt) { gu64* src = (gu64*)(HS + (((size_t)su * 4 + vt) * 4 + kt) * 256 + lane * 4); u64x2 q;
                if (CHAIN_PLAIN) Sc[kt] = *(const f32x4*)(HS + (((size_t)su * 4 + vt) * 4 + kt) * 256 + lane * 4); else { q[0] = __hip_atomic_load(src, __ATOMIC_RELAXED, __HIP_MEMORY_SCOPE_AGENT); q[1] = __hip_atomic_load(src + 1, __ATOMIC_RELAXED, __HIP_MEMORY_SCOPE_AGENT); Sc[kt] = __builtin_bit_cast(f32x4, q); } }
        } else {
#pragma unroll
            for (int kt = 0; kt < 4; ++kt) Sc[kt] = (f32x4){0.f, 0.f, 0.f, 0.f}; }
        if (wave >= 4) {
            if (c64 < 127) {
                f32x4 Sl[4];
#pragma unroll
                for (int kt = 0; kt < 4; ++kt)
#pragma unroll
                    for (int r = 0; r < 4; ++r) { const float hi = __builtin_bit_cast(float, f2bf(Sc[kt][r]) << 16); Sl[kt][r] = Sc[kt][r] - hi; }
                const bf16x8 wh0 = frag8(Sc[0], Sc[1]), wh1 = frag8(Sc[2], Sc[3]), wl0 = frag8(Sl[0], Sl[1]), wl1 = frag8(Sl[2], Sl[3]);
                typedef GAS unsigned long long gu64;
#pragma unroll
                for (int kt = 0; kt < 4; ++kt) { f32x4 a = W[kt]; a = mfma16(gc[2 * kt], wh0, a); a = mfma16(gc[2 * kt + 1], wh1, a); if (CHAIN_HILO) { a = mfma16(gc[2 * kt], wl0, a); a = mfma16(gc[2 * kt + 1], wl1, a); }
                    gu64* dst = (gu64*)(HS + (((size_t)(su + 1) * 4 + vt) * 4 + kt) * 256 + lane * 4);
                    typedef unsigned long long u64x2 __attribute__((ext_vector_type(2))); const u64x2 q = __builtin_bit_cast(u64x2, a);
                    if (CHAIN_PLAIN) *(f32x4*)(HS + (((size_t)(su + 1) * 4 + vt) * 4 + kt) * 256 + lane * 4) = a; else { __hip_atomic_store(dst, q[0], __ATOMIC_RELAXED, __HIP_MEMORY_SCOPE_AGENT); __hip_atomic_store(dst + 1, q[1], __ATOMIC_RELAXED, __HIP_MEMORY_SCOPE_AGENT); } }
                asm volatile("s_waitcnt vmcnt(0)" ::: "memory");
#ifdef PROBE_LINK_SLEEP
                __builtin_amdgcn_s_sleep(PROBE_LINK_SLEEP);
#endif
                if (lane == 0) __hip_atomic_store(FL + ((size_t)(su + 1) * 4 + vt) * 4, 1u, __ATOMIC_RELAXED, __HIP_MEMORY_SCOPE_AGENT);
            }
        } else {
#pragma unroll
            for (int kt = 0; kt < 4; ++kt) W[kt] = Sc[kt];
            rwkv_recur<true>(W, true, 16 * wave + fr, lds, fr, fq);
        }
        __syncthreads();

#endif
    }
    if (MODE == 0) {
        const int f = wave, kot = f >> 1, s = f & 1; const LAS bf16* gp = GT + (16 * kot + fr) * 72 + 32 * s + 4 * fq;
        const v2u lo = *(const LAS v2u*)gp, hi = *(const LAS v2u*)(gp + 16); v4u o; o.x = lo.x; o.y = lo.y; o.z = hi.x; o.w = hi.y;
        *(v4u*)(GF + ((size_t)su * 8 + f) * 512 + lane * 8) = o;
    } else if (MODE == 1) { rwkv_post(u, Y, lds, tid); }
    if (MODE != 2) __syncthreads();
}
constexpr int RS_SLOT = 12288;
__device__ __forceinline__ void rwkv_scan_issue(const bf16* GF, const float* HS, size_t unit, int vt, LAS unsigned char* slot, int lane) {
#pragma unroll
    for (int f = 0; f < 8; ++f) __builtin_amdgcn_global_load_lds((const unsigned*)(GF + (unit * 8 + f) * 512 + lane * 8), (LAS unsigned*)(slot + f * 1024), 16, 0, 0);
#pragma unroll
    for (int kt = 0; kt < 4; ++kt) __builtin_amdgcn_global_load_lds((const unsigned*)(HS + ((unit * 4 + vt) * 4 + kt) * 256 + lane * 4), (LAS unsigned*)(slot + 8192 + kt * 1024), 16, 0, 0);
}
__device__ __forceinline__ void rwkv_scan_phase(const bf16* GF, float* HS, LAS unsigned char* lds, int tid, int G) {
    if ((tid >> 6) != 0) return;
    const int lane = tid & 63;
    for (int job = blockIdx.x; job < 128; job += G) {
        const int bh = job >> 2, vt = job & 3; const size_t u0 = (size_t)bh * 128;
        f32x4 W[4];
#pragma unroll
        for (int kt = 0; kt < 4; ++kt) W[kt] = (f32x4){0.f, 0.f, 0.f, 0.f};
#pragma unroll
        for (int p = 0; p < 5; ++p) rwkv_scan_issue(GF, HS, u0 + p, vt, lds + p * RS_SLOT, lane);
        for (int c0 = 0; c0 < 128; c0 += 8) {
#pragma unroll
            for (int j = 0; j < 8; ++j) {
                const int c = c0 + j;
                asm volatile("s_waitcnt vmcnt(48)" ::: "memory");
                LAS unsigned char* slot = lds + j * RS_SLOT;
                bf16x8 gc[8]; f32x4 hc[4];
#pragma unroll
                for (int f = 0; f < 8; ++f) gc[f] = *(const LAS bf16x8*)(slot + f * 1024 + lane * 16);
#pragma unroll
                for (int kt = 0; kt < 4; ++kt) hc[kt] = *(const LAS f32x4*)(slot + 8192 + kt * 1024 + lane * 16);
                { const int cn = c + 5 < 128 ? c + 5 : 127;
                  rwkv_scan_issue(GF, HS, u0 + cn, vt, lds + ((j + 5) & 7) * RS_SLOT, lane); }
                if (c >= 122) asm volatile("s_waitcnt vmcnt(0)" ::: "memory");
                const size_t uu = u0 + c;
#pragma unroll
                for (int kt = 0; kt < 4; ++kt) *(f32x4*)(HS + ((uu * 4 + vt) * 4 + kt) * 256 + lane * 4) = W[kt];
                f32x4 Wl[4];
#pragma unroll
                for (int kt = 0; kt < 4; ++kt)
#pragma unroll
                    for (int r = 0; r < 4; ++r) { const float hi = __builtin_bit_cast(float, f2bf(W[kt][r]) << 16); Wl[kt][r] = W[kt][r] - hi; }
                const bf16x8 wh0 = frag8(W[0], W[1]), wh1 = frag8(W[2], W[3]), wl0 = frag8(Wl[0], Wl[1]), wl1 = frag8(Wl[2], Wl[3]);
#pragma unroll
                for (int kt = 0; kt < 4; ++kt) { f32x4 a = hc[kt]; a = mfma16(gc[2 * kt], wh0, a); a = mfma16(gc[2 * kt + 1], wh1, a); a = mfma16(gc[2 * kt], wl0, a); a = mfma16(gc[2 * kt + 1], wl1, a); W[kt] = a; }
            }
        }
        asm volatile("s_waitcnt vmcnt(0)" ::: "memory");
    }
}
struct Args { const float* in[33]; float* out; unsigned char* ws; int ph_lo, ph_hi; };
__global__ void __launch_bounds__(NWAVES * 64, 2) trunk_fwd(Args args) {
    extern __shared__ __attribute__((aligned(16))) unsigned char lds_raw[];
    LAS unsigned char* lds = (LAS unsigned char*)lds_raw;
    const int tid = threadIdx.x, G = gridDim.x;
    unsigned char* ws = args.ws;
    gu32* ctl = (gu32*)(ws + WS_CTL);
    for (int u = tid; u < (LDS_BYTES - LDSCTL_OFF) / 4; u += NWAVES * 64) ((LAS unsigned*)(lds + LDSCTL_OFF))[u] = 0u;
    __syncthreads();
    XcdBarrier bar; bar.bar = (unsigned*)(ctl + CW_BAR); bar.x = 0; bar.st = nullptr;
    if (!MK_PER_PHASE) bar = xcd_barrier_post((unsigned*)(ctl + CW_BAR), (volatile LAS unsigned*)(lds + LDSCTL_OFF + 32));
    const int lo = args.ph_lo, hi = args.ph_hi;
#ifdef SLEEP_US
    { const unsigned long long t0 = __builtin_amdgcn_s_memrealtime(); while (__builtin_amdgcn_s_memrealtime() - t0 < (unsigned long long)SLEEP_US * 100ull) __builtin_amdgcn_s_sleep(64); }
#endif
#ifndef RG
#define RG 0
#endif
#ifndef RATT
#define RATT 1
#endif
#ifndef RMLL
#define RMLL 1
#endif
#ifndef RMLO
#define RMLO 1
#endif
#ifndef RSSL
#define RSSL 1
#endif
#ifndef RSSO
#define RSSO 1
#endif
#ifndef RRWA
#define RRWA 1
#endif
#ifndef RRWB
#define RRWB 1
#endif
#ifndef RNORM
#define RNORM 1
#endif
#ifndef CH_REP
#define CH_REP 0
#endif
#ifndef CHAIN_ON
#define CHAIN_ON 1
#endif
#ifndef STAGGER
#define STAGGER 0
#endif
#ifndef NO_SSD
#define NO_SSD 0
#endif
#ifndef NO_RWKV
#define NO_RWKV 0
#endif
#ifndef FUSE_FINAL
#define FUSE_FINAL 1
#endif
#ifndef CONV_FIRST
#define CONV_FIRST 1
#endif
#ifndef PHMASK
#define PHMASK 0x7ffffu
#endif
#define IN(k) ((((PHMASK) >> (k)) & 1u) && lo <= (k) && (k) < hi)
#ifdef PROBE_PHASE
    unsigned long long tph_ = __builtin_amdgcn_s_memrealtime();
#define PROBE_AFTER(k) do { const unsigned long long t1_ = __builtin_amdgcn_s_memrealtime(); if ((k) == PROBE_PHASE) { const unsigned long long d_ = (t1_ - tph_) * PROBE_MULT; while (__builtin_amdgcn_s_memrealtime() - t1_ < d_) __builtin_amdgcn_s_sleep(16); } tph_ = __builtin_amdgcn_s_memrealtime(); } while (0)
#else
#define PROBE_AFTER(k) do {} while (0)
#endif
#define SEAM(k) do { if (IN(k) && IN((k) + 1)) xcd_barrier(bar); PROBE_AFTER(k); } while (0)
    const float* x = args.in[0]; float* hres = args.out; bf16* hb = (bf16*)args.out + (size_t)M * D;
    bf16* hb2 = (bf16*)(ws + WS_Y);
    bf16* hbx = (bf16*)(ws + WS_XN);
    const bool fuse_final = FUSE_FINAL && FUSE_MLPNORM && (G == 256) && !MK_PER_PHASE && lo <= 14 && hi >= 19;
    bf16* XN = (bf16*)(ws + WS_XN); bf16* P = (bf16*)(ws + WS_R1); bf16* HB = (bf16*)(ws + WS_R1); bf16* Y = (bf16*)(ws + WS_Y);
    float* G0 = (float*)(ws + WS_G0); float* DT = (float*)(ws + WS_DT);
    float* MLS = (float*)(ws + WS_MLS); float* MPREV = MLS + 4096; float* NL = MLS + 8192;
    float* CT = (float*)(ws + WS_XN); float* ST = (float*)(ws + WS_XN); float* DEC = (float*)(ws + WS_DEC);
    bf16* GF = (bf16*)(ws + WS_GF); float* HS = (float*)(ws + WS_HS); bf16* LX = (bf16*)(ws + WS_LX); float* SSP = (float*)(ws + WS_SSP); float* RS = (float*)(ws + WS_RS);
    const float2* rope = (const float2*)(ws + WS_ROPE); const bf16* lora = (const bf16*)(ws + WS_LORA);

#ifdef PROBE_PHASE
    if (PROBE_PHASE == 200) { xcd_barrier(bar); PROBE_AFTER(200); }
#endif
    if (IN(0)) { p0_prologue(args.in, ws, lds, tid, G); __syncthreads();
        for (int rep_ = 0; rep_ < RNORM; ++rep_) norm_x_gates_phase(x, args.in[1], XN, args.in[5] + 2304, 2312, G0, lds, tid, G); }
    SEAM(0);
    if (IN(1)) { pg8::Gemm g{XN, (const bf16*)(ws + WS_WINE), M, NE, D}; pg8::StaticOrder S; S.init(M, NE, G, (int)blockIdx.x); pg8::EpiBf16<0> E{P, NE};
        const int nfull = ((M / 256) * (NE / 256)) % G;
        if (DEFER_MLPW && CONV_FIRST && nfull != 0 && (int)blockIdx.x >= nfull) { mlp_weights_convert(args.in, ws, 0, lds, tid, nfull, G - nfull); __syncthreads(); }
        pg8::gemm_phase<pg8::EpiBf16<0>, pg8::StaticOrder, PG8_ALIGN, PG8_SP2>(lds, g, S, E);
        if (DEFER_MLPW) { if (nfull == 0) mlp_weights_convert(args.in, ws, 0, lds, tid, 0, G); else if (!CONV_FIRST && (int)blockIdx.x >= nfull) mlp_weights_convert(args.in, ws, 0, lds, tid, nfull, G - nfull); } }
    SEAM(1);
    if (IN(2)) { for (int rep_ = 0; rep_ < RATT; ++rep_) for (int u = blockIdx.x; u < 512; u += G) attn_unit(u, P, rope, args.in[7], Y, lds, tid);
        for (int rep_ = 0; rep_ < RMLL; ++rep_) for (int u = blockIdx.x; u < 1024; u += G) mlstm_local_unit(u, P, G0, args.in[8], args.in[9], args.in[10], args.in[11], CT, NL, MLS, lds, tid); }
    SEAM(2);
    if (IN(3)) mlstm_scan_phase(CT, NL, MLS, MPREV, lds, tid, G);
    SEAM(3);
    if (IN(4)) { for (int rep_ = 0; rep_ < RMLO; ++rep_) for (int u = blockIdx.x; u < 1024; u += G) mlstm_out_unit(u, P, G0, args.in[8], args.in[9], args.in[10], args.in[11], args.in[12], CT, NL, MPREV, Y, lds, tid); }
    SEAM(4);
    if (IN(5)) { pg8::Gemm g{Y, (const bf16*)(ws + WS_WOUTE), M, D, D}; pg8::StaticOrder S; S.init(M, D, G, (int)blockIdx.x);
        if (FUSE_MLPNORM) { pg8::EpiBf16ResSS<true> E{x, hb, D, SSP}; pg8::gemm_phase<pg8::EpiBf16ResSS<true>, pg8::StaticOrder, PG8_ALIGN, PG8_SP2>(lds, g, S, E); }
        else { pg8::EpiBf16Res<true> E{x, hb, D}; pg8::gemm_phase<pg8::EpiBf16Res<true>, pg8::StaticOrder, PG8_ALIGN, PG8_SP2>(lds, g, S, E); } }
    SEAM(5);
    if (!FUSE_MLPNORM) { if (IN(6)) for (int rep_ = 0; rep_ < RNORM; ++rep_) norm_phase_b<0>(hb, args.in[2], XN, nullptr, nullptr, 0, nullptr, lds, tid, G);
    SEAM(6); }
    if (IN(7)) { if (STAGGER) { const unsigned long long t0 = __builtin_amdgcn_s_memrealtime(); const unsigned long long dl = (unsigned long long)((blockIdx.x >> 3) & 7) * STAGGER; while (__builtin_amdgcn_s_memrealtime() - t0 < dl) __builtin_amdgcn_s_sleep(8); }
        pg8::Gemm g{FUSE_MLPNORM ? hb : XN, (const bf16*)(ws + WS_WUP0), M, FF, D}; pg8::StaticOrder S; S.init(M, FF, G, (int)blockIdx.x); pg8::EpiBf16<2> E{HB, FF};
        pg8::gemm_phase<pg8::EpiBf16<2>, pg8::StaticOrder, PG8_ALIGN, PG8_SP2>(lds, g, S, E);
        if (RG & 2) pg8::gemm_phase<pg8::EpiBf16<2>, pg8::StaticOrder, PG8_ALIGN, PG8_SP2>(lds, g, S, E); }
    SEAM(7);
    if (IN(8)) { pg8::Gemm g{HB, (const bf16*)(ws + WS_WDN0), M, D, FF}; pg8::StaticOrderRev S; S.init(M, D, G, (int)blockIdx.x);
        if (FUSE_MLPNORM) { pg8::EpiBf16ResScale E{hb, hb, D, SSP, 1e-5f}; pg8::gemm_phase<pg8::EpiBf16ResScale, pg8::StaticOrderRev, PG8_ALIGN, PG8_SP2>(lds, g, S, E); }
        else { pg8::EpiBf16Res<false> E{hb, hb, D}; pg8::gemm_phase<pg8::EpiBf16Res<false>, pg8::StaticOrderRev, PG8_ALIGN, PG8_SP2>(lds, g, S, E); } }
    SEAM(8);
#ifdef EXTRA_BARS
    if (IN(8) && IN(9)) for (int eb = 0; eb < EXTRA_BARS; ++eb) xcd_barrier(bar);
#endif
    if (IN(9)) for (int rep_ = 0; rep_ < RNORM; ++rep_) { if (FUSE_N9) norm_rs_dt_phase(hb, args.in[1] + D, RS, (const float*)(ws + WS_GWT), 0, DT, lds, tid, G); else norm_phase_b<1>(hb, args.in[1] + D, XN, nullptr, args.in[13] + 1536, 3336, DT, lds, tid, G); }
    SEAM(9);
    if (IN(10)) { pg8::Gemm g{FUSE_N9 ? hb : XN, (const bf16*)(ws + WS_WINO), M, NO, D}; pg8::StaticOrder S; S.init(M, NO, G, (int)blockIdx.x);
        const int nfull = ((M / 256) * (NO / 256)) % G;
        if (DEFER_MLPW && CONV_FIRST && nfull != 0 && (int)blockIdx.x >= nfull) { mlp_weights_convert(args.in, ws, 1, lds, tid, nfull, G - nfull); __syncthreads(); }
        if (FUSE_N9) { pg8::EpiBf16RS E{P, NO, RS}; pg8::gemm_phase<pg8::EpiBf16RS, pg8::StaticOrder, PG8_ALIGN, PG8_SP2>(lds, g, S, E); }
        else { pg8::EpiBf16<0> E{P, NO}; pg8::gemm_phase<pg8::EpiBf16<0>, pg8::StaticOrder, PG8_ALIGN, PG8_SP2>(lds, g, S, E); }
        if (DEFER_MLPW) { if (nfull == 0) mlp_weights_convert(args.in, ws, 1, lds, tid, 0, G); else if (!CONV_FIRST && (int)blockIdx.x >= nfull) mlp_weights_convert(args.in, ws, 1, lds, tid, nfull, G - nfull); } }
    SEAM(10);
    int cur_h = -1;
    if (IN(11)) { rwkv_lx_phase(P, args.in[21], LX, tid, G);
#ifdef PROBE_PHASE
        if (PROBE_PHASE == 111) PROBE_AFTER(111);
#endif
        if (!NO_SSD) for (int rep_ = 0; rep_ < RSSL; ++rep_) for (int u = blockIdx.x; u < 512; u += G) ssd_local_unit(u, P, DT, args.in[15], args.in[16], args.in[17], args.in[18], ST, DEC, lds, tid); }
    if (IN(11) && IN(12)) xcd_barrier(bar);
    PROBE_AFTER(110);
    const bool chain = (G == 256) && !MK_PER_PHASE && CHAIN_ON;
    if (IN(11)) {
        if (chain) { const int xq = blockIdx.x & 7, mq = blockIdx.x >> 3;
            if (mq < 24) { const int sq = xq * 4 + mq / 6, jj = mq % 6; v4u rraw[5]; float rmm[8], rkk[8]; rwkv_consts_load(sq & 7, args.in, tid, rmm, rkk);
                const int ubase = ((sq >> 3) << 10) | (sq & 7); rwkv_rows_load(ubase | (jj << 3), P, tid, rraw); bf16x8 lxa[8]; rwkv_lx_load(ubase | (jj << 3), LX, tid, lxa);
                int c = jj; for (; c < 128; c += 6) { const int u = ubase | (c << 3); rwkv_chunk_unit<2>(u, (c + 6 < 128) ? (ubase | ((c + 6) << 3)) : -1, (c >= 6) ? (ubase | ((c - 6) << 3)) : -1, cur_h, rraw, lxa, rmm, rkk, P, LX, args.in, lora, GF, HS, Y, ctl, lds, tid); }
                rwkv_post(ubase | ((c - 6) << 3), Y, lds, tid); __syncthreads(); }
            else { const int pr = xq, k8 = mq - 24;
                ssd_scan_pair(ST, DEC, pr, k8, tid);
                asm volatile("s_waitcnt vmcnt(0)" ::: "memory"); __syncthreads();
                if (tid == 0) { unsigned* cnt = (unsigned*)ctl + 90112 + pr * 64; unsigned* tmo = (unsigned*)ctl + CW_BAR + XB_TMO;
                    __builtin_amdgcn_fence(__ATOMIC_RELEASE, "agent"); asm volatile("s_waitcnt vmcnt(0)" ::: "memory");
                    __hip_atomic_fetch_add(cnt, 1u, __ATOMIC_RELAXED, __HIP_MEMORY_SCOPE_AGENT);
                    unsigned spins = 0;
                    while (__hip_atomic_load(cnt, __ATOMIC_RELAXED, __HIP_MEMORY_SCOPE_AGENT) < 8u) { __builtin_amdgcn_s_sleep(4);
                        if ((++spins & 1023u) == 0u) { if (spins > (1u << 19) || __hip_atomic_load(tmo, __ATOMIC_RELAXED, __HIP_MEMORY_SCOPE_AGENT) != 0u) { __hip_atomic_store(tmo, 1u, __ATOMIC_RELAXED, __HIP_MEMORY_SCOPE_AGENT); break; } } }
                    __builtin_amdgcn_fence(__ATOMIC_ACQUIRE, "agent"); asm volatile("s_waitcnt vmcnt(0)" ::: "memory"); }
                __syncthreads();
                for (int c = k8; c < 64; c += 8) ssd_out_unit(pr * 64 + c, P, DT, args.in[15], args.in[16], args.in[17], args.in[18], args.in[19], args.in[20], ST, Y, lds, tid); } }
        else { ssd_scan_phase(ST, DEC, tid, G);
            if (!NO_RWKV) for (int rep_ = 0; rep_ < RRWA; ++rep_) { v4u rraw[5]; float rmm[8], rkk[8]; rwkv_consts_load(blockIdx.x & 7, args.in, tid, rmm, rkk); bf16x8 lxa[8]; if ((int)blockIdx.x < 4096) { rwkv_rows_load(blockIdx.x, P, tid, rraw); rwkv_lx_load(blockIdx.x, LX, tid, lxa); }
                for (int u = blockIdx.x; u < 4096; u += G) { if ((G & 7) != 0) rwkv_consts_load(u & 7, args.in, tid, rmm, rkk); rwkv_chunk_unit<0>(u, (u + G < 4096) ? u + G : -1, -1, cur_h, rraw, lxa, rmm, rkk, P, LX, args.in, lora, GF, HS, Y, ctl, lds, tid); } } } }
    if (!chain) { SEAM(11); }
    if (IN(12) && !chain) { const int nscan = (G >= 256) ? 128 : 0;
        if ((int)blockIdx.x < nscan || nscan == 0) { rwkv_scan_phase(GF, HS, lds, tid, nscan ? nscan : G); __syncthreads(); }
        if (!NO_SSD) for (int rep_ = 0; rep_ < RSSO; ++rep_) {
            if (nscan <= 0) { for (int u = blockIdx.x; u < 512; u += G) ssd_out_unit(u, P, DT, args.in[15], args.in[16], args.in[17], args.in[18], args.in[19], args.in[20], ST, Y, lds, tid); }
            else if ((int)blockIdx.x >= nscan) { for (int u = blockIdx.x - nscan; u < 384; u += G - nscan) ssd_out_unit(u, P, DT, args.in[15], args.in[16], args.in[17], args.in[18], args.in[19], args.in[20], ST, Y, lds, tid); }
            else { for (int u = 384 + blockIdx.x; u < 512; u += nscan) ssd_out_unit(u, P, DT, args.in[15], args.in[16], args.in[17], args.in[18], args.in[19], args.in[20], ST, Y, lds, tid); } } }
    if (!chain) { SEAM(12); }
    cur_h = -1;
    if (IN(13) && !chain) { if (!NO_RWKV) for (int rep_ = 0; rep_ < RRWB; ++rep_) { v4u rraw[5]; float rmm[8], rkk[8]; rwkv_consts_load(blockIdx.x & 7, args.in, tid, rmm, rkk); bf16x8 lxa[8]; if ((int)blockIdx.x < 4096) { rwkv_rows_load(blockIdx.x, P, tid, rraw); rwkv_lx_load(blockIdx.x, LX, tid, lxa); }
            for (int u = blockIdx.x; u < 4096; u += G) { if ((G & 7) != 0) rwkv_consts_load(u & 7, args.in, tid, rmm, rkk); rwkv_chunk_unit<1>(u, (u + G < 4096) ? u + G : -1, -1, cur_h, rraw, lxa, rmm, rkk, P, LX, args.in, lora, GF, HS, Y, ctl, lds, tid); } } }
    SEAM(13);
    if (IN(14)) { pg8::Gemm g{Y, (const bf16*)(ws + WS_WOUTO), M, D, D}; pg8::StaticOrder S; S.init(M, D, G, (int)blockIdx.x);
        if (FUSE_MLPNORM) { pg8::EpiBf16ResSS<false> E{hb, fuse_final ? hbx : hb, D, SSP}; pg8::gemm_phase<pg8::EpiBf16ResSS<false>, pg8::StaticOrder, PG8_ALIGN, PG8_SP2>(lds, g, S, E); }
        else { pg8::EpiBf16Res<false> E{hb, hb, D}; pg8::gemm_phase<pg8::EpiBf16Res<false>, pg8::StaticOrder, PG8_ALIGN, PG8_SP2>(lds, g, S, E); } }
    SEAM(14);
    if (!FUSE_MLPNORM) { if (IN(15)) for (int rep_ = 0; rep_ < RNORM; ++rep_) norm_phase_b<0>(hb, args.in[2] + D, XN, nullptr, nullptr, 0, nullptr, lds, tid, G);
    SEAM(15); }
    if (IN(16)) { if (STAGGER) { const unsigned long long t0 = __builtin_amdgcn_s_memrealtime(); const unsigned long long dl = (unsigned long long)((blockIdx.x >> 3) & 7) * STAGGER; while (__builtin_amdgcn_s_memrealtime() - t0 < dl) __builtin_amdgcn_s_sleep(8); }
        pg8::Gemm g{FUSE_MLPNORM ? (fuse_final ? hbx : hb) : XN, (const bf16*)(ws + WS_WUP1), M, FF, D}; pg8::StaticOrder S; S.init(M, FF, G, (int)blockIdx.x); pg8::EpiBf16<2> E{HB, FF};
        pg8::gemm_phase<pg8::EpiBf16<2>, pg8::StaticOrder, PG8_ALIGN, PG8_SP2>(lds, g, S, E); }
    SEAM(16);
    if (IN(17)) { pg8::Gemm g{HB, (const bf16*)(ws + WS_WDN1), M, D, FF}; pg8::StaticOrderRev S; S.init(M, D, G, (int)blockIdx.x);
        if (fuse_final) { pg8::EpiFinalNorm E{hbx, hres, D, SSP, 1e-5f, args.in[32], (unsigned*)(ws + WS_XS), (unsigned*)ctl + CW_BAR + XB_TMO, (PG8_LAS float*)(lds + pg8::STAGE_BYTES)};
            pg8::gemm_phase<pg8::EpiFinalNorm, pg8::StaticOrderRev, PG8_ALIGN, PG8_SP2>(lds, g, S, E); }
        else if (FUSE_MLPNORM) { pg8::EpiBf16ResScale E{hb, hb2, D, SSP, 1e-5f}; pg8::gemm_phase<pg8::EpiBf16ResScale, pg8::StaticOrderRev, PG8_ALIGN, PG8_SP2>(lds, g, S, E); }
        else { pg8::EpiBf16Res<false> E{hb, hb2, D}; pg8::gemm_phase<pg8::EpiBf16Res<false>, pg8::StaticOrderRev, PG8_ALIGN, PG8_SP2>(lds, g, S, E); } }
    if (!fuse_final) { SEAM(17);
    if (IN(18)) norm_phase_b<2>(hb2, args.in[32], nullptr, hres, nullptr, 0, nullptr, lds, tid, G); }
#undef IN
#undef SEAM
}
extern "C" void kernel_launch(void* const* d_in, const int* in_sizes, int n_in, void* d_out, int out_size, void* d_ws, size_t ws_size, hipStream_t stream) {
    static int grid = 0;
    if (grid == 0) {
        if (n_in != 33 || in_sizes[0] != M * D || out_size != M * D || ws_size < WS_END) { fprintf(stderr, "kernel_launch: unexpected shapes (n_in %d, in0 %d, out %d, ws %zu < %zu); nothing launched\n", n_in, n_in > 0 ? in_sizes[0] : -1, out_size, ws_size, (size_t)WS_END); grid = -1; return; }
        int dev = 0, cus = 0, per_cu = 0;
        if (hipGetDevice(&dev) != hipSuccess || hipDeviceGetAttribute(&cus, hipDeviceAttributeMultiprocessorCount, dev) != hipSuccess) { grid = -1; return; }
        if (hipFuncSetAttribute((const void*)trunk_fwd, hipFuncAttributeMaxDynamicSharedMemorySize, LDS_BYTES) != hipSuccess) { fprintf(stderr, "kernel_launch: hipFuncSetAttribute failed\n"); grid = -1; return; }
        if (hipOccupancyMaxActiveBlocksPerMultiprocessor(&per_cu, (const void*)trunk_fwd, NWAVES * 64, LDS_BYTES) != hipSuccess || per_cu < 1) { fprintf(stderr, "kernel_launch: occupancy query reports %d workgroups per CU\n", per_cu); }
        (void)hipGetLastError();
        grid = cus;
    }
    if (grid < 0) return;
    if (hipMemsetAsync((char*)d_ws + WS_CTL, 0, CTL_ZERO_BYTES, stream) != hipSuccess) return;
    Args a{};
    for (int i = 0; i < 33; ++i) a.in[i] = (const float*)d_in[i];
    a.out = (float*)d_out; a.ws = (unsigned char*)d_ws;
#if MK_PER_PHASE
    for (int p = 0; p < N_PHASES; ++p) { a.ph_lo = p; a.ph_hi = p + 1; hipLaunchKernelGGL(trunk_fwd, dim3(grid), dim3(NWAVES * 64), LDS_BYTES, stream, a); }
#else
    a.ph_lo = 0; a.ph_hi = N_PHASES; hipLaunchKernelGGL(trunk_fwd, dim3(grid), dim3(NWAVES * 64), LDS_BYTES, stream, a);
#endif
}
```
